# Optimizing an MI355X kernel written in HIP

```python
import math
import jax, jax.numpy as jnp
from jax import lax
import numpy as np

D_MODEL = 1024
BATCH = 2
SEQ = 16384
DEPTH = 2

GRID_W = 64
CTX_LEN = 256
EPS = 1e-6
N_HEADS = 8
N_KV_HEADS = 2
GQA_GROUP = N_HEADS // N_KV_HEADS
HEAD_DIM = 64
AXIS_DIM = HEAD_DIM // 2
ATT_W = N_HEADS * HEAD_DIM
KV_W = N_KV_HEADS * HEAD_DIM
ATT_SCALE = HEAD_DIM ** -0.5
ROPE_THETA = 10000.0
Q_BLOCK = 128
SC_W = 512
CONV_K = 3
HY_W = 512
HY_ORDER = 2
HY_BANDS = 16
HY_EMB = 1 + 2 * HY_BANDS
HY_FH = 64
HY_FAST_DECAY = 0.3
HY_SLOW_DECAY = 1.5
HY_DECAY_TARGET = 1e-2
PEER_HEADS = 8
PEER_NKEYS = 128
PEER_N = PEER_NKEYS * PEER_NKEYS
PEER_DK = 128
PEER_TOPK = 16
PEER_CHUNK = 128
Q0 = 0
K0 = Q0 + ATT_W
V0 = K0 + KV_W
SC0 = V0 + KV_W
HY0 = SC0 + 3 * SC_W
GT0 = HY0 + (HY_ORDER + 1) * HY_W
IN_W = GT0 + 3 * D_MODEL

kernel_name = 'hybrid_attn_conv_hyena_peer_dit'


def _rmsnorm(x, g):
    xf = x.astype(jnp.float32)
    y = xf * lax.rsqrt(jnp.mean(xf * xf, axis=-1, keepdims=True) + EPS)
    return (y * g.astype(jnp.float32)).astype(x.dtype)


def _dwconv3(u, w):
    up = jnp.pad(u, ((0, 0), (1, 1), (0, 0)))
    return up[:, :-2] * w[0] + up[:, 1:-1] * w[1] + up[:, 2:] * w[2]


def _axial_rope(x):
    L = x.shape[1]
    pos = jnp.arange(L, dtype=jnp.int32)
    row = (pos // GRID_W).astype(jnp.float32)
    col = (pos % GRID_W).astype(jnp.float32)
    inv = jnp.power(ROPE_THETA, -jnp.arange(0, AXIS_DIM, 2, dtype=jnp.float32) / AXIS_DIM)

    def rot(xa, p):
        ang = p[:, None] * inv[None, :]
        cos = jnp.cos(ang)[None, :, None, :]
        sin = jnp.sin(ang)[None, :, None, :]
        x1, x2 = jnp.split(xa.astype(jnp.float32), 2, axis=-1)
        return jnp.concatenate([x1 * cos - x2 * sin, x2 * cos + x1 * sin], axis=-1)

    xr, xc = jnp.split(x, 2, axis=-1)
    return jnp.concatenate([rot(xr, row), rot(xc, col)], axis=-1).astype(x.dtype)


def _attend(q, k, v):
    s = jnp.einsum('bqhgd,bkhd->bhgqk', q, k, preferred_element_type=jnp.float32) * ATT_SCALE
    p = jax.nn.softmax(s, axis=-1).astype(v.dtype)
    return jnp.einsum('bhgqk,bkhd->bqhgd', p, v)


def _latent_attention(q, k_all, v_all):
    B, S = q.shape[:2]
    nb = S // Q_BLOCK
    qb = q.reshape(B, nb, Q_BLOCK, N_KV_HEADS, GQA_GROUP, HEAD_DIM).transpose(1, 0, 2, 3, 4, 5)
    ob = lax.map(lambda qi: _attend(qi, k_all, v_all), qb)
    return ob.transpose(1, 0, 2, 3, 4, 5).reshape(B, S, ATT_W)


def _short_conv(p, w):
    bg, cg, xs = jnp.split(p, 3, axis=-1)
    return bg * _dwconv3(cg * xs, w)


def _hyena_filter_fft(L, w1, b1, f1, w2, b2, f2, w3, decay):
    t = jnp.linspace(0.0, 1.0, L, dtype=jnp.float32)[:, None]
    w = 2.0 * math.pi * jnp.arange(L, dtype=jnp.float32)[:, None] / L
    bands = jnp.linspace(1e-4, HY_BANDS - 1, HY_BANDS, dtype=jnp.float32)[None, :]
    z = jnp.concatenate([t, jnp.cos(bands * w), -jnp.sin(bands * w)], axis=-1)
    h = jnp.sin(f1.astype(jnp.float32) * (z @ w1.astype(jnp.float32) + b1.astype(jnp.float32)))
    h = jnp.sin(f2.astype(jnp.float32) * (h @ w2.astype(jnp.float32) + b2.astype(jnp.float32)))
    h = (h @ w3.astype(jnp.float32)).reshape(L, HY_ORDER, 2, HY_W)
    window = jnp.exp(-t[:, :, None] * jnp.abs(decay.astype(jnp.float32)))
    h = h * window[:, :, None, :]
    h = h / jnp.sum(jnp.abs(h), axis=(0, 2), keepdims=True)
    hf, hb = h[:, :, 0], h[:, :, 1]
    k = jnp.concatenate([hf, jnp.zeros_like(hf[:1]), hb[:0:-1]], axis=0)
    return jnp.fft.rfft(k, axis=0)


def _long_conv(u, kf, bias):
    L = u.shape[1]
    uf = u.astype(jnp.float32)
    y = jnp.fft.irfft(jnp.fft.rfft(uf, n=2 * L, axis=1) * kf[None], n=2 * L, axis=1)[:, :L]
    return (y + uf * bias.astype(jnp.float32)).astype(u.dtype)


def _hyena(p, conv_w, conv_b, kf, bias):
    u = _dwconv3(p, conv_w) + conv_b
    v, x1, x2 = jnp.split(u, HY_ORDER + 1, axis=-1)
    z = v
    for o, gate in enumerate((x1, x2)):
        z = gate * _long_conv(z, kf[:, o], bias[o])
    return z


def _merge(gate_pre, y_att, y_sc, y_hy, w_att, w_sc, w_hy, w_o):
    g_att, g_sc, g_hy = jnp.split(jax.nn.sigmoid(gate_pre), 3, axis=-1)
    m = g_att * (y_att @ w_att) + g_sc * (y_sc @ w_sc) + g_hy * (y_hy @ w_hy)
    return m @ w_o


def _peer(tok, wq, subkeys, u_tab, v_tab):
    T, D = tok.shape

    def chunk(hc):
        q = (hc @ wq).reshape(PEER_CHUNK, PEER_HEADS, 2, PEER_DK // 2)
        s = jnp.einsum('chpd,hpnd->chpn', q, subkeys, preferred_element_type=jnp.float32)
        s1, i1 = lax.top_k(s[:, :, 0], PEER_TOPK)
        s2, i2 = lax.top_k(s[:, :, 1], PEER_TOPK)
        cand = (s1[..., :, None] + s2[..., None, :]).reshape(PEER_CHUNK, PEER_HEADS, PEER_TOPK * PEER_TOPK)
        sc, ic = lax.top_k(cand, PEER_TOPK)
        e = (jnp.take_along_axis(i1, ic // PEER_TOPK, axis=-1) * PEER_NKEYS
             + jnp.take_along_axis(i2, ic % PEER_TOPK, axis=-1))
        g = jax.nn.softmax(sc, axis=-1)
        a = jax.nn.gelu(jnp.einsum('chkd,cd->chk', u_tab[e], hc, preferred_element_type=jnp.float32),
                        approximate=False)
        return jnp.einsum('chk,chkd->cd', (g * a).astype(v_tab.dtype), v_tab[e])

    out = lax.map(chunk, tok.reshape(T // PEER_CHUNK, PEER_CHUNK, D))
    return out.reshape(T, D)


def setup_inputs(seed: int = 0) -> dict:
    key = jax.random.key(seed)
    ks = list(jax.random.split(key, 40))
    cnt = [0]

    def nrm(shape, scale):
        k = ks[cnt[0]]
        cnt[0] += 1
        return jax.random.normal(k, shape, jnp.float32) * scale

    L = DEPTH
    D = D_MODEL
    dec = jnp.linspace(math.log(HY_DECAY_TARGET) / HY_SLOW_DECAY, math.log(HY_DECAY_TARGET) / HY_FAST_DECAY,
                       HY_W, dtype=jnp.float32)
    return {
        'x': nrm((BATCH, SEQ, D), 1.0),
        'c': nrm((BATCH, D), 1.0),
        'ctx': nrm((BATCH, CTX_LEN, D), 1.0),
        'c_ctx': nrm((D,), 1.0),
        'w_mod': nrm((L, D, 6 * D), D ** -0.5),
        'b_mod': nrm((L, 6 * D), 0.02),
        'g_norm1': 1.0 + nrm((L, D), 0.02),
        'g_norm2': 1.0 + nrm((L, D), 0.02),
        'w_in': nrm((L, D, IN_W), D ** -0.5),
        'q_gain': 1.0 + nrm((L, HEAD_DIM), 0.02),
        'k_gain': 1.0 + nrm((L, HEAD_DIM), 0.02),
        'sc_conv_w': nrm((L, CONV_K, SC_W), CONV_K ** -0.5),
        'hy_conv_w': nrm((L, CONV_K, (HY_ORDER + 1) * HY_W), CONV_K ** -0.5),
        'hy_conv_b': nrm((L, (HY_ORDER + 1) * HY_W), 0.02),
        'hy_w1': nrm((L, HY_EMB, HY_FH), HY_EMB ** -0.5),
        'hy_b1': nrm((L, HY_FH), 0.02),
        'hy_f1': 1.0 + nrm((L, HY_FH), 0.02),
        'hy_w2': nrm((L, HY_FH, HY_FH), HY_FH ** -0.5),
        'hy_b2': nrm((L, HY_FH), 0.02),
        'hy_f2': 1.0 + nrm((L, HY_FH), 0.02),
        'hy_w3': nrm((L, HY_FH, HY_ORDER * 2 * HY_W), HY_FH ** -0.5),
        'hy_decay': dec[None, None, :] + nrm((L, HY_ORDER, HY_W), 0.1),
        'hy_bias': nrm((L, HY_ORDER, HY_W), 1.0),
        'w_br_att': nrm((L, ATT_W, D), ATT_W ** -0.5),
        'w_br_sc': nrm((L, SC_W, D), SC_W ** -0.5),
        'w_br_hy': nrm((L, HY_W, D), HY_W ** -0.5),
        'w_out': nrm((L, D, D), D ** -0.5),
        'peer_wq': nrm((L, D, PEER_HEADS * PEER_DK), D ** -0.5),
        'peer_subkeys': nrm((L, PEER_HEADS, 2, PEER_NKEYS, PEER_DK // 2), (PEER_DK // 2) ** -0.5),
        'peer_u': nrm((L, PEER_N, D), D ** -0.5),
        'peer_v': nrm((L, PEER_N, D), PEER_HEADS ** -0.5),
        'g_final': 1.0 + nrm((D,), 0.02),
    }


def reference(x, c, ctx, c_ctx, w_mod, b_mod, g_norm1, g_norm2, w_in, q_gain, k_gain, sc_conv_w,
              hy_conv_w, hy_conv_b, hy_w1, hy_b1, hy_f1, hy_w2, hy_b2, hy_f2, hy_w3, hy_decay, hy_bias,
              w_br_att, w_br_sc, w_br_hy, w_out, peer_wq, peer_subkeys, peer_u, peer_v, g_final):
    B, S, D = x.shape
    Lc = ctx.shape[1]
    cond_lat = jax.nn.silu(c)
    cond_ctx = jax.nn.silu(c_ctx)
    for l in range(DEPTH):
        need_ctx = l < DEPTH - 1
        mod_lat = (cond_lat @ w_mod[l] + b_mod[l])[:, None, :]
        mod_ctx = cond_ctx @ w_mod[l] + b_mod[l]
        sh1, sc1, gt1, sh2, sc2, gt2 = jnp.split(mod_lat, 6, axis=-1)
        csh1, csc1, cgt1, csh2, csc2, cgt2 = jnp.split(mod_ctx, 6, axis=-1)
        hy_params = (hy_w1[l], hy_b1[l], hy_f1[l], hy_w2[l], hy_b2[l], hy_f2[l], hy_w3[l], hy_decay[l])

        h = _rmsnorm(x, g_norm1[l]) * (1.0 + sc1) + sh1
        hc = _rmsnorm(ctx, g_norm1[l]) * (1.0 + csc1) + csh1
        p = h @ w_in[l]
        q = _axial_rope(_rmsnorm(p[..., Q0:K0].reshape(B, S, N_HEADS, HEAD_DIM), q_gain[l]))
        k = _axial_rope(_rmsnorm(p[..., K0:V0].reshape(B, S, N_KV_HEADS, HEAD_DIM), k_gain[l]))
        v = p[..., V0:SC0].reshape(B, S, N_KV_HEADS, HEAD_DIM)
        if need_ctx:
            pc = hc @ w_in[l]
            kvc = pc[..., K0:SC0]
        else:
            kvc = hc @ w_in[l][:, K0:SC0]
        kc = _rmsnorm(kvc[..., :KV_W].reshape(B, Lc, N_KV_HEADS, HEAD_DIM), k_gain[l])
        vc = kvc[..., KV_W:].reshape(B, Lc, N_KV_HEADS, HEAD_DIM)
        k_all = jnp.concatenate([kc, k], axis=1)
        v_all = jnp.concatenate([vc, v], axis=1)

        y_att = _latent_attention(q, k_all, v_all)
        y_sc = _short_conv(p[..., SC0:HY0], sc_conv_w[l])
        y_hy = _hyena(p[..., HY0:GT0], hy_conv_w[l], hy_conv_b[l], _hyena_filter_fft(S, *hy_params), hy_bias[l])
        x = x + gt1 * _merge(p[..., GT0:], y_att, y_sc, y_hy, w_br_att[l], w_br_sc[l], w_br_hy[l], w_out[l])

        if need_ctx:
            qc = _rmsnorm(pc[..., Q0:K0].reshape(B, Lc, N_HEADS, HEAD_DIM), q_gain[l])
            yc_att = _attend(qc.reshape(B, Lc, N_KV_HEADS, GQA_GROUP, HEAD_DIM), kc, vc).reshape(B, Lc, ATT_W)
            yc_sc = _short_conv(pc[..., SC0:HY0], sc_conv_w[l])
            yc_hy = _hyena(pc[..., HY0:GT0], hy_conv_w[l], hy_conv_b[l], _hyena_filter_fft(Lc, *hy_params),
                           hy_bias[l])
            ctx = ctx + cgt1 * _merge(pc[..., GT0:], yc_att, yc_sc, yc_hy, w_br_att[l], w_br_sc[l], w_br_hy[l],
                                      w_out[l])

        h2 = _rmsnorm(x, g_norm2[l]) * (1.0 + sc2) + sh2
        if need_ctx:
            h2c = _rmsnorm(ctx, g_norm2[l]) * (1.0 + csc2) + csh2
            tok = jnp.concatenate([h2.reshape(B * S, D), h2c.reshape(B * Lc, D)], axis=0)
            f = _peer(tok, peer_wq[l], peer_subkeys[l], peer_u[l], peer_v[l])
            x = x + gt2 * f[:B * S].reshape(B, S, D)
            ctx = ctx + cgt2 * f[B * S:].reshape(B, Lc, D)
        else:
            f = _peer(h2.reshape(B * S, D), peer_wq[l], peer_subkeys[l], peer_u[l], peer_v[l])
            x = x + gt2 * f.reshape(B, S, D)
    return _rmsnorm(x, g_final)
```

```cpp
#include <hip/hip_runtime.h>
#include <hip/hip_bf16.h>
#include <cstdio>
#include <cstdint>
#include <cmath>

#define SELFCHECK_ON 0
#if SELFCHECK_ON
#define SELFCHECK
#endif
#define REP_ROUTE 1
#define REP_GATHER 1
#define REP_HY 1
#define PROBE_FFT 0
#define REP_FILT 1
#define PROBE_REST 0
#define PROBE_PRO 0
#define PROBE_ATT 0
#ifndef FP6_ILV
#define FP6_ILV 1
#endif
#define REP_P2 1
#define REP_GM 1
#define REP_SG 1
#ifndef ABL
#define ABL 0
#endif
constexpr int D_MODEL = 1024, BATCH = 2, SEQ = 16384, DEPTH = 2, GRID_W = 64, CTX_LEN = 256;
constexpr int N_HEADS = 8, N_KV = 2, HEAD_DIM = 64, ATT_W = 512, KV_W = 128;
constexpr int SC_W = 512, HY_W = 512, HY_EMB = 33, HY_FH = 64;
constexpr int PEER_HEADS = 8, PEER_NKEYS = 128, PEER_N = 16384, PEER_TOPK = 16;
constexpr int Q0 = 0, K0 = 512, V0 = 640, SC0 = 768, HY0 = 2304, GT0 = 3840, IN_W = 6912;
constexpr int ML = BATCH * SEQ;
constexpr int MC = BATCH * CTX_LEN;
constexpr int MT = ML + MC;
constexpr int KVL = CTX_LEN + SEQ;
constexpr float EPS = 1e-6f;
constexpr float C2Q = 0.125f * 1.4426950408889634f;

constexpr size_t MiB = 1u << 20;
constexpr size_t WS_CTL = 0, CTL_ZERO_BYTES = 64 * 1024;
constexpr size_t WS_MOD = 1 * MiB;
constexpr size_t WS_ROPE = 2 * MiB;
constexpr size_t WS_H2 = 3 * MiB;
constexpr size_t WS_H2C = 11 * MiB;
constexpr size_t WS_CTXB = 12 * MiB;
constexpr size_t WS_WIN = 16 * MiB;
constexpr size_t WS_WBR = 43 * MiB;
constexpr size_t WS_WOUT = 49 * MiB;
constexpr size_t WS_WPEER = 53 * MiB;
constexpr size_t WS_XN = 64 * MiB;
constexpr size_t WS_Q = 129 * MiB;
constexpr size_t WS_K = 162 * MiB;
constexpr size_t WS_V = WS_K + (size_t)BATCH * KVL * KV_W * 2;
constexpr size_t WS_BG = 179 * MiB;
constexpr size_t WS_CX = 212 * MiB;
constexpr size_t WS_YHYT = WS_CX + (size_t)MT * 512 * 2;
constexpr size_t WS_MM = WS_CX;
constexpr size_t WS_YHY = 277 * MiB;
constexpr size_t WS_R1 = 310 * MiB;
constexpr size_t WS_HYTC = WS_R1 + (size_t)BATCH * 1536 * SEQ * 2;
constexpr size_t WS_PLIST = 440 * MiB;
constexpr size_t WS_TAB = 472 * MiB;
constexpr size_t WS_HSCR = 472 * MiB;
constexpr size_t WS_END = 506 * MiB;
static_assert(WS_YHYT + (size_t)BATCH * 512 * (SEQ + CTX_LEN) * 2 <= WS_YHY, "ws map");
static_assert(WS_HYTC + (size_t)BATCH * 1536 * CTX_LEN * 2 <= WS_PLIST && WS_R1 + (size_t)2048 * (16384 + 64) * 4 <= WS_PLIST && WS_PLIST + 16 * MiB <= WS_HSCR, "ws map");
static_assert(WS_V + (size_t)BATCH * KVL * KV_W * 2 <= WS_BG, "ws map");
constexpr int CW_TMO = 0, CW_CODE = 1, CW_BAR = 4096;

constexpr int RING_BYTES = 131072;
constexpr int HYB_BYTES = 17408 * 8;
constexpr int HYS_OFF = HYB_BYTES;
constexpr int LDSCTL_OFF = 143360, MISC_OFF = LDSCTL_OFF + 320;
constexpr int LDS_BYTES = 147456;
constexpr int NWAVES = 8, NTHREADS = 512;

#define GAS __attribute__((address_space(1)))
#define LAS __attribute__((address_space(3)))
typedef unsigned short bf16;
typedef unsigned v4u __attribute__((ext_vector_type(4)));
typedef unsigned v2u __attribute__((ext_vector_type(2)));
typedef float f32x4 __attribute__((ext_vector_type(4)));
typedef float f32x2 __attribute__((ext_vector_type(2)));
typedef int v6i __attribute__((ext_vector_type(6)));
typedef float v16f __attribute__((ext_vector_type(16)));
typedef float v32f __attribute__((ext_vector_type(32)));
typedef short bf16x8 __attribute__((ext_vector_type(8)));
typedef GAS unsigned gu32;
#define RLX_AGENT __ATOMIC_RELAXED, __HIP_MEMORY_SCOPE_AGENT
#define LDS_WAIT() asm volatile("s_waitcnt lgkmcnt(0)" ::: "memory")
#define VM_WAIT() asm volatile("s_waitcnt vmcnt(0)" ::: "memory")
__device__ __forceinline__ unsigned f2bf(float f) { unsigned u = __builtin_bit_cast(unsigned, f); return (u + 0x7fffu + ((u >> 16) & 1u)) >> 16; }
__device__ __forceinline__ unsigned pk2(float lo, float hi) { return f2bf(lo) | (f2bf(hi) << 16); }
__device__ __forceinline__ float bflo(unsigned w) { return __builtin_bit_cast(float, w << 16); }
__device__ __forceinline__ float bfhi(unsigned w) { return __builtin_bit_cast(float, w & 0xffff0000u); }
__device__ __forceinline__ float bf1(bf16 h) { return __builtin_bit_cast(float, (unsigned)h << 16); }
__device__ __forceinline__ int opq_tid() { int t = threadIdx.x; asm volatile("" : "+v"(t)); return t; }
__device__ __forceinline__ float wave_sum(float v) {
#pragma unroll
    for (int o = 1; o < 64; o <<= 1) v += __shfl_xor(v, o);
    return v;
}
__device__ __forceinline__ float wave_max(float v) {
#pragma unroll
    for (int o = 1; o < 64; o <<= 1) v = fmaxf(v, __shfl_xor(v, o));
    return v;
}

#define XB_TMO      128
#define XB_XCNT(j)  (256  + 64 * (j))
#define XB_XSUB(j)  (1280 + 64 * (j))
#define XB_XGEN(j)  (2304 + 64 * (j))
#define XB_TOP      3328
#define XB_TOPGEN   3392
#define XCD_BAR_WORDS 3456
#define XB_SPIN_CAP (1u << 22)
__device__ __forceinline__ unsigned xb_ld(unsigned* p)              { return __hip_atomic_load(p, __ATOMIC_RELAXED, __HIP_MEMORY_SCOPE_AGENT); }
__device__ __forceinline__ unsigned xb_add(unsigned* p, unsigned v) { return __hip_atomic_fetch_add(p, v, __ATOMIC_RELAXED, __HIP_MEMORY_SCOPE_AGENT); }
__device__ __forceinline__ unsigned xb_xcc_id() { return (unsigned)__builtin_amdgcn_s_getreg((3 << 11) | 20) & 0xFu; }
#define XB_SPIN(cond, bar) do { unsigned _sp = 0; while (cond) { __builtin_amdgcn_s_sleep(1); \
    if ((++_sp & 255u) == 0u) { if (xb_ld(&(bar)[XB_TMO])) break; if (_sp > XB_SPIN_CAP) { atomicAdd(&(bar)[XB_TMO], 1u); break; } } } } while (0)
struct XcdBarrier { unsigned* bar; unsigned x; volatile LAS unsigned* st; };
__device__ __forceinline__ XcdBarrier xcd_barrier_post(unsigned* bar, volatile LAS unsigned* st) {
    XcdBarrier b; b.bar = bar; b.x = xb_xcc_id(); b.st = st;
    if (threadIdx.x == 0) (void)xb_add(&bar[XB_XCNT(b.x)], 1u);
    return b;
}
__device__ __forceinline__ void xcd_barrier_complete(unsigned* bar, unsigned x, unsigned& nloc, unsigned& nx) {
    const unsigned G = gridDim.x * gridDim.y * gridDim.z;
    unsigned sum, cnt, mine, sp = 0u;
    for (;;) {
        sum = 0u; cnt = 0u; mine = 0u;
#pragma unroll
        for (unsigned j = 0; j < 16; ++j) { const unsigned c = xb_ld(&bar[XB_XCNT(j)]); sum += c; cnt += (c > 0u) ? 1u : 0u; mine = (j == x) ? c : mine; }
        if (sum == G) break;
        __builtin_amdgcn_s_sleep(1);
        if ((++sp & 255u) == 0u) { if (xb_ld(&bar[XB_TMO])) break; if (sp > XB_SPIN_CAP) { atomicAdd(&bar[XB_TMO], 1u); break; } }
    }
    nloc = mine > 0u ? mine : 1u; nx = cnt > 0u ? cnt : 1u;
}
__device__ __forceinline__ void xcd_barrier(const XcdBarrier& b) {
    asm volatile("s_waitcnt vmcnt(0)" ::: "memory");
    __syncthreads();
    if (threadIdx.x == 0) {
        unsigned* bar = b.bar;
        __builtin_amdgcn_s_waitcnt(0);
        unsigned nloc = b.st[0], nx = b.st[1];
        if (nloc == 0u) { xcd_barrier_complete(bar, b.x, nloc, nx); b.st[0] = nloc; b.st[1] = nx; }
        const unsigned old = xb_add(&bar[XB_XSUB(b.x)], 1u);
        const unsigned gen = old / nloc;
        if (old + 1u == (gen + 1u) * nloc) {
            __builtin_amdgcn_fence(__ATOMIC_RELEASE, "agent");
            asm volatile("s_waitcnt vmcnt(0)" ::: "memory");
            const unsigned og = xb_add(&bar[XB_TOP], 1u);
            const unsigned tg = og / nx;
            if (og + 1u == (tg + 1u) * nx) xb_add(&bar[XB_TOPGEN], 1u);
            else XB_SPIN(xb_ld(&bar[XB_TOPGEN]) == tg, bar);
            __builtin_amdgcn_fence(__ATOMIC_ACQUIRE, "agent");
            xb_add(&bar[XB_XGEN(b.x)], 1u);
            asm volatile("s_waitcnt vmcnt(0)" ::: "memory");
        } else {
            XB_SPIN(xb_ld(&bar[XB_XGEN(b.x)]) == gen, bar);
            __builtin_amdgcn_fence(__ATOMIC_ACQUIRE, "agent");
            asm volatile("s_waitcnt vmcnt(0)" ::: "memory");
        }
    }
    __syncthreads();
}
namespace pg8 {
#define PG8_LAS __attribute__((address_space(3)))
typedef unsigned short bf16_t;
typedef short bf16x8 __attribute__((ext_vector_type(8)));
typedef float f32x4 __attribute__((ext_vector_type(4)));
typedef unsigned u32x4 __attribute__((ext_vector_type(4)));
constexpr int BM = 256, BK = 64, HALF = 128, HTB = HALF * BK * 2  , STAGE_BYTES = 8 * HTB, NXCD = 8, WGM = 8;

__host__ __device__ __forceinline__ int lds_byte(int r, int c) { const int st = (r >> 4) * 2 + (c >> 5), rr = r & 15, cc = c & 31, ob = rr * 64 + cc * 2; return st * 1024 + (ob ^ (((ob >> 9) & 1) << 5)); }
__host__ __device__ __forceinline__ void stage_rc(int b, int& R, int& C) { const int st = b / 1024, sb = b % 1024, swz = sb ^ (((sb >> 9) & 1) << 5); R = (st >> 1) * 16 + swz / 64; C = (st & 1) * 32 + (swz % 64) / 2; }
__host__ __device__ __forceinline__ int perm32(int rho) { const int n = rho >> 4, i = rho & 15; return 8 * (i >> 2) + 4 * n + (i & 3); }

struct Unit { int pm, pn, z; };
struct Gemm { const bf16_t* A; const bf16_t* Bt; int M, N, K; };


struct StaticOrder {
    int nM, nN, nwg, G, c;
    __host__ __device__ void init(int M, int N, int G_, int c_, int rot = 0) { nM = M / BM; nN = N / BM; nwg = nM * nN; G = G_; c = (c_ + G_ - (rot % G_)) % G_; }
    __host__ __device__ bool next(int i, Unit& u) const {
        const long L = (long)i * G + c; if (L >= nwg) return false;
        int wgid = (int)L; { const int q = nwg / NXCD, r = nwg % NXCD, xcd = wgid % NXCD, off = wgid / NXCD; wgid = (xcd < r ? xcd * (q + 1) : r * (q + 1) + (xcd - r) * q) + off; }
        const int nig = WGM * nN, gid = wgid / nig, fm = gid * WGM, gsz = (nM - fm) < WGM ? (nM - fm) : WGM;
        u.pm = fm + ((wgid % nig) % gsz); u.pn = (wgid % nig) / gsz; return true;
    }
    __device__ __forceinline__ void a_ready(const Unit&) const {}
    __device__ __forceinline__ void done(const Unit&) const {}
    __device__ __forceinline__ const char* baseA(const Gemm& g, const Unit& u, size_t tstep) const { return (const char*)g.A + (size_t)u.pm * tstep; }
    __device__ __forceinline__ const char* baseB(const Gemm& g, const Unit& u, size_t tstep) const { return (const char*)g.Bt + (size_t)u.pn * tstep; }
};
struct OneUnit {
    int idx, nN;
    __host__ __device__ bool next(int i, Unit& u) const { if (i != 0 || idx < 0) return false; u.pm = idx / nN; u.pn = idx % nN; u.z = 0; return true; }
    __device__ __forceinline__ void a_ready(const Unit&) const {}
    __device__ __forceinline__ void done(const Unit&) const {}
    __device__ __forceinline__ const char* baseA(const Gemm& g, const Unit& u, size_t tstep) const { return (const char*)g.A + (size_t)u.pm * tstep; }
    __device__ __forceinline__ const char* baseB(const Gemm& g, const Unit& u, size_t tstep) const { return (const char*)g.Bt + (size_t)u.pn * tstep; }
};
struct GateOrder {
    StaticOrder S;
    __host__ __device__ bool next(int i, Unit& u) const { if (!S.next(i / 3, u)) return false; u.pn += 4 * (i % 3); u.z = 0; return true; }
    __device__ __forceinline__ void a_ready(const Unit&) const {}
    __device__ __forceinline__ void done(const Unit&) const {}
    __device__ __forceinline__ const char* baseA(const Gemm& g, const Unit& u, size_t tstep) const { return (const char*)g.A + (size_t)u.pm * tstep; }
    __device__ __forceinline__ const char* baseB(const Gemm& g, const Unit& u, size_t tstep) const { return (const char*)g.Bt + (size_t)u.pn * tstep; }
};
struct MergeOrder {
    StaticOrder S; const char* A0; long d1, d2;
    __host__ __device__ bool next(int i, Unit& u) const { if (!S.next(i / 3, u)) return false; u.z = i % 3; return true; }
    __device__ __forceinline__ void a_ready(const Unit&) const {}
    __device__ __forceinline__ void done(const Unit&) const {}
    __device__ __forceinline__ const char* baseA(const Gemm& g, const Unit& u, size_t tstep) const { return A0 + (long)(u.z & 1) * d1 + (long)(u.z >> 1) * d2 + (size_t)u.pm * tstep; }
    __device__ __forceinline__ const char* baseB(const Gemm& g, const Unit& u, size_t tstep) const { return (const char*)g.Bt + ((size_t)u.z * g.N * g.K) * 2 + (size_t)u.pn * tstep; }
};

typedef float f32x2_t __attribute__((ext_vector_type(2))); typedef __bf16 bf16x2_t __attribute__((ext_vector_type(2)));
__device__ __forceinline__ unsigned cvt_pk_bf16(float lo, float hi) { f32x2_t v = {lo, hi}; bf16x2_t b = __builtin_convertvector(v, bf16x2_t); return __builtin_bit_cast(unsigned, b); }
__device__ __forceinline__ u32x4 pack8(const f32x4& a, const f32x4& b) { u32x4 w; w.x = cvt_pk_bf16(a[0], a[1]); w.y = cvt_pk_bf16(a[2], a[3]); w.z = cvt_pk_bf16(b[0], b[1]); w.w = cvt_pk_bf16(b[2], b[3]); return w; }
__device__ __forceinline__ void unpack8(const u32x4& w, f32x4& a, f32x4& b) {
    a[0] = __builtin_bit_cast(float, w.x << 16); a[1] = __builtin_bit_cast(float, w.x & 0xffff0000u); a[2] = __builtin_bit_cast(float, w.y << 16); a[3] = __builtin_bit_cast(float, w.y & 0xffff0000u);
    b[0] = __builtin_bit_cast(float, w.z << 16); b[1] = __builtin_bit_cast(float, w.z & 0xffff0000u); b[2] = __builtin_bit_cast(float, w.w << 16); b[3] = __builtin_bit_cast(float, w.w & 0xffff0000u);
}

struct EpiIn {
    static constexpr bool PERM = true, AFTER_DRAIN = false, RESCALE = false;
    bf16_t* Q; bf16_t* Kb; bf16_t* Vb; bf16_t* BG; bf16_t* CX; const float* qgain; const float* kgain; const float* ropec; const float* ropes;
    __device__ __forceinline__ void operator()(const f32x4 (&acc)[2][2][4][2], const Unit& u, int wr, int wc, int fr_, int fq_) const {
        const int ln_ = opq_tid() & 63; const int fr = ln_ & 15, fq = ln_ >> 4;
        const int row0 = u.pm * BM + wr * 64 + fr;
        const int pn = u.pn;
        if (pn < 2 || (pn == 2 && wc < 2)) {
            const bool isq = pn < 2;
            const float* gain = isq ? qgain : kgain;
            const float qs = isq ? 0.18033688011112042f : 1.0f;
#pragma unroll
            for (int ai = 0; ai < 2; ++ai)
#pragma unroll
                for (int m = 0; m < 4; ++m) {
                    const int r = row0 + ai * HALF + m * 16;
                    float ss = 0.f;
#pragma unroll
                    for (int bj = 0; bj < 2; ++bj)
#pragma unroll
                        for (int n = 0; n < 2; ++n) { const f32x4 x = acc[ai][bj][m][n]; ss += (x[0] * x[0] + x[1] * x[1]) + (x[2] * x[2] + x[3] * x[3]); }
                    ss += __shfl_xor(ss, 16); ss += __shfl_xor(ss, 32);
                    const float rs = qs / sqrtf(ss * (1.0f / 64.0f) + 1e-6f);
                    const bool latent = r < 32768;
                    const int t = r & 16383;
                    bf16_t* dst;
                    if (isq) dst = Q + (size_t)r * 512 + (4 * pn + wc) * 64 + 8 * fq;
                    else { const int kvrow = latent ? ((r >> 14) * 16640 + 256 + t) : (((r - 32768) >> 8) * 16640 + ((r - 32768) & 255)); dst = Kb + (size_t)kvrow * 128 + wc * 64 + 8 * fq; }
#pragma unroll
                    for (int bj = 0; bj < 2; ++bj) {
                        f32x4 x1 = acc[ai][bj][m][0] * rs * *(const f32x4*)(gain + 32 * bj + 4 * fq), x2 = acc[ai][bj][m][1] * rs * *(const f32x4*)(gain + 32 * bj + 16 + 4 * fq);
                        if (latent) {
                            const int pos = bj ? (t & 63) : (t >> 6);
                            const f32x4 cs = *(const f32x4*)(ropec + pos * 16 + 4 * fq), sn = *(const f32x4*)(ropes + pos * 16 + 4 * fq);
                            const f32x4 o1 = x1 * cs - x2 * sn, o2 = x2 * cs + x1 * sn; x1 = o1; x2 = o2;
                        }
                        *(u32x4*)(dst + 32 * bj) = pack8(x1, x2);
                    }
                    asm volatile("" ::: "memory");
                }
        } else if (pn == 2) {
#pragma unroll
            for (int ai = 0; ai < 2; ++ai)
#pragma unroll
                for (int m = 0; m < 4; ++m) {
                    const int r = row0 + ai * HALF + m * 16; const bool latent = r < 32768; const int t = r & 16383;
                    const int kvrow = latent ? ((r >> 14) * 16640 + 256 + t) : (((r - 32768) >> 8) * 16640 + ((r - 32768) & 255));
                    bf16_t* dst = Vb + (size_t)kvrow * 128 + (wc - 2) * 64 + 8 * fq;
#pragma unroll
                    for (int bj = 0; bj < 2; ++bj) *(u32x4*)(dst + 32 * bj) = pack8(acc[ai][bj][m][0], acc[ai][bj][m][1]);
                }
        } else if (pn < 5) {
#pragma unroll
            for (int ai = 0; ai < 2; ++ai)
#pragma unroll
                for (int m = 0; m < 4; ++m) {
                    const int r = row0 + ai * HALF + m * 16;
                    bf16_t* dst = BG + (size_t)r * 512 + (pn - 3) * 256 + wc * 32 + 8 * fq;
#pragma unroll
                    for (int bj = 0; bj < 2; ++bj) *(u32x4*)(dst + bj * HALF) = pack8(acc[ai][bj][m][0], acc[ai][bj][m][1]);
                }
        } else {
#pragma unroll
            for (int ai = 0; ai < 2; ++ai)
#pragma unroll
                for (int m = 0; m < 4; ++m) {
                    const int r = row0 + ai * HALF + m * 16;
                    bf16_t* dst = CX + (size_t)r * 512 + (pn - 5) * 128 + wc * 32 + 8 * fq;
                    *(u32x4*)dst = pack8(acc[ai][0][m][0] * acc[ai][1][m][0], acc[ai][0][m][1] * acc[ai][1][m][1]);
                }
        }
    }
};
struct EpiHyT {
    static constexpr bool PERM = true, AFTER_DRAIN = false, RESCALE = false;
    bf16_t* HYT; bf16_t* HYTC;
    __device__ __forceinline__ void operator()(const f32x4 (&acc)[2][2][4][2], const Unit& u, int wr, int wc, int fr_, int fq_) const {
        const int ln_ = opq_tid() & 63; const int fr = ln_ & 15, fq = ln_ >> 4;
        const int ch0 = u.pm * BM + wr * 64 + fr;
        bf16_t* base; size_t pitch;
        if (u.pn < 128) { const int b = u.pn >> 6, t0 = (u.pn & 63) * 256; base = HYT + (size_t)b * 1536 * 16384 + t0; pitch = 16384; }
        else { const int b = u.pn - 128; base = HYTC + (size_t)b * 1536 * 256; pitch = 256; }
        base += wc * 32 + 8 * fq;
#pragma unroll
        for (int ai = 0; ai < 2; ++ai)
#pragma unroll
            for (int m = 0; m < 4; ++m) { bf16_t* rowp = base + (size_t)(ch0 + ai * HALF + m * 16) * pitch;
#pragma unroll
                for (int bj = 0; bj < 2; ++bj) *(u32x4*)(rowp + bj * HALF) = pack8(acc[ai][bj][m][0], acc[ai][bj][m][1]); }
    }
};
struct EpiGate {
    static constexpr bool PERM = true, AFTER_DRAIN = false, RESCALE = false;
    bf16_t* G;
    __device__ __forceinline__ void operator()(const f32x4 (&acc)[2][2][4][2], const Unit& u, int wr, int wc, int fr_, int fq_) const {
        const int ln_ = opq_tid() & 63; const int fr = ln_ & 15, fq = ln_ >> 4;
        const int row0 = u.pm * BM + wr * 64 + fr, col0 = u.pn * BM + wc * 32 + 8 * fq;
#pragma unroll
        for (int ai = 0; ai < 2; ++ai)
#pragma unroll
            for (int m = 0; m < 4; ++m) { bf16_t* rowp = G + (size_t)(row0 + ai * HALF + m * 16) * 3072 + col0;
#pragma unroll
                for (int bj = 0; bj < 2; ++bj) { f32x4 a = acc[ai][bj][m][0], b = acc[ai][bj][m][1];
#pragma unroll
                    for (int e = 0; e < 4; ++e) { a[e] = __builtin_amdgcn_rcpf(1.0f + __builtin_amdgcn_exp2f(-1.4426950408889634f * a[e])); b[e] = __builtin_amdgcn_rcpf(1.0f + __builtin_amdgcn_exp2f(-1.4426950408889634f * b[e])); }
                    *(u32x4*)(rowp + bj * HALF) = pack8(a, b); } }
    }
};
struct EpiMerge {
    static constexpr bool PERM = true, AFTER_DRAIN = false, RESCALE = false;
    const bf16_t* G; bf16_t* MM; int br;
    __device__ __forceinline__ void operator()(const f32x4 (&acc)[2][2][4][2], const Unit& u, int wr, int wc, int fr_, int fq_) const {
        const int ln_ = opq_tid() & 63; const int fr = ln_ & 15, fq = ln_ >> 4;
        const int row0 = u.pm * BM + wr * 64 + fr, col0 = u.pn * BM + wc * 32 + 8 * fq;
#pragma unroll
        for (int ai = 0; ai < 2; ++ai)
#pragma unroll
            for (int m = 0; m < 4; ++m) { const size_t r = (size_t)(row0 + ai * HALF + m * 16);
#pragma unroll
                for (int bj = 0; bj < 2; ++bj) {
                    const u32x4 gw = *(const u32x4*)(G + r * 3072 + br * 1024 + col0 + bj * HALF);
                    f32x4 g0, g1; unpack8(gw, g0, g1);
                    f32x4 v0 = g0 * acc[ai][bj][m][0], v1 = g1 * acc[ai][bj][m][1];
                    if ((ABL >> br) & 1) { v0 = v0 * 0.f; v1 = v1 * 0.f; }
                    bf16_t* mp = MM + r * 1024 + col0 + bj * HALF;
                    if (br > 0) { const u32x4 mw = *(const u32x4*)mp; f32x4 m0, m1; unpack8(mw, m0, m1); v0 += m0; v1 += m1; }
                    *(u32x4*)mp = pack8(v0, v1); } }
    }
};
struct EpiMerge3 {
    static constexpr bool PERM = true, AFTER_DRAIN = false, RESCALE = true;
    const bf16_t* G; bf16_t* MM;
    __device__ __forceinline__ bool keep(const Unit& u) const { return u.z < 2; }
    __device__ __forceinline__ void fin(f32x4 (&acc)[2][2][4][2], const Unit& u, int wr, int wc) const {
        const int ln_ = opq_tid() & 63; const int fr = ln_ & 15, fq = ln_ >> 4;
        const int row0 = u.pm * BM + wr * 64 + fr, col0 = u.pn * BM + wc * 32 + 8 * fq;
        if (u.z < 2) {
#pragma unroll
            for (int ai = 0; ai < 2; ++ai)
#pragma unroll
                for (int m = 0; m < 4; ++m) { const size_t r = (size_t)(row0 + ai * HALF + m * 16);
#pragma unroll
                    for (int bj = 0; bj < 2; ++bj) {
                        const bf16_t* gp = G + r * 3072 + u.z * 1024 + col0 + bj * HALF;
                        const u32x4 ga = *(const u32x4*)gp, gb = *(const u32x4*)(gp + 1024);
                        f32x4 a0, a1, b0, b1; unpack8(ga, a0, a1); unpack8(gb, b0, b1);
                        f32x4 r0, r1;
#pragma unroll
                        for (int e = 0; e < 4; ++e) { r0[e] = a0[e] * __builtin_amdgcn_rcpf(b0[e]); r1[e] = a1[e] * __builtin_amdgcn_rcpf(b1[e]); }
                        acc[ai][bj][m][0] = acc[ai][bj][m][0] * r0; acc[ai][bj][m][1] = acc[ai][bj][m][1] * r1; } }
        } else {
#pragma unroll
            for (int ai = 0; ai < 2; ++ai)
#pragma unroll
                for (int m = 0; m < 4; ++m) { const size_t r = (size_t)(row0 + ai * HALF + m * 16);
#pragma unroll
                    for (int bj = 0; bj < 2; ++bj) {
                        const u32x4 gw = *(const u32x4*)(G + r * 3072 + 2 * 1024 + col0 + bj * HALF);
                        f32x4 g0, g1; unpack8(gw, g0, g1);
                        *(u32x4*)(MM + r * 1024 + col0 + bj * HALF) = pack8(g0 * acc[ai][bj][m][0], g1 * acc[ai][bj][m][1]); } }
        }
    }
};
struct EpiResid {
    static constexpr bool PERM = false, AFTER_DRAIN = false, RESCALE = false;
    const float* xold; float* xnew; const float* cold; float* cnew; const float* mod;
    __device__ __forceinline__ void operator()(const f32x4 (&acc)[2][2][4][2], const Unit& u, int wr, int wc, int fr_, int fq_) const {
        const int ln_ = opq_tid() & 63; const int fr = ln_ & 15, fq = ln_ >> 4;
        const int row0 = u.pm * BM + wr * 64 + fr, col0 = u.pn * BM + wc * 32 + 4 * fq;
        const bool latent = u.pm < 128;
        const int which = latent ? (u.pm >> 6) : 2;
        const float* gp = mod + which * 6144 + 2 * 1024 + col0;
        f32x4 gv[2][2];
#pragma unroll
        for (int bj = 0; bj < 2; ++bj)
#pragma unroll
            for (int n = 0; n < 2; ++n) gv[bj][n] = *(const f32x4*)(gp + bj * HALF + n * 16);
        const float* src = latent ? xold : cold - (size_t)32768 * 1024; float* dst = latent ? xnew : cnew - (size_t)32768 * 1024;
#pragma unroll
        for (int ai = 0; ai < 2; ++ai)
#pragma unroll
            for (int m = 0; m < 4; ++m) { const size_t off = (size_t)(row0 + ai * HALF + m * 16) * 1024 + col0;
#pragma unroll
                for (int bj = 0; bj < 2; ++bj)
#pragma unroll
                    for (int n = 0; n < 2; ++n) { const f32x4 o = *(const f32x4*)(src + off + bj * HALF + n * 16) + gv[bj][n] * acc[ai][bj][m][n]; *(f32x4*)(dst + off + bj * HALF + n * 16) = o; }
                if (m & 1) asm volatile("" ::: "memory"); }
    }
};
struct EpiF32 {
    static constexpr bool PERM = false, AFTER_DRAIN = false, RESCALE = false;
    float* S; int ldc;
    __device__ __forceinline__ void operator()(const f32x4 (&acc)[2][2][4][2], const Unit& u, int wr, int wc, int fr_, int fq_) const {
        const int ln_ = opq_tid() & 63; const int fr = ln_ & 15, fq = ln_ >> 4;
        const int row0 = u.pm * BM + wr * 64 + fr, col0 = u.pn * BM + wc * 32 + 4 * fq;
#pragma unroll
        for (int ai = 0; ai < 2; ++ai)
#pragma unroll
            for (int m = 0; m < 4; ++m) { float* rowp = S + (size_t)(row0 + ai * HALF + m * 16) * ldc + col0;
#pragma unroll
                for (int bj = 0; bj < 2; ++bj)
#pragma unroll
                    for (int n = 0; n < 2; ++n) *(f32x4*)(rowp + bj * HALF + n * 16) = acc[ai][bj][m][n]; }
    }
};

struct EpiScoreT {
    static constexpr bool PERM = false, AFTER_DRAIN = false, RESCALE = false;
    float* S;
    __device__ __forceinline__ void operator()(const f32x4 (&acc)[2][2][4][2], const Unit& u, int wr, int wc, int fr_, int fq_) const {
        const int ln_ = opq_tid() & 63; const int fr = ln_ & 15, fq = ln_ >> 4;
        const int row0 = u.pm * BM + wr * 64 + fr, col0 = u.pn * BM + wc * 32 + 4 * fq;
#pragma unroll
        for (int ai = 0; ai < 2; ++ai)
#pragma unroll
            for (int m = 0; m < 4; ++m) { const int row = row0 + ai * HALF + m * 16;
#pragma unroll
                for (int bj = 0; bj < 2; ++bj)
#pragma unroll
                    for (int n = 0; n < 2; ++n) { const int col = col0 + bj * HALF + n * 16; *(f32x4*)(S + ((size_t)(col >> 6) * 2048 + row) * 64 + (col & 63)) = acc[ai][bj][m][n]; } }
    }
};
template <class Epi, class Sched, bool ALIGN_EPI = false, bool SP2 = false>
__device__ __forceinline__ void gemm_phase(PG8_LAS unsigned char* lds, const Gemm g, const Sched& S, const Epi& E) {
    const int tid = opq_tid(), wid = __builtin_amdgcn_readfirstlane(tid >> 6), lane = tid & 63, wr = wid >> 2, wc = wid & 3, fr = lane & 15, fq = lane >> 4;
    const int K = g.K, nt = K / BK;
    unsigned voffA[2], voffB[2];
#pragma unroll
    for (int i = 0; i < 2; ++i) { int R, C; stage_rc(tid * 16 + i * 8192, R, C); const int Rb = Epi::PERM ? ((R & ~31) + perm32(R & 31)) : R;
        voffA[i] = (unsigned)(R * K + C) * 2u; voffB[i] = (unsigned)(Rb * K + C) * 2u; }
    const size_t kstep = (size_t)(BK * 2);
    const size_t hstep = (size_t)HALF * K * 2;
    const size_t tstep = 2 * hstep;
    const unsigned ldsw = (unsigned)wid * 1024u;
    const int aoff = lds_byte(wr * 64 + fr, fq * 8), boff = lds_byte(wc * 32 + fr, fq * 8);
#define PG8_SA(b, h) (((b) * 2 + (h)) * HTB)
#define PG8_SB(b, h) ((4 + (b) * 2 + (h)) * HTB)
#define PG8_STAGE(bufoff, gbase, voff) do { _Pragma("unroll") for (int _i = 0; _i < 2; ++_i) \
        __builtin_amdgcn_global_load_lds((const unsigned*)((const char*)(gbase) + (voff)[_i]), (PG8_LAS unsigned*)(lds + (bufoff) + ldsw + _i * 8192), 16, 0, 0); } while (0)
#define PG8_LDA(dst, b, h) do { _Pragma("unroll") for (int m = 0; m < 4; ++m) _Pragma("unroll") for (int k = 0; k < 2; ++k) dst[m][k] = *(const PG8_LAS bf16x8*)(lds + PG8_SA(b, h) + aoff + m * 2048 + k * 1024); } while (0)
#define PG8_LDB(dst, b, h) do { _Pragma("unroll") for (int n = 0; n < 2; ++n) _Pragma("unroll") for (int k = 0; k < 2; ++k) dst[n][k] = *(const PG8_LAS bf16x8*)(lds + PG8_SB(b, h) + boff + n * 2048 + k * 1024); } while (0)
#define PG8_MMA(ai, bj, At, Bt) do { __builtin_amdgcn_s_setprio(1); _Pragma("unroll") for (int m = 0; m < 4; ++m) _Pragma("unroll") for (int n = 0; n < 2; ++n) _Pragma("unroll") for (int k = 0; k < 2; ++k) \
        acc[ai][bj][m][n] = __builtin_amdgcn_mfma_f32_16x16x32_bf16(Bt[n][k], At[m][k], acc[ai][bj][m][n], 0, 0, 0); __builtin_amdgcn_s_setprio(0); } while (0)
#define PG8_WAIT_V(n) asm volatile("s_waitcnt vmcnt(" #n ")" ::: "memory")
#define PG8_WAIT_L(n) asm volatile("s_waitcnt lgkmcnt(" #n ")" ::: "memory")
#define PG8_BAR __builtin_amdgcn_s_barrier()
#define PG8_SCHED __builtin_amdgcn_sched_barrier(0)
    Unit cur, nxt; int ui = 0;
    if (!S.next(0, cur)) return;
    f32x4 acc[2][2][4][2];
#pragma unroll
    for (int a = 0; a < 2; ++a)
#pragma unroll
        for (int b = 0; b < 2; ++b)
#pragma unroll
            for (int m = 0; m < 4; ++m)
#pragma unroll
                for (int n = 0; n < 2; ++n) acc[a][b][m][n] = (f32x4){0.f, 0.f, 0.f, 0.f};
    bf16x8 At[4][2], B0[2][2], B1[2][2];
    const char* cA = S.baseA(g, cur, tstep); const char* cB = S.baseB(g, cur, tstep);
    S.a_ready(cur);
    if constexpr (SP2) {
        PG8_STAGE(PG8_SB(0, 0), cB, voffB); PG8_STAGE(PG8_SB(0, 1), cB + hstep, voffB); PG8_STAGE(PG8_SA(0, 0), cA, voffA); PG8_STAGE(PG8_SA(0, 1), cA + hstep, voffA);
        if (wr == 1) PG8_BAR;
        PG8_WAIT_V(2); PG8_BAR;
        PG8_STAGE(PG8_SB(1, 0), cB + kstep, voffB); PG8_STAGE(PG8_SA(1, 0), cA + kstep, voffA); PG8_STAGE(PG8_SB(1, 1), cB + hstep + kstep, voffB);
        PG8_WAIT_V(6); PG8_BAR;
    } else {
        PG8_STAGE(PG8_SB(0, 0), cB, voffB); PG8_STAGE(PG8_SA(0, 0), cA, voffA); PG8_STAGE(PG8_SB(0, 1), cB + hstep, voffB); PG8_STAGE(PG8_SA(0, 1), cA + hstep, voffA);
        if (wr == 1) PG8_BAR;
        PG8_WAIT_V(4); PG8_BAR;
        PG8_STAGE(PG8_SB(1, 0), cB + kstep, voffB); PG8_STAGE(PG8_SA(1, 0), cA + kstep, voffA); PG8_STAGE(PG8_SB(1, 1), cB + hstep + kstep, voffB);
        PG8_WAIT_V(6); PG8_BAR;
    }
    for (;;) {
        const bool has_next = S.next(ui + 1, nxt);
        const char* nA = has_next ? S.baseA(g, nxt, tstep) : cA; const char* nB = has_next ? S.baseB(g, nxt, tstep) : cB;
        for (int t = 0; t < nt; t += 2) {
            const bool last = (t == nt - 2);
            const char* a1 = cA + (size_t)(t + 1) * kstep;
            const char* a2 = last ? nA : cA + (size_t)(t + 2) * kstep; const char* b2 = last ? nB : cB + (size_t)(t + 2) * kstep;
            const char* a3 = a2 + kstep; const char* b3 = b2 + kstep;
            if (last && has_next) S.a_ready(nxt);
            if constexpr (SP2) {
            PG8_LDB(B0, 0, 0); PG8_LDB(B1, 0, 1); PG8_SCHED; PG8_LDA(At, 0, 0); PG8_STAGE(PG8_SA(1, 1), a1 + hstep, voffA);
            PG8_WAIT_V(8); PG8_WAIT_L(0); PG8_BAR; PG8_MMA(0, 0, At, B0); PG8_MMA(0, 1, At, B1); PG8_BAR; PG8_SCHED;
            PG8_LDA(At, 0, 1); PG8_STAGE(PG8_SB(0, 0), b2, voffB); PG8_STAGE(PG8_SB(0, 1), b2 + hstep, voffB); PG8_STAGE(PG8_SA(0, 0), a2, voffA);
            PG8_WAIT_V(8); PG8_WAIT_L(0); PG8_BAR; PG8_MMA(1, 0, At, B0); PG8_MMA(1, 1, At, B1); PG8_BAR; PG8_SCHED;
            PG8_LDB(B0, 1, 0); PG8_LDB(B1, 1, 1); PG8_SCHED; PG8_LDA(At, 1, 0); PG8_STAGE(PG8_SA(0, 1), a2 + hstep, voffA);
            PG8_WAIT_V(8); PG8_WAIT_L(0); PG8_BAR; PG8_MMA(0, 0, At, B0); PG8_MMA(0, 1, At, B1); PG8_BAR; PG8_SCHED;
            PG8_LDA(At, 1, 1); PG8_STAGE(PG8_SB(1, 0), b3, voffB); PG8_STAGE(PG8_SB(1, 1), b3 + hstep, voffB); PG8_STAGE(PG8_SA(1, 0), a3, voffA);
            PG8_WAIT_V(8); PG8_WAIT_L(0); PG8_BAR; PG8_MMA(1, 0, At, B0); PG8_MMA(1, 1, At, B1); PG8_BAR; PG8_SCHED;
            } else {
            PG8_LDB(B0, 0, 0); PG8_SCHED; PG8_LDA(At, 0, 0); PG8_STAGE(PG8_SA(1, 1), a1 + hstep, voffA);
            PG8_WAIT_L(8); PG8_BAR; PG8_WAIT_L(0); PG8_MMA(0, 0, At, B0); PG8_BAR; PG8_SCHED;
            PG8_LDB(B1, 0, 1); PG8_STAGE(PG8_SB(0, 0), b2, voffB);
            PG8_BAR; PG8_WAIT_L(0); PG8_MMA(0, 1, At, B1); PG8_BAR;
            PG8_LDA(At, 0, 1); PG8_STAGE(PG8_SA(0, 0), a2, voffA);
            PG8_BAR; PG8_WAIT_L(0); PG8_MMA(1, 0, At, B0); PG8_BAR; PG8_SCHED;
            PG8_STAGE(PG8_SB(0, 1), b2 + hstep, voffB);
            PG8_WAIT_V(6); PG8_BAR; PG8_MMA(1, 1, At, B1); PG8_BAR;
            PG8_LDB(B0, 1, 0); PG8_SCHED; PG8_LDA(At, 1, 0); PG8_STAGE(PG8_SA(0, 1), a2 + hstep, voffA);
            PG8_WAIT_L(8); PG8_BAR; PG8_WAIT_L(0); PG8_MMA(0, 0, At, B0); PG8_BAR; PG8_SCHED;
            PG8_LDB(B1, 1, 1); PG8_STAGE(PG8_SB(1, 0), b3, voffB);
            PG8_BAR; PG8_WAIT_L(0); PG8_MMA(0, 1, At, B1); PG8_BAR;
            PG8_LDA(At, 1, 1); PG8_STAGE(PG8_SA(1, 0), a3, voffA);
            PG8_BAR; PG8_WAIT_L(0); PG8_MMA(1, 0, At, B0); PG8_BAR; PG8_SCHED;
            PG8_STAGE(PG8_SB(1, 1), b3 + hstep, voffB);
            PG8_WAIT_V(6); PG8_BAR; PG8_MMA(1, 1, At, B1); PG8_BAR;
            }
        }
        if constexpr (ALIGN_EPI) { if (wr == 0) PG8_BAR; }
        if constexpr (Epi::RESCALE) { E.fin(acc, cur, wr, wc); S.done(cur); }
        else if constexpr (!Epi::AFTER_DRAIN) { E(acc, cur, wr, wc, fr, fq); S.done(cur); }
        if (!has_next) break;
        bool keep_ = false; if constexpr (Epi::RESCALE) keep_ = E.keep(cur);
        if (!keep_) {
#pragma unroll
        for (int a = 0; a < 2; ++a)
#pragma unroll
            for (int b = 0; b < 2; ++b)
#pragma unroll
                for (int m = 0; m < 4; ++m)
#pragma unroll
                    for (int n = 0; n < 2; ++n) acc[a][b][m][n] = (f32x4){0.f, 0.f, 0.f, 0.f};
        }
        cur = nxt; cA = nA; cB = nB; ++ui;
        if constexpr (ALIGN_EPI) { if (wr == 1) PG8_BAR; }
    }
    PG8_WAIT_V(0);
    if constexpr (!ALIGN_EPI) { if (wr == 0) PG8_BAR; }
    PG8_BAR;
    if constexpr (Epi::AFTER_DRAIN) { E.fused(acc, cur, wr, wc, fr, fq, lds, wid, lane); S.done(cur); }
#undef PG8_SA
#undef PG8_SB
#undef PG8_STAGE
#undef PG8_LDA
#undef PG8_LDB
#undef PG8_MMA
#undef PG8_WAIT_V
#undef PG8_WAIT_L
#undef PG8_BAR
#undef PG8_SCHED
}
}
#include <hip/hip_bf16.h>
#include <cmath>
namespace attn_body {
using bf16=__hip_bfloat16;
using bf16x8=__attribute__((ext_vector_type(8)))short;
using s16x4=__attribute__((ext_vector_type(4)))short;
using f32x16=__attribute__((ext_vector_type(16)))float;
using u32x4=__attribute__((ext_vector_type(4)))unsigned;
constexpr int D=64,QP=512,KP=128;
constexpr int NW=8,QBLK=32,QB=QBLK*NW,KVBLK=64;
constexpr int ATTN_UNIT_ROWS=QB;
__device__ __forceinline__ int crow(int r,int hi){return (r&3)+8*(r>>2)+4*hi;}
#define SBAR() __builtin_amdgcn_sched_barrier(0)
constexpr int NSLOT=3, SLOTB=8192;
constexpr int LDS_K=0, LDS_V=NSLOT*SLOTB, LDS_WS=2*NSLOT*SLOTB, LDS_OST=LDS_WS+NW*64*4, LDS_BYTES=LDS_OST+NW*4096;
constexpr float C2=0.125f*1.4426950408889634f;
__device__ __forceinline__ void glds16(const void*gsrc,unsigned lds_dst){unsigned keep;
  asm volatile("s_mov_b32 %0, m0\n\ts_mov_b32 m0, %2\n\ts_nop 0\n\tglobal_load_lds_dwordx4 %1, off\n\ts_mov_b32 m0, %0":"=&s"(keep):"v"(gsrc),"s"(lds_dst):"memory");}
__device__ __forceinline__ float max3f(float a,float b,float c){float r;asm("v_max3_f32 %0, %1, %2, %3":"=v"(r):"v"(a),"v"(b),"v"(c));return r;}
__device__ __forceinline__ float max2f(float a,float b){float r;asm("v_max_f32_e32 %0, %1, %2":"=v"(r):"v"(a),"v"(b));return r;}
__device__ __forceinline__ float fadd_s(float a,float b){float r;asm("v_add_f32_e32 %0, %1, %2":"=v"(r):"v"(a),"v"(b));return r;}
__device__ __forceinline__ float fsub_s(float a,float b){float r;asm("v_sub_f32_e32 %0, %1, %2":"=v"(r):"v"(a),"v"(b));return r;}
typedef float f32x2_t __attribute__((ext_vector_type(2))); typedef __bf16 bf16x2_t __attribute__((ext_vector_type(2)));
__device__ __forceinline__ unsigned cvtpk_s(float lo,float hi){f32x2_t v={lo,hi};bf16x2_t b=__builtin_convertvector(v,bf16x2_t);return __builtin_bit_cast(unsigned,b);}
#define WAIT_BAR(N) asm volatile("s_waitcnt vmcnt(" #N ") lgkmcnt(0)\n\ts_barrier":::"memory")

__device__ __forceinline__ void qkt(f32x16&p0,f32x16&p1,const char*Kslot,const bf16x8*qr,const f32x16&negm,int r32,int hi){
  const char*kb=Kslot+hi*1024+r32*16;
  #pragma unroll
  for(int d0=0;d0<4;++d0){
    const bf16x8 b0=*reinterpret_cast<const bf16x8*>(kb+d0*2048);
    const bf16x8 b1=*reinterpret_cast<const bf16x8*>(kb+d0*2048+512);
    if(d0==0){p0=__builtin_amdgcn_mfma_f32_32x32x16_bf16(b0,qr[0],negm,0,0,0);p1=__builtin_amdgcn_mfma_f32_32x32x16_bf16(b1,qr[0],negm,0,0,0);}
    else{p0=__builtin_amdgcn_mfma_f32_32x32x16_bf16(b0,qr[d0],p0,0,0,0);p1=__builtin_amdgcn_mfma_f32_32x32x16_bf16(b1,qr[d0],p1,0,0,0);}}
}
typedef __attribute__((address_space(3))) const char* lds_cptr;
typedef short v4i16_t __attribute__((ext_vector_type(4)));
__device__ __forceinline__ void kload8(bf16x8*kf,lds_cptr kp){
  kf[0]=*(const __attribute__((address_space(3))) bf16x8*)(kp);      kf[1]=*(const __attribute__((address_space(3))) bf16x8*)(kp+512);
  kf[2]=*(const __attribute__((address_space(3))) bf16x8*)(kp+2048); kf[3]=*(const __attribute__((address_space(3))) bf16x8*)(kp+2560);
  kf[4]=*(const __attribute__((address_space(3))) bf16x8*)(kp+4096); kf[5]=*(const __attribute__((address_space(3))) bf16x8*)(kp+4608);
  kf[6]=*(const __attribute__((address_space(3))) bf16x8*)(kp+6144); kf[7]=*(const __attribute__((address_space(3))) bf16x8*)(kp+6656);
}
__device__ __forceinline__ void kload2(bf16x8*kf,lds_cptr kp,int j){ kf[2*j]=*(const __attribute__((address_space(3))) bf16x8*)(kp+j*2048); kf[2*j+1]=*(const __attribute__((address_space(3))) bf16x8*)(kp+j*2048+512); }
__device__ __forceinline__ s16x4 vtr(lds_cptr p){ return __builtin_bit_cast(s16x4,__builtin_amdgcn_ds_read_tr16_b64_v4i16((__attribute__((address_space(3))) v4i16_t*)p)); }
__device__ __forceinline__ float rowmax(const f32x16&p0,const f32x16&p1){
  float a=max3f(p0[0],p0[1],p1[0]),b=max3f(p0[2],p0[3],p1[1]);a=max3f(a,p1[2],p1[3]);
  #pragma unroll
  for(int r=4;r<16;r+=4){a=max3f(a,p0[r],p0[r+1]);b=max3f(b,p0[r+2],p0[r+3]);a=max3f(a,p1[r],p1[r+1]);b=max3f(b,p1[r+2],p1[r+3]);}
  const float m=max2f(a,b);
  auto rr=__builtin_amdgcn_permlane32_swap(__float_as_uint(m),__float_as_uint(m),false,false);
  return max2f(__uint_as_float(rr[0]),__uint_as_float(rr[1]));
}
__device__ __forceinline__ void pv(f32x16*o,int vb,bf16x8 pa0,bf16x8 pa1,bf16x8 pa2,bf16x8 pa3){
  #pragma unroll
  for(int d0=0;d0<2;++d0){s16x4 lo[4],hi[4];
    #pragma unroll
    for(int ks=0;ks<4;++ks){
      asm volatile("ds_read_b64_tr_b16 %0,%1 offset:%c2":"=&v"(lo[ks]):"v"(vb),"i"(d0*4096+ks*1024):"memory");
      asm volatile("ds_read_b64_tr_b16 %0,%1 offset:%c2":"=&v"(hi[ks]):"v"(vb),"i"(d0*4096+ks*1024+512):"memory");}
    asm volatile("s_waitcnt lgkmcnt(0)":::"memory");SBAR();
    #define PK(k) (bf16x8){lo[k][0],lo[k][1],lo[k][2],lo[k][3],hi[k][0],hi[k][1],hi[k][2],hi[k][3]}
    o[d0]=__builtin_amdgcn_mfma_f32_32x32x16_bf16(pa0,PK(0),o[d0],0,0,0);
    o[d0]=__builtin_amdgcn_mfma_f32_32x32x16_bf16(pa1,PK(1),o[d0],0,0,0);
    o[d0]=__builtin_amdgcn_mfma_f32_32x32x16_bf16(pa2,PK(2),o[d0],0,0,0);
    o[d0]=__builtin_amdgcn_mfma_f32_32x32x16_bf16(pa3,PK(3),o[d0],0,0,0);
    #undef PK
  }
}

#ifndef ATTN_STORE16
#define ATTN_STORE16(p,v) (*(u32x4*)(p)=(v))
#endif
template<int THRL> __device__ __forceinline__ void attn_unit(const bf16*Qu,const bf16*__restrict__ Kh,const bf16*__restrict__ Vh,bf16*Ou,const int NT,char*shm){
  const int tid=opq_tid(),lane=tid&63,r32=lane&31,hi=lane>>5; const int wid=__builtin_amdgcn_readfirstlane(tid>>6);
  const bf16*Qw=Qu+(long)(wid*QBLK)*QP;
  const unsigned lds0=(unsigned)(uintptr_t)shm;
  float*wsf=(float*)(shm+LDS_WS)+wid*64;
  const bf16*ksrc=Kh+(long)lane*KP+wid*8;
  const bf16*vsrc=Vh+(long)(16*(wid&3)+(lane>>2))*KP+(wid>>2)*32+(lane&3)*8;
  const unsigned kdst=lds0+LDS_K+wid*1024, vdst=lds0+LDS_V+wid*1024;
  #define DMA_K(t,slot) glds16(ksrc+(long)(t)*KVBLK*KP,(unsigned)__builtin_amdgcn_readfirstlane(kdst+(slot)))
  #define DMA_V(t,slot) glds16(vsrc+(long)(t)*KVBLK*KP,(unsigned)__builtin_amdgcn_readfirstlane(vdst+(slot)))
  const int vb0=(int)(lds0+LDS_V)+((lane>>4)&1)*32+(lane&3)*8+(4*hi+((lane&15)>>2))*64;
  const char*Kbase=shm+LDS_K; bf16x8 kf[8];
  const lds_cptr shm3=(lds_cptr)shm; const lds_cptr kp0=shm3+LDS_K+hi*1024+r32*16; const lds_cptr vp0=shm3+LDS_V+((lane>>4)&1)*32+(lane&3)*8+(4*hi+((lane&15)>>2))*64;
  DMA_K(0,0);DMA_V(0,0);DMA_K(1,SLOTB);
  bf16x8 qr[4];
  #pragma unroll
  for(int d0=0;d0<4;++d0)qr[d0]=*reinterpret_cast<const bf16x8*>(&Qw[(long)r32*QP+d0*16+hi*8]);
  float mhat=0.f,l_reg=0.f;f32x16 o[2];o[0]=f32x16{};o[1]=f32x16{};f32x16 negm=f32x16{};asm volatile("":"+v"(negm));
  #define CMASK(P0,P1,t) do{}while(0)
  bool resc=false;
  #define START(P0,P1) do{ const float rm=rowmax(P0,P1); resc=false; \
    { const float dl=rm; mhat=fadd_s(mhat,dl); \
      _Pragma("unroll") for(int r=0;r<16;++r){P0[r]=fsub_s(P0[r],dl);P1[r]=fsub_s(P1[r],dl);} \
      _Pragma("unroll") for(int r=0;r<16;++r)negm[r]=-mhat; asm volatile("":"+v"(negm)); } \
    _Pragma("unroll") for(int r=0;r<16;++r)P0[r]=__builtin_amdgcn_exp2f(P0[r]); }while(0)
  #define RESC() do{ if(resc){ asm volatile("s_waitcnt lgkmcnt(0)":::"memory"); \
      _Pragma("unroll") for(int d_=0;d_<2;++d_) _Pragma("unroll") for(int r=0;r<16;++r)o[d_][r]*=wsf[crow(r,hi)]; } }while(0)
  f32x16 pA0,pA1,pB0,pB1;
  int sl_prev=0,sl_cur=0,sl_next=SLOTB;
  #define ROT() do{sl_prev=sl_cur;sl_cur=sl_next;sl_next=(sl_next==(NSLOT-1)*SLOTB)?0:sl_next+SLOTB;}while(0)
  DMA_K(2,2*SLOTB);
  WAIT_BAR(3);
  qkt(pA0,pA1,Kbase,qr,negm,r32,hi);asm volatile("s_nop 15\n\ts_nop 7":"+v"(pA0),"+v"(pA1));CMASK(pA0,pA1,0);
  START(pA0,pA1);
  _Pragma("unroll") for(int r=0;r<16;++r)pA1[r]=__builtin_amdgcn_exp2f(pA1[r]);
  WAIT_BAR(0);
  DMA_K(3,0);DMA_V(1,SLOTB);
  ROT();
  kload8(kf,kp0+sl_cur);
  WAIT_BAR(2);
  s16x4 vlo[8],vhi[8]; u32x4 pw0,pw1,pw2,pw3;
  #define PKW(P,B) cvtpk_s(P[B],P[B+1])
  #define PAF(k) __builtin_bit_cast(bf16x8,pw##k)
  #define VFR(i) (bf16x8){vlo[i][0],vlo[i][1],vlo[i][2],vlo[i][3],vhi[i][0],vhi[i][1],vhi[i][2],vhi[i][3]}
  #define PIN(x) asm volatile("":"+v"(x))
  #define MX3(a,b,c) __builtin_fmaxf(__builtin_fmaxf((a),(b)),(c))
  #define GAPA(MF,A0,A1,A2,A3,W0,W1,PW) do{ MF; sacc+=A0; sacc+=A1; sacc+=A2; sacc+=A3; PIN(sacc); W0; W1; PIN(PW); SBAR(); }while(0)
  #define EX(v) __builtin_amdgcn_exp2f(v)
  #define GAPB(MF,X,B) do{ MF; X[B]=EX(X[B]); X[B+1]=EX(X[B+1]); X[B+2]=EX(X[B+2]); X[B+3]=EX(X[B+3]); PIN(X); SBAR(); }while(0)
  #define VRD(i) do{ vlo[i]=vtr(vp_+(((i)>>2)*4096+((i)&3)*1024)); vhi[i]=vtr(vp_+(((i)>>2)*4096+((i)&3)*1024+512)); }while(0)
  #define KRD(G,j) do{ if(G){ kload2(kf,kp0+sl_next,j); SBAR(); } }while(0)
  #define STEP(C0,C1,P0,P1,t,GK,GV,GL) do{ SBAR(); \
    const lds_cptr vp_=vp0+sl_prev; \
    VRD(0); SBAR(); float sacc=(P0[0]+P0[1]); \
    GAPA(C0=__builtin_amdgcn_mfma_f32_32x32x16_bf16(kf[0],qr[0],negm,0,0,0), P0[2],P0[3],P0[4],P0[5],     pw0[0]=PKW(P0,0), pw0[1]=PKW(P0,2), pw0); \
    VRD(4); SBAR(); GAPA(C1=__builtin_amdgcn_mfma_f32_32x32x16_bf16(kf[1],qr[0],negm,0,0,0), P0[6],P0[7],P0[8],P0[9],     pw0[2]=PKW(P0,4), pw0[3]=PKW(P0,6), pw0); \
    VRD(1); SBAR(); GAPA(C0=__builtin_amdgcn_mfma_f32_32x32x16_bf16(kf[2],qr[1],C0,0,0,0),   P0[10],P0[11],P0[12],P0[13], pw1[0]=PKW(P0,8), pw1[1]=PKW(P0,10), pw1); \
    VRD(5); SBAR(); GAPA(C1=__builtin_amdgcn_mfma_f32_32x32x16_bf16(kf[3],qr[1],C1,0,0,0),   P0[14],P0[15],P1[0],P1[1],   pw1[2]=PKW(P0,12),pw1[3]=PKW(P0,14), pw1); \
    VRD(2); SBAR(); GAPA(C0=__builtin_amdgcn_mfma_f32_32x32x16_bf16(kf[4],qr[2],C0,0,0,0),   P1[2],P1[3],P1[4],P1[5],     pw2[0]=PKW(P1,0), pw2[1]=PKW(P1,2), pw2); \
    VRD(6); SBAR(); GAPA(C1=__builtin_amdgcn_mfma_f32_32x32x16_bf16(kf[5],qr[2],C1,0,0,0),   P1[6],P1[7],P1[8],P1[9],     pw2[2]=PKW(P1,4), pw2[3]=PKW(P1,6), pw2); \
    VRD(3); SBAR(); GAPA(C0=__builtin_amdgcn_mfma_f32_32x32x16_bf16(kf[6],qr[3],C0,0,0,0),   P1[10],P1[11],P1[12],P1[13], pw3[0]=PKW(P1,8), pw3[1]=PKW(P1,10), pw3); \
    VRD(7); SBAR(); GAPA(C1=__builtin_amdgcn_mfma_f32_32x32x16_bf16(kf[7],qr[3],C1,0,0,0),   P1[14],P1[15],0.f,0.f,       pw3[2]=PKW(P1,12),pw3[3]=PKW(P1,14), pw3); \
    l_reg+=sacc; \
    if(GK){DMA_K((t)+3,sl_cur);} if(GV){DMA_V((t)+1,sl_next);} \
    CMASK(C0,C1,t); \
    resc=false; if(THRL<1000){ float a=MX3(C0[0],C0[1],C1[0]),b=MX3(C0[2],C0[3],C1[1]); a=MX3(a,C1[2],C1[3]); \
      _Pragma("unroll") for(int r=4;r<16;r+=4){a=MX3(a,C0[r],C0[r+1]);b=MX3(b,C0[r+2],C0[r+3]);a=MX3(a,C1[r],C1[r+1]);b=MX3(b,C1[r+2],C1[r+3]);} \
      float rm=__builtin_fmaxf(a,b); { auto rr=__builtin_amdgcn_permlane32_swap(__float_as_uint(rm),__float_as_uint(rm),false,false); rm=__builtin_fmaxf(__uint_as_float(rr[0]),__uint_as_float(rr[1])); } \
      resc=false; \
      if(__builtin_expect(__any(rm>(float)THRL),0)){ const float dl=__builtin_fmaxf(rm,0.f); mhat+=dl; \
        _Pragma("unroll") for(int r=0;r<16;++r){C0[r]-=dl;C1[r]-=dl;} \
        _Pragma("unroll") for(int r=0;r<16;++r)negm[r]=-mhat; asm volatile("":"+v"(negm)); \
        const float f=__builtin_amdgcn_exp2f(-dl); l_reg*=f; if(hi==0)wsf[r32]=f; resc=true; } } \
    SBAR(); \
    GAPB(o[0]=__builtin_amdgcn_mfma_f32_32x32x16_bf16(PAF(0),VFR(0),o[0],0,0,0), C0,0); \
    GAPB(o[1]=__builtin_amdgcn_mfma_f32_32x32x16_bf16(PAF(0),VFR(4),o[1],0,0,0), C0,4); \
    KRD(GL,0); GAPB(o[0]=__builtin_amdgcn_mfma_f32_32x32x16_bf16(PAF(1),VFR(1),o[0],0,0,0), C0,8); \
    KRD(GL,1); GAPB(o[1]=__builtin_amdgcn_mfma_f32_32x32x16_bf16(PAF(1),VFR(5),o[1],0,0,0), C0,12); \
    KRD(GL,2); GAPB(o[0]=__builtin_amdgcn_mfma_f32_32x32x16_bf16(PAF(2),VFR(2),o[0],0,0,0), C1,0); \
    KRD(GL,3); GAPB(o[1]=__builtin_amdgcn_mfma_f32_32x32x16_bf16(PAF(2),VFR(6),o[1],0,0,0), C1,4); \
    GAPB(o[0]=__builtin_amdgcn_mfma_f32_32x32x16_bf16(PAF(3),VFR(3),o[0],0,0,0), C1,8); \
    GAPB(o[1]=__builtin_amdgcn_mfma_f32_32x32x16_bf16(PAF(3),VFR(7),o[1],0,0,0), C1,12); \
    }while(0)
  int t=1;
  #undef CMASK
  #define CMASK(P0,P1,t) do{}while(0)
  for(;t+5<NT;t+=2){
    STEP(pB0,pB1,pA0,pA1,t,true,true,true);     WAIT_BAR(2); RESC(); ROT();
    STEP(pA0,pA1,pB0,pB1,t+1,true,true,true);   WAIT_BAR(2); RESC(); ROT();
  }
  #undef CMASK
  #define CMASK(P0,P1,t) do{}while(0)
  #define ENDW(tt) do{ if((tt)+3<NT){WAIT_BAR(2);} else if((tt)+2<NT){WAIT_BAR(1);} else {WAIT_BAR(0);} }while(0)
  for(;t+1<NT;t+=2){
    STEP(pB0,pB1,pA0,pA1,t,(t+3<NT),(t+1<NT),(t+1<NT));       ENDW(t);   RESC(); ROT();
    STEP(pA0,pA1,pB0,pB1,t+1,(t+4<NT),(t+2<NT),(t+2<NT));     ENDW(t+1); RESC(); ROT();
  }
  STEP(pB0,pB1,pA0,pA1,NT-1,false,false,false); RESC();
  { float sacc=pB0[0]+pB0[1]; _Pragma("unroll") for(int r=2;r<16;++r)sacc+=pB0[r]; _Pragma("unroll") for(int r=0;r<16;++r)sacc+=pB1[r]; l_reg+=sacc;
    pw0=(u32x4){PKW(pB0,0),PKW(pB0,2),PKW(pB0,4),PKW(pB0,6)};pw1=(u32x4){PKW(pB0,8),PKW(pB0,10),PKW(pB0,12),PKW(pB0,14)};pw2=(u32x4){PKW(pB1,0),PKW(pB1,2),PKW(pB1,4),PKW(pB1,6)};pw3=(u32x4){PKW(pB1,8),PKW(pB1,10),PKW(pB1,12),PKW(pB1,14)};
    SBAR(); pv(o,vb0+sl_cur,PAF(0),PAF(1),PAF(2),PAF(3)); }
  #undef PKW
  #undef PAF
  #undef VFR
  #undef PIN
  #undef MX3
  #undef GAPA
  #undef GAPB
  #undef EX
  #undef VRD
  #undef KRD
  #undef STEP
  #undef ENDW
  {auto rr=__builtin_amdgcn_permlane32_swap(__float_as_uint(l_reg),__float_as_uint(l_reg),false,false);l_reg=__uint_as_float(rr[0])+__uint_as_float(rr[1]);}
  if(hi==0)wsf[32+r32]=l_reg;asm volatile("s_waitcnt lgkmcnt(0)":::"memory");
  float rli[16];
  #pragma unroll
  for(int r=0;r<16;++r)rli[r]=__builtin_amdgcn_rcpf(wsf[32+crow(r,hi)]);
  bf16*Ow=Ou+(long)(wid*QBLK)*QP;
  { bf16*stg=(bf16*)(shm+LDS_OST)+wid*2048;
    #pragma unroll
    for(int r=0;r<16;++r){const int orow=crow(r,hi);
      #pragma unroll
      for(int d0=0;d0<2;++d0)stg[orow*64+d0*32+r32]=__float2bfloat16(o[d0][r]*rli[r]);}
    asm volatile("s_waitcnt lgkmcnt(0)":::"memory");
    #pragma unroll
    for(int i=0;i<4;++i){const int row=i*8+(lane>>3),ch=lane&7; const u32x4 v=*(const u32x4*)(stg+row*64+ch*8); ATTN_STORE16(Ow+(long)row*QP+ch*8,v);} }
  asm volatile("s_waitcnt lgkmcnt(0)\n\ts_barrier":::"memory");
  #undef DMA_K
  #undef DMA_V
  #undef CMASK
  #undef START
  #undef RESC
  #undef ROT
}
constexpr int ATTN_LDS_BYTES=LDS_BYTES;
#undef SBAR
#undef WAIT_BAR
}

struct Args {
    const float *x, *c, *ctx, *c_ctx, *w_mod, *b_mod, *g_norm1, *g_norm2, *w_in, *q_gain, *k_gain, *sc_conv_w, *hy_conv_w, *hy_conv_b,
                *hy_w1, *hy_b1, *hy_f1, *hy_w2, *hy_b2, *hy_f2, *hy_w3, *hy_decay, *hy_bias, *w_br_att, *w_br_sc, *w_br_hy, *w_out,
                *peer_wq, *peer_subkeys, *peer_u, *peer_v, *g_final;
    float* out; unsigned char* ws;
};
struct Ctx {
    LAS unsigned char* lds; int tid, lane, wave, vcu, G;
};

__device__ __forceinline__ int inv_sigma(int src) {
    if (src < 512) { const int head = src >> 6, d = src & 63, bj = d >> 5, dd = d & 31, n = dd >> 4, f = dd & 15, fq = f >> 2, e = f & 3; return 256 * (head >> 2) + 128 * bj + 32 * (head & 3) + 8 * fq + 4 * n + e; }
    if (src < 640) { const int s = src - 512, kvh = s >> 6, d = s & 63, bj = d >> 5, dd = d & 31, n = dd >> 4, f = dd & 15, fq = f >> 2, e = f & 3; return 512 + 128 * bj + 32 * kvh + 8 * fq + 4 * n + e; }
    if (src < 768) { const int s = src - 640, kvh = s >> 6, d = s & 63, bj = d >> 5, i = d & 31; return 512 + 128 * bj + 32 * (2 + kvh) + i; }
    if (src < 2304) { const int s = src - 768, part = s >> 9, ch = s & 511;
        if (part == 0) return 768 + ch;
        return 768 + 512 + (ch >> 7) * 256 + (part == 2 ? 128 : 0) + (ch & 127); }
    return src;
}
template <bool PERMUTE>
__device__ __forceinline__ void transpose_item(const float* W, int K, int N, bf16* WT, LAS float* scr, int item, int lane) {
    const int nblk = N / 32, kb = item / nblk, nb = item % nblk, k0 = 64 * kb, n0 = 32 * nb;
#pragma unroll 8
    for (int i = 0; i < 32; ++i) { const int kk = 2 * i + (lane >> 5); scr[kk * 33 + (lane & 31)] = W[(size_t)(k0 + kk) * N + n0 + (lane & 31)]; }
    LDS_WAIT(); asm volatile("" ::: "memory");
    const int c = lane & 7;
#pragma unroll
    for (int j = 0; j < 4; ++j) { const int n = (lane >> 3) + 8 * j; const LAS float* s = scr + (8 * c) * 33 + n;
        v4u o; o.x = pk2(s[0 * 33], s[1 * 33]); o.y = pk2(s[2 * 33], s[3 * 33]); o.z = pk2(s[4 * 33], s[5 * 33]); o.w = pk2(s[6 * 33], s[7 * 33]);
        const int drow = PERMUTE ? inv_sigma(n0 + n) : (n0 + n);
        *(GAS v4u*)(WT + (size_t)drow * K + k0 + 8 * c) = o; }
    LDS_WAIT(); asm volatile("" ::: "memory");
}
__device__ __forceinline__ float silu_f(float v) { return v / (1.0f + __expf(-v)); }

__device__ __forceinline__ void p0_prologue(const Args& A, const Ctx& C) {
    unsigned char* ws = A.ws;
    const int gw = C.vcu * NWAVES + C.wave, NGW = C.G * NWAVES;
    LAS float* scr = (LAS float*)(C.lds + C.wave * 16384);
    {
        constexpr int I_IN = 16 * (IN_W / 32), I_BR = 8 * 32, I_OUT = 16 * 32, PER_L = I_IN + 3 * I_BR + I_OUT;
        for (int it = gw; it < 2 * PER_L; it += NGW) {
            const int l = it / PER_L; int r = it % PER_L;
            if (r < I_IN) { transpose_item<true>(A.w_in + (size_t)l * 1024 * IN_W, 1024, IN_W, (bf16*)(ws + WS_WIN) + (size_t)l * IN_W * 1024, scr, r, C.lane); continue; } r -= I_IN;
            if (r < 3 * I_BR) { const int br = r / I_BR; const float* W = (br == 0 ? A.w_br_att : br == 1 ? A.w_br_sc : A.w_br_hy) + (size_t)l * 512 * 1024;
                transpose_item<false>(W, 512, 1024, (bf16*)(ws + WS_WBR) + (size_t)(l * 3 + br) * 1024 * 512, scr, r % I_BR, C.lane); continue; } r -= 3 * I_BR;
            transpose_item<false>(A.w_out + (size_t)l * 1024 * 1024, 1024, 1024, (bf16*)(ws + WS_WOUT) + (size_t)l * 1024 * 1024, scr, r, C.lane);
        }
    }
    for (int i = (C.vcu * NTHREADS + C.tid); i < 256 * 16; i += C.G * NTHREADS) {
        const int pos = i >> 4, f = i & 15; const float inv = powf(10000.0f, -(float)f * (1.0f / 16.0f)), ang = (float)pos * inv;
        ((float*)(ws + WS_ROPE))[i] = cosf(ang); ((float*)(ws + WS_ROPE))[4096 + i] = sinf(ang);
    }
    {
        LAS float* hs = (LAS float*)(C.lds + C.wave * 16384);
        const int j = C.lane;
#pragma unroll 1
        for (int l = 0; l < 2; ++l) {
            const float* w1 = A.hy_w1 + (size_t)l * HY_EMB * 64; const float* w2 = A.hy_w2 + (size_t)l * 64 * 64;
            float w1r[33], w2r[64];
#pragma unroll
            for (int k = 0; k < 33; ++k) w1r[k] = w1[k * 64 + j];
#pragma unroll
            for (int k = 0; k < 64; ++k) w2r[k] = w2[k * 64 + j];
            const float b1 = A.hy_b1[l * 64 + j], f1 = A.hy_f1[l * 64 + j], b2 = A.hy_b2[l * 64 + j], f2 = A.hy_f2[l * 64 + j];
#pragma unroll 1
            for (int tt = gw; tt < SEQ + CTX_LEN; tt += NGW) {
                const bool isc = tt >= SEQ; const int t = isc ? tt - SEQ : tt, L = isc ? CTX_LEN : SEQ;
                const float tl = (float)t / (float)(L - 1), w = 6.2831855f * (float)t / (float)L;
                float a = b1 + tl * w1r[0];
                float ck, sk;
                { const int kb = j & 15; const float band = 1e-4f + (float)kb * ((15.0f - 1e-4f) / 15.0f), ang = band * w; ck = cosf(ang); sk = sinf(ang); }
#pragma unroll
                for (int k = 0; k < 16; ++k) { const float c_ = __builtin_bit_cast(float, __builtin_amdgcn_readlane(__builtin_bit_cast(int, ck), k)), s_ = __builtin_bit_cast(float, __builtin_amdgcn_readlane(__builtin_bit_cast(int, sk), k));
                    a += c_ * w1r[1 + k] - s_ * w1r[17 + k]; }
                const float h1 = sinf(f1 * a);
                LDS_WAIT(); hs[j] = h1; LDS_WAIT(); asm volatile("" ::: "memory");
                float b = b2;
#pragma unroll
                for (int k = 0; k < 64; ++k) b += hs[k] * w2r[k];
                const float h2 = sinf(f2 * b);
                if (isc) ((float*)(ws + WS_H2C))[(size_t)(l * 64 + j) * CTX_LEN + t] = h2; else ((bf16*)(ws + WS_H2))[((size_t)l * SEQ + t) * 64 + j] = (bf16)f2bf(h2);
                asm volatile("" ::: "memory");
            }
        }
    }
    __syncthreads();
    {
        LAS float* red = (LAS float*)C.lds;
        LAS float* sc = (LAS float*)(C.lds + 8192);
        if (C.vcu < 2 * 96) { for (int i = C.tid; i < 3072; i += NTHREADS) sc[i] = silu_f(i < 2048 ? A.c[i] : A.c_ctx[i - 2048]); }
        __syncthreads();
        for (int it = C.vcu; it < 2 * 96; it += C.G) {
            const int l = it / 96, n = (it % 96) * 64 + C.lane;
            const float* W = A.w_mod + (size_t)l * 1024 * 6144 + n;
            float s0 = 0.f, s1 = 0.f, s2 = 0.f;
#pragma unroll 8
            for (int kk = 0; kk < 128; ++kk) { const int k = C.wave * 128 + kk; const float wv = W[(size_t)k * 6144];
                s0 += sc[k] * wv; s1 += sc[1024 + k] * wv; s2 += sc[2048 + k] * wv; }
            red[(C.wave * 3 + 0) * 64 + C.lane] = s0; red[(C.wave * 3 + 1) * 64 + C.lane] = s1; red[(C.wave * 3 + 2) * 64 + C.lane] = s2;
            __syncthreads();
            if (C.wave < 3) { float s = A.b_mod[l * 6144 + n];
#pragma unroll
                for (int w8 = 0; w8 < 8; ++w8) s += red[(w8 * 3 + C.wave) * 64 + C.lane];
                ((float*)(ws + WS_MOD))[(size_t)(l * 3 + C.wave) * 6144 + n] = s; }
            __syncthreads();
        }
    }
    {
        LAS float* sk = (LAS float*)C.lds;
        LAS float* wq = (LAS float*)(C.lds + 128 * 65 * 4);
        for (int it = C.vcu; it < 2 * 16 * 16; it += C.G) {
            const int l = it >> 8, hp = (it >> 4) & 15, kc = it & 15, k0 = kc * 64;
            const float* SK = A.peer_subkeys + ((size_t)l * 16 + hp) * 128 * 64;
            for (int i = C.tid; i < 128 * 64; i += NTHREADS) sk[(i >> 6) * 65 + (i & 63)] = SK[i];
            const float* WQ = A.peer_wq + (size_t)l * 1024 * 1024 + hp * 64;
            for (int i = C.tid; i < 64 * 64; i += NTHREADS) wq[(i >> 6) * 65 + (i & 63)] = WQ[(size_t)(k0 + (i >> 6)) * 1024 + (i & 63)];
            __syncthreads();
            bf16* WP = (bf16*)(ws + WS_WPEER) + ((size_t)l * 2048 + hp * 128) * 1024 + k0;
            {
                const int n0 = (C.tid >> 4) * 4, kq = (C.tid & 15) * 4; float s[4][4];
#pragma unroll
                for (int i = 0; i < 4; ++i)
#pragma unroll
                    for (int jj = 0; jj < 4; ++jj) s[i][jj] = 0.f;
#pragma unroll 4
                for (int d = 0; d < 64; ++d) { float a[4], b[4];
#pragma unroll
                    for (int i = 0; i < 4; ++i) { a[i] = sk[(n0 + i) * 65 + d]; b[i] = wq[(kq + i) * 65 + d]; }
#pragma unroll
                    for (int i = 0; i < 4; ++i)
#pragma unroll
                        for (int jj = 0; jj < 4; ++jj) s[i][jj] += a[i] * b[jj]; }
#pragma unroll
                for (int i = 0; i < 4; ++i) *(GAS v2u*)(WP + (size_t)(n0 + i) * 1024 + kq) = (v2u){pk2(s[i][0], s[i][1]), pk2(s[i][2], s[i][3])};
            }
            __syncthreads();
        }
    }
}

__device__ __forceinline__ void norm_rows(const Ctx& C, const float* xlat, const float* xctx, int nrows, const float* g, const float* mod  , int shi, bf16* XN) {
    const int gw = C.vcu * NWAVES + C.wave, NGW = C.G * NWAVES;
    f32x4 gv[4];
#pragma unroll
    for (int j = 0; j < 4; ++j) gv[j] = ((const f32x4*)g)[C.lane + 64 * j];
    for (int r = gw; r < nrows; r += NGW) {
        const bool latent = r < ML;
        const float* xr = latent ? xlat + (size_t)r * 1024 : xctx + (size_t)(r - ML) * 1024;
        const float* mp = mod + (latent ? (r >> 14) : 2) * 6144 + shi * 1024;
        f32x4 v[4]; float s = 0.f;
#pragma unroll
        for (int j = 0; j < 4; ++j) { v[j] = ((const GAS f32x4*)xr)[C.lane + 64 * j]; s += (v[j].x * v[j].x + v[j].y * v[j].y) + (v[j].z * v[j].z + v[j].w * v[j].w); }
        const float rstd = 1.0f / sqrtf(wave_sum(s) * (1.0f / 1024.0f) + EPS);
        GAS unsigned long long* o8 = (GAS unsigned long long*)(XN + (size_t)r * 1024) + C.lane;
#pragma unroll
        for (int j = 0; j < 4; ++j) { const f32x4 sh = ((const f32x4*)mp)[C.lane + 64 * j], sc = ((const f32x4*)(mp + 1024))[C.lane + 64 * j];
            const f32x4 y = v[j] * rstd * gv[j] * (sc + 1.0f) + sh;
            o8[64 * j] = (unsigned long long)pk2(y.x, y.y) | ((unsigned long long)pk2(y.z, y.w) << 32); }
    }
}

__device__ __forceinline__ void ysc_pass(const Ctx& C, bf16* BG, const bf16* CX, const float* w  , int nrows) {
    const long total = (long)nrows * 64;
    for (long i = (long)C.vcu * NTHREADS + C.tid; i < total; i += (long)C.G * NTHREADS) {
        const int r = (int)(i >> 6), c8 = (int)(i & 63) * 8;
        int t, L; if (r < ML) { t = r & (SEQ - 1); L = SEQ; } else { t = (r - ML) & (CTX_LEN - 1); L = CTX_LEN; }
        const v4u z4 = (v4u){0u, 0u, 0u, 0u};
        const int rm = (t > 0) ? r - 1 : r, rp = (t < L - 1) ? r + 1 : r;
        const v4u cmv = *(const GAS v4u*)(CX + (size_t)rm * 512 + c8);
        const v4u c0 = *(const GAS v4u*)(CX + (size_t)r * 512 + c8);
        const v4u cpv = *(const GAS v4u*)(CX + (size_t)rp * 512 + c8);
        const v4u cm = (t > 0) ? cmv : z4, cp = (t < L - 1) ? cpv : z4;
        const v4u bg = *(const GAS v4u*)(BG + (size_t)r * 512 + c8);
        f32x4 w0a = *(const f32x4*)(w + c8), w0b = *(const f32x4*)(w + c8 + 4), w1a = *(const f32x4*)(w + 512 + c8), w1b = *(const f32x4*)(w + 512 + c8 + 4), w2a = *(const f32x4*)(w + 1024 + c8), w2b = *(const f32x4*)(w + 1024 + c8 + 4);
        f32x4 ma, mb, ca, cb, pa, pb, ga, gb; pg8::unpack8(cm, ma, mb); pg8::unpack8(c0, ca, cb); pg8::unpack8(cp, pa, pb); pg8::unpack8(bg, ga, gb);
        const f32x4 ya = ga * (w0a * ma + w1a * ca + w2a * pa), yb = gb * (w0b * mb + w1b * cb + w2b * pb);
        *(GAS v4u*)(BG + (size_t)r * 512 + c8) = pg8::pack8(ya, yb);
    }
}

__device__ __forceinline__ void yhy_transpose(const Ctx& C, const bf16* YHYT, bf16* YHY, bool with_ctx) {
    LAS unsigned short* scr = (LAS unsigned short*)(C.lds + C.wave * 16384);
    const int gw = C.vcu * NWAVES + C.wave, NGW = C.G * NWAVES;
    const int NLAT = 2 * 8 * 256, NIT = NLAT + (with_ctx ? 2 * 8 * 4 : 0);
    for (int it = gw; it < NIT; it += NGW) {
        const bf16* src; size_t pitch; size_t row0; int cb;
        if (it < NLAT) { const int b = it >> 11, r = it & 2047; cb = r >> 8; const int tb = r & 255; src = YHYT + ((size_t)(b * 512 + cb * 64)) * SEQ + tb * 64; pitch = SEQ; row0 = (size_t)b * SEQ + tb * 64; }
        else { const int q = it - NLAT, b = q >> 5, r = q & 31; cb = r >> 2; const int tb = r & 3; src = YHYT + (size_t)BATCH * 512 * SEQ + ((size_t)(b * 512 + cb * 64)) * CTX_LEN + tb * 64; pitch = CTX_LEN; row0 = (size_t)ML + b * CTX_LEN + tb * 64; }
#pragma unroll 8
        for (int i = 0; i < 32; ++i) { const int c = 2 * i + (C.lane >> 5); const unsigned w = *(const GAS unsigned*)(src + (size_t)c * pitch + (C.lane & 31) * 2);
            scr[c * 66 + (C.lane & 31) * 2] = (unsigned short)(w & 0xffffu); scr[c * 66 + (C.lane & 31) * 2 + 1] = (unsigned short)(w >> 16); }
        LDS_WAIT(); asm volatile("" ::: "memory");
        const int ch = C.lane & 7;
#pragma unroll
        for (int j = 0; j < 8; ++j) { const int t = (C.lane >> 3) + 8 * j; const LAS unsigned short* s = scr + (8 * ch) * 66 + t;
            v4u o; o.x = (unsigned)s[0] | ((unsigned)s[66] << 16); o.y = (unsigned)s[2 * 66] | ((unsigned)s[3 * 66] << 16); o.z = (unsigned)s[4 * 66] | ((unsigned)s[5 * 66] << 16); o.w = (unsigned)s[6 * 66] | ((unsigned)s[7 * 66] << 16);
            *(GAS v4u*)(YHY + (row0 + t) * 512 + cb * 64 + 8 * ch) = o; }
        LDS_WAIT(); asm volatile("" ::: "memory");
    }
}

__device__ __forceinline__ void cvt_table(const Ctx& C, const float* src, bf16* dst, size_t n) {
    const size_t n8 = n / 8;
    for (size_t i = (size_t)C.vcu * NTHREADS + C.tid; i < n8; i += (size_t)C.G * NTHREADS) {
        const f32x4 a = ((const GAS f32x4*)src)[2 * i], b = ((const GAS f32x4*)src)[2 * i + 1];
        v4u o; o.x = pk2(a.x, a.y); o.y = pk2(a.z, a.w); o.z = pk2(b.x, b.y); o.w = pk2(b.z, b.w);
        ((GAS v4u*)dst)[i] = o;
    }
}

__device__ __forceinline__ void cvt_table_fp6(const Ctx& C, const float* src, unsigned char* dst, float* deq, int rows, int cu = -1, int ncu = 0) {
    const int gw = (cu < 0 ? C.vcu : cu) * NWAVES + C.wave, NGW = (cu < 0 ? C.G : ncu) * NWAVES, lp = C.lane & 31, half = C.lane >> 5;
    for (int r2 = gw; r2 < rows / 2; r2 += NGW) {
        const int r = 2 * r2 + half;
        const GAS f32x4* s = (const GAS f32x4*)(src + (size_t)r * 1024) + 8 * lp;
        f32x4 v[8]; float mx = 0.f;
#pragma unroll
        for (int j = 0; j < 8; ++j) { v[j] = s[j]; mx = fmaxf(mx, fmaxf(fmaxf(fabsf(v[j].x), fabsf(v[j].y)), fmaxf(fabsf(v[j].z), fabsf(v[j].w)))); }
        mx = fmaxf(mx, __shfl_xor(mx, 16)); mx = fmaxf(mx, __shfl_xor(mx, 8)); mx = fmaxf(mx, __shfl_xor(mx, 4)); mx = fmaxf(mx, __shfl_xor(mx, 2)); mx = fmaxf(mx, __shfl_xor(mx, 1));
        const float sc = mx > 0.f ? 7.5f / mx : 1.0f;
        v16f a, b;
#pragma unroll
        for (int i = 0; i < 16; ++i) {
#if FP6_ILV
            const int ia = 2 * i, ib = 2 * i + 1;
#else
            const int ia = i, ib = 16 + i;
#endif
            a[i] = v[ia >> 2][ia & 3] * sc; b[i] = v[ib >> 2][ib & 3] * sc; }
        const v6i w = __builtin_amdgcn_cvt_scalef32_2xpk16_fp6_f32(a, b, 1.0f);
        unsigned char* d = dst + (size_t)r * 768;
        *(GAS v4u*)(d + 16 * lp) = (v4u){(unsigned)w[0], (unsigned)w[1], (unsigned)w[2], (unsigned)w[3]};
        *(GAS v2u*)(d + 512 + 8 * lp) = (v2u){(unsigned)w[4], (unsigned)w[5]};
        if (lp == 0) deq[r] = mx > 0.f ? mx * (1.0f / 7.5f) : 1.0f;
    }
}
__device__ __forceinline__ void cvt_table_fp8(const Ctx& C, const float* src, unsigned char* dst, float* deq, int rows) {
    const int gw = C.vcu * NWAVES + C.wave, NGW = C.G * NWAVES;
    for (int r = gw; r < rows; r += NGW) {
        const GAS f32x4* s = (const GAS f32x4*)(src + (size_t)r * 1024) + 4 * C.lane;
        f32x4 v[4]; float mx = 0.f;
#pragma unroll
        for (int j = 0; j < 4; ++j) { v[j] = s[j]; mx = fmaxf(mx, fmaxf(fmaxf(fabsf(v[j].x), fabsf(v[j].y)), fmaxf(fabsf(v[j].z), fabsf(v[j].w)))); }
        mx = wave_max(mx);
        const float sc = mx > 0.f ? 240.0f / mx : 1.0f;
        v4u o;
#pragma unroll
        for (int j = 0; j < 4; ++j) { int w = 0; w = __builtin_amdgcn_cvt_pk_fp8_f32(v[j].x * sc, v[j].y * sc, w, false); w = __builtin_amdgcn_cvt_pk_fp8_f32(v[j].z * sc, v[j].w * sc, w, true); o[j] = (unsigned)w; }
        *(GAS v4u*)(dst + (size_t)r * 1024 + 16 * C.lane) = o;
        if (C.lane == 0) deq[r] = mx > 0.f ? mx * (1.0f / 240.0f) : 1.0f;
    }
}

namespace hy {
constexpr int L = SEQ, NFFT = 2 * SEQ;
__device__ __forceinline__ int cidx(int p) { return p + ((p >> 6) << 2); }
__device__ __forceinline__ f32x2 cmul(f32x2 a, f32x2 b) { return (f32x2){a.x * b.x - a.y * b.y, a.x * b.y + a.y * b.x}; }
__device__ __forceinline__ f32x2 cmulc(f32x2 a, f32x2 b) { return (f32x2){a.x * b.x + a.y * b.y, a.y * b.x - a.x * b.y}; }
__device__ __forceinline__ f32x2 twid(float frac) { return (f32x2){__builtin_amdgcn_cosf(frac), -__builtin_amdgcn_sinf(frac)}; }
__device__ __forceinline__ unsigned cpack(f32x2 v) { return pk2(v.x, v.y); }
__device__ __forceinline__ f32x2 cunpack(unsigned w) { return (f32x2){bflo(w), bfhi(w)}; }
__device__ __forceinline__ f32x2 w16(int k) {
    constexpr float c1 = 0.9238795325112867f, s1 = 0.3826834323650898f, r2 = 0.7071067811865476f;
    switch (k) { case 0: return (f32x2){1.f, 0.f}; case 1: return (f32x2){c1, -s1}; case 2: return (f32x2){r2, -r2}; case 3: return (f32x2){s1, -c1};
                 case 4: return (f32x2){0.f, -1.f}; case 5: return (f32x2){-s1, -c1}; case 6: return (f32x2){-r2, -r2}; default: return (f32x2){-c1, -s1}; }
}
__device__ __forceinline__ void fwd16(LAS f32x2* buf, int base, int j0, int n) {
    const int st = n >> 4; f32x2 v[16];
#pragma unroll
    for (int m = 0; m < 16; ++m) v[m] = buf[cidx(base + j0 + m * st)];
    f32x2 w[4]; w[0] = twid((float)j0 / (float)n); w[1] = cmul(w[0], w[0]); w[2] = cmul(w[1], w[1]); w[3] = cmul(w[2], w[2]);
#pragma unroll
    for (int q = 0; q < 4; ++q) { const int span = 8 >> q;
#pragma unroll
        for (int m = 0; m < 16; ++m) if (((m / span) & 1) == 0) { const int mp = m % span;
            const f32x2 a = v[m], b = v[m + span], d = a - b; v[m] = a + b;
            v[m + span] = (mp == 0) ? cmul(d, w[q]) : cmul(cmul(d, w16(mp << q)), w[q]); } }
#pragma unroll
    for (int m = 0; m < 16; ++m) buf[cidx(base + j0 + m * st)] = v[m];
}
__device__ __forceinline__ void inv16(LAS f32x2* buf, int base, int j0, int nlo) {
    f32x2 v[16];
#pragma unroll
    for (int m = 0; m < 16; ++m) v[m] = buf[cidx(base + j0 + m * nlo)];
    f32x2 pw[4]; pw[3] = twid((float)j0 / (float)(nlo * 16)); pw[2] = cmul(pw[3], pw[3]); pw[1] = cmul(pw[2], pw[2]); pw[0] = cmul(pw[1], pw[1]);
#pragma unroll
    for (int q = 0; q < 4; ++q) { const int span = 1 << q;
#pragma unroll
        for (int m = 0; m < 16; ++m) if (((m / span) & 1) == 0) { const int mp = m % span;
            const f32x2 a = v[m]; f32x2 b = cmulc(v[m + span], pw[q]); if (mp != 0) b = cmulc(b, w16(mp << (3 - q)));
            v[m] = a + b; v[m + span] = a - b; } }
#pragma unroll
    for (int m = 0; m < 16; ++m) buf[cidx(base + j0 + m * nlo)] = v[m];
}
__device__ __forceinline__ void fwd4_last(LAS f32x2* buf, int base) {
    f32x2 a = buf[cidx(base)], b = buf[cidx(base + 1)], c = buf[cidx(base + 2)], d = buf[cidx(base + 3)];
    const f32x2 s0 = a + c, d0 = a - c, s1 = b + d, t = b - d; const f32x2 d1 = (f32x2){t.y, -t.x};
    buf[cidx(base)] = s0 + s1; buf[cidx(base + 1)] = s0 - s1; buf[cidx(base + 2)] = d0 + d1; buf[cidx(base + 3)] = d0 - d1;
}
__device__ __forceinline__ void inv4_first(LAS f32x2* buf, int base) {
    f32x2 a = buf[cidx(base)], b = buf[cidx(base + 1)], c = buf[cidx(base + 2)], d = buf[cidx(base + 3)];
    const f32x2 s0 = a + b, d0 = a - b, s1 = c + d, t = c - d; const f32x2 d1 = (f32x2){-t.y, t.x};
    buf[cidx(base)] = s0 + s1; buf[cidx(base + 2)] = s0 - s1; buf[cidx(base + 1)] = d0 + d1; buf[cidx(base + 3)] = d0 - d1;
}
__device__ __forceinline__ void fft_fwd(LAS f32x2* buf, int tid) {
#pragma unroll 1
    for (int k = 0; k < 2; ++k) { const int bf = tid + 512 * k; fwd16(buf, 0, bf, 16384); }
    __syncthreads();
#pragma unroll 1
    for (int k = 0; k < 2; ++k) { const int bf = tid + 512 * k; fwd16(buf, (bf >> 6) * 1024, bf & 63, 1024); }
    __syncthreads();
#pragma unroll 1
    for (int k = 0; k < 2; ++k) { const int bf = tid + 512 * k; fwd16(buf, (bf >> 2) * 64, bf & 3, 64); }
    __syncthreads();
#pragma unroll 1
    for (int k = 0; k < 8; ++k) { const int bf = tid + 512 * k; fwd4_last(buf, 4 * bf); }
    __syncthreads();
}
__device__ __forceinline__ void fft_inv(LAS f32x2* buf, int tid) {
#pragma unroll 1
    for (int k = 0; k < 8; ++k) { const int bf = tid + 512 * k; inv4_first(buf, 4 * bf); }
    __syncthreads();
#pragma unroll 1
    for (int k = 0; k < 2; ++k) { const int bf = tid + 512 * k; inv16(buf, (bf >> 2) * 64, bf & 3, 4); }
    __syncthreads();
#pragma unroll 1
    for (int k = 0; k < 2; ++k) { const int bf = tid + 512 * k; inv16(buf, (bf >> 6) * 1024, bf & 63, 64); }
    __syncthreads();
#pragma unroll 1
    for (int k = 0; k < 2; ++k) { const int bf = tid + 512 * k; inv16(buf, 0, bf, 1024); }
    __syncthreads();
}
__device__ __forceinline__ void fft_fwd_pack(LAS f32x2* buf, int tid, GAS v4u* slot) {
#pragma unroll 1
    for (int k = 0; k < 2; ++k) { const int bf = tid + 512 * k; fwd16(buf, 0, bf, 16384); }
    __syncthreads();
#pragma unroll 1
    for (int k = 0; k < 2; ++k) { const int bf = tid + 512 * k; fwd16(buf, (bf >> 6) * 1024, bf & 63, 1024); }
    __syncthreads();
#pragma unroll 1
    for (int k = 0; k < 2; ++k) { const int bf = tid + 512 * k; fwd16(buf, (bf >> 2) * 64, bf & 3, 64); }
    __syncthreads();
#pragma unroll
    for (int k = 0; k < 8; ++k) { const int p = cidx(4 * (tid + 512 * k));
        const f32x2 a = buf[p], b = buf[p + 1], c = buf[p + 2], d = buf[p + 3];
        const f32x2 s0 = a + c, d0 = a - c, s1 = b + d, t = b - d; const f32x2 d1 = (f32x2){t.y, -t.x};
        slot[512 * k] = (v4u){cpack(s0 + s1), cpack(s0 - s1), cpack(d0 + d1), cpack(d0 - d1)}; if (k & 1) __builtin_amdgcn_sched_barrier(0); }
}
__device__ __forceinline__ void fft_conv(LAS f32x2* buf, int tid, const GAS v4u* slot) {
#pragma unroll 1
    for (int k = 0; k < 2; ++k) { const int bf = tid + 512 * k; fwd16(buf, 0, bf, 16384); }
    __syncthreads();
#pragma unroll 1
    for (int k = 0; k < 2; ++k) { const int bf = tid + 512 * k; fwd16(buf, (bf >> 6) * 1024, bf & 63, 1024); }
    __syncthreads();
    v4u spv[8];
#pragma unroll
    for (int k = 0; k < 8; ++k) spv[k] = slot[512 * k];
    __builtin_amdgcn_sched_barrier(0);
#pragma unroll 1
    for (int k = 0; k < 2; ++k) { const int bf = tid + 512 * k; fwd16(buf, (bf >> 2) * 64, bf & 3, 64); }
    __syncthreads();
#pragma unroll
    for (int k = 0; k < 8; ++k) { const int p = cidx(4 * (tid + 512 * k)); const v4u sp = spv[k];
        f32x2 a = buf[p], b = buf[p + 1], c = buf[p + 2], d = buf[p + 3];
        { const f32x2 s0 = a + c, d0 = a - c, s1 = b + d, t = b - d; const f32x2 d1 = (f32x2){t.y, -t.x};
          a = cmul(s0 + s1, cunpack(sp[0])); b = cmul(s0 - s1, cunpack(sp[1])); c = cmul(d0 + d1, cunpack(sp[2])); d = cmul(d0 - d1, cunpack(sp[3])); }
        { const f32x2 s0 = a + b, d0 = a - b, s1 = c + d, t = c - d; const f32x2 d1 = (f32x2){-t.y, t.x};
          buf[p] = s0 + s1; buf[p + 2] = s0 - s1; buf[p + 1] = d0 + d1; buf[p + 3] = d0 - d1; } if (k & 1) __builtin_amdgcn_sched_barrier(0); }
    __syncthreads();
#pragma unroll 1
    for (int k = 0; k < 2; ++k) { const int bf = tid + 512 * k; inv16(buf, (bf >> 2) * 64, bf & 3, 4); }
    __syncthreads();
#pragma unroll 1
    for (int k = 0; k < 2; ++k) { const int bf = tid + 512 * k; inv16(buf, (bf >> 6) * 1024, bf & 63, 64); }
    __syncthreads();
#pragma unroll 1
    for (int k = 0; k < 2; ++k) { const int bf = tid + 512 * k; inv16(buf, 0, bf, 1024); }
    __syncthreads();
}
__device__ __forceinline__ float conv3_at(const bf16* P, int t, int T, float w0, float w1, float w2, float cb) {
    const int tm = t > 0 ? t - 1 : 0, tp = t < T - 1 ? t + 1 : T - 1;
    const float vm = bf1(P[tm]), v0 = bf1(P[t]), vp = bf1(P[tp]);
    const float pm = t > 0 ? vm : 0.f, pp = t < T - 1 ? vp : 0.f;
    return w0 * pm + w1 * v0 + w2 * pp + cb;
}
__device__ __forceinline__ float wave_sum_t(float v, int tid) {
#pragma unroll
    for (int m = 1; m < 64; m <<= 1) v += __builtin_bit_cast(float, __builtin_amdgcn_ds_bpermute(((tid ^ m) & 63) << 2, __builtin_bit_cast(int, v)));
    return v;
}
__device__ __forceinline__ float block_sum(float v, LAS float* red, int wave, int lane, int tid) {
    v = wave_sum_t(v, tid);
    __syncthreads();
    if (lane == 0) red[wave] = v;
    __syncthreads();
    float s = 0.f;
#pragma unroll
    for (int w = 0; w < 8; ++w) s += red[w];
    return s;
}

__device__ __forceinline__ void hyena_unit(const Args& A, const Ctx& C, int l_, int c_, bool with_ctx) {
    const int l = __builtin_amdgcn_readfirstlane(l_), c0 = __builtin_amdgcn_readfirstlane(c_);
#define OPQC() int c = c0; asm volatile("" : "+s"(c))
    OPQC();
    unsigned char* ws = A.ws;
    LAS f32x2* buf = (LAS f32x2*)C.lds;
    LAS float* sW = (LAS float*)(C.lds + HYS_OFF);
    LAS float* red = sW + 256;
    const int tid0 = C.tid;
#define OPQ() int tid = tid0; asm volatile("" : "+v"(tid))
    const bf16* HYT = (const bf16*)(ws + WS_R1);
    const bf16* HYTC = (const bf16*)(ws + WS_HYTC);
    bf16* YT = (bf16*)(ws + WS_YHYT);
#define SZ ((GAS v4u*)(ws + WS_HSCR) + (size_t)blockIdx.x * 8192 + tid)
#define SA (SZ + 4096)
#define SB ((GAS v4u*)(ws + WS_YHY) + (size_t)blockIdx.x * 4096 + tid)
#define SF ((GAS v4u*)(ws + WS_YHY) + (size_t)(256 + blockIdx.x) * 4096 + tid)
    __syncthreads();
    { OPQ(); if (tid < 256) { const int od = tid >> 6, j = tid & 63; sW[tid] = A.hy_w3[((size_t)l * 64 + j) * 2048 + od * 512 + c]; } }
    __syncthreads();
#define HY_CW(X, k) (A.hy_conv_w[((size_t)l * 3 + (k)) * 1536 + (X) * 512 + c])
#define HY_CB(X) (A.hy_conv_b[l * 1536 + (X) * 512 + c])
#define HY_CONV4(u, P, t0, w0, w1, w2, wb) do { const v2u w_ = *(const GAS v2u*)((P) + (t0)); const int tl_ = (t0) > 0 ? (t0) - 1 : 0, tr_ = (t0) + 4 < L ? (t0) + 4 : L - 1; \
        const float xl_ = (t0) > 0 ? bf1((P)[tl_]) : 0.f, xr_ = (t0) + 4 < L ? bf1((P)[tr_]) : 0.f, x0_ = bflo(w_.x), x1_ = bfhi(w_.x), x2_ = bflo(w_.y), x3_ = bfhi(w_.y); \
        u[0] = (w0) * xl_ + (w1) * x0_ + (w2) * x1_ + (wb); u[1] = (w0) * x0_ + (w1) * x1_ + (w2) * x2_ + (wb); u[2] = (w0) * x1_ + (w1) * x2_ + (w2) * x3_ + (wb); u[3] = (w0) * x2_ + (w1) * x3_ + (w2) * xr_ + (wb); } while (0)
#define HY_RAW(P, t0, W, XL, XR) do { W = *(const GAS v2u*)((P) + (t0)); XL = (P)[(t0) > 0 ? (t0) - 1 : 0]; XR = (P)[(t0) + 4 < L ? (t0) + 4 : L - 1]; } while (0)
#define HY_CALC(u, W, XL, XR, t0, w0, w1, w2, wb) do { const float xl_ = (t0) > 0 ? bf1(XL) : 0.f, xr_ = (t0) + 4 < L ? bf1(XR) : 0.f, x0_ = bflo(W.x), x1_ = bfhi(W.x), x2_ = bflo(W.y), x3_ = bfhi(W.y); \
        u[0] = (w0) * xl_ + (w1) * x0_ + (w2) * x1_ + (wb); u[1] = (w0) * x0_ + (w1) * x1_ + (w2) * x2_ + (wb); u[2] = (w0) * x1_ + (w1) * x2_ + (w2) * x3_ + (wb); u[3] = (w0) * x2_ + (w1) * x3_ + (w2) * xr_ + (wb); } while (0)
    float inv0, inv1;
    {
        OPQ();
        const int lane = tid & 63, wv = __builtin_amdgcn_readfirstlane(tid >> 6), col = lane & 15, kg = lane >> 4;
        const float dec0 = fabsf(A.hy_decay[((size_t)l * 2 + 0) * 512 + c]), dec1 = fabsf(A.hy_decay[((size_t)l * 2 + 1) * 512 + c]);
        bf16x8 af[2];
#pragma unroll
        for (int s2 = 0; s2 < 2; ++s2)
#pragma unroll
            for (int jj = 0; jj < 8; ++jj) { const int j = 32 * s2 + 8 * kg + jj; const float w = A.hy_w3[((size_t)l * 64 + j) * 2048 + (col & 3) * 512 + c]; af[s2][jj] = (short)f2bf(col < 4 ? w : 0.f); }
        const bf16* H2T = (const bf16*)(ws + WS_H2) + (size_t)l * L * 64;
        GAS unsigned* SFF = (GAS unsigned*)((GAS v4u*)(ws + WS_YHY) + (size_t)(256 + blockIdx.x) * 4096);
        float as0 = 0.f, as1 = 0.f;
#define HYF_LOAD(B, bt) { _Pragma("unroll") for (int i = 0; i < 8; ++i) { const int t = 2048 * wv + 16 * (8 * (bt) + i) + col; \
            B[i][0] = *(const GAS bf16x8*)(H2T + (size_t)t * 64 + 8 * kg); B[i][1] = *(const GAS bf16x8*)(H2T + (size_t)t * 64 + 32 + 8 * kg); } }
#define HYF_USE(B, bt) { _Pragma("unroll") for (int i = 0; i < 8; ++i) { const int t = 2048 * wv + 16 * (8 * (bt) + i) + col; \
            f32x4 acc = (f32x4){0.f, 0.f, 0.f, 0.f}; \
            acc = __builtin_amdgcn_mfma_f32_16x16x32_bf16(af[0], B[i][0], acc, 0, 0, 0); \
            acc = __builtin_amdgcn_mfma_f32_16x16x32_bf16(af[1], B[i][1], acc, 0, 0, 0); \
            if (kg == 0) { const float tl = (float)t * (1.0f / (float)(L - 1)); const float w0 = __expf(-tl * dec0), w1 = __expf(-tl * dec1); \
                const float h0 = acc[0] * w0, h1 = acc[1] * w0, h2 = acc[2] * w1, h3 = acc[3] * w1; \
                as0 += fabsf(h0) + fabsf(h1); as1 += fabsf(h2) + fabsf(h3); \
                buf[cidx(t)] = (f32x2){h0, h1}; SFF[t] = pk2(h2, h3); } } }
        bf16x8 fa_[8][2], fb_[8][2];
        HYF_LOAD(fa_, 0)
#pragma unroll 1
        for (int bt = 0; bt < 16; bt += 2) {
            HYF_LOAD(fb_, bt + 1)
            HYF_USE(fa_, bt)
            if (bt + 2 < 16) HYF_LOAD(fa_, bt + 2)
            HYF_USE(fb_, bt + 1)
        }
#undef HYF_LOAD
#undef HYF_USE
        inv0 = 1.0f / block_sum(as0, red, C.wave, C.lane, tid);
        inv1 = 1.0f / block_sum(as1, red, C.wave, C.lane, tid);
        __syncthreads();
    }
    {
        OPQ();
        const float v0 = HY_CW(0, 0), v1 = HY_CW(0, 1), v2 = HY_CW(0, 2), vb = HY_CB(0);
        v2u ra[8], rb[8]; bf16 la[8], ha[8], lb[8], hb_[8];
#pragma unroll
        for (int g = 0; g < 8; ++g) { const int t0 = 2048 * g + 4 * tid; HY_RAW(HYT + ((size_t)(0 * 1536 + c)) * L, t0, ra[g], la[g], ha[g]); HY_RAW(HYT + ((size_t)(1 * 1536 + c)) * L, t0, rb[g], lb[g], hb_[g]); }
#pragma unroll
        for (int g = 0; g < 8; ++g) { const int t0 = 2048 * g + 4 * tid; float ua[4], ub[4];
            HY_CALC(ua, ra[g], la[g], ha[g], t0, v0, v1, v2, vb); HY_CALC(ub, rb[g], lb[g], hb_[g], t0, v0, v1, v2, vb);
            SZ[512 * g] = (v4u){pk2(ua[0], ub[0]), pk2(ua[1], ub[1]), pk2(ua[2], ub[2]), pk2(ua[3], ub[3])}; }
    }
#pragma unroll 1
    for (int o = 0; o < 2; ++o) {
        OPQC();
        const float bias = __builtin_bit_cast(float, __builtin_amdgcn_readfirstlane(__builtin_bit_cast(int, A.hy_bias[((size_t)l * 2 + o) * 512 + c])));
        if (o == 1) {
            OPQ();
            const GAS v4u* sf4 = (const GAS v4u*)((GAS v4u*)(ws + WS_YHY) + (size_t)(256 + blockIdx.x) * 4096);
#pragma unroll
            for (int g = 0; g < 8; ++g) { const v4u w = sf4[512 * g + tid]; const int p = cidx(2048 * g + 4 * tid);
#pragma unroll
                for (int k = 0; k < 4; ++k) buf[p + k] = cunpack(w[k]); }
            __syncthreads();
        }
        {
            OPQ();
            f32x2 zs[32];
            const float invo = o ? inv1 : inv0;
#pragma unroll
            for (int g = 0; g < 8; ++g)
#pragma unroll
                for (int k = 0; k < 4; ++k) { const int n = 2048 * g + 4 * tid + k;
                    if (g < 4) { zs[g * 4 + k] = (f32x2){buf[cidx(2 * n)].x * invo, buf[cidx(2 * n + 1)].x * invo}; }
                    else { const int m = 2 * L - 2 * n; const int mc = m < L ? m : L - 1; const float re = buf[cidx(mc)].y; zs[g * 4 + k] = (f32x2){m < L ? re * invo : 0.f, buf[cidx(m - 1)].y * invo}; } }
            __syncthreads();
#pragma unroll
            for (int g = 0; g < 8; ++g) { const int p = cidx(2048 * g + 4 * tid);
#pragma unroll
                for (int k = 0; k < 4; ++k) buf[p + k] = zs[g * 4 + k]; }
            __syncthreads();
        }
        v4u zv[8];
        { OPQ(); fft_fwd(buf, tid);
#pragma unroll
          for (int g = 0; g < 8; ++g) zv[g] = SZ[512 * g];
          const f32x2 w1c = twid(1.0f / (float)NFFT);
#pragma unroll
          for (int g = 0; g < 8; ++g) { v4u ke4, ko4;
#pragma unroll
              for (int k = 0; k < 4; ++k) { const int p = 2048 * g + 4 * tid + k; const int kp = (int)(__builtin_bitreverse32((unsigned)p) >> 18);
                  const int m0 = (2 * kp) & (L - 1); const bool neg = kp >= L / 2;
                  const int q0 = p >> 1, q1 = q0 + L / 2, q0c = (int)(__builtin_bitreverse32((unsigned)((L - m0) & (L - 1))) >> 18), q1c = L - 1 - q0;
                  const f32x2 a0 = buf[cidx(q0)], b0 = buf[cidx(q0c)], a1 = buf[cidx(q1)], b1 = buf[cidx(q1c)];
                  const f32x2 t0 = twid((float)m0 * (1.0f / (float)NFFT)), t1 = cmul(t0, w1c);
                  const f32x2 xe0 = (f32x2){0.5f * (a0.x + b0.x), 0.5f * (a0.y - b0.y)}, d0 = (f32x2){a0.x - b0.x, a0.y + b0.y}, xo0 = (f32x2){0.5f * d0.y, -0.5f * d0.x};
                  const f32x2 xe1 = (f32x2){0.5f * (a1.x + b1.x), 0.5f * (a1.y - b1.y)}, d1 = (f32x2){a1.x - b1.x, a1.y + b1.y}, xo1 = (f32x2){0.5f * d1.y, -0.5f * d1.x};
                  const f32x2 c0 = cmul(t0, xo0), c1 = cmul(t1, xo1);
                  const f32x2 v0 = neg ? xe0 - c0 : xe0 + c0, v1 = neg ? xe1 - c1 : xe1 + c1;
                  ke4[k] = cpack(v0); ko4[k] = cpack(v1); }
              SA[512 * g] = ke4; SB[512 * g] = ko4; __builtin_amdgcn_sched_barrier(0); }
          __syncthreads(); }
        { OPQ();
#pragma unroll
        for (int g = 0; g < 8; ++g) { const int p = cidx(2048 * g + 4 * tid); const v4u w = zv[g];
#pragma unroll
            for (int k = 0; k < 4; ++k) buf[p + k] = cunpack(w[k]); }
        __syncthreads();
        fft_conv(buf, tid, SA); }
        { OPQ();
#pragma unroll
        for (int g = 0; g < 8; ++g) zv[g] = SZ[512 * g];
#pragma unroll
        for (int g = 0; g < 8; ++g) { const int p = cidx(2048 * g + 4 * tid); v4u w;
#pragma unroll
            for (int k = 0; k < 4; ++k) { const f32x2 y = buf[p + k]; w[k] = pk2(y.x * (1.0f / (float)NFFT), y.y * (1.0f / (float)NFFT)); }
            SA[512 * g] = w; }
        __syncthreads(); }
        { OPQ();
#pragma unroll
        for (int g = 0; g < 8; ++g) { const int t0 = 2048 * g + 4 * tid, p = cidx(t0); const v4u w = zv[g];
#pragma unroll
            for (int k = 0; k < 4; ++k) buf[p + k] = cmul(cunpack(w[k]), twid((float)(t0 + k) * (1.0f / (float)NFFT))); }
        __syncthreads();
        fft_conv(buf, tid, SB); }
        const int X = o + 1; const float q0 = HY_CW(X, 0), q1 = HY_CW(X, 1), q2 = HY_CW(X, 2), qb = HY_CB(X);
        { OPQ();
        v4u wyv[8], wzv[8]; v2u ra[8], rb[8]; bf16 la[8], ha[8], lb[8], hb_[8];
#pragma unroll
        for (int g = 0; g < 8; ++g) { const int t0 = 2048 * g + 4 * tid; wyv[g] = SA[512 * g]; wzv[g] = SZ[512 * g];
            HY_RAW(HYT + ((size_t)(0 * 1536 + X * 512 + c)) * L, t0, ra[g], la[g], ha[g]); HY_RAW(HYT + ((size_t)(1 * 1536 + X * 512 + c)) * L, t0, rb[g], lb[g], hb_[g]); }
#pragma unroll
        for (int g = 0; g < 8; ++g) { const int t0 = 2048 * g + 4 * tid, p = cidx(t0); const v4u wy = wyv[g], wz = wzv[g];
            float ga[4], gb[4]; HY_CALC(ga, ra[g], la[g], ha[g], t0, q0, q1, q2, qb); HY_CALC(gb, rb[g], lb[g], hb_[g], t0, q0, q1, q2, qb);
            float oa[4], ob[4];
#pragma unroll
            for (int k = 0; k < 4; ++k) { const f32x2 yo = cmulc(buf[p + k], twid((float)(t0 + k) * (1.0f / (float)NFFT)));
                const f32x2 yev = cunpack(wy[k]), z = cunpack(wz[k]);
                float y0 = yev.x + yo.x * (1.0f / (float)NFFT) + bias * z.x, y1 = yev.y + yo.y * (1.0f / (float)NFFT) + bias * z.y;
                if (ABL & 16) { y0 = bias * z.x; y1 = bias * z.y; }
                oa[k] = ga[k] * y0; ob[k] = gb[k] * y1; }
            if (g == 3) asm volatile("" ::: "memory");
            if (o == 0) SZ[512 * g] = (v4u){pk2(oa[0], ob[0]), pk2(oa[1], ob[1]), pk2(oa[2], ob[2]), pk2(oa[3], ob[3])};
            else { *(GAS v2u*)(YT + ((size_t)(0 * 512 + c)) * L + t0) = (v2u){pk2(oa[0], oa[1]), pk2(oa[2], oa[3])}; *(GAS v2u*)(YT + ((size_t)(1 * 512 + c)) * L + t0) = (v2u){pk2(ob[0], ob[1]), pk2(ob[2], ob[3])}; } } }
        __syncthreads();
    }
    if (with_ctx) {
        OPQ(); OPQC();
        const float v0 = HY_CW(0, 0), v1 = HY_CW(0, 1), v2 = HY_CW(0, 2), vb = HY_CB(0);
        LAS float* F = (LAS float*)C.lds;
        LAS float* Z = F + 1024;
        const float* H2C = (const float*)(ws + WS_H2C) + (size_t)l * 64 * CTX_LEN;
        const int b = tid >> 8, t = tid & 255;
        __syncthreads();
        {
            const int o = b; float f0 = 0.f, f1 = 0.f;
            for (int j = 0; j < 64; ++j) { const float h = H2C[j * CTX_LEN + t]; f0 += h * sW[(o * 2 + 0) * 64 + j]; f1 += h * sW[(o * 2 + 1) * 64 + j]; }
            const float decay = fabsf(A.hy_decay[((size_t)l * 2 + o) * 512 + c]);
            const float win = __expf(-((float)t * (1.0f / (float)(CTX_LEN - 1))) * decay); f0 *= win; f1 *= win;
            float s = wave_sum_t(fabsf(f0) + fabsf(f1), tid);
            __syncthreads();
            if (C.lane == 0) red[C.wave] = s;
            __syncthreads();
            const int w0 = (C.wave >> 2) * 4; const float tot = red[w0] + red[w0 + 1] + red[w0 + 2] + red[w0 + 3];
            F[(o * 2 + 0) * 256 + t] = f0 / tot; F[(o * 2 + 1) * 256 + t] = f1 / tot;
        }
        float z = conv3_at(HYTC + ((size_t)(b * 1536 + c)) * CTX_LEN, t, CTX_LEN, v0, v1, v2, vb);
#pragma unroll 1
        for (int o = 0; o < 2; ++o) {
            const float bias = A.hy_bias[((size_t)l * 2 + o) * 512 + c];
            __syncthreads();
            Z[b * 256 + t] = z;
            __syncthreads();
            float y = 0.f; const LAS float* hfp = F + (o * 2 + 0) * 256; const LAS float* hbp = F + (o * 2 + 1) * 256; const LAS float* zp = Z + b * 256;
            for (int s = 0; s <= t; ++s) y += hfp[t - s] * zp[s];
            for (int s = t + 1; s < 256; ++s) y += hbp[s - t] * zp[s];
            y += bias * z;
            const int X = o + 1; const float q0 = HY_CW(X, 0), q1 = HY_CW(X, 1), q2 = HY_CW(X, 2), qb = HY_CB(X);
            const float g = conv3_at(HYTC + ((size_t)(b * 1536 + X * 512 + c)) * CTX_LEN, t, CTX_LEN, q0, q1, q2, qb);
            z = g * y;
        }
        YT[(size_t)BATCH * 512 * L + ((size_t)(b * 512 + c)) * CTX_LEN + t] = (bf16)f2bf(z);
        __syncthreads();
    }
}
#undef OPQ
#undef OPQC
#undef SZ
#undef SA
#undef SB
#undef SF
#undef HY_CONV4
#undef HY_RAW
#undef HY_CALC
#undef HY_CW
#undef HY_CB
}

#ifdef SELFCHECK
namespace chk {
constexpr size_t WS_DBG = 504 * MiB;
constexpr int NCHK = 24;
__device__ __forceinline__ unsigned hsh(unsigned x) { x ^= x >> 16; x *= 0x7feb352dU; x ^= x >> 15; x *= 0x846ca68bU; x ^= x >> 16; return x; }
__device__ __forceinline__ void acc_err(unsigned char* ws, int id, float got, float ref) {
    float* a = (float*)(ws + WS_DBG) + id * 2; const float d = got - ref;
    atomicAdd(a, d * d); atomicAdd(a + 1, ref * ref);
}
__device__ __forceinline__ float dot_bf_f32col(const bf16* arow, const float* W, int K, int N, int col, int lane) {
    float s = 0.f; for (int k = lane; k < K; k += 64) s += bf1(arow[k]) * W[(size_t)k * N + col]; return wave_sum(s);
}
__device__ __forceinline__ void c_norm(const Args& A, const Ctx& C, const float* xlat, const float* xctx, const float* g, const float* mod, int shi, const bf16* XN, int id) {
    const int gw = C.vcu * NWAVES + C.wave;
    if (gw < 96) { const int r = (gw < 64) ? (int)(hsh(gw * 7 + 1) % ML) : ML + (int)(hsh(gw) % MC);
        const float* xr = r < ML ? xlat + (size_t)r * 1024 : xctx + (size_t)(r - ML) * 1024; const float* mp = mod + (r < ML ? (r >> 14) : 2) * 6144 + shi * 1024;
        float s = 0.f; for (int k = C.lane; k < 1024; k += 64) s += xr[k] * xr[k]; s = wave_sum(s); const float rstd = 1.0f / sqrtf(s / 1024.f + EPS);
        for (int k = C.lane; k < 1024; k += 64) acc_err(A.ws, id, bf1(XN[(size_t)r * 1024 + k]), xr[k] * rstd * g[k] * (1.f + mp[1024 + k]) + mp[k]); }
}
__device__ __forceinline__ void c_mod(const Args& A, const Ctx& C, int id) {
    const int gw = C.vcu * NWAVES + C.wave;
    if (gw < 128) { const int l = gw & 1, w = (gw >> 1) % 3, n = (int)(hsh(gw + 77) % 6144);
        float s = 0.f; for (int k = C.lane; k < 1024; k += 64) { const float cv = (w < 2) ? A.c[w * 1024 + k] : A.c_ctx[k]; s += (cv / (1.f + expf(-cv))) * A.w_mod[((size_t)l * 1024 + k) * 6144 + n]; }
        s = wave_sum(s) + A.b_mod[l * 6144 + n];
        if (C.lane == 0) acc_err(A.ws, id, ((const float*)(A.ws + WS_MOD))[(l * 3 + w) * 6144 + n], s); }
}
__device__ __forceinline__ void c_proj(const Args& A, const Ctx& C, int l, int id0) {
    const int gw = C.vcu * NWAVES + C.wave, lane = C.lane; unsigned char* ws = A.ws;
    const bf16* XN = (const bf16*)(ws + WS_XN); const float* W = A.w_in + (size_t)l * 1024 * IN_W;
    const unsigned h0 = hsh(gw * 31 + 5);
    const int r = (gw & 7) == 7 ? ML + (int)(h0 % MC) : (int)(h0 % ML);
    const bf16* xr = XN + (size_t)r * 1024;
    const bool latent = r < ML; const int t = r & 16383;
    const int kvrow = latent ? ((r >> 14) * KVL + 256 + t) : (((r - ML) >> 8) * KVL + ((r - ML) & 255));
    const int kind = (gw >> 3) % 6;
    if (kind == 0) { const int ch = (int)(hsh(h0) % 512); const float p = dot_bf_f32col(xr, W, 1024, IN_W, SC0 + ch, lane);
        if (lane == 0) acc_err(ws, id0 + 0, bf1(((const bf16*)(ws + WS_BG))[(size_t)r * 512 + ch]), p); }
    else if (kind == 1) { const int ch = (int)(hsh(h0) % 512); const float p1 = dot_bf_f32col(xr, W, 1024, IN_W, SC0 + 512 + ch, lane), p2 = dot_bf_f32col(xr, W, 1024, IN_W, SC0 + 1024 + ch, lane);
        if (lane == 0) acc_err(ws, id0 + 1, bf1(((const bf16*)(ws + WS_CX))[(size_t)r * 512 + ch]), p1 * p2); }
    else if (kind == 2) { const int d = (int)(hsh(h0) % 128); const float p = dot_bf_f32col(xr, W, 1024, IN_W, V0 + d, lane);
        if (lane == 0) acc_err(ws, id0 + 2, bf1(((const bf16*)(ws + WS_V))[(size_t)kvrow * 128 + d]), p); }
    else if (kind == 3) { const int ch = (int)(hsh(h0) % 1536); const float p = dot_bf_f32col(xr, W, 1024, IN_W, HY0 + ch, lane);
        const bf16* HY = latent ? (const bf16*)(ws + WS_R1) + ((size_t)((r >> 14) * 1536 + ch)) * SEQ + t : (const bf16*)(ws + WS_HYTC) + ((size_t)(((r - ML) >> 8) * 1536 + ch)) * CTX_LEN + ((r - ML) & 255);
        if (lane == 0) acc_err(ws, id0 + 3, bf1(*HY), p); }
    else {
        const bool isq = kind == 4; const int head = isq ? (int)(hsh(h0) % 8) : (int)(hsh(h0) % 2);
        const float* gain = (isq ? A.q_gain : A.k_gain) + l * 64;
        const float v = dot_bf_f32col(xr, W, 1024, IN_W, (isq ? Q0 : K0) + head * 64 + 0, lane);
        (void)v;
        float mine = 0.f;
        for (int d = 0; d < 64; ++d) { const float p = dot_bf_f32col(xr, W, 1024, IN_W, (isq ? Q0 : K0) + head * 64 + d, lane); if (lane == d) mine = p; }
        const float ss = wave_sum(mine * mine); float y = mine / sqrtf(ss / 64.f + EPS) * gain[lane];
        if (latent) { const int half = lane >> 5, dd = lane & 31, f = dd & 15; const bool second = dd >= 16;
            const float pos = (float)(half ? (t & 63) : (t >> 6)), ang = pos * powf(10000.f, -(float)f / 16.f);
            const float other = __shfl(y, lane ^ 16);
            y = second ? (y * cosf(ang) + other * sinf(ang)) : (y * cosf(ang) - other * sinf(ang)); }
        if (isq) y *= C2Q;
        const int bj = lane >> 5, n = (lane >> 4) & 1, fq = (lane >> 2) & 3, e = lane & 3, j = 32 * bj + 8 * fq + 4 * n + e;
        const float got = isq ? bf1(((const bf16*)(ws + WS_Q))[(size_t)r * 512 + head * 64 + j]) : bf1(((const bf16*)(ws + WS_K))[(size_t)kvrow * 128 + head * 64 + j]);
        acc_err(ws, id0 + (isq ? 4 : 5), got, y); }
}
__device__ __forceinline__ float hy_u(const Args& A, int l, int b, int X, int c, int t) {
    const bf16* P = (const bf16*)(A.ws + WS_R1) + ((size_t)(b * 1536 + X * 512 + c)) * SEQ;
    const float w0 = A.hy_conv_w[((size_t)l * 3 + 0) * 1536 + X * 512 + c], w1 = A.hy_conv_w[((size_t)l * 3 + 1) * 1536 + X * 512 + c], w2 = A.hy_conv_w[((size_t)l * 3 + 2) * 1536 + X * 512 + c];
    return w0 * (t > 0 ? bf1(P[t - 1]) : 0.f) + w1 * bf1(P[t]) + w2 * (t < SEQ - 1 ? bf1(P[t + 1]) : 0.f) + A.hy_conv_b[l * 1536 + X * 512 + c];
}
__device__ __forceinline__ void c_hy1(const Args& A, const Ctx& C, int l, int c) {
    float* F = (float*)(A.ws + WS_DBG + 65536); float* ABS = (float*)(A.ws + WS_DBG + 8192);
    const float* H2 = (const float*)(A.ws + WS_H2) + (size_t)l * 64 * SEQ;
    for (int i = C.vcu * NTHREADS + C.tid; i < 4 * SEQ; i += C.G * NTHREADS) { const int od = i >> 14, t = i & 16383, o = od >> 1;
        float s = 0.f; for (int j = 0; j < 64; ++j) s += H2[(size_t)j * SEQ + t] * A.hy_w3[((size_t)l * 64 + j) * 2048 + od * 512 + c];
        s *= expf(-((float)t / (float)(SEQ - 1)) * fabsf(A.hy_decay[((size_t)l * 2 + o) * 512 + c]));
        F[i] = s; atomicAdd(ABS + o, fabsf(s)); }
}
__device__ __forceinline__ float hy_conv(const float* hf, const float* hb, float inv, const float* z, int t, int lane) {
    float s = 0.f; for (int q = lane; q < SEQ; q += 64) s += (q <= t ? hf[t - q] : hb[q - t]) * z[q]; return wave_sum(s) * inv;
}
__device__ __forceinline__ void c_hy2(const Args& A, const Ctx& C, int l, int b, int c) {
    float* F = (float*)(A.ws + WS_DBG + 65536); float* ABS = (float*)(A.ws + WS_DBG + 8192); float* Z1 = F + 4 * SEQ; float* Z2 = Z1 + SEQ;
    for (int i = C.vcu * NTHREADS + C.tid; i < SEQ; i += C.G * NTHREADS) Z1[i] = hy_u(A, l, b, 0, c, i);
}
__device__ __forceinline__ void c_hy3(const Args& A, const Ctx& C, int l, int b, int c) {
    float* F = (float*)(A.ws + WS_DBG + 65536); float* ABS = (float*)(A.ws + WS_DBG + 8192); float* Z1 = F + 4 * SEQ; float* Z2 = Z1 + SEQ;
    const int gw = C.vcu * NWAVES + C.wave, NGW = C.G * NWAVES; const float inv = 1.0f / ABS[0], b1 = A.hy_bias[((size_t)l * 2 + 0) * 512 + c];
    for (int s = gw; s < SEQ; s += NGW) { const float cv = hy_conv(F, F + SEQ, inv, Z1, s, C.lane); if (C.lane == 0) Z2[s] = hy_u(A, l, b, 1, c, s) * (cv + b1 * Z1[s]); }
}
__device__ __forceinline__ void c_hy4(const Args& A, const Ctx& C, int l, int b, int c, int id) {
    float* F = (float*)(A.ws + WS_DBG + 65536); float* ABS = (float*)(A.ws + WS_DBG + 8192); float* Z1 = F + 4 * SEQ; float* Z2 = Z1 + SEQ;
    const int gw = C.vcu * NWAVES + C.wave; const float inv = 1.0f / ABS[1], b2 = A.hy_bias[((size_t)l * 2 + 1) * 512 + c];
    if (gw < 256) { const int t = (gw < 4) ? (gw & 1 ? SEQ - 1 - (gw >> 1) : (gw >> 1)) : (int)(hsh(gw * 13 + 3) % SEQ);
        const float cv = hy_conv(F + 2 * SEQ, F + 3 * SEQ, inv, Z2, t, C.lane);
        const float y = hy_u(A, l, b, 2, c, t) * (cv + b2 * Z2[t]);
        if (C.lane == 0) acc_err(A.ws, id, bf1(((const bf16*)(A.ws + WS_YHYT))[((size_t)(b * 512 + c)) * SEQ + t]), y); }
}
__device__ __forceinline__ void c_ysc(const Args& A, const Ctx& C, int l, int id) {
    const int gw = C.vcu * NWAVES + C.wave, lane = C.lane; unsigned char* ws = A.ws;
    if (gw >= 256) return;
    const bf16* XN = (const bf16*)(ws + WS_XN); const float* W = A.w_in + (size_t)l * 1024 * IN_W;
    const unsigned h0 = hsh(gw * 17 + 9); int r = (int)(h0 % ML); if (gw < 4) r = (gw & 1) ? SEQ - 1 + (gw >> 1) : (gw >> 1) * SEQ;
    const int ch = (int)(hsh(h0) % 512), t = r & 16383;
    float cv = 0.f;
    for (int k = -1; k <= 1; ++k) { const int tt = t + k; if (tt < 0 || tt >= SEQ) continue; const bf16* xr = XN + (size_t)(r + k) * 1024;
        cv += A.sc_conv_w[((size_t)l * 3 + (k + 1)) * 512 + ch] * dot_bf_f32col(xr, W, 1024, IN_W, SC0 + 512 + ch, lane) * dot_bf_f32col(xr, W, 1024, IN_W, SC0 + 1024 + ch, lane); }
    const float bg = dot_bf_f32col(XN + (size_t)r * 1024, W, 1024, IN_W, SC0 + ch, lane);
    if (lane == 0) acc_err(ws, id, bf1(((const bf16*)(ws + WS_BG))[(size_t)r * 512 + ch]), bg * cv);
}
__device__ __forceinline__ void c_att_sample(int i, int& r, int& h) { const unsigned hh = hsh(i * 101 + 7); r = (i < 16) ? ML + (int)(hh % MC) : (int)(hh % ML); h = (int)(hsh(hh) % 8); }
__device__ __forceinline__ void c_att_save(const Args& A, const Ctx& C) {
    const int gw = C.vcu * NWAVES + C.wave; float* QS = (float*)(A.ws + WS_DBG + 1 * MiB);
    if (gw < 256) { int r, h; c_att_sample(gw, r, h); QS[gw * 64 + C.lane] = bf1(((const bf16*)(A.ws + WS_Q))[(size_t)r * 512 + h * 64 + C.lane]); }
}
__device__ __forceinline__ void c_att(const Args& A, const Ctx& C, int id) {
    const int gw = C.vcu * NWAVES + C.wave, lane = C.lane; const float* QS = (const float*)(A.ws + WS_DBG + 1 * MiB);
    if (gw >= 256) return;
    int r, h; c_att_sample(gw, r, h);
    const bool latent = r < ML; const int b = latent ? (r >> 14) : ((r - ML) >> 8); const int nk = latent ? KVL : CTX_LEN;
    const bf16* Kp = (const bf16*)(A.ws + WS_K) + (size_t)b * KVL * 128 + (h >> 2) * 64; const bf16* Vp = (const bf16*)(A.ws + WS_V) + (size_t)b * KVL * 128 + (h >> 2) * 64;
    const float q = QS[gw * 64 + lane];
    float m = -INFINITY, lsum = 0.f, o = 0.f;
    for (int k = 0; k < nk; ++k) { const float s = wave_sum(q * bf1(Kp[(size_t)k * 128 + lane]));
        const float mn = fmaxf(m, s), f = exp2f(m - mn), p = exp2f(s - mn); lsum = lsum * f + p; o = o * f + p * bf1(Vp[(size_t)k * 128 + lane]); m = mn; }
    acc_err(A.ws, id, bf1(((const bf16*)(A.ws + WS_Q))[(size_t)r * 512 + h * 64 + lane]), o / lsum);
}
__device__ __forceinline__ void c_gate(const Args& A, const Ctx& C, int l, int rowbase, int nr, int id) {
    const int gw = C.vcu * NWAVES + C.wave; if (gw >= 256) return;
    const unsigned h0 = hsh(gw * 23 + 11); const int rr = (int)(h0 % nr), col = (int)(hsh(h0) % 3072);
    const float p = dot_bf_f32col((const bf16*)(A.ws + WS_XN) + (size_t)(rowbase + rr) * 1024, A.w_in + (size_t)l * 1024 * IN_W, 1024, IN_W, GT0 + col, C.lane);
    if (C.lane == 0) { const float got = bf1(((const bf16*)(A.ws + WS_R1))[(size_t)rr * 3072 + col]), ref = 1.f / (1.f + expf(-p)); acc_err(A.ws, id, got, ref); }
}
__device__ __forceinline__ void c_wcopy(const Args& A, const Ctx& C, int l) {
    const int gw = C.vcu * NWAVES + C.wave; if (gw >= 512) return;
    const unsigned h0 = hsh(gw * 59 + 21); const bool hi = gw & 1; const int row = hi ? 3840 + (int)(h0 % 3072) : 2304 + (int)(h0 % 1536);
    const bf16* WT = (const bf16*)(A.ws + WS_WIN) + ((size_t)l * IN_W + row) * 1024;
    for (int k = C.lane; k < 1024; k += 64) acc_err(A.ws, hi ? 19 : 18, bf1(WT[k]), A.w_in[((size_t)l * 1024 + k) * IN_W + row]);
}
__device__ __forceinline__ void c_merge(const Args& A, const Ctx& C, int l, int rowbase, int nr, int id) {
    const int gw = C.vcu * NWAVES + C.wave; if (gw >= 256) return;
    const unsigned h0 = hsh(gw * 29 + 13); const int rr = (int)(h0 % nr), r = rowbase + rr, col = (int)(hsh(h0) % 1024);
    const bf16* G = (const bf16*)(A.ws + WS_R1) + (size_t)rr * 3072;
    const float a = dot_bf_f32col((const bf16*)(A.ws + WS_Q) + (size_t)r * 512, A.w_br_att + (size_t)l * 512 * 1024, 512, 1024, col, C.lane);
    const float s = dot_bf_f32col((const bf16*)(A.ws + WS_BG) + (size_t)r * 512, A.w_br_sc + (size_t)l * 512 * 1024, 512, 1024, col, C.lane);
    const float y = dot_bf_f32col((const bf16*)(A.ws + WS_YHY) + (size_t)r * 512, A.w_br_hy + (size_t)l * 512 * 1024, 512, 1024, col, C.lane);
    if (C.lane == 0) acc_err(A.ws, id, bf1(((const bf16*)(A.ws + WS_MM))[(size_t)r * 1024 + col]), bf1(G[col]) * a + bf1(G[1024 + col]) * s + bf1(G[2048 + col]) * y);
}
__device__ __forceinline__ void c_yhyT(const Args& A, const Ctx& C, int id) {
    const int gw = C.vcu * NWAVES + C.wave; if (gw >= 64) return;
    const unsigned h0 = hsh(gw * 37 + 1); const int r = (gw < 8) ? ML + (int)(h0 % MC) : (int)(h0 % ML), c = (int)(hsh(h0) % 512);
    const bf16* YT = (const bf16*)(A.ws + WS_YHYT);
    const float ref = r < ML ? bf1(YT[((size_t)((r >> 14) * 512 + c)) * SEQ + (r & 16383)]) : bf1(YT[(size_t)BATCH * 512 * SEQ + ((size_t)(((r - ML) >> 8) * 512 + c)) * CTX_LEN + ((r - ML) & 255)]);
    if (C.lane == 0) acc_err(A.ws, id, bf1(((const bf16*)(A.ws + WS_YHY))[(size_t)r * 512 + c]), ref);
}
__device__ __forceinline__ void c_wout(const Args& A, const Ctx& C, int l, int id) {
    const int gw = C.vcu * NWAVES + C.wave; if (gw >= 256) return;
    const unsigned h0 = hsh(gw * 41 + 3); const int r = (gw < 16) ? ML + (int)(h0 % MC) : (int)(h0 % ML), col = (int)(hsh(h0) % 1024);
    const float d = dot_bf_f32col((const bf16*)(A.ws + WS_MM) + (size_t)r * 1024, A.w_out + (size_t)l * 1024 * 1024, 1024, 1024, col, C.lane);
    const float* mod = (const float*)(A.ws + WS_MOD) + (size_t)l * 3 * 6144;
    const float xo = r < ML ? A.x[(size_t)r * 1024 + col] : A.ctx[(size_t)(r - ML) * 1024 + col], gt = mod[(r < ML ? (r >> 14) : 2) * 6144 + 2 * 1024 + col];
    const float got = r < ML ? A.out[(size_t)r * 1024 + col] : ((const float*)(A.ws + WS_CTXB))[(size_t)(r - ML) * 1024 + col];
    if (C.lane == 0) acc_err(A.ws, id, got, xo + gt * d);
}
__device__ __forceinline__ void c_scores(const Args& A, const Ctx& C, int l, int row0, int nr, int id) {
    const int gw = C.vcu * NWAVES + C.wave, lane = C.lane; if (gw >= 128) return;
    const unsigned h0 = hsh(gw * 43 + 5); const int rr = (int)(h0 % nr), hp = (int)(hsh(h0) % 16), n = (int)(hsh(h0 + 1) % 128);
    const bf16* xr = (const bf16*)(A.ws + WS_XN) + (size_t)(row0 + rr) * 1024;
    float qd = 0.f; for (int d = 0; d < 64; ++d) { const float q = dot_bf_f32col(xr, A.peer_wq + (size_t)l * 1024 * 1024, 1024, 1024, hp * 64 + d, lane); if (lane == d) qd = q; }
    const float s = wave_sum(qd * A.peer_subkeys[(((size_t)l * 16 + hp) * 128 + n) * 64 + lane]);
    if (lane == 0) acc_err(A.ws, id, ((const float*)(A.ws + WS_R1))[(size_t)rr * 2048 + hp * 128 + n], s);
}
__device__ __forceinline__ int c_peer_row(int i, int nr) { return (int)(hsh(i * 53 + 17) % nr); }
__device__ __forceinline__ void c_peer_save(const Args& A, const Ctx& C, int row0, int nr) {
    const int gw = C.vcu * NWAVES + C.wave; if (gw >= 64) return; const int r = row0 + c_peer_row(gw, nr);
    float* XS = (float*)(A.ws + WS_DBG + 2 * MiB); for (int k = C.lane; k < 1024; k += 64) XS[gw * 1024 + k] = A.out[(size_t)r * 1024 + k];
}
__device__ __forceinline__ void c_peer(const Args& A, const Ctx& C, int l, int row0, int nr, int id) {
    const int gw = C.vcu * NWAVES + C.wave, lane = C.lane; if (gw >= 64) return;
    const int rr = c_peer_row(gw, nr), r = row0 + rr; const float* S = (const float*)(A.ws + WS_R1) + (size_t)rr * 2048; const float* XS = (const float*)(A.ws + WS_DBG + 2 * MiB) + gw * 1024;
    const bf16* xr = (const bf16*)(A.ws + WS_XN) + (size_t)r * 1024;
    float f[16];
#pragma unroll
    for (int i = 0; i < 16; ++i) f[i] = 0.f;
    for (int h = 0; h < 8; ++h) {
        const float* s1 = S + h * 256; const float* s2 = s1 + 128;
        int r1a = 0, r1b = 0, r2a = 0, r2b = 0; const float a1 = s1[lane], b1 = s1[lane + 64], a2 = s2[lane], b2 = s2[lane + 64];
        for (int k = 0; k < 128; ++k) { const float u = s1[k], v = s2[k]; r1a += (u > a1) || (u == a1 && k < lane); r1b += (u > b1) || (u == b1 && k < lane + 64); r2a += (v > a2) || (v == a2 && k < lane); r2b += (v > b2) || (v == b2 && k < lane + 64); }
        float t1 = 0.f, t2 = 0.f; int i1 = 0, i2 = 0;
        for (int k = 0; k < 16; ++k) {
            const unsigned long long ma = __ballot(r1a == k), mb = __ballot(r1b == k);
            const float v1 = ma ? __shfl(a1, __builtin_ctzll(ma)) : __shfl(b1, __builtin_ctzll(mb)); const int j1 = ma ? __builtin_ctzll(ma) : 64 + __builtin_ctzll(mb);
            const unsigned long long na = __ballot(r2a == k), nb = __ballot(r2b == k);
            const float v2 = na ? __shfl(a2, __builtin_ctzll(na)) : __shfl(b2, __builtin_ctzll(nb)); const int j2 = na ? __builtin_ctzll(na) : 64 + __builtin_ctzll(nb);
            if (lane == k) { t1 = v1; i1 = j1; t2 = v2; i2 = j2; } }
        float cv[4]; int rk[4];
#pragma unroll
        for (int q = 0; q < 4; ++q) { const int c = lane * 4 + q; cv[q] = __shfl(t1, c >> 4) + __shfl(t2, c & 15); rk[q] = 0; }
        for (int c2 = 0; c2 < 256; ++c2) { const float o = __shfl(t1, c2 >> 4) + __shfl(t2, c2 & 15);
#pragma unroll
            for (int q = 0; q < 4; ++q) { const int c = lane * 4 + q; rk[q] += (o > cv[q]) || (o == cv[q] && c2 < c); } }
        float mx = -INFINITY;
#pragma unroll
        for (int q = 0; q < 4; ++q) if (rk[q] < 16) mx = fmaxf(mx, cv[q]);
        mx = wave_max(mx);
        float den = 0.f;
#pragma unroll
        for (int q = 0; q < 4; ++q) if (rk[q] < 16) den += expf(cv[q] - mx);
        den = wave_sum(den);
        for (int c = 0; c < 256; ++c) { const int ow = c >> 2, q = c & 3;
            const int sel = __shfl((q == 0 ? rk[0] : q == 1 ? rk[1] : q == 2 ? rk[2] : rk[3]) < 16 ? 1 : 0, ow); if (!sel) continue;
            const float sc = __shfl(q == 0 ? cv[0] : q == 1 ? cv[1] : q == 2 ? cv[2] : cv[3], ow);
            const int e = __shfl(i1, c >> 4) * 128 + __shfl(i2, c & 15);
            const float* ur = A.peer_u + ((size_t)l * PEER_N + e) * 1024; const float* vr = A.peer_v + ((size_t)l * PEER_N + e) * 1024;
            float d = 0.f; for (int k = lane; k < 1024; k += 64) d += ur[k] * bf1(xr[k]); d = wave_sum(d);
            const float w = expf(sc - mx) / den * 0.5f * d * (1.f + erff(d * 0.7071067811865476f));
#pragma unroll
            for (int i = 0; i < 16; ++i) f[i] += w * vr[lane + 64 * i]; }
    }
    const float* mod = (const float*)(A.ws + WS_MOD) + (size_t)l * 3 * 6144 + (r >> 14) * 6144 + 5 * 1024;
#pragma unroll
    for (int i = 0; i < 16; ++i) { const int col = lane + 64 * i; acc_err(A.ws, id, A.out[(size_t)r * 1024 + col], XS[col] + mod[col] * f[i]); }
}
}
#endif

namespace peer {
__device__ __forceinline__ unsigned fkey(float f) { const unsigned b = __builtin_bit_cast(unsigned, f); return b ^ ((unsigned)((int)b >> 31) | 0x80000000u); }
__device__ __forceinline__ int mbcnt64(unsigned long long m) { return (int)__builtin_amdgcn_mbcnt_hi((unsigned)(m >> 32), __builtin_amdgcn_mbcnt_lo((unsigned)m, 0u)); }
__device__ __forceinline__ void compact2(unsigned k0, unsigned k1, unsigned T, float v0, float v1, int lane, LAS float* lv, LAS int* li) {
    const unsigned long long g0 = __ballot(k0 > T), g1 = __ballot(k1 > T), e0 = __ballot(k0 == T), e1 = __ballot(k1 == T);
    const int need = 16 - (__popcll(g0) + __popcll(g1));
    const bool s0 = (k0 > T) || ((k0 == T) && (mbcnt64(e0) < need));
    const bool s1 = (k1 > T) || ((k1 == T) && (__popcll(e0) + mbcnt64(e1) < need));
    const unsigned long long m0 = __ballot(s0), m1 = __ballot(s1);
    if (s0) { const int p = mbcnt64(m0); lv[p] = v0; li[p] = lane; }
    if (s1) { const int p = __popcll(m0) + mbcnt64(m1); lv[p] = v1; li[p] = lane + 64; }
}
__device__ __forceinline__ float gelu_erf(float v) { return 0.5f * v * (1.0f + erff(v * 0.7071067811865476f)); }

__device__ __forceinline__ float unkey(unsigned k) { const unsigned b = (k & 0x80000000u) ? (k ^ 0x80000000u) : ~k; return __builtin_bit_cast(float, b); }
__device__ __forceinline__ void cnt4(int (&n)[4], unsigned k0, unsigned k1, unsigned k2, unsigned k3, unsigned cc) {
    asm volatile("v_cmp_ge_u32_e64 s[92:93], %4, %8\n\t"
                 "v_cmp_ge_u32_e64 s[94:95], %5, %8\n\t"
                 "v_cmp_ge_u32_e64 s[96:97], %6, %8\n\t"
                 "v_cmp_ge_u32_e64 s[98:99], %7, %8\n\t"
                 "v_addc_co_u32_e64 %0, s[100:101], 0, %0, s[92:93]\n\t"
                 "v_addc_co_u32_e64 %1, s[100:101], 0, %1, s[94:95]\n\t"
                 "v_addc_co_u32_e64 %2, s[100:101], 0, %2, s[96:97]\n\t"
                 "v_addc_co_u32_e64 %3, s[100:101], 0, %3, s[98:99]"
                 : "+v"(n[0]), "+v"(n[1]), "+v"(n[2]), "+v"(n[3]) : "v"(k0), "v"(k1), "v"(k2), "v"(k3), "v"(cc)
                 : "s92", "s93", "s94", "s95", "s96", "s97", "s98", "s99", "s100", "s101");
}
#define CE2(v, x, y) { const unsigned hi_ = v[x] > v[y] ? v[x] : v[y], lo_ = v[x] > v[y] ? v[y] : v[x]; v[x] = hi_; v[y] = lo_; }
__device__ __forceinline__ void part_top16(const float* sp, unsigned (&run)[16]) {
#pragma unroll
    for (int g = 0; g < 8; ++g) {
        unsigned x[16];
#pragma unroll
        for (int i = 0; i < 16; ++i) x[i] = (fkey(sp[(g * 16 + i) * 64]) & 0xFFFFFF80u) | (unsigned)(g * 16 + i);
        CE2(x,0,1) CE2(x,2,3) CE2(x,0,2) CE2(x,1,3) CE2(x,1,2) CE2(x,4,5) CE2(x,6,7) CE2(x,4,6) CE2(x,5,7) CE2(x,5,6) CE2(x,0,4) CE2(x,2,6) CE2(x,2,4) CE2(x,1,5) CE2(x,3,7) CE2(x,3,5) CE2(x,1,2) CE2(x,3,4) CE2(x,5,6) CE2(x,8,9) CE2(x,10,11) CE2(x,8,10) CE2(x,9,11) CE2(x,9,10) CE2(x,12,13) CE2(x,14,15) CE2(x,12,14) CE2(x,13,15) CE2(x,13,14) CE2(x,8,12) CE2(x,10,14) CE2(x,10,12) CE2(x,9,13) CE2(x,11,15) CE2(x,11,13) CE2(x,9,10) CE2(x,11,12) CE2(x,13,14) CE2(x,0,8) CE2(x,4,12) CE2(x,4,8) CE2(x,2,10) CE2(x,6,14) CE2(x,6,10) CE2(x,2,4) CE2(x,6,8) CE2(x,10,12) CE2(x,1,9) CE2(x,5,13) CE2(x,5,9) CE2(x,3,11) CE2(x,7,15) CE2(x,7,11) CE2(x,3,5) CE2(x,7,9) CE2(x,11,13) CE2(x,1,2) CE2(x,3,4) CE2(x,5,6) CE2(x,7,8) CE2(x,9,10) CE2(x,11,12) CE2(x,13,14)
        if (g == 0) {
#pragma unroll
            for (int i = 0; i < 16; ++i) run[i] = x[i];
        } else {
#pragma unroll
            for (int i = 0; i < 16; ++i) run[i] = run[i] > x[15 - i] ? run[i] : x[15 - i];
            CE2(run,0,8) CE2(run,1,9) CE2(run,2,10) CE2(run,3,11) CE2(run,4,12) CE2(run,5,13) CE2(run,6,14) CE2(run,7,15) CE2(run,0,4) CE2(run,1,5) CE2(run,2,6) CE2(run,3,7) CE2(run,8,12) CE2(run,9,13) CE2(run,10,14) CE2(run,11,15) CE2(run,0,2) CE2(run,1,3) CE2(run,4,6) CE2(run,5,7) CE2(run,8,10) CE2(run,9,11) CE2(run,12,14) CE2(run,13,15) CE2(run,0,1) CE2(run,2,3) CE2(run,4,5) CE2(run,6,7) CE2(run,8,9) CE2(run,10,11) CE2(run,12,13) CE2(run,14,15)
        }
    }
}
__device__ __forceinline__ void route_tasks(const Ctx& C, const float* ST, int nt, int* EL, float* GL, const pg8::StaticOrder& SO) {
    const int lane = C.lane;
#pragma unroll 1
    for (int it = C.wave; ; it += NWAVES) {
        pg8::Unit un; if (!SO.next(it >> 2, un)) break;
        const int h = un.pm, tb = un.pn * 4 + (it & 3), t = tb * 64 + lane;
        float a[16], b[16]; int ai[16], bi[16];
        {   const float* sp = ST + ((size_t)tb * 2048 + h * 256) * 64 + lane;
            unsigned ra[16], rb[16];
            part_top16(sp, ra); part_top16(sp + 128 * 64, rb);
#pragma unroll
            for (int q = 0; q < 16; ++q) { a[q] = unkey(ra[q] & 0xFFFFFF80u); ai[q] = (int)(ra[q] & 127u); b[q] = unkey(rb[q] & 0xFFFFFF80u); bi[q] = (int)(rb[q] & 127u); } }
        float cs[64]; int ce[64];
        cs[0] = a[0] + b[0]; ce[0] = ai[0] * 128 + bi[0]; cs[1] = a[0] + b[1]; ce[1] = ai[0] * 128 + bi[1]; cs[2] = a[0] + b[2]; ce[2] = ai[0] * 128 + bi[2]; cs[3] = a[0] + b[3]; ce[3] = ai[0] * 128 + bi[3]; cs[4] = a[0] + b[4]; ce[4] = ai[0] * 128 + bi[4]; cs[5] = a[0] + b[5]; ce[5] = ai[0] * 128 + bi[5]; cs[6] = a[0] + b[6]; ce[6] = ai[0] * 128 + bi[6]; cs[7] = a[0] + b[7]; ce[7] = ai[0] * 128 + bi[7]; cs[8] = a[0] + b[8]; ce[8] = ai[0] * 128 + bi[8]; cs[9] = a[0] + b[9]; ce[9] = ai[0] * 128 + bi[9]; cs[10] = a[0] + b[10]; ce[10] = ai[0] * 128 + bi[10]; cs[11] = a[0] + b[11]; ce[11] = ai[0] * 128 + bi[11]; cs[12] = a[0] + b[12]; ce[12] = ai[0] * 128 + bi[12]; cs[13] = a[0] + b[13]; ce[13] = ai[0] * 128 + bi[13]; cs[14] = a[0] + b[14]; ce[14] = ai[0] * 128 + bi[14]; cs[15] = a[0] + b[15]; ce[15] = ai[0] * 128 + bi[15]; cs[16] = a[1] + b[0]; ce[16] = ai[1] * 128 + bi[0]; cs[17] = a[1] + b[1]; ce[17] = ai[1] * 128 + bi[1]; cs[18] = a[1] + b[2]; ce[18] = ai[1] * 128 + bi[2]; cs[19] = a[1] + b[3]; ce[19] = ai[1] * 128 + bi[3]; cs[20] = a[1] + b[4]; ce[20] = ai[1] * 128 + bi[4]; cs[21] = a[1] + b[5]; ce[21] = ai[1] * 128 + bi[5]; cs[22] = a[1] + b[6]; ce[22] = ai[1] * 128 + bi[6]; cs[23] = a[1] + b[7]; ce[23] = ai[1] * 128 + bi[7]; cs[24] = a[2] + b[0]; ce[24] = ai[2] * 128 + bi[0]; cs[25] = a[2] + b[1]; ce[25] = ai[2] * 128 + bi[1]; cs[26] = a[2] + b[2]; ce[26] = ai[2] * 128 + bi[2]; cs[27] = a[2] + b[3]; ce[27] = ai[2] * 128 + bi[3]; cs[28] = a[2] + b[4]; ce[28] = ai[2] * 128 + bi[4]; cs[29] = a[3] + b[0]; ce[29] = ai[3] * 128 + bi[0]; cs[30] = a[3] + b[1]; ce[30] = ai[3] * 128 + bi[1]; cs[31] = a[3] + b[2]; ce[31] = ai[3] * 128 + bi[2]; cs[32] = a[3] + b[3]; ce[32] = ai[3] * 128 + bi[3]; cs[33] = a[4] + b[0]; ce[33] = ai[4] * 128 + bi[0]; cs[34] = a[4] + b[1]; ce[34] = ai[4] * 128 + bi[1]; cs[35] = a[4] + b[2]; ce[35] = ai[4] * 128 + bi[2]; cs[36] = a[5] + b[0]; ce[36] = ai[5] * 128 + bi[0]; cs[37] = a[5] + b[1]; ce[37] = ai[5] * 128 + bi[1]; cs[38] = a[6] + b[0]; ce[38] = ai[6] * 128 + bi[0]; cs[39] = a[6] + b[1]; ce[39] = ai[6] * 128 + bi[1]; cs[40] = a[7] + b[0]; ce[40] = ai[7] * 128 + bi[0]; cs[41] = a[7] + b[1]; ce[41] = ai[7] * 128 + bi[1]; cs[42] = a[8] + b[0]; ce[42] = ai[8] * 128 + bi[0]; cs[43] = a[9] + b[0]; ce[43] = ai[9] * 128 + bi[0]; cs[44] = a[10] + b[0]; ce[44] = ai[10] * 128 + bi[0]; cs[45] = a[11] + b[0]; ce[45] = ai[11] * 128 + bi[0]; cs[46] = a[12] + b[0]; ce[46] = ai[12] * 128 + bi[0]; cs[47] = a[13] + b[0]; ce[47] = ai[13] * 128 + bi[0]; cs[48] = a[14] + b[0]; ce[48] = ai[14] * 128 + bi[0]; cs[49] = a[15] + b[0]; ce[49] = ai[15] * 128 + bi[0];
#pragma unroll
        for (int c = 50; c < 64; ++c) { cs[c] = -INFINITY; ce[c] = 0; }
#define CE3(k, pl, x, y) { const bool sw_ = k[x] < k[y]; const float k0_ = sw_ ? k[y] : k[x], k1_ = sw_ ? k[x] : k[y]; const int p0_ = sw_ ? pl[y] : pl[x], p1_ = sw_ ? pl[x] : pl[y]; k[x] = k0_; k[y] = k1_; pl[x] = p0_; pl[y] = p1_; }
        CE3(cs,ce,16,17) CE3(cs,ce,18,19) CE3(cs,ce,16,18) CE3(cs,ce,17,19) CE3(cs,ce,17,18) CE3(cs,ce,20,21) CE3(cs,ce,22,23) CE3(cs,ce,20,22) CE3(cs,ce,21,23) CE3(cs,ce,21,22) CE3(cs,ce,16,20) CE3(cs,ce,18,22) CE3(cs,ce,18,20) CE3(cs,ce,17,21) CE3(cs,ce,19,23) CE3(cs,ce,19,21) CE3(cs,ce,17,18) CE3(cs,ce,19,20) CE3(cs,ce,21,22) CE3(cs,ce,24,25) CE3(cs,ce,26,27) CE3(cs,ce,24,26) CE3(cs,ce,25,27) CE3(cs,ce,25,26) CE3(cs,ce,28,29) CE3(cs,ce,30,31) CE3(cs,ce,28,30) CE3(cs,ce,29,31) CE3(cs,ce,29,30) CE3(cs,ce,24,28) CE3(cs,ce,26,30) CE3(cs,ce,26,28) CE3(cs,ce,25,29) CE3(cs,ce,27,31) CE3(cs,ce,27,29) CE3(cs,ce,25,26) CE3(cs,ce,27,28) CE3(cs,ce,29,30) CE3(cs,ce,16,24) CE3(cs,ce,20,28) CE3(cs,ce,20,24) CE3(cs,ce,18,26) CE3(cs,ce,22,30) CE3(cs,ce,22,26) CE3(cs,ce,18,20) CE3(cs,ce,22,24) CE3(cs,ce,26,28) CE3(cs,ce,17,25) CE3(cs,ce,21,29) CE3(cs,ce,21,25) CE3(cs,ce,19,27) CE3(cs,ce,23,31) CE3(cs,ce,23,27) CE3(cs,ce,19,21) CE3(cs,ce,23,25) CE3(cs,ce,27,29) CE3(cs,ce,17,18) CE3(cs,ce,19,20) CE3(cs,ce,21,22) CE3(cs,ce,23,24) CE3(cs,ce,25,26) CE3(cs,ce,27,28) CE3(cs,ce,29,30)
        CE3(cs,ce,32,33) CE3(cs,ce,34,35) CE3(cs,ce,32,34) CE3(cs,ce,33,35) CE3(cs,ce,33,34) CE3(cs,ce,36,37) CE3(cs,ce,38,39) CE3(cs,ce,36,38) CE3(cs,ce,37,39) CE3(cs,ce,37,38) CE3(cs,ce,32,36) CE3(cs,ce,34,38) CE3(cs,ce,34,36) CE3(cs,ce,33,37) CE3(cs,ce,35,39) CE3(cs,ce,35,37) CE3(cs,ce,33,34) CE3(cs,ce,35,36) CE3(cs,ce,37,38) CE3(cs,ce,40,41) CE3(cs,ce,42,43) CE3(cs,ce,40,42) CE3(cs,ce,41,43) CE3(cs,ce,41,42) CE3(cs,ce,44,45) CE3(cs,ce,46,47) CE3(cs,ce,44,46) CE3(cs,ce,45,47) CE3(cs,ce,45,46) CE3(cs,ce,40,44) CE3(cs,ce,42,46) CE3(cs,ce,42,44) CE3(cs,ce,41,45) CE3(cs,ce,43,47) CE3(cs,ce,43,45) CE3(cs,ce,41,42) CE3(cs,ce,43,44) CE3(cs,ce,45,46) CE3(cs,ce,32,40) CE3(cs,ce,36,44) CE3(cs,ce,36,40) CE3(cs,ce,34,42) CE3(cs,ce,38,46) CE3(cs,ce,38,42) CE3(cs,ce,34,36) CE3(cs,ce,38,40) CE3(cs,ce,42,44) CE3(cs,ce,33,41) CE3(cs,ce,37,45) CE3(cs,ce,37,41) CE3(cs,ce,35,43) CE3(cs,ce,39,47) CE3(cs,ce,39,43) CE3(cs,ce,35,37) CE3(cs,ce,39,41) CE3(cs,ce,43,45) CE3(cs,ce,33,34) CE3(cs,ce,35,36) CE3(cs,ce,37,38) CE3(cs,ce,39,40) CE3(cs,ce,41,42) CE3(cs,ce,43,44) CE3(cs,ce,45,46)
        CE3(cs,ce,48,49) CE3(cs,ce,50,51) CE3(cs,ce,48,50) CE3(cs,ce,49,51) CE3(cs,ce,49,50) CE3(cs,ce,52,53) CE3(cs,ce,54,55) CE3(cs,ce,52,54) CE3(cs,ce,53,55) CE3(cs,ce,53,54) CE3(cs,ce,48,52) CE3(cs,ce,50,54) CE3(cs,ce,50,52) CE3(cs,ce,49,53) CE3(cs,ce,51,55) CE3(cs,ce,51,53) CE3(cs,ce,49,50) CE3(cs,ce,51,52) CE3(cs,ce,53,54) CE3(cs,ce,56,57) CE3(cs,ce,58,59) CE3(cs,ce,56,58) CE3(cs,ce,57,59) CE3(cs,ce,57,58) CE3(cs,ce,60,61) CE3(cs,ce,62,63) CE3(cs,ce,60,62) CE3(cs,ce,61,63) CE3(cs,ce,61,62) CE3(cs,ce,56,60) CE3(cs,ce,58,62) CE3(cs,ce,58,60) CE3(cs,ce,57,61) CE3(cs,ce,59,63) CE3(cs,ce,59,61) CE3(cs,ce,57,58) CE3(cs,ce,59,60) CE3(cs,ce,61,62) CE3(cs,ce,48,56) CE3(cs,ce,52,60) CE3(cs,ce,52,56) CE3(cs,ce,50,58) CE3(cs,ce,54,62) CE3(cs,ce,54,58) CE3(cs,ce,50,52) CE3(cs,ce,54,56) CE3(cs,ce,58,60) CE3(cs,ce,49,57) CE3(cs,ce,53,61) CE3(cs,ce,53,57) CE3(cs,ce,51,59) CE3(cs,ce,55,63) CE3(cs,ce,55,59) CE3(cs,ce,51,53) CE3(cs,ce,55,57) CE3(cs,ce,59,61) CE3(cs,ce,49,50) CE3(cs,ce,51,52) CE3(cs,ce,53,54) CE3(cs,ce,55,56) CE3(cs,ce,57,58) CE3(cs,ce,59,60) CE3(cs,ce,61,62)

#pragma unroll
        for (int i = 0; i < 16; ++i) { const bool sw_ = cs[i] < cs[16 + 15 - i]; cs[i] = sw_ ? cs[16 + 15 - i] : cs[i]; ce[i] = sw_ ? ce[16 + 15 - i] : ce[i]; }
        CE3(cs,ce,0,8) CE3(cs,ce,1,9) CE3(cs,ce,2,10) CE3(cs,ce,3,11) CE3(cs,ce,4,12) CE3(cs,ce,5,13) CE3(cs,ce,6,14) CE3(cs,ce,7,15) CE3(cs,ce,0,4) CE3(cs,ce,1,5) CE3(cs,ce,2,6) CE3(cs,ce,3,7) CE3(cs,ce,8,12) CE3(cs,ce,9,13) CE3(cs,ce,10,14) CE3(cs,ce,11,15) CE3(cs,ce,0,2) CE3(cs,ce,1,3) CE3(cs,ce,4,6) CE3(cs,ce,5,7) CE3(cs,ce,8,10) CE3(cs,ce,9,11) CE3(cs,ce,12,14) CE3(cs,ce,13,15) CE3(cs,ce,0,1) CE3(cs,ce,2,3) CE3(cs,ce,4,5) CE3(cs,ce,6,7) CE3(cs,ce,8,9) CE3(cs,ce,10,11) CE3(cs,ce,12,13) CE3(cs,ce,14,15)

#pragma unroll
        for (int i = 0; i < 16; ++i) { const bool sw_ = cs[i] < cs[32 + 15 - i]; cs[i] = sw_ ? cs[32 + 15 - i] : cs[i]; ce[i] = sw_ ? ce[32 + 15 - i] : ce[i]; }
        CE3(cs,ce,0,8) CE3(cs,ce,1,9) CE3(cs,ce,2,10) CE3(cs,ce,3,11) CE3(cs,ce,4,12) CE3(cs,ce,5,13) CE3(cs,ce,6,14) CE3(cs,ce,7,15) CE3(cs,ce,0,4) CE3(cs,ce,1,5) CE3(cs,ce,2,6) CE3(cs,ce,3,7) CE3(cs,ce,8,12) CE3(cs,ce,9,13) CE3(cs,ce,10,14) CE3(cs,ce,11,15) CE3(cs,ce,0,2) CE3(cs,ce,1,3) CE3(cs,ce,4,6) CE3(cs,ce,5,7) CE3(cs,ce,8,10) CE3(cs,ce,9,11) CE3(cs,ce,12,14) CE3(cs,ce,13,15) CE3(cs,ce,0,1) CE3(cs,ce,2,3) CE3(cs,ce,4,5) CE3(cs,ce,6,7) CE3(cs,ce,8,9) CE3(cs,ce,10,11) CE3(cs,ce,12,13) CE3(cs,ce,14,15)

#pragma unroll
        for (int i = 0; i < 16; ++i) { const bool sw_ = cs[i] < cs[48 + 15 - i]; cs[i] = sw_ ? cs[48 + 15 - i] : cs[i]; ce[i] = sw_ ? ce[48 + 15 - i] : ce[i]; }
        CE3(cs,ce,0,8) CE3(cs,ce,1,9) CE3(cs,ce,2,10) CE3(cs,ce,3,11) CE3(cs,ce,4,12) CE3(cs,ce,5,13) CE3(cs,ce,6,14) CE3(cs,ce,7,15) CE3(cs,ce,0,4) CE3(cs,ce,1,5) CE3(cs,ce,2,6) CE3(cs,ce,3,7) CE3(cs,ce,8,12) CE3(cs,ce,9,13) CE3(cs,ce,10,14) CE3(cs,ce,11,15) CE3(cs,ce,0,2) CE3(cs,ce,1,3) CE3(cs,ce,4,6) CE3(cs,ce,5,7) CE3(cs,ce,8,10) CE3(cs,ce,9,11) CE3(cs,ce,12,14) CE3(cs,ce,13,15) CE3(cs,ce,0,1) CE3(cs,ce,2,3) CE3(cs,ce,4,5) CE3(cs,ce,6,7) CE3(cs,ce,8,9) CE3(cs,ce,10,11) CE3(cs,ce,12,13) CE3(cs,ce,14,15)
#undef CE3
        {   float w[16]; float sm = 0.f;
#pragma unroll
            for (int k = 0; k < 16; ++k) { w[k] = __expf(cs[k] - cs[0]); sm += w[k]; }
            const float rs = 1.0f / sm; const size_t eo = (size_t)t * 128 + h * 16;
#pragma unroll
            for (int k = 0; k < 16; ++k) { EL[eo + k] = ce[k]; GL[eo + k] = w[k] * rs; } }
    }
}

__device__ __forceinline__ void route_tokens_wave(const Ctx& C, const float* ST, int nt, int* EL, float* GL) {
    const int gw = C.wave * C.G + C.vcu, NGW = C.G * NWAVES, lane = C.lane;
    constexpr int NH = 4;
    LAS float* slist = (LAS float*)(C.lds + C.wave * 16384);
    LAS float* l1v = (LAS float*)(C.lds + C.wave * 16384 + 512); LAS int* l1i = (LAS int*)(C.lds + C.wave * 16384 + 1024);
    LAS float* l2v = (LAS float*)(C.lds + C.wave * 16384 + 1536); LAS int* l2i = (LAS int*)(C.lds + C.wave * 16384 + 2048);
#pragma unroll 1
    for (int task = gw; task < nt * (8 / NH); task += NGW) {
        const int t = task / (8 / NH), hp = task % (8 / NH);
        const float* sp = ST + ((size_t)(t >> 6) * 2048 + hp * NH * 256 + lane) * 64 + (t & 63);
        float cv[4 * NH]; unsigned ck[4 * NH];
#pragma unroll
        for (int q = 0; q < 4 * NH; ++q) { cv[q] = sp[(size_t)q * 64 * 64]; ck[q] = fkey(cv[q]); }
        unsigned T[2 * NH]; bool fin[2 * NH];
#pragma unroll
        for (int c = 0; c < 2 * NH; ++c) { T[c] = 0u; fin[c] = false; }
#pragma unroll 1
        for (int bit = 31; bit >= 0; --bit) { bool all = true;
#pragma unroll
            for (int c = 0; c < 2 * NH; ++c) { const unsigned cc = T[c] | (1u << bit);
                const int n = __popcll(__ballot(ck[2 * c] >= cc)) + __popcll(__ballot(ck[2 * c + 1] >= cc));
                T[c] = (!fin[c] && n >= 16) ? cc : T[c]; fin[c] = fin[c] || (n == 16); all = all && fin[c]; }
            if (all) break; }
#pragma unroll
        for (int u = 0; u < NH; ++u) {
            compact2(ck[4 * u], ck[4 * u + 1], T[2 * u], cv[4 * u], cv[4 * u + 1], lane, l1v + 16 * u, l1i + 16 * u);
            compact2(ck[4 * u + 2], ck[4 * u + 3], T[2 * u + 1], cv[4 * u + 2], cv[4 * u + 3], lane, l2v + 16 * u, l2i + 16 * u); }
        LDS_WAIT(); asm volatile("" ::: "memory");
        const int ci = lane >> 2, cjb = (lane & 3) * 4;
        float cs[NH][4]; unsigned kc[NH][4]; int ce[NH][4];
#pragma unroll
        for (int u = 0; u < NH; ++u) { const float v1 = l1v[16 * u + ci]; const int e1 = l1i[16 * u + ci] * 128;
#pragma unroll
            for (int q = 0; q < 4; ++q) { cs[u][q] = v1 + l2v[16 * u + cjb + q]; kc[u][q] = fkey(cs[u][q]); ce[u][q] = e1 + l2i[16 * u + cjb + q]; } }
        unsigned Tc[NH]; bool finc[NH];
#pragma unroll
        for (int u = 0; u < NH; ++u) { Tc[u] = 0u; finc[u] = false; }
#pragma unroll 1
        for (int bit = 31; bit >= 0; --bit) { bool all = true;
#pragma unroll
            for (int u = 0; u < NH; ++u) { const unsigned cc = Tc[u] | (1u << bit);
                const int n = (__popcll(__ballot(kc[u][0] >= cc)) + __popcll(__ballot(kc[u][1] >= cc))) + (__popcll(__ballot(kc[u][2] >= cc)) + __popcll(__ballot(kc[u][3] >= cc)));
                Tc[u] = (!finc[u] && n >= 16) ? cc : Tc[u]; finc[u] = finc[u] || (n == 16); all = all && finc[u]; }
            if (all) break; }
#pragma unroll
        for (int u = 0; u < NH; ++u) {
            const int h = NH * hp + u;
            unsigned long long gq[4], eq[4];
#pragma unroll
            for (int q = 0; q < 4; ++q) { gq[q] = __ballot(kc[u][q] > Tc[u]); eq[q] = __ballot(kc[u][q] == Tc[u]); }
            const int need = 16 - ((__popcll(gq[0]) + __popcll(gq[1])) + (__popcll(gq[2]) + __popcll(gq[3])));
            int ebase = 0, mbase = 0;
#pragma unroll
            for (int q = 0; q < 4; ++q) { const bool sel = (kc[u][q] > Tc[u]) || ((kc[u][q] == Tc[u]) && (ebase + mbcnt64(eq[q]) < need)); ebase += __popcll(eq[q]);
                const unsigned long long mq = __ballot(sel); const int pos = mbase + mbcnt64(mq); mbase += __popcll(mq);
                if (sel) { slist[u * 16 + pos] = cs[u][q]; EL[(size_t)t * 128 + h * 16 + pos] = ce[u][q]; } }
        }
        LDS_WAIT(); asm volatile("" ::: "memory");
        {
            const int u = lane >> 4;
            float m = -INFINITY, sm = 0.f;
#pragma unroll
            for (int k = 0; k < 16; ++k) m = fmaxf(m, slist[u * 16 + k]);
#pragma unroll
            for (int k = 0; k < 16; ++k) sm += __expf(slist[u * 16 + k] - m);
            GL[(size_t)t * 128 + (NH * hp + u) * 16 + (lane & 15)] = __expf(slist[u * 16 + (lane & 15)] - m) / sm;
        }
        LDS_WAIT(); asm volatile("" ::: "memory");
    }
}

__device__ __forceinline__ void topk_gather(const Args& A, const Ctx& C, int l, int row0, int nrows, const int* EL, const float* GL, const unsigned char* U, const unsigned char* V, const float* US, const float* VS, const bf16* XN,
                                            float* xlat, float* xctx, const float* mod  , bool final_out, const float* gn, const float* nmod, bf16* XNw) {
    const int gw = C.wave * C.G + C.vcu, NGW = C.G * NWAVES, lane = C.lane, lp = lane & 31, half = lane >> 5, cl = 2 * lp + half;
    LAS int* elist = (LAS int*)(C.lds + C.wave * 16384);
    LAS float* glist = (LAS float*)(C.lds + C.wave * 16384 + 512);
    LAS float* clist = (LAS float*)(C.lds + C.wave * 16384 + 1024);
    LAS float* uslist = (LAS float*)(C.lds + C.wave * 16384 + 1536);
    LAS float* vslist = (LAS float*)(C.lds + C.wave * 16384 + 2048);
    int ne0 = 0, ne1 = 0; float ng0 = 0.f, ng1 = 0.f;
    if (gw < nrows) { ne0 = EL[(size_t)gw * 128 + lane]; ne1 = EL[(size_t)gw * 128 + 64 + lane]; ng0 = GL[(size_t)gw * 128 + lane]; ng1 = GL[(size_t)gw * 128 + 64 + lane]; }
    for (int rr = gw; rr < nrows; rr += NGW) {
        const int r = row0 + rr;
        elist[lane] = ne0; elist[64 + lane] = ne1; glist[lane] = ng0; glist[64 + lane] = ng1;
        const float us0 = US[ne0], us1 = US[ne1], vs0 = VS[ne0], vs1 = VS[ne1];
        { const int rn = rr + NGW; if (rn < nrows) { ne0 = EL[(size_t)rn * 128 + lane]; ne1 = EL[(size_t)rn * 128 + 64 + lane]; ng0 = GL[(size_t)rn * 128 + lane]; ng1 = GL[(size_t)rn * 128 + 64 + lane]; } }
        LDS_WAIT(); asm volatile("" ::: "memory");
        f32x2 acc[16];
#define GLOAD(T, bA, bB, xb) { _Pragma("unroll") for (int s = 0; s < 4; ++s) { const unsigned e = (unsigned)elist[(xb) + 2 * s + half]; const unsigned o = __umul24(e, 768u);        \
            bA[s] = *(const GAS v4u*)(T + (o + lo16)); bB[s] = *(const GAS v2u*)(T + (o + lo8)); } }
#define UCOMP(bA, bB, xb) { float p[4]; \
            _Pragma("unroll") for (int s = 0; s < 4; ++s) { \
                v6i w; w[0] = (int)bA[s].x; w[1] = (int)bA[s].y; w[2] = (int)bA[s].z; w[3] = (int)bA[s].w; w[4] = (int)bB[s].x; w[5] = (int)bB[s].y; \
                const v32f d = __builtin_amdgcn_cvt_scalef32_pk32_f32_fp6(w, 1.0f); \
                f32x2 sA = (f32x2){0.f, 0.f}, sB = (f32x2){0.f, 0.f}; \
                _Pragma("unroll") for (int i = 0; i < 8; ++i) { sA = __builtin_elementwise_fma((f32x2){d[4 * i], d[4 * i + 1]}, hf[2 * i], sA); sB = __builtin_elementwise_fma((f32x2){d[4 * i + 2], d[4 * i + 3]}, hf[2 * i + 1], sB); } \
                const f32x2 s2 = sA + sB; p[s] = (s2.x + s2.y) * uslist[(xb) + 2 * s + half]; } \
              \
            float q2[2]; \
            _Pragma("unroll") for (int j = 0; j < 2; ++j) q2[j] = (b4 ? p[j + 2] : p[j]) + __shfl_xor(b4 ? p[j] : p[j + 2], 16); \
            float sm = (b3 ? q2[1] : q2[0]) + __shfl_xor(b3 ? q2[0] : q2[1], 8); \
            sm += __shfl_xor(sm, 4); sm += __shfl_xor(sm, 2); sm += __shfl_xor(sm, 1); \
            const int ent = (xb) + 2 * (2 * (b4 ? 1 : 0) + (b3 ? 1 : 0)) + half; \
            const float cf = gelu_erf(sm) * glist[ent]; \
            if ((lane & 7) == 0) clist[ent] = cf; }
#define VCOMP(bA, bB, xb) { _Pragma("unroll") for (int s = 0; s < 4; ++s) { \
                v6i w; w[0] = (int)bA[s].x; w[1] = (int)bA[s].y; w[2] = (int)bA[s].z; w[3] = (int)bA[s].w; w[4] = (int)bB[s].x; w[5] = (int)bB[s].y; \
                const v32f d = __builtin_amdgcn_cvt_scalef32_pk32_f32_fp6(w, 1.0f); \
                const float c1_ = clist[(xb) + 2 * s + half] * vslist[(xb) + 2 * s + half]; const f32x2 c2 = (f32x2){c1_, c1_}; \
                _Pragma("unroll") for (int i = 0; i < 16; ++i) acc[i] = __builtin_elementwise_fma((f32x2){d[2 * i], d[2 * i + 1]}, c2, acc[i]); } }
        const bool b4 = (lane & 16) != 0, b3 = (lane & 8) != 0; const unsigned lo16 = 16u * (unsigned)lp, lo8 = 512u + 8u * (unsigned)lp;
#pragma unroll 1
        for (int rep2_ = 0; rep2_ < REP_GATHER; ++rep2_) {
        {
        f32x2 hf[16];
        { const GAS v4u* hp = (const GAS v4u*)(XN + (size_t)r * 1024 + 32 * lp);
#pragma unroll
          for (int q = 0; q < 4; ++q) { const v4u h4 = hp[q]; hf[4 * q] = (f32x2){bflo(h4.x), bfhi(h4.x)}; hf[4 * q + 1] = (f32x2){bflo(h4.y), bfhi(h4.y)}; hf[4 * q + 2] = (f32x2){bflo(h4.z), bfhi(h4.z)}; hf[4 * q + 3] = (f32x2){bflo(h4.w), bfhi(h4.w)}; } }
        v4u aA[4], bA[4], cA[4]; v2u aB[4], bB[4], cB[4];
        GLOAD(U, aA, aB, 0)
        GLOAD(U, bA, bB, 8)
        if (rep2_ == 0) { uslist[lane] = us0; uslist[64 + lane] = us1; vslist[lane] = vs0; vslist[64 + lane] = vs1; }
        LDS_WAIT(); asm volatile("" ::: "memory");
#pragma unroll 1
        for (int x0 = 0; x0 < 120; x0 += 24) {
            GLOAD(U, cA, cB, x0 + 16)
            UCOMP(aA, aB, x0)
            GLOAD(U, aA, aB, x0 + 24)
            UCOMP(bA, bB, x0 + 8)
            if (x0 + 32 < 128) GLOAD(U, bA, bB, x0 + 32)
            UCOMP(cA, cB, x0 + 16)
        }
        UCOMP(aA, aB, 120)
        }
        LDS_WAIT(); asm volatile("" ::: "memory");
#pragma unroll
        for (int i = 0; i < 16; ++i) acc[i] = (f32x2){0.f, 0.f};
        {
        v4u aA[4], bA[4], cA[4]; v2u aB[4], bB[4], cB[4];
        GLOAD(V, aA, aB, 0)
        GLOAD(V, bA, bB, 8)
#pragma unroll 1
        for (int x0 = 0; x0 < 120; x0 += 24) {
            GLOAD(V, cA, cB, x0 + 16)
            VCOMP(aA, aB, x0)
            GLOAD(V, aA, aB, x0 + 24)
            VCOMP(bA, bB, x0 + 8)
            if (x0 + 32 < 128) GLOAD(V, bA, bB, x0 + 32)
            VCOMP(cA, cB, x0 + 16)
        }
        VCOMP(aA, aB, 120)
        }
        asm volatile("" ::: "memory"); }
#undef GLOAD
#undef UCOMP
#undef VCOMP
        if (ABL & 8) {
#pragma unroll
            for (int i = 0; i < 16; ++i) acc[i] = (f32x2){0.f, 0.f}; }
        float tot[16];
#pragma unroll
        for (int i = 0; i < 16; ++i) { const float lo_ = acc[i >> 1][i & 1], hi_ = acc[8 + (i >> 1)][i & 1];
            tot[i] = (half ? hi_ : lo_) + __shfl_xor(half ? lo_ : hi_, 32); }
        const bool latent = r < ML;
        float* xr = latent ? xlat + (size_t)r * 1024 : xctx + (size_t)(r - ML) * 1024;
        const float* gp = mod + (latent ? (r >> 14) : 2) * 6144 + 5 * 1024;
        f32x4 xv[4]; float ss = 0.f;
#pragma unroll
        for (int k = 0; k < 4; ++k) { const int col = 16 * cl + 4 * k; const f32x4 xo = *(const GAS f32x4*)(xr + col), gt = *(const f32x4*)(gp + col);
            const f32x4 a4 = (f32x4){tot[4 * k], tot[4 * k + 1], tot[4 * k + 2], tot[4 * k + 3]};
            const f32x4 xn = xo + gt * a4; xv[k] = xn; ss += (xn.x * xn.x + xn.y * xn.y) + (xn.z * xn.z + xn.w * xn.w); }
        if (final_out) {
            const float rstd = 1.0f / sqrtf(wave_sum(ss) * (1.0f / 1024.0f) + EPS);
#pragma unroll
            for (int k = 0; k < 4; ++k) { const int col = 16 * cl + 4 * k; const f32x4 gf = *(const f32x4*)(A.g_final + col); *(GAS f32x4*)(xr + col) = xv[k] * rstd * gf; }
        } else {
#pragma unroll
            for (int k = 0; k < 4; ++k) { const int col = 16 * cl + 4 * k; *(GAS f32x4*)(xr + col) = xv[k]; }
            const float rstd = 1.0f / sqrtf(wave_sum(ss) * (1.0f / 1024.0f) + EPS);
            const float* mp = nmod + (latent ? (r >> 14) : 2) * 6144;
            v4u o[2];
#pragma unroll
            for (int k = 0; k < 4; ++k) { const int col = 16 * cl + 4 * k; const f32x4 g4 = *(const f32x4*)(gn + col), sh = *(const f32x4*)(mp + col), sc = *(const f32x4*)(mp + 1024 + col);
                const f32x4 y = xv[k] * rstd * g4 * (sc + 1.0f) + sh; o[k >> 1][(k & 1) * 2] = pk2(y.x, y.y); o[k >> 1][(k & 1) * 2 + 1] = pk2(y.z, y.w); }
            *(GAS v4u*)(XNw + (size_t)r * 1024 + 16 * cl) = o[0]; *(GAS v4u*)(XNw + (size_t)r * 1024 + 16 * cl + 8) = o[1];
        }
        LDS_WAIT(); asm volatile("" ::: "memory");
    }
}
}

#ifndef PHMASK
#define PHMASK 0xFFFF
#endif
#define PH(n) if constexpr (((PHMASK) >> (n)) & 1)
#ifndef ATT_THRL
#define ATT_THRL 4096
#endif
#ifndef NAIVE_G3
#define NAIVE_G3 0
#endif
#ifndef CHKSKIP
#define CHKSKIP ((1 << 12) | (1 << 20))
#endif
__global__ void __launch_bounds__(NTHREADS, 2) mega_fwd(Args A) {
    extern __shared__ __attribute__((aligned(16))) unsigned char lds_raw[];
    Ctx C;
    C.lds = (LAS unsigned char*)lds_raw;
    C.tid = threadIdx.x; C.lane = C.tid & 63; C.wave = __builtin_amdgcn_readfirstlane(C.tid >> 6);
    C.G = gridDim.x; { const int bx = blockIdx.x; C.vcu = (C.G % 8 == 0) ? (bx % 8) * (C.G / 8) + bx / 8 : bx; }
    volatile LAS unsigned* MISC = (volatile LAS unsigned*)(C.lds + MISC_OFF);
    for (int u = C.tid; u < (LDS_BYTES - LDSCTL_OFF) / 4; u += NTHREADS) ((LAS unsigned*)(C.lds + LDSCTL_OFF))[u] = 0u;
    __syncthreads();
    unsigned char* ws = A.ws;
    gu32* ctl = (gu32*)(ws + WS_CTL);
    (void)xcd_barrier_post((unsigned*)(ctl + CW_BAR), MISC + 8);
#ifdef PROBE_DEC
    { typedef int v6i_ __attribute__((ext_vector_type(6))); typedef float v32f_ __attribute__((ext_vector_type(32)));
      v6i_ w_; w_[0] = C.tid; w_[1] = C.tid * 3; w_[2] = C.tid * 5; w_[3] = C.tid * 7; w_[4] = C.tid * 11; w_[5] = C.tid * 13;
#pragma unroll 4
      for (int i_ = 0; i_ < PROBE_DEC; ++i_) { asm volatile("" : "+v"(w_)); const v32f_ r_ = __builtin_amdgcn_cvt_scalef32_pk32_f32_fp6(w_, 1.0f); asm volatile("" :: "v"(r_)); } }
#endif
#define GRID_BAR() do { unsigned char* w_ = A.ws; asm volatile("" : "+s"(w_)); XcdBarrier b_; b_.bar = (unsigned*)(w_ + WS_CTL) + CW_BAR; b_.x = xb_xcc_id(); b_.st = (volatile LAS unsigned*)(C.lds + MISC_OFF) + 8; xcd_barrier(b_); } while (0)
#ifdef SELFCHECK
#define CHK(stmt) do { if (l == 0) { PCTX(Cq); stmt; } GRID_BAR(); } while (0)
#else
#define CHK(stmt) do {} while (0)
#endif
#define PCTX(Cn) Ctx Cn; { const int t_ = opq_tid(); Cn.lds = C.lds; Cn.tid = t_; Cn.lane = t_ & 63; Cn.wave = __builtin_amdgcn_readfirstlane(t_ >> 6); Cn.G = C.G; Cn.vcu = C.vcu; }
    LAS unsigned char* ring = C.lds;

    bf16* XN = (bf16*)(ws + WS_XN); bf16* Qb = (bf16*)(ws + WS_Q); bf16* Kb = (bf16*)(ws + WS_K); bf16* Vb = (bf16*)(ws + WS_V);
    bf16* BG = (bf16*)(ws + WS_BG); bf16* CX = (bf16*)(ws + WS_CX); bf16* MM = (bf16*)(ws + WS_MM); bf16* YHY = (bf16*)(ws + WS_YHY);
    bf16* YHYT = (bf16*)(ws + WS_YHYT); bf16* HYT = (bf16*)(ws + WS_R1); bf16* HYTC = (bf16*)(ws + WS_HYTC); bf16* GG = (bf16*)(ws + WS_R1); float* SS = (float*)(ws + WS_R1);
    int* PEL = (int*)(ws + WS_PLIST); float* PGL = (float*)(ws + WS_PLIST + 8 * MiB);
    unsigned char* TU = ws + WS_TAB; unsigned char* TV = TU + (size_t)PEER_N * 768; float* TUS = (float*)(ws + WS_TAB + 32 * MiB); float* TVS = TUS + PEER_N;
    float* CTXB = (float*)(ws + WS_CTXB); const float* MOD = (const float*)(ws + WS_MOD);
    const float* ropec = (const float*)(ws + WS_ROPE); const float* ropes = ropec + 4096;

    PH(0) { PCTX(Cp); p0_prologue(A, Cp); }
#if PROBE_PRO
    __syncthreads();
    PH(0) { PCTX(Cp); p0_prologue(A, Cp); }
#endif
    GRID_BAR();

#pragma unroll 1
    for (int l = 0; l < DEPTH; ++l) {
        const bool need_ctx = (l < DEPTH - 1);
        const int MR = need_ctx ? MT : ML;
#define xold ((l == 0) ? A.x : (const float*)A.out)
#define cold ((l == 0) ? A.ctx : (const float*)CTXB)
#define WIN ((const bf16*)(ws + WS_WIN) + (size_t)l * IN_W * 1024)
#define MODl (MOD + (size_t)l * 3 * 6144)

        if (l == 0) { PH(1) { PCTX(Cp); norm_rows(Cp, xold, cold, MT, A.g_norm1 + l * 1024, MODl, 0, XN); }
        GRID_BAR(); }
        CHK(chk::c_norm(A, Cq, xold, cold, A.g_norm1 + l * 1024, MODl, 0, XN, 0); chk::c_mod(A, Cq, 1));

#pragma unroll 1
        for (int repg_ = 0; repg_ < REP_P2; ++repg_) {
        PH(2) {
            pg8::Gemm g{XN, WIN, MT, 2304, 1024}; pg8::StaticOrder S; S.init(MT, 2304, C.G, (int)blockIdx.x);
            pg8::EpiIn E{Qb, Kb, Vb, BG, CX, A.q_gain + l * 64, A.k_gain + l * 64, ropec, ropes};
            pg8::gemm_phase<pg8::EpiIn, pg8::StaticOrder, true, true>(ring, g, S, E);
        }
        PH(3) {
            pg8::Gemm g{WIN + (size_t)HY0 * 1024, XN, 1536, MR, 1024}; pg8::StaticOrder S; S.init(1536, MR, C.G, (int)blockIdx.x, (MT / 256) * 9);
            pg8::EpiHyT E{HYT, HYTC};
            pg8::gemm_phase<pg8::EpiHyT, pg8::StaticOrder, true, true>(ring, g, S, E);
        }
        }
        GRID_BAR();

        CHK(chk::c_proj(A, Cq, l, 2); chk::c_att_save(A, Cq); chk::c_hy1(A, Cq, l, 300); chk::c_hy2(A, Cq, l, 1, 300));
        CHK(chk::c_hy3(A, Cq, l, 1, 300));
        PH(4)
#pragma unroll 1
        for (int rep3_ = 0; rep3_ < REP_HY; ++rep3_)
        for (int c = C.vcu; c < HY_W; c += C.G) { PCTX(Cp); hy::hyena_unit(A, Cp, l, c, need_ctx); }
        __syncthreads();
        PH(5) { PCTX(Cp); ysc_pass(Cp, BG, CX, A.sc_conv_w + (size_t)l * 3 * 512, MR); }
        GRID_BAR();

        CHK(chk::c_ysc(A, Cq, l, 8); chk::c_hy4(A, Cq, l, 1, 300, 9));
        PH(5) { PCTX(Cp); yhy_transpose(Cp, YHYT, YHY, need_ctx); }
        __syncthreads();
        PH(6) {
#if PROBE_ATT
            for (int ug = C.vcu; ug < 1024; ug += C.G) {
                const int grp = (ug >> 6) & 3, rest = (ug & 63) | ((ug >> 8) << 6), b = grp >> 1, kvh = grp & 1, h = kvh * 4 + (rest & 3), qb = rest >> 2;
                const attn_body::bf16* Qu = (const attn_body::bf16*)(Qb + ((size_t)b * SEQ + (size_t)qb * 256) * 512 + h * 64);
                const attn_body::bf16* Kh = (const attn_body::bf16*)(Kb + (size_t)b * KVL * 128 + kvh * 64);
                const attn_body::bf16* Vh = (const attn_body::bf16*)(Vb + (size_t)b * KVL * 128 + kvh * 64);
                attn_body::attn_unit<ATT_THRL>(Qu, Kh, Vh, (attn_body::bf16*)(CX + ((size_t)b * SEQ + (size_t)qb * 256) * 512 + h * 64), KVL / 64, (char*)lds_raw);
            }
#endif
            for (int ug = C.vcu; ug < 1024; ug += C.G) {
                const int grp = (ug >> 6) & 3, rest = (ug & 63) | ((ug >> 8) << 6), b = grp >> 1, kvh = grp & 1, h = kvh * 4 + (rest & 3), qb = rest >> 2;
                const attn_body::bf16* Qu = (const attn_body::bf16*)(Qb + ((size_t)b * SEQ + (size_t)qb * 256) * 512 + h * 64);
                const attn_body::bf16* Kh = (const attn_body::bf16*)(Kb + (size_t)b * KVL * 128 + kvh * 64);
                const attn_body::bf16* Vh = (const attn_body::bf16*)(Vb + (size_t)b * KVL * 128 + kvh * 64);
                attn_body::attn_unit<ATT_THRL>(Qu, Kh, Vh, (attn_body::bf16*)Qu, KVL / 64, (char*)lds_raw);
            }
            if (need_ctx) for (int ug = C.vcu; ug < 16; ug += C.G) {
                const int b = ug >> 3, h = ug & 7;
                const attn_body::bf16* Qu = (const attn_body::bf16*)(Qb + ((size_t)ML + (size_t)b * CTX_LEN) * 512 + h * 64);
                const attn_body::bf16* Kh = (const attn_body::bf16*)(Kb + (size_t)b * KVL * 128 + (h >> 2) * 64);
                const attn_body::bf16* Vh = (const attn_body::bf16*)(Vb + (size_t)b * KVL * 128 + (h >> 2) * 64);
                attn_body::attn_unit<ATT_THRL>(Qu, Kh, Vh, (attn_body::bf16*)Qu, CTX_LEN / 64, (char*)lds_raw);
            }
        }
        GRID_BAR();

        CHK(chk::c_att(A, Cq, 10); chk::c_yhyT(A, Cq, 11));
        const bool packed_ctx = need_ctx && C.G == 256;
#pragma unroll 1
        for (int half = 0; half < (MR + 16383) / 16384; ++half) {
            const int rowbase = half * 16384, nr = (MR - rowbase) < 16384 ? (MR - rowbase) : 16384;
            if (nr == 16384) {
                PH(7) {
                    pg8::Gemm g{XN + (size_t)rowbase * 1024, WIN + (size_t)GT0 * 1024, nr, 3072, 1024}; pg8::GateOrder S; S.S.init(nr, 1024, C.G, (int)blockIdx.x);
                    pg8::EpiGate E{GG};
                    pg8::gemm_phase<pg8::EpiGate, pg8::GateOrder, true, true>(ring, g, S, E);
                }
                VM_WAIT(); __syncthreads();
                PH(8) {
                    pg8::Gemm g{Qb + (size_t)rowbase * 512, (const bf16*)(ws + WS_WBR) + (size_t)(l * 3) * 1024 * 512, nr, 1024, 512};
                    pg8::MergeOrder S; S.S.init(nr, 1024, C.G, (int)blockIdx.x); S.A0 = (const char*)(Qb + (size_t)rowbase * 512); S.d1 = (const char*)BG - (const char*)Qb; S.d2 = (const char*)YHY - (const char*)Qb;
                    pg8::EpiMerge3 E{GG, MM + (size_t)rowbase * 1024};
                    pg8::gemm_phase<pg8::EpiMerge3, pg8::MergeOrder, true, true>(ring, g, S, E);
                }
                VM_WAIT(); __syncthreads();
                if (rowbase + nr >= ML) GRID_BAR();
            } else if (!packed_ctx) {
                PH(7) {
                    pg8::Gemm g{XN + (size_t)rowbase * 1024, WIN + (size_t)GT0 * 1024, nr, 3072, 1024}; pg8::StaticOrder S; S.init(nr, 3072, C.G, (int)blockIdx.x);
                    pg8::EpiGate E{GG};
                    pg8::gemm_phase<pg8::EpiGate, pg8::StaticOrder, true, true>(ring, g, S, E);
                }
                PH(10) { const int nb_ = (nr / 256) * 12; if ((int)blockIdx.x >= nb_) { PCTX(Cp); cvt_table_fp6(Cp, A.peer_u + (size_t)l * PEER_N * 1024, TU, TUS, PEER_N, (int)blockIdx.x - nb_, C.G - nb_); } }
                GRID_BAR();
                PH(8) {
                    pg8::Gemm g{Qb + (size_t)rowbase * 512, (const bf16*)(ws + WS_WBR) + (size_t)(l * 3) * 1024 * 512, nr, 1024, 512};
                    pg8::MergeOrder S; S.S.init(nr, 1024, C.G, (int)blockIdx.x); S.A0 = (const char*)(Qb + (size_t)rowbase * 512); S.d1 = (const char*)BG - (const char*)Qb; S.d2 = (const char*)YHY - (const char*)Qb;
                    pg8::EpiMerge3 E{GG, MM + (size_t)rowbase * 1024};
                    pg8::gemm_phase<pg8::EpiMerge3, pg8::MergeOrder, true, true>(ring, g, S, E);
                }
                PH(10) { const int nb_ = (nr / 256) * 4; if ((int)blockIdx.x >= nb_) { PCTX(Cp); cvt_table_fp6(Cp, A.peer_v + (size_t)l * PEER_N * 1024, TV, TVS, PEER_N, (int)blockIdx.x - nb_, C.G - nb_); } }
                GRID_BAR();
            }
        }

        if (packed_ctx) {
            const int b = (int)blockIdx.x;
            const pg8::Gemm gP{MM, (const bf16*)(ws + WS_WOUT) + (size_t)l * 1024 * 1024, MR, 1024, 1024};
            const pg8::EpiResid EP{xold, A.out, cold, CTXB, MODl};
            const int rowbase = ML, nr = MR - ML;
            if (b < 24) PH(7) {
                pg8::Gemm g{XN + (size_t)rowbase * 1024, WIN + (size_t)GT0 * 1024, nr, 3072, 1024}; pg8::StaticOrder S; S.init(nr, 3072, C.G, b);
                pg8::EpiGate E{GG};
                pg8::gemm_phase<pg8::EpiGate, pg8::StaticOrder, true, true>(ring, g, S, E);
            }
            PH(9) { const int k = b - 24; pg8::OneUnit S{k >= 0 ? (k & 7) * 64 + (k >> 3) : -1, 4}; pg8::gemm_phase<pg8::EpiResid, pg8::OneUnit, true, true>(ring, gP, S, EP); }
            GRID_BAR();
            if (b < 8) PH(8) {
                pg8::Gemm g{Qb + (size_t)rowbase * 512, (const bf16*)(ws + WS_WBR) + (size_t)(l * 3) * 1024 * 512, nr, 1024, 512};
                pg8::MergeOrder S; S.S.init(nr, 1024, C.G, b); S.A0 = (const char*)(Qb + (size_t)rowbase * 512); S.d1 = (const char*)BG - (const char*)Qb; S.d2 = (const char*)YHY - (const char*)Qb;
                pg8::EpiMerge3 E{GG, MM + (size_t)rowbase * 1024};
                pg8::gemm_phase<pg8::EpiMerge3, pg8::MergeOrder, true, true>(ring, g, S, E);
            }
            PH(9) { const int k = b >= 8 ? 232 + (b - 8) : -1; pg8::OneUnit S{k >= 0 ? (k & 7) * 64 + (k >> 3) : -1, 4}; pg8::gemm_phase<pg8::EpiResid, pg8::OneUnit, true, true>(ring, gP, S, EP); }
            GRID_BAR();
            PH(9) { const int k = b < 32 ? 480 + b : -1; const int idx = k >= 0 ? (k & 7) * 64 + (k >> 3) : (b < 40 ? 512 + (b - 32) : -1);
                    pg8::OneUnit S{idx, 4}; pg8::gemm_phase<pg8::EpiResid, pg8::OneUnit, true, true>(ring, gP, S, EP); }
            if (b >= 40) PH(10) { PCTX(Cp); cvt_table_fp6(Cp, A.peer_u + (size_t)l * PEER_N * 1024, TU, TUS, PEER_N, b - 40, C.G - 40); cvt_table_fp6(Cp, A.peer_v + (size_t)l * PEER_N * 1024, TV, TVS, PEER_N, b - 40, C.G - 40); }
            GRID_BAR();
        } else {
        PH(9) {
            pg8::Gemm g{MM, (const bf16*)(ws + WS_WOUT) + (size_t)l * 1024 * 1024, MR, 1024, 1024}; pg8::StaticOrder S; S.init(MR, 1024, C.G, (int)blockIdx.x);
            pg8::EpiResid E{xold, A.out, cold, CTXB, MODl};
            pg8::gemm_phase<pg8::EpiResid, pg8::StaticOrder, true, true>(ring, g, S, E);
        }
        GRID_BAR();
        }

        CHK(chk::c_wout(A, Cq, l, 14));
        PH(10) { PCTX(Cp); norm_rows(Cp, A.out, CTXB, MR, A.g_norm2 + l * 1024, MODl, 3, XN); }
        if (!need_ctx) {
        PH(10) { PCTX(Cp); cvt_table_fp6(Cp, A.peer_u + (size_t)l * PEER_N * 1024, TU, TUS, PEER_N); }
        PH(10) { PCTX(Cp); cvt_table_fp6(Cp, A.peer_v + (size_t)l * PEER_N * 1024, TV, TVS, PEER_N); }
        }
        GRID_BAR();

        CHK(chk::c_norm(A, Cq, A.out, CTXB, A.g_norm2 + l * 1024, MODl, 3, XN, 15));
        const int nchunk = (MR + 16383) / 16384;
        const bool fold_ctx = packed_ctx && nchunk == 3;
        float* SSC = (float*)(ws + WS_PLIST + 16 * MiB); int* ELC = (int*)(ws + WS_PLIST + 20 * MiB); float* GLC = (float*)(ws + WS_PLIST + 21 * MiB);
#pragma unroll 1
        for (int ch = 0; ch < nchunk; ++ch) {
            const int row0 = ch * 16384, nr = (MR - row0) < 16384 ? (MR - row0) : 16384;
            if (fold_ctx && ch == 2) break;
            pg8::StaticOrder SSO; SSO.init(2048, nr, C.G, (int)blockIdx.x);
#pragma unroll 1
            for (int reps_ = 0; reps_ < REP_SG; ++reps_)
            PH(11) {
                pg8::Gemm g{(const bf16*)(ws + WS_WPEER) + (size_t)l * 2048 * 1024, XN + (size_t)row0 * 1024, 2048, nr, 1024};
                pg8::EpiScoreT E{SS};
                pg8::gemm_phase<pg8::EpiScoreT, pg8::StaticOrder, true, true>(ring, g, SSO, E);
            }
            if (nr < 4096) {
                GRID_BAR();
                PH(12) { PCTX(Cp); peer::route_tokens_wave(Cp, SS, nr, PEL, PGL); }
            } else {
                VM_WAIT(); __syncthreads();
#pragma unroll 1
                for (int repr_ = 0; repr_ < REP_ROUTE; ++repr_) { PH(12) { PCTX(Cp); peer::route_tasks(Cp, SS, nr, PEL, PGL, SSO); } }
                if (fold_ctx && ch == 1) PH(12) { PCTX(Cp); peer::route_tokens_wave(Cp, SSC, MR - ML, ELC, GLC); }
            }
            GRID_BAR();
            if (fold_ctx && ch == 0 && (int)blockIdx.x < 16) PH(11) {
                pg8::Gemm g{(const bf16*)(ws + WS_WPEER) + (size_t)l * 2048 * 1024, XN + (size_t)ML * 1024, 2048, MR - ML, 1024};
                pg8::OneUnit S1{(int)blockIdx.x, 2}; pg8::EpiScoreT E{SSC};
                pg8::gemm_phase<pg8::EpiScoreT, pg8::OneUnit, true, true>(ring, g, S1, E);
            }
            PH(12) { PCTX(Cp); peer::topk_gather(A, Cp, l, row0, nr, PEL, PGL, TU, TV, TUS, TVS, XN, A.out, CTXB, MODl, !need_ctx, A.g_norm1 + (l + 1) * 1024, MOD + (size_t)(l + 1) * 3 * 6144, XN); }
            if (fold_ctx && ch == 1) PH(12) { PCTX(Cp); peer::topk_gather(A, Cp, l, ML, MR - ML, ELC, GLC, TU, TV, TUS, TVS, XN, A.out, CTXB, MODl, !need_ctx, A.g_norm1 + (l + 1) * 1024, MOD + (size_t)(l + 1) * 3 * 6144, XN); }
            GRID_BAR();
        }
    }
#ifdef SELFCHECK
    {
        const float* acc = (const float*)(ws + chk::WS_DBG); int first = -1;
        const int order[21] = {0, 1, 2, 3, 4, 5, 6, 7, 8, 9, 10, 11, 12, 18, 19, 20, 13, 14, 15, 16, 17};
#pragma unroll
        for (int p = 0; p < 21; ++p) { const int k = order[p]; const float se = acc[2 * k], sr = acc[2 * k + 1]; const float tol = (k == 17) ? 0.15f : 0.03f;
            if (first < 0 && !((CHKSKIP >> k) & 1) && (!(se <= tol * tol * sr) || sr == 0.f)) first = p; }
        if (first >= 0) { const float sc = 1.0f + 0.25f * (float)(first + 1);
            for (size_t i = (size_t)C.vcu * NTHREADS + C.tid; i < (size_t)ML * 1024; i += (size_t)C.G * NTHREADS) A.out[i] *= sc; }
    }
#endif
#undef GRID_BAR
#undef xold
#undef cold
#undef WIN
#undef MODl
}

extern "C" void kernel_launch(void* const* d_in, const int* in_sizes, int n_in, void* d_out, int out_size, void* d_ws, size_t ws_size, hipStream_t stream) {
    static int grid = 0;
    if (grid == 0) {
        if (n_in != 32 || in_sizes[0] != ML * D_MODEL || out_size != ML * D_MODEL || ws_size < WS_END) { fprintf(stderr, "kernel_launch: unexpected shapes (n_in %d, in0 %d, out %d, ws %zu)\n", n_in, n_in > 0 ? in_sizes[0] : -1, out_size, ws_size); grid = -1; return; }
        int dev = 0, cus = 0, per_cu = 0;
        if (hipGetDevice(&dev) != hipSuccess || hipDeviceGetAttribute(&cus, hipDeviceAttributeMultiprocessorCount, dev) != hipSuccess) { grid = -1; return; }
        if (hipFuncSetAttribute((const void*)mega_fwd, hipFuncAttributeMaxDynamicSharedMemorySize, LDS_BYTES) != hipSuccess) { fprintf(stderr, "kernel_launch: hipFuncSetAttribute failed\n"); grid = -1; return; }
        if (hipOccupancyMaxActiveBlocksPerMultiprocessor(&per_cu, (const void*)mega_fwd, NTHREADS, LDS_BYTES) != hipSuccess || per_cu < 1) { fprintf(stderr, "kernel_launch: occupancy query says %d\n", per_cu); }
        (void)hipGetLastError();
        grid = cus;
    }
    if (grid < 0) return;
    if (hipMemsetAsync((char*)d_ws + WS_CTL, 0, CTL_ZERO_BYTES, stream) != hipSuccess) return;
#ifdef SELFCHECK
    (void)hipMemsetAsync((char*)d_ws + chk::WS_DBG, 0, 65536, stream);
#endif
    Args a{};
    const float** ap = (const float**)&a;
    for (int i = 0; i < 32; ++i) ap[i] = (const float*)d_in[i];
    a.out = (float*)d_out; a.ws = (unsigned char*)d_ws;
    hipLaunchKernelGGL(mega_fwd, dim3(grid), dim3(NTHREADS), LDS_BYTES, stream, a);
}
```

```cpp
#include <hip/hip_runtime.h>
#include <hip/hip_bf16.h>
#include <cstdio>
#include <cstdint>
#include <cmath>

#define SELFCHECK_ON 0
#if SELFCHECK_ON
#define SELFCHECK
#endif
#define REP_ROUTE 1
#define REP_GATHER 1
#define REP_HY 1
#define PROBE_FFT 0
#define REP_FILT 1
#define PROBE_REST 0
#define PROBE_PRO 0
#define PROBE_ATT 0
#ifndef FP6_ILV
#define FP6_ILV 1
#endif
#define REP_P2 1
#define REP_GM 1
#define REP_SG 1
#ifndef ABL
#define ABL 0
#endif
constexpr int D_MODEL = 1024, BATCH = 2, SEQ = 16384, DEPTH = 2, GRID_W = 64, CTX_LEN = 256;
constexpr int N_HEADS = 8, N_KV = 2, HEAD_DIM = 64, ATT_W = 512, KV_W = 128;
constexpr int SC_W = 512, HY_W = 512, HY_EMB = 33, HY_FH = 64;
constexpr int PEER_HEADS = 8, PEER_NKEYS = 128, PEER_N = 16384, PEER_TOPK = 16;
constexpr int Q0 = 0, K0 = 512, V0 = 640, SC0 = 768, HY0 = 2304, GT0 = 3840, IN_W = 6912;
constexpr int ML = BATCH * SEQ;
constexpr int MC = BATCH * CTX_LEN;
constexpr int MT = ML + MC;
constexpr int KVL = CTX_LEN + SEQ;
constexpr float EPS = 1e-6f;
constexpr float C2Q = 0.125f * 1.4426950408889634f;

constexpr size_t MiB = 1u << 20;
constexpr size_t WS_CTL = 0, CTL_ZERO_BYTES = 64 * 1024;
constexpr size_t WS_MOD = 1 * MiB;
constexpr size_t WS_ROPE = 2 * MiB;
constexpr size_t WS_H2 = 3 * MiB;
constexpr size_t WS_H2C = 11 * MiB;
constexpr size_t WS_CTXB = 12 * MiB;
constexpr size_t WS_WIN = 16 * MiB;
constexpr size_t WS_WBR = 43 * MiB;
constexpr size_t WS_WOUT = 49 * MiB;
constexpr size_t WS_WPEER = 53 * MiB;
constexpr size_t WS_XN = 64 * MiB;
constexpr size_t WS_Q = 129 * MiB;
constexpr size_t WS_K = 162 * MiB;
constexpr size_t WS_V = WS_K + (size_t)BATCH * KVL * KV_W * 2;
constexpr size_t WS_BG = 179 * MiB;
constexpr size_t WS_CX = 212 * MiB;
constexpr size_t WS_YHYT = WS_CX + (size_t)MT * 512 * 2;
constexpr size_t WS_MM = WS_CX;
constexpr size_t WS_YHY = 277 * MiB;
constexpr size_t WS_R1 = 310 * MiB;
constexpr size_t WS_HYTC = WS_R1 + (size_t)BATCH * 1536 * SEQ * 2;
constexpr size_t WS_PLIST = 440 * MiB;
constexpr size_t WS_TAB = 472 * MiB;
constexpr size_t WS_HSCR = 472 * MiB;
constexpr size_t WS_END = 506 * MiB;
static_assert(WS_YHYT + (size_t)BATCH * 512 * (SEQ + CTX_LEN) * 2 <= WS_YHY, "ws map");
static_assert(WS_HYTC + (size_t)BATCH * 1536 * CTX_LEN * 2 <= WS_PLIST && WS_R1 + (size_t)2048 * (16384 + 64) * 4 <= WS_PLIST && WS_PLIST + 16 * MiB <= WS_HSCR, "ws map");
static_assert(WS_V + (size_t)BATCH * KVL * KV_W * 2 <= WS_BG, "ws map");
constexpr int CW_TMO = 0, CW_CODE = 1, CW_BAR = 4096;

constexpr int RING_BYTES = 131072;
constexpr int HYB_BYTES = 17408 * 8;
constexpr int HYS_OFF = HYB_BYTES;
constexpr int LDSCTL_OFF = 143360, MISC_OFF = LDSCTL_OFF + 320;
constexpr int LDS_BYTES = 147456;
constexpr int NWAVES = 8, NTHREADS = 512;

#define GAS __attribute__((address_space(1)))
#define LAS __attribute__((address_space(3)))
typedef unsigned short bf16;
typedef unsigned v4u __attribute__((ext_vector_type(4)));
typedef unsigned v2u __attribute__((ext_vector_type(2)));
typedef float f32x4 __attribute__((ext_vector_type(4)));
typedef float f32x2 __attribute__((ext_vector_type(2)));
typedef int v6i __attribute__((ext_vector_type(6)));
typedef float v16f __attribute__((ext_vector_type(16)));
typedef float v32f __attribute__((ext_vector_type(32)));
typedef short bf16x8 __attribute__((ext_vector_type(8)));
typedef GAS unsigned gu32;
#define RLX_AGENT __ATOMIC_RELAXED, __HIP_MEMORY_SCOPE_AGENT
#define LDS_WAIT() asm volatile("s_waitcnt lgkmcnt(0)" ::: "memory")
#define VM_WAIT() asm volatile("s_waitcnt vmcnt(0)" ::: "memory")
__device__ __forceinline__ unsigned f2bf(float f) { unsigned u = __builtin_bit_cast(unsigned, f); return (u + 0x7fffu + ((u >> 16) & 1u)) >> 16; }
__device__ __forceinline__ unsigned pk2(float lo, float hi) { return f2bf(lo) | (f2bf(hi) << 16); }
__device__ __forceinline__ float bflo(unsigned w) { return __builtin_bit_cast(float, w << 16); }
__device__ __forceinline__ float bfhi(unsigned w) { return __builtin_bit_cast(float, w & 0xffff0000u); }
__device__ __forceinline__ float bf1(bf16 h) { return __builtin_bit_cast(float, (unsigned)h << 16); }
__device__ __forceinline__ int opq_tid() { int t = threadIdx.x; asm volatile("" : "+v"(t)); return t; }
__device__ __forceinline__ float wave_sum(float v) {
#pragma unroll
    for (int o = 1; o < 64; o <<= 1) v += __shfl_xor(v, o);
    return v;
}
__device__ __forceinline__ float wave_max(float v) {
#pragma unroll
    for (int o = 1; o < 64; o <<= 1) v = fmaxf(v, __shfl_xor(v, o));
    return v;
}

#define XB_TMO      128
#define XB_XCNT(j)  (256  + 64 * (j))
#define XB_XSUB(j)  (1280 + 64 * (j))
#define XB_XGEN(j)  (2304 + 64 * (j))
#define XB_TOP      3328
#define XB_TOPGEN   3392
#define XCD_BAR_WORDS 3456
#define XB_SPIN_CAP (1u << 22)
__device__ __forceinline__ unsigned xb_ld(unsigned* p)              { return __hip_atomic_load(p, __ATOMIC_RELAXED, __HIP_MEMORY_SCOPE_AGENT); }
__device__ __forceinline__ unsigned xb_add(unsigned* p, unsigned v) { return __hip_atomic_fetch_add(p, v, __ATOMIC_RELAXED, __HIP_MEMORY_SCOPE_AGENT); }
__device__ __forceinline__ unsigned xb_xcc_id() { return (unsigned)__builtin_amdgcn_s_getreg((3 << 11) | 20) & 0xFu; }
#define XB_SPIN(cond, bar) do { unsigned _sp = 0; while (cond) { __builtin_amdgcn_s_sleep(1); \
    if ((++_sp & 255u) == 0u) { if (xb_ld(&(bar)[XB_TMO])) break; if (_sp > XB_SPIN_CAP) { atomicAdd(&(bar)[XB_TMO], 1u); break; } } } } while (0)
struct XcdBarrier { unsigned* bar; unsigned x; volatile LAS unsigned* st; };
__device__ __forceinline__ XcdBarrier xcd_barrier_post(unsigned* bar, volatile LAS unsigned* st) {
    XcdBarrier b; b.bar = bar; b.x = xb_xcc_id(); b.st = st;
    if (threadIdx.x == 0) (void)xb_add(&bar[XB_XCNT(b.x)], 1u);
    return b;
}
__device__ __forceinline__ void xcd_barrier_complete(unsigned* bar, unsigned x, unsigned& nloc, unsigned& nx) {
    const unsigned G = gridDim.x * gridDim.y * gridDim.z;
    unsigned sum, cnt, mine, sp = 0u;
    for (;;) {
        sum = 0u; cnt = 0u; mine = 0u;
#pragma unroll
        for (unsigned j = 0; j < 16; ++j) { const unsigned c = xb_ld(&bar[XB_XCNT(j)]); sum += c; cnt += (c > 0u) ? 1u : 0u; mine = (j == x) ? c : mine; }
        if (sum == G) break;
        __builtin_amdgcn_s_sleep(1);
        if ((++sp & 255u) == 0u) { if (xb_ld(&bar[XB_TMO])) break; if (sp > XB_SPIN_CAP) { atomicAdd(&bar[XB_TMO], 1u); break; } }
    }
    nloc = mine > 0u ? mine : 1u; nx = cnt > 0u ? cnt : 1u;
}
__device__ __forceinline__ void xcd_barrier(const XcdBarrier& b) {
    asm volatile("s_waitcnt vmcnt(0)" ::: "memory");
    __syncthreads();
    if (threadIdx.x == 0) {
        unsigned* bar = b.bar;
        __builtin_amdgcn_s_waitcnt(0);
        unsigned nloc = b.st[0], nx = b.st[1];
        if (nloc == 0u) { xcd_barrier_complete(bar, b.x, nloc, nx); b.st[0] = nloc; b.st[1] = nx; }
        const unsigned old = xb_add(&bar[XB_XSUB(b.x)], 1u);
        const unsigned gen = old / nloc;
        if (old + 1u == (gen + 1u) * nloc) {
            __builtin_amdgcn_fence(__ATOMIC_RELEASE, "agent");
            asm volatile("s_waitcnt vmcnt(0)" ::: "memory");
            const unsigned og = xb_add(&bar[XB_TOP], 1u);
            const unsigned tg = og / nx;
            if (og + 1u == (tg + 1u) * nx) xb_add(&bar[XB_TOPGEN], 1u);
            else XB_SPIN(xb_ld(&bar[XB_TOPGEN]) == tg, bar);
            __builtin_amdgcn_fence(__ATOMIC_ACQUIRE, "agent");
            xb_add(&bar[XB_XGEN(b.x)], 1u);
            asm volatile("s_waitcnt vmcnt(0)" ::: "memory");
        } else {
            XB_SPIN(xb_ld(&bar[XB_XGEN(b.x)]) == gen, bar);
            __builtin_amdgcn_fence(__ATOMIC_ACQUIRE, "agent");
            asm volatile("s_waitcnt vmcnt(0)" ::: "memory");
        }
    }
    __syncthreads();
}
namespace pg8 {
#define PG8_LAS __attribute__((address_space(3)))
typedef unsigned short bf16_t;
typedef short bf16x8 __attribute__((ext_vector_type(8)));
typedef float f32x4 __attribute__((ext_vector_type(4)));
typedef unsigned u32x4 __attribute__((ext_vector_type(4)));
constexpr int BM = 256, BK = 64, HALF = 128, HTB = HALF * BK * 2  , STAGE_BYTES = 8 * HTB, NXCD = 8, WGM = 8;

__host__ __device__ __forceinline__ int lds_byte(int r, int c) { const int st = (r >> 4) * 2 + (c >> 5), rr = r & 15, cc = c & 31, ob = rr * 64 + cc * 2; return st * 1024 + (ob ^ (((ob >> 9) & 1) << 5)); }
__host__ __device__ __forceinline__ void stage_rc(int b, int& R, int& C) { const int st = b / 1024, sb = b % 1024, swz = sb ^ (((sb >> 9) & 1) << 5); R = (st >> 1) * 16 + swz / 64; C = (st & 1) * 32 + (swz % 64) / 2; }
__host__ __device__ __forceinline__ int perm32(int rho) { const int n = rho >> 4, i = rho & 15; return 8 * (i >> 2) + 4 * n + (i & 3); }

struct Unit { int pm, pn, z; };
struct Gemm { const bf16_t* A; const bf16_t* Bt; int M, N, K; };


struct StaticOrder {
    int nM, nN, nwg, G, c;
    __host__ __device__ void init(int M, int N, int G_, int c_, int rot = 0) { nM = M / BM; nN = N / BM; nwg = nM * nN; G = G_; c = (c_ + G_ - (rot % G_)) % G_; }
    __host__ __device__ bool next(int i, Unit& u) const {
        const long L = (long)i * G + c; if (L >= nwg) return false;
        int wgid = (int)L; { const int q = nwg / NXCD, r = nwg % NXCD, xcd = wgid % NXCD, off = wgid / NXCD; wgid = (xcd < r ? xcd * (q + 1) : r * (q + 1) + (xcd - r) * q) + off; }
        const int nig = WGM * nN, gid = wgid / nig, fm = gid * WGM, gsz = (nM - fm) < WGM ? (nM - fm) : WGM;
        u.pm = fm + ((wgid % nig) % gsz); u.pn = (wgid % nig) / gsz; return true;
    }
    __device__ __forceinline__ void a_ready(const Unit&) const {}
    __device__ __forceinline__ void done(const Unit&) const {}
    __device__ __forceinline__ const char* baseA(const Gemm& g, const Unit& u, size_t tstep) const { return (const char*)g.A + (size_t)u.pm * tstep; }
    __device__ __forceinline__ const char* baseB(const Gemm& g, const Unit& u, size_t tstep) const { return (const char*)g.Bt + (size_t)u.pn * tstep; }
};
struct OneUnit {
    int idx, nN;
    __host__ __device__ bool next(int i, Unit& u) const { if (i != 0 || idx < 0) return false; u.pm = idx / nN; u.pn = idx % nN; u.z = 0; return true; }
    __device__ __forceinline__ void a_ready(const Unit&) const {}
    __device__ __forceinline__ void done(const Unit&) const {}
    __device__ __forceinline__ const char* baseA(const Gemm& g, const Unit& u, size_t tstep) const { return (const char*)g.A + (size_t)u.pm * tstep; }
    __device__ __forceinline__ const char* baseB(const Gemm& g, const Unit& u, size_t tstep) const { return (const char*)g.Bt + (size_t)u.pn * tstep; }
};
struct GateOrder {
    StaticOrder S;
    __host__ __device__ bool next(int i, Unit& u) const { if (!S.next(i / 3, u)) return false; u.pn += 4 * (i % 3); u.z = 0; return true; }
    __device__ __forceinline__ void a_ready(const Unit&) const {}
    __device__ __forceinline__ void done(const Unit&) const {}
    __device__ __forceinline__ const char* baseA(const Gemm& g, const Unit& u, size_t tstep) const { return (const char*)g.A + (size_t)u.pm * tstep; }
    __device__ __forceinline__ const char* baseB(const Gemm& g, const Unit& u, size_t tstep) const { return (const char*)g.Bt + (size_t)u.pn * tstep; }
};
struct MergeOrder {
    StaticOrder S; const char* A0; long d1, d2;
    __host__ __device__ bool next(int i, Unit& u) const { if (!S.next(i / 3, u)) return false; u.z = i % 3; return true; }
    __device__ __forceinline__ void a_ready(const Unit&) const {}
    __device__ __forceinline__ void done(const Unit&) const {}
    __device__ __forceinline__ const char* baseA(const Gemm& g, const Unit& u, size_t tstep) const { return A0 + (long)(u.z & 1) * d1 + (long)(u.z >> 1) * d2 + (size_t)u.pm * tstep; }
    __device__ __forceinline__ const char* baseB(const Gemm& g, const Unit& u, size_t tstep) const { return (const char*)g.Bt + ((size_t)u.z * g.N * g.K) * 2 + (size_t)u.pn * tstep; }
};

typedef float f32x2_t __attribute__((ext_vector_type(2))); typedef __bf16 bf16x2_t __attribute__((ext_vector_type(2)));
__device__ __forceinline__ unsigned cvt_pk_bf16(float lo, float hi) { f32x2_t v = {lo, hi}; bf16x2_t b = __builtin_convertvector(v, bf16x2_t); return __builtin_bit_cast(unsigned, b); }
__device__ __forceinline__ u32x4 pack8(const f32x4& a, const f32x4& b) { u32x4 w; w.x = cvt_pk_bf16(a[0], a[1]); w.y = cvt_pk_bf16(a[2], a[3]); w.z = cvt_pk_bf16(b[0], b[1]); w.w = cvt_pk_bf16(b[2], b[3]); return w; }
__device__ __forceinline__ void unpack8(const u32x4& w, f32x4& a, f32x4& b) {
    a[0] = __builtin_bit_cast(float, w.x << 16); a[1] = __builtin_bit_cast(float, w.x & 0xffff0000u); a[2] = __builtin_bit_cast(float, w.y << 16); a[3] = __builtin_bit_cast(float, w.y & 0xffff0000u);
    b[0] = __builtin_bit_cast(float, w.z << 16); b[1] = __builtin_bit_cast(float, w.z & 0xffff0000u); b[2] = __builtin_bit_cast(float, w.w << 16); b[3] = __builtin_bit_cast(float, w.w & 0xffff0000u);
}

struct EpiIn {
    static constexpr bool PERM = true, AFTER_DRAIN = false, RESCALE = false;
    bf16_t* Q; bf16_t* Kb; bf16_t* Vb; bf16_t* BG; bf16_t* CX; const float* qgain; const float* kgain; const float* ropec; const float* ropes;
    __device__ __forceinline__ void operator()(const f32x4 (&acc)[2][2][4][2], const Unit& u, int wr, int wc, int fr_, int fq_) const {
        const int ln_ = opq_tid() & 63; const int fr = ln_ & 15, fq = ln_ >> 4;
        const int row0 = u.pm * BM + wr * 64 + fr;
        const int pn = u.pn;
        if (pn < 2 || (pn == 2 && wc < 2)) {
            const bool isq = pn < 2;
            const float* gain = isq ? qgain : kgain;
            const float qs = isq ? 0.18033688011112042f : 1.0f;
#pragma unroll
            for (int ai = 0; ai < 2; ++ai)
#pragma unroll
                for (int m = 0; m < 4; ++m) {
                    const int r = row0 + ai * HALF + m * 16;
                    float ss = 0.f;
#pragma unroll
                    for (int bj = 0; bj < 2; ++bj)
#pragma unroll
                        for (int n = 0; n < 2; ++n) { const f32x4 x = acc[ai][bj][m][n]; ss += (x[0] * x[0] + x[1] * x[1]) + (x[2] * x[2] + x[3] * x[3]); }
                    ss += __shfl_xor(ss, 16); ss += __shfl_xor(ss, 32);
                    const float rs = qs / sqrtf(ss * (1.0f / 64.0f) + 1e-6f);
                    const bool latent = r < 32768;
                    const int t = r & 16383;
                    bf16_t* dst;
                    if (isq) dst = Q + (size_t)r * 512 + (4 * pn + wc) * 64 + 8 * fq;
                    else { const int kvrow = latent ? ((r >> 14) * 16640 + 256 + t) : (((r - 32768) >> 8) * 16640 + ((r - 32768) & 255)); dst = Kb + (size_t)kvrow * 128 + wc * 64 + 8 * fq; }
#pragma unroll
                    for (int bj = 0; bj < 2; ++bj) {
                        f32x4 x1 = acc[ai][bj][m][0] * rs * *(const f32x4*)(gain + 32 * bj + 4 * fq), x2 = acc[ai][bj][m][1] * rs * *(const f32x4*)(gain + 32 * bj + 16 + 4 * fq);
                        if (latent) {
                            const int pos = bj ? (t & 63) : (t >> 6);
                            const f32x4 cs = *(const f32x4*)(ropec + pos * 16 + 4 * fq), sn = *(const f32x4*)(ropes + pos * 16 + 4 * fq);
                            const f32x4 o1 = x1 * cs - x2 * sn, o2 = x2 * cs + x1 * sn; x1 = o1; x2 = o2;
                        }
                        *(u32x4*)(dst + 32 * bj) = pack8(x1, x2);
                    }
                    asm volatile("" ::: "memory");
                }
        } else if (pn == 2) {
#pragma unroll
            for (int ai = 0; ai < 2; ++ai)
#pragma unroll
                for (int m = 0; m < 4; ++m) {
                    const int r = row0 + ai * HALF + m * 16; const bool latent = r < 32768; const int t = r & 16383;
                    const int kvrow = latent ? ((r >> 14) * 16640 + 256 + t) : (((r - 32768) >> 8) * 16640 + ((r - 32768) & 255));
                    bf16_t* dst = Vb + (size_t)kvrow * 128 + (wc - 2) * 64 + 8 * fq;
#pragma unroll
                    for (int bj = 0; bj < 2; ++bj) *(u32x4*)(dst + 32 * bj) = pack8(acc[ai][bj][m][0], acc[ai][bj][m][1]);
                }
        } else if (pn < 5) {
#pragma unroll
            for (int ai = 0; ai < 2; ++ai)
#pragma unroll
                for (int m = 0; m < 4; ++m) {
                    const int r = row0 + ai * HALF + m * 16;
                    bf16_t* dst = BG + (size_t)r * 512 + (pn - 3) * 256 + wc * 32 + 8 * fq;
#pragma unroll
                    for (int bj = 0; bj < 2; ++bj) *(u32x4*)(dst + bj * HALF) = pack8(acc[ai][bj][m][0], acc[ai][bj][m][1]);
                }
        } else {
#pragma unroll
            for (int ai = 0; ai < 2; ++ai)
#pragma unroll
                for (int m = 0; m < 4; ++m) {
                    const int r = row0 + ai * HALF + m * 16;
                    bf16_t* dst = CX + (size_t)r * 512 + (pn - 5) * 128 + wc * 32 + 8 * fq;
                    *(u32x4*)dst = pack8(acc[ai][0][m][0] * acc[ai][1][m][0], acc[ai][0][m][1] * acc[ai][1][m][1]);
                }
        }
    }
};
struct EpiHyT {
    static constexpr bool PERM = true, AFTER_DRAIN = false, RESCALE = false;
    bf16_t* HYT; bf16_t* HYTC;
    __device__ __forceinline__ void operator()(const f32x4 (&acc)[2][2][4][2], const Unit& u, int wr, int wc, int fr_, int fq_) const {
        const int ln_ = opq_tid() & 63; const int fr = ln_ & 15, fq = ln_ >> 4;
        const int ch0 = u.pm * BM + wr * 64 + fr;
        bf16_t* base; size_t pitch;
        if (u.pn < 128) { const int b = u.pn >> 6, t0 = (u.pn & 63) * 256; base = HYT + (size_t)b * 1536 * 16384 + t0; pitch = 16384; }
        else { const int b = u.pn - 128; base = HYTC + (size_t)b * 1536 * 256; pitch = 256; }
        base += wc * 32 + 8 * fq;
#pragma unroll
        for (int ai = 0; ai < 2; ++ai)
#pragma unroll
            for (int m = 0; m < 4; ++m) { bf16_t* rowp = base + (size_t)(ch0 + ai * HALF + m * 16) * pitch;
#pragma unroll
                for (int bj = 0; bj < 2; ++bj) *(u32x4*)(rowp + bj * HALF) = pack8(acc[ai][bj][m][0], acc[ai][bj][m][1]); }
    }
};
struct EpiGate {
    static constexpr bool PERM = true, AFTER_DRAIN = false, RESCALE = false;
    bf16_t* G;
    __device__ __forceinline__ void operator()(const f32x4 (&acc)[2][2][4][2], const Unit& u, int wr, int wc, int fr_, int fq_) const {
        const int ln_ = opq_tid() & 63; const int fr = ln_ & 15, fq = ln_ >> 4;
        const int row0 = u.pm * BM + wr * 64 + fr, col0 = u.pn * BM + wc * 32 + 8 * fq;
#pragma unroll
        for (int ai = 0; ai < 2; ++ai)
#pragma unroll
            for (int m = 0; m < 4; ++m) { bf16_t* rowp = G + (size_t)(row0 + ai * HALF + m * 16) * 3072 + col0;
#pragma unroll
                for (int bj = 0; bj < 2; ++bj) { f32x4 a = acc[ai][bj][m][0], b = acc[ai][bj][m][1];
#pragma unroll
                    for (int e = 0; e < 4; ++e) { a[e] = __builtin_amdgcn_rcpf(1.0f + __builtin_amdgcn_exp2f(-1.4426950408889634f * a[e])); b[e] = __builtin_amdgcn_rcpf(1.0f + __builtin_amdgcn_exp2f(-1.4426950408889634f * b[e])); }
                    *(u32x4*)(rowp + bj * HALF) = pack8(a, b); } }
    }
};
struct EpiMerge {
    static constexpr bool PERM = true, AFTER_DRAIN = false, RESCALE = false;
    const bf16_t* G; bf16_t* MM; int br;
    __device__ __forceinline__ void operator()(const f32x4 (&acc)[2][2][4][2], const Unit& u, int wr, int wc, int fr_, int fq_) const {
        const int ln_ = opq_tid() & 63; const int fr = ln_ & 15, fq = ln_ >> 4;
        const int row0 = u.pm * BM + wr * 64 + fr, col0 = u.pn * BM + wc * 32 + 8 * fq;
#pragma unroll
        for (int ai = 0; ai < 2; ++ai)
#pragma unroll
            for (int m = 0; m < 4; ++m) { const size_t r = (size_t)(row0 + ai * HALF + m * 16);
#pragma unroll
                for (int bj = 0; bj < 2; ++bj) {
                    const u32x4 gw = *(const u32x4*)(G + r * 3072 + br * 1024 + col0 + bj * HALF);
                    f32x4 g0, g1; unpack8(gw, g0, g1);
                    f32x4 v0 = g0 * acc[ai][bj][m][0], v1 = g1 * acc[ai][bj][m][1];
                    if ((ABL >> br) & 1) { v0 = v0 * 0.f; v1 = v1 * 0.f; }
                    bf16_t* mp = MM + r * 1024 + col0 + bj * HALF;
                    if (br > 0) { const u32x4 mw = *(const u32x4*)mp; f32x4 m0, m1; unpack8(mw, m0, m1); v0 += m0; v1 += m1; }
                    *(u32x4*)mp = pack8(v0, v1); } }
    }
};
struct EpiMerge3 {
    static constexpr bool PERM = true, AFTER_DRAIN = false, RESCALE = true;
    const bf16_t* G; bf16_t* MM;
    __device__ __forceinline__ bool keep(const Unit& u) const { return u.z < 2; }
    __device__ __forceinline__ void fin(f32x4 (&acc)[2][2][4][2], const Unit& u, int wr, int wc) const {
        const int ln_ = opq_tid() & 63; const int fr = ln_ & 15, fq = ln_ >> 4;
        const int row0 = u.pm * BM + wr * 64 + fr, col0 = u.pn * BM + wc * 32 + 8 * fq;
        if (u.z < 2) {
#pragma unroll
            for (int ai = 0; ai < 2; ++ai)
#pragma unroll
                for (int m = 0; m < 4; ++m) { const size_t r = (size_t)(row0 + ai * HALF + m * 16);
#pragma unroll
                    for (int bj = 0; bj < 2; ++bj) {
                        const bf16_t* gp = G + r * 3072 + u.z * 1024 + col0 + bj * HALF;
                        const u32x4 ga = *(const u32x4*)gp, gb = *(const u32x4*)(gp + 1024);
                        f32x4 a0, a1, b0, b1; unpack8(ga, a0, a1); unpack8(gb, b0, b1);
                        f32x4 r0, r1;
#pragma unroll
                        for (int e = 0; e < 4; ++e) { r0[e] = a0[e] * __builtin_amdgcn_rcpf(b0[e]); r1[e] = a1[e] * __builtin_amdgcn_rcpf(b1[e]); }
                        acc[ai][bj][m][0] = acc[ai][bj][m][0] * r0; acc[ai][bj][m][1] = acc[ai][bj][m][1] * r1; } }
        } else {
#pragma unroll
            for (int ai = 0; ai < 2; ++ai)
#pragma unroll
                for (int m = 0; m < 4; ++m) { const size_t r = (size_t)(row0 + ai * HALF + m * 16);
#pragma unroll
                    for (int bj = 0; bj < 2; ++bj) {
                        const u32x4 gw = *(const u32x4*)(G + r * 3072 + 2 * 1024 + col0 + bj * HALF);
                        f32x4 g0, g1; unpack8(gw, g0, g1);
                        *(u32x4*)(MM + r * 1024 + col0 + bj * HALF) = pack8(g0 * acc[ai][bj][m][0], g1 * acc[ai][bj][m][1]); } }
        }
    }
};
struct EpiResid {
    static constexpr bool PERM = false, AFTER_DRAIN = false, RESCALE = false;
    const float* xold; float* xnew; const float* cold; float* cnew; const float* mod;
    __device__ __forceinline__ void operator()(const f32x4 (&acc)[2][2][4][2], const Unit& u, int wr, int wc, int fr_, int fq_) const {
        const int ln_ = opq_tid() & 63; const int fr = ln_ & 15, fq = ln_ >> 4;
        const int row0 = u.pm * BM + wr * 64 + fr, col0 = u.pn * BM + wc * 32 + 4 * fq;
        const bool latent = u.pm < 128;
        const int which = latent ? (u.pm >> 6) : 2;
        const float* gp = mod + which * 6144 + 2 * 1024 + col0;
        f32x4 gv[2][2];
#pragma unroll
        for (int bj = 0; bj < 2; ++bj)
#pragma unroll
            for (int n = 0; n < 2; ++n) gv[bj][n] = *(const f32x4*)(gp + bj * HALF + n * 16);
        const float* src = latent ? xold : cold - (size_t)32768 * 1024; float* dst = latent ? xnew : cnew - (size_t)32768 * 1024;
#pragma unroll
        for (int ai = 0; ai < 2; ++ai)
#pragma unroll
            for (int m2 = 0; m2 < 4; m2 += 2) {
                f32x4 xin[2][2][2];
#pragma unroll
                for (int mm = 0; mm < 2; ++mm) { const size_t off = (size_t)(row0 + ai * HALF + (m2 + mm) * 16) * 1024 + col0;
#pragma unroll
                    for (int bj = 0; bj < 2; ++bj)
#pragma unroll
                        for (int n = 0; n < 2; ++n) xin[mm][bj][n] = *(const f32x4*)(src + off + bj * HALF + n * 16); }
                asm volatile("" ::: "memory");
#pragma unroll
                for (int mm = 0; mm < 2; ++mm) { const size_t off = (size_t)(row0 + ai * HALF + (m2 + mm) * 16) * 1024 + col0;
#pragma unroll
                    for (int bj = 0; bj < 2; ++bj)
#pragma unroll
                        for (int n = 0; n < 2; ++n) *(f32x4*)(dst + off + bj * HALF + n * 16) = xin[mm][bj][n] + gv[bj][n] * acc[ai][bj][m2 + mm][n]; }
                asm volatile("" ::: "memory"); }
    }
};
struct EpiF32 {
    static constexpr bool PERM = false, AFTER_DRAIN = false, RESCALE = false;
    float* S; int ldc;
    __device__ __forceinline__ void operator()(const f32x4 (&acc)[2][2][4][2], const Unit& u, int wr, int wc, int fr_, int fq_) const {
        const int ln_ = opq_tid() & 63; const int fr = ln_ & 15, fq = ln_ >> 4;
        const int row0 = u.pm * BM + wr * 64 + fr, col0 = u.pn * BM + wc * 32 + 4 * fq;
#pragma unroll
        for (int ai = 0; ai < 2; ++ai)
#pragma unroll
            for (int m = 0; m < 4; ++m) { float* rowp = S + (size_t)(row0 + ai * HALF + m * 16) * ldc + col0;
#pragma unroll
                for (int bj = 0; bj < 2; ++bj)
#pragma unroll
                    for (int n = 0; n < 2; ++n) *(f32x4*)(rowp + bj * HALF + n * 16) = acc[ai][bj][m][n]; }
    }
};

struct EpiScoreT {
    static constexpr bool PERM = false, AFTER_DRAIN = false, RESCALE = false;
    float* S;
    __device__ __forceinline__ void operator()(const f32x4 (&acc)[2][2][4][2], const Unit& u, int wr, int wc, int fr_, int fq_) const {
        const int ln_ = opq_tid() & 63; const int fr = ln_ & 15, fq = ln_ >> 4;
        const int row0 = u.pm * BM + wr * 64 + fr, col0 = u.pn * BM + wc * 32 + 4 * fq;
#pragma unroll
        for (int ai = 0; ai < 2; ++ai)
#pragma unroll
            for (int m = 0; m < 4; ++m) { const int row = row0 + ai * HALF + m * 16;
#pragma unroll
                for (int bj = 0; bj < 2; ++bj)
#pragma unroll
                    for (int n = 0; n < 2; ++n) { const int col = col0 + bj * HALF + n * 16; *(f32x4*)(S + ((size_t)(col >> 6) * 2048 + row) * 64 + (col & 63)) = acc[ai][bj][m][n]; } }
    }
};
template <class Epi, class Sched, bool ALIGN_EPI = false, bool SP2 = false>
__device__ __forceinline__ void gemm_phase(PG8_LAS unsigned char* lds, const Gemm g, const Sched& S, const Epi& E) {
    const int tid = opq_tid(), wid = __builtin_amdgcn_readfirstlane(tid >> 6), lane = tid & 63, wr = wid >> 2, wc = wid & 3, fr = lane & 15, fq = lane >> 4;
    const int K = g.K, nt = K / BK;
    unsigned voffA[2], voffB[2];
#pragma unroll
    for (int i = 0; i < 2; ++i) { int R, C; stage_rc(tid * 16 + i * 8192, R, C); const int Rb = Epi::PERM ? ((R & ~31) + perm32(R & 31)) : R;
        voffA[i] = (unsigned)(R * K + C) * 2u; voffB[i] = (unsigned)(Rb * K + C) * 2u; }
    const size_t kstep = (size_t)(BK * 2);
    const size_t hstep = (size_t)HALF * K * 2;
    const size_t tstep = 2 * hstep;
    const unsigned ldsw = (unsigned)wid * 1024u;
    const int aoff = lds_byte(wr * 64 + fr, fq * 8), boff = lds_byte(wc * 32 + fr, fq * 8);
#define PG8_SA(b, h) (((b) * 2 + (h)) * HTB)
#define PG8_SB(b, h) ((4 + (b) * 2 + (h)) * HTB)
#define PG8_STAGE(bufoff, gbase, voff) do { _Pragma("unroll") for (int _i = 0; _i < 2; ++_i) \
        __builtin_amdgcn_global_load_lds((const unsigned*)((const char*)(gbase) + (voff)[_i]), (PG8_LAS unsigned*)(lds + (bufoff) + ldsw + _i * 8192), 16, 0, 0); } while (0)
#define PG8_LDA(dst, b, h) do { _Pragma("unroll") for (int m = 0; m < 4; ++m) _Pragma("unroll") for (int k = 0; k < 2; ++k) dst[m][k] = *(const PG8_LAS bf16x8*)(lds + PG8_SA(b, h) + aoff + m * 2048 + k * 1024); } while (0)
#define PG8_LDB(dst, b, h) do { _Pragma("unroll") for (int n = 0; n < 2; ++n) _Pragma("unroll") for (int k = 0; k < 2; ++k) dst[n][k] = *(const PG8_LAS bf16x8*)(lds + PG8_SB(b, h) + boff + n * 2048 + k * 1024); } while (0)
#define PG8_MMA(ai, bj, At, Bt) do { __builtin_amdgcn_s_setprio(1); _Pragma("unroll") for (int m = 0; m < 4; ++m) _Pragma("unroll") for (int n = 0; n < 2; ++n) _Pragma("unroll") for (int k = 0; k < 2; ++k) \
        acc[ai][bj][m][n] = __builtin_amdgcn_mfma_f32_16x16x32_bf16(Bt[n][k], At[m][k], acc[ai][bj][m][n], 0, 0, 0); __builtin_amdgcn_s_setprio(0); } while (0)
#define PG8_WAIT_V(n) asm volatile("s_waitcnt vmcnt(" #n ")" ::: "memory")
#define PG8_WAIT_L(n) asm volatile("s_waitcnt lgkmcnt(" #n ")" ::: "memory")
#define PG8_BAR __builtin_amdgcn_s_barrier()
#define PG8_SCHED __builtin_amdgcn_sched_barrier(0)
    Unit cur, nxt; int ui = 0;
    if (!S.next(0, cur)) return;
    f32x4 acc[2][2][4][2];
#pragma unroll
    for (int a = 0; a < 2; ++a)
#pragma unroll
        for (int b = 0; b < 2; ++b)
#pragma unroll
            for (int m = 0; m < 4; ++m)
#pragma unroll
                for (int n = 0; n < 2; ++n) acc[a][b][m][n] = (f32x4){0.f, 0.f, 0.f, 0.f};
    bf16x8 At[4][2], B0[2][2], B1[2][2];
    const char* cA = S.baseA(g, cur, tstep); const char* cB = S.baseB(g, cur, tstep);
    S.a_ready(cur);
    if constexpr (SP2) {
        PG8_STAGE(PG8_SB(0, 0), cB, voffB); PG8_STAGE(PG8_SB(0, 1), cB + hstep, voffB); PG8_STAGE(PG8_SA(0, 0), cA, voffA); PG8_STAGE(PG8_SA(0, 1), cA + hstep, voffA);
        if (wr == 1) PG8_BAR;
        PG8_WAIT_V(2); PG8_BAR;
        PG8_STAGE(PG8_SB(1, 0), cB + kstep, voffB); PG8_STAGE(PG8_SA(1, 0), cA + kstep, voffA); PG8_STAGE(PG8_SB(1, 1), cB + hstep + kstep, voffB);
        PG8_WAIT_V(6); PG8_BAR;
    } else {
        PG8_STAGE(PG8_SB(0, 0), cB, voffB); PG8_STAGE(PG8_SA(0, 0), cA, voffA); PG8_STAGE(PG8_SB(0, 1), cB + hstep, voffB); PG8_STAGE(PG8_SA(0, 1), cA + hstep, voffA);
        if (wr == 1) PG8_BAR;
        PG8_WAIT_V(4); PG8_BAR;
        PG8_STAGE(PG8_SB(1, 0), cB + kstep, voffB); PG8_STAGE(PG8_SA(1, 0), cA + kstep, voffA); PG8_STAGE(PG8_SB(1, 1), cB + hstep + kstep, voffB);
        PG8_WAIT_V(6); PG8_BAR;
    }
    for (;;) {
        const bool has_next = S.next(ui + 1, nxt);
        const char* nA = has_next ? S.baseA(g, nxt, tstep) : cA; const char* nB = has_next ? S.baseB(g, nxt, tstep) : cB;
        for (int t = 0; t < nt; t += 2) {
            const bool last = (t == nt - 2);
            const char* a1 = cA + (size_t)(t + 1) * kstep;
            const char* a2 = last ? nA : cA + (size_t)(t + 2) * kstep; const char* b2 = last ? nB : cB + (size_t)(t + 2) * kstep;
            const char* a3 = a2 + kstep; const char* b3 = b2 + kstep;
            if (last && has_next) S.a_ready(nxt);
            if constexpr (SP2) {
            PG8_LDB(B0, 0, 0); PG8_LDB(B1, 0, 1); PG8_SCHED; PG8_LDA(At, 0, 0); PG8_STAGE(PG8_SA(1, 1), a1 + hstep, voffA);
            PG8_WAIT_V(8); PG8_WAIT_L(0); PG8_BAR; PG8_MMA(0, 0, At, B0); PG8_MMA(0, 1, At, B1); PG8_BAR; PG8_SCHED;
            PG8_LDA(At, 0, 1); PG8_STAGE(PG8_SB(0, 0), b2, voffB); PG8_STAGE(PG8_SB(0, 1), b2 + hstep, voffB); PG8_STAGE(PG8_SA(0, 0), a2, voffA);
            PG8_WAIT_V(8); PG8_WAIT_L(0); PG8_BAR; PG8_MMA(1, 0, At, B0); PG8_MMA(1, 1, At, B1); PG8_BAR; PG8_SCHED;
            PG8_LDB(B0, 1, 0); PG8_LDB(B1, 1, 1); PG8_SCHED; PG8_LDA(At, 1, 0); PG8_STAGE(PG8_SA(0, 1), a2 + hstep, voffA);
            PG8_WAIT_V(8); PG8_WAIT_L(0); PG8_BAR; PG8_MMA(0, 0, At, B0); PG8_MMA(0, 1, At, B1); PG8_BAR; PG8_SCHED;
            PG8_LDA(At, 1, 1); PG8_STAGE(PG8_SB(1, 0), b3, voffB); PG8_STAGE(PG8_SB(1, 1), b3 + hstep, voffB); PG8_STAGE(PG8_SA(1, 0), a3, voffA);
            PG8_WAIT_V(8); PG8_WAIT_L(0); PG8_BAR; PG8_MMA(1, 0, At, B0); PG8_MMA(1, 1, At, B1); PG8_BAR; PG8_SCHED;
            } else {
            PG8_LDB(B0, 0, 0); PG8_SCHED; PG8_LDA(At, 0, 0); PG8_STAGE(PG8_SA(1, 1), a1 + hstep, voffA);
            PG8_WAIT_L(8); PG8_BAR; PG8_WAIT_L(0); PG8_MMA(0, 0, At, B0); PG8_BAR; PG8_SCHED;
            PG8_LDB(B1, 0, 1); PG8_STAGE(PG8_SB(0, 0), b2, voffB);
            PG8_BAR; PG8_WAIT_L(0); PG8_MMA(0, 1, At, B1); PG8_BAR;
            PG8_LDA(At, 0, 1); PG8_STAGE(PG8_SA(0, 0), a2, voffA);
            PG8_BAR; PG8_WAIT_L(0); PG8_MMA(1, 0, At, B0); PG8_BAR; PG8_SCHED;
            PG8_STAGE(PG8_SB(0, 1), b2 + hstep, voffB);
            PG8_WAIT_V(6); PG8_BAR; PG8_MMA(1, 1, At, B1); PG8_BAR;
            PG8_LDB(B0, 1, 0); PG8_SCHED; PG8_LDA(At, 1, 0); PG8_STAGE(PG8_SA(0, 1), a2 + hstep, voffA);
            PG8_WAIT_L(8); PG8_BAR; PG8_WAIT_L(0); PG8_MMA(0, 0, At, B0); PG8_BAR; PG8_SCHED;
            PG8_LDB(B1, 1, 1); PG8_STAGE(PG8_SB(1, 0), b3, voffB);
            PG8_BAR; PG8_WAIT_L(0); PG8_MMA(0, 1, At, B1); PG8_BAR;
            PG8_LDA(At, 1, 1); PG8_STAGE(PG8_SA(1, 0), a3, voffA);
            PG8_BAR; PG8_WAIT_L(0); PG8_MMA(1, 0, At, B0); PG8_BAR; PG8_SCHED;
            PG8_STAGE(PG8_SB(1, 1), b3 + hstep, voffB);
            PG8_WAIT_V(6); PG8_BAR; PG8_MMA(1, 1, At, B1); PG8_BAR;
            }
        }
        if constexpr (ALIGN_EPI) { if (wr == 0) PG8_BAR; }
        if constexpr (Epi::RESCALE) { E.fin(acc, cur, wr, wc); S.done(cur); }
        else if constexpr (!Epi::AFTER_DRAIN) { E(acc, cur, wr, wc, fr, fq); S.done(cur); }
        if (!has_next) break;
        bool keep_ = false; if constexpr (Epi::RESCALE) keep_ = E.keep(cur);
        if (!keep_) {
#pragma unroll
        for (int a = 0; a < 2; ++a)
#pragma unroll
            for (int b = 0; b < 2; ++b)
#pragma unroll
                for (int m = 0; m < 4; ++m)
#pragma unroll
                    for (int n = 0; n < 2; ++n) acc[a][b][m][n] = (f32x4){0.f, 0.f, 0.f, 0.f};
        }
        cur = nxt; cA = nA; cB = nB; ++ui;
        if constexpr (ALIGN_EPI) { if (wr == 1) PG8_BAR; }
    }
    PG8_WAIT_V(0);
    if constexpr (!ALIGN_EPI) { if (wr == 0) PG8_BAR; }
    PG8_BAR;
    if constexpr (Epi::AFTER_DRAIN) { E.fused(acc, cur, wr, wc, fr, fq, lds, wid, lane); S.done(cur); }
#undef PG8_SA
#undef PG8_SB
#undef PG8_STAGE
#undef PG8_LDA
#undef PG8_LDB
#undef PG8_MMA
#undef PG8_WAIT_V
#undef PG8_WAIT_L
#undef PG8_BAR
#undef PG8_SCHED
}
}
#include <hip/hip_bf16.h>
#include <cmath>
namespace attn_body {
using bf16=__hip_bfloat16;
using bf16x8=__attribute__((ext_vector_type(8)))short;
using s16x4=__attribute__((ext_vector_type(4)))short;
using f32x16=__attribute__((ext_vector_type(16)))float;
using u32x4=__attribute__((ext_vector_type(4)))unsigned;
constexpr int D=64,QP=512,KP=128;
constexpr int NW=8,QBLK=32,QB=QBLK*NW,KVBLK=64;
constexpr int ATTN_UNIT_ROWS=QB;
__device__ __forceinline__ int crow(int r,int hi){return (r&3)+8*(r>>2)+4*hi;}
#define SBAR() __builtin_amdgcn_sched_barrier(0)
constexpr int NSLOT=3, SLOTB=8192;
constexpr int LDS_K=0, LDS_V=NSLOT*SLOTB, LDS_WS=2*NSLOT*SLOTB, LDS_OST=LDS_WS+NW*64*4, LDS_BYTES=LDS_OST+NW*4096;
constexpr float C2=0.125f*1.4426950408889634f;
__device__ __forceinline__ void glds16(const void*gsrc,unsigned lds_dst){unsigned keep;
  asm volatile("s_mov_b32 %0, m0\n\ts_mov_b32 m0, %2\n\ts_nop 0\n\tglobal_load_lds_dwordx4 %1, off\n\ts_mov_b32 m0, %0":"=&s"(keep):"v"(gsrc),"s"(lds_dst):"memory");}
__device__ __forceinline__ float max3f(float a,float b,float c){float r;asm("v_max3_f32 %0, %1, %2, %3":"=v"(r):"v"(a),"v"(b),"v"(c));return r;}
__device__ __forceinline__ float max2f(float a,float b){float r;asm("v_max_f32_e32 %0, %1, %2":"=v"(r):"v"(a),"v"(b));return r;}
__device__ __forceinline__ float fadd_s(float a,float b){float r;asm("v_add_f32_e32 %0, %1, %2":"=v"(r):"v"(a),"v"(b));return r;}
__device__ __forceinline__ float fsub_s(float a,float b){float r;asm("v_sub_f32_e32 %0, %1, %2":"=v"(r):"v"(a),"v"(b));return r;}
typedef float f32x2_t __attribute__((ext_vector_type(2))); typedef __bf16 bf16x2_t __attribute__((ext_vector_type(2)));
__device__ __forceinline__ unsigned cvtpk_s(float lo,float hi){f32x2_t v={lo,hi};bf16x2_t b=__builtin_convertvector(v,bf16x2_t);return __builtin_bit_cast(unsigned,b);}
#define WAIT_BAR(N) asm volatile("s_waitcnt vmcnt(" #N ") lgkmcnt(0)\n\ts_barrier":::"memory")

__device__ __forceinline__ void qkt(f32x16&p0,f32x16&p1,const char*Kslot,const bf16x8*qr,const f32x16&negm,int r32,int hi){
  const char*kb=Kslot+hi*1024+r32*16;
  #pragma unroll
  for(int d0=0;d0<4;++d0){
    const bf16x8 b0=*reinterpret_cast<const bf16x8*>(kb+d0*2048);
    const bf16x8 b1=*reinterpret_cast<const bf16x8*>(kb+d0*2048+512);
    if(d0==0){p0=__builtin_amdgcn_mfma_f32_32x32x16_bf16(b0,qr[0],negm,0,0,0);p1=__builtin_amdgcn_mfma_f32_32x32x16_bf16(b1,qr[0],negm,0,0,0);}
    else{p0=__builtin_amdgcn_mfma_f32_32x32x16_bf16(b0,qr[d0],p0,0,0,0);p1=__builtin_amdgcn_mfma_f32_32x32x16_bf16(b1,qr[d0],p1,0,0,0);}}
}
typedef __attribute__((address_space(3))) const char* lds_cptr;
typedef short v4i16_t __attribute__((ext_vector_type(4)));
__device__ __forceinline__ void kload8(bf16x8*kf,lds_cptr kp){
  kf[0]=*(const __attribute__((address_space(3))) bf16x8*)(kp);      kf[1]=*(const __attribute__((address_space(3))) bf16x8*)(kp+512);
  kf[2]=*(const __attribute__((address_space(3))) bf16x8*)(kp+2048); kf[3]=*(const __attribute__((address_space(3))) bf16x8*)(kp+2560);
  kf[4]=*(const __attribute__((address_space(3))) bf16x8*)(kp+4096); kf[5]=*(const __attribute__((address_space(3))) bf16x8*)(kp+4608);
  kf[6]=*(const __attribute__((address_space(3))) bf16x8*)(kp+6144); kf[7]=*(const __attribute__((address_space(3))) bf16x8*)(kp+6656);
}
__device__ __forceinline__ void kload2(bf16x8*kf,lds_cptr kp,int j){ kf[2*j]=*(const __attribute__((address_space(3))) bf16x8*)(kp+j*2048); kf[2*j+1]=*(const __attribute__((address_space(3))) bf16x8*)(kp+j*2048+512); }
__device__ __forceinline__ s16x4 vtr(lds_cptr p){ return __builtin_bit_cast(s16x4,__builtin_amdgcn_ds_read_tr16_b64_v4i16((__attribute__((address_space(3))) v4i16_t*)p)); }
__device__ __forceinline__ float rowmax(const f32x16&p0,const f32x16&p1){
  float a=max3f(p0[0],p0[1],p1[0]),b=max3f(p0[2],p0[3],p1[1]);a=max3f(a,p1[2],p1[3]);
  #pragma unroll
  for(int r=4;r<16;r+=4){a=max3f(a,p0[r],p0[r+1]);b=max3f(b,p0[r+2],p0[r+3]);a=max3f(a,p1[r],p1[r+1]);b=max3f(b,p1[r+2],p1[r+3]);}
  const float m=max2f(a,b);
  auto rr=__builtin_amdgcn_permlane32_swap(__float_as_uint(m),__float_as_uint(m),false,false);
  return max2f(__uint_as_float(rr[0]),__uint_as_float(rr[1]));
}
__device__ __forceinline__ void pv(f32x16*o,int vb,bf16x8 pa0,bf16x8 pa1,bf16x8 pa2,bf16x8 pa3){
  #pragma unroll
  for(int d0=0;d0<2;++d0){s16x4 lo[4],hi[4];
    #pragma unroll
    for(int ks=0;ks<4;++ks){
      asm volatile("ds_read_b64_tr_b16 %0,%1 offset:%c2":"=&v"(lo[ks]):"v"(vb),"i"(d0*4096+ks*1024):"memory");
      asm volatile("ds_read_b64_tr_b16 %0,%1 offset:%c2":"=&v"(hi[ks]):"v"(vb),"i"(d0*4096+ks*1024+512):"memory");}
    asm volatile("s_waitcnt lgkmcnt(0)":::"memory");SBAR();
    #define PK(k) (bf16x8){lo[k][0],lo[k][1],lo[k][2],lo[k][3],hi[k][0],hi[k][1],hi[k][2],hi[k][3]}
    o[d0]=__builtin_amdgcn_mfma_f32_32x32x16_bf16(pa0,PK(0),o[d0],0,0,0);
    o[d0]=__builtin_amdgcn_mfma_f32_32x32x16_bf16(pa1,PK(1),o[d0],0,0,0);
    o[d0]=__builtin_amdgcn_mfma_f32_32x32x16_bf16(pa2,PK(2),o[d0],0,0,0);
    o[d0]=__builtin_amdgcn_mfma_f32_32x32x16_bf16(pa3,PK(3),o[d0],0,0,0);
    #undef PK
  }
}

#ifndef ATTN_STORE16
#define ATTN_STORE16(p,v) (*(u32x4*)(p)=(v))
#endif
template<int THRL> __device__ __forceinline__ void attn_unit(const bf16*Qu,const bf16*__restrict__ Kh,const bf16*__restrict__ Vh,bf16*Ou,const int NT,char*shm){
  const int tid=opq_tid(),lane=tid&63,r32=lane&31,hi=lane>>5; const int wid=__builtin_amdgcn_readfirstlane(tid>>6);
  const bf16*Qw=Qu+(long)(wid*QBLK)*QP;
  const unsigned lds0=(unsigned)(uintptr_t)shm;
  float*wsf=(float*)(shm+LDS_WS)+wid*64;
  const bf16*ksrc=Kh+(long)lane*KP+wid*8;
  const bf16*vsrc=Vh+(long)(16*(wid&3)+(lane>>2))*KP+(wid>>2)*32+(lane&3)*8;
  const unsigned kdst=lds0+LDS_K+wid*1024, vdst=lds0+LDS_V+wid*1024;
  #define DMA_K(t,slot) glds16(ksrc+(long)(t)*KVBLK*KP,(unsigned)__builtin_amdgcn_readfirstlane(kdst+(slot)))
  #define DMA_V(t,slot) glds16(vsrc+(long)(t)*KVBLK*KP,(unsigned)__builtin_amdgcn_readfirstlane(vdst+(slot)))
  const int vb0=(int)(lds0+LDS_V)+((lane>>4)&1)*32+(lane&3)*8+(4*hi+((lane&15)>>2))*64;
  const char*Kbase=shm+LDS_K; bf16x8 kf[8];
  const lds_cptr shm3=(lds_cptr)shm; const lds_cptr kp0=shm3+LDS_K+hi*1024+r32*16; const lds_cptr vp0=shm3+LDS_V+((lane>>4)&1)*32+(lane&3)*8+(4*hi+((lane&15)>>2))*64;
  DMA_K(0,0);DMA_V(0,0);DMA_K(1,SLOTB);
  bf16x8 qr[4];
  #pragma unroll
  for(int d0=0;d0<4;++d0)qr[d0]=*reinterpret_cast<const bf16x8*>(&Qw[(long)r32*QP+d0*16+hi*8]);
  float mhat=0.f,l_reg=0.f;f32x16 o[2];o[0]=f32x16{};o[1]=f32x16{};f32x16 negm=f32x16{};asm volatile("":"+v"(negm));
  #define CMASK(P0,P1,t) do{}while(0)
  bool resc=false;
  #define START(P0,P1) do{ const float rm=rowmax(P0,P1); resc=false; \
    { const float dl=rm; mhat=fadd_s(mhat,dl); \
      _Pragma("unroll") for(int r=0;r<16;++r){P0[r]=fsub_s(P0[r],dl);P1[r]=fsub_s(P1[r],dl);} \
      _Pragma("unroll") for(int r=0;r<16;++r)negm[r]=-mhat; asm volatile("":"+v"(negm)); } \
    _Pragma("unroll") for(int r=0;r<16;++r)P0[r]=__builtin_amdgcn_exp2f(P0[r]); }while(0)
  #define RESC() do{ if(resc){ asm volatile("s_waitcnt lgkmcnt(0)":::"memory"); \
      _Pragma("unroll") for(int d_=0;d_<2;++d_) _Pragma("unroll") for(int r=0;r<16;++r)o[d_][r]*=wsf[crow(r,hi)]; } }while(0)
  f32x16 pA0,pA1,pB0,pB1;
  int sl_prev=0,sl_cur=0,sl_next=SLOTB;
  #define ROT() do{sl_prev=sl_cur;sl_cur=sl_next;sl_next=(sl_next==(NSLOT-1)*SLOTB)?0:sl_next+SLOTB;}while(0)
  DMA_K(2,2*SLOTB);
  WAIT_BAR(3);
  qkt(pA0,pA1,Kbase,qr,negm,r32,hi);asm volatile("s_nop 15\n\ts_nop 7":"+v"(pA0),"+v"(pA1));CMASK(pA0,pA1,0);
  START(pA0,pA1);
  _Pragma("unroll") for(int r=0;r<16;++r)pA1[r]=__builtin_amdgcn_exp2f(pA1[r]);
  WAIT_BAR(0);
  DMA_K(3,0);DMA_V(1,SLOTB);
  ROT();
  kload8(kf,kp0+sl_cur);
  WAIT_BAR(2);
  s16x4 vlo[8],vhi[8]; u32x4 pw0,pw1,pw2,pw3;
  #define PKW(P,B) cvtpk_s(P[B],P[B+1])
  #define PAF(k) __builtin_bit_cast(bf16x8,pw##k)
  #define VFR(i) (bf16x8){vlo[i][0],vlo[i][1],vlo[i][2],vlo[i][3],vhi[i][0],vhi[i][1],vhi[i][2],vhi[i][3]}
  #define PIN(x) asm volatile("":"+v"(x))
  #define MX3(a,b,c) __builtin_fmaxf(__builtin_fmaxf((a),(b)),(c))
  #define GAPA(MF,A0,A1,A2,A3,W0,W1,PW) do{ MF; sacc+=A0; sacc+=A1; sacc+=A2; sacc+=A3; PIN(sacc); W0; W1; PIN(PW); SBAR(); }while(0)
  #define EX(v) __builtin_amdgcn_exp2f(v)
  #define GAPB(MF,X,B) do{ MF; X[B]=EX(X[B]); X[B+1]=EX(X[B+1]); X[B+2]=EX(X[B+2]); X[B+3]=EX(X[B+3]); PIN(X); SBAR(); }while(0)
  #define VRD(i) do{ vlo[i]=vtr(vp_+(((i)>>2)*4096+((i)&3)*1024)); vhi[i]=vtr(vp_+(((i)>>2)*4096+((i)&3)*1024+512)); }while(0)
  #define KRD(G,j) do{ if(G){ kload2(kf,kp0+sl_next,j); SBAR(); } }while(0)
  #define STEP(C0,C1,P0,P1,t,GK,GV,GL) do{ SBAR(); \
    const lds_cptr vp_=vp0+sl_prev; \
    VRD(0); SBAR(); float sacc=(P0[0]+P0[1]); \
    GAPA(C0=__builtin_amdgcn_mfma_f32_32x32x16_bf16(kf[0],qr[0],negm,0,0,0), P0[2],P0[3],P0[4],P0[5],     pw0[0]=PKW(P0,0), pw0[1]=PKW(P0,2), pw0); \
    VRD(4); SBAR(); GAPA(C1=__builtin_amdgcn_mfma_f32_32x32x16_bf16(kf[1],qr[0],negm,0,0,0), P0[6],P0[7],P0[8],P0[9],     pw0[2]=PKW(P0,4), pw0[3]=PKW(P0,6), pw0); \
    VRD(1); SBAR(); GAPA(C0=__builtin_amdgcn_mfma_f32_32x32x16_bf16(kf[2],qr[1],C0,0,0,0),   P0[10],P0[11],P0[12],P0[13], pw1[0]=PKW(P0,8), pw1[1]=PKW(P0,10), pw1); \
    VRD(5); SBAR(); GAPA(C1=__builtin_amdgcn_mfma_f32_32x32x16_bf16(kf[3],qr[1],C1,0,0,0),   P0[14],P0[15],P1[0],P1[1],   pw1[2]=PKW(P0,12),pw1[3]=PKW(P0,14), pw1); \
    VRD(2); SBAR(); GAPA(C0=__builtin_amdgcn_mfma_f32_32x32x16_bf16(kf[4],qr[2],C0,0,0,0),   P1[2],P1[3],P1[4],P1[5],     pw2[0]=PKW(P1,0), pw2[1]=PKW(P1,2), pw2); \
    VRD(6); SBAR(); GAPA(C1=__builtin_amdgcn_mfma_f32_32x32x16_bf16(kf[5],qr[2],C1,0,0,0),   P1[6],P1[7],P1[8],P1[9],     pw2[2]=PKW(P1,4), pw2[3]=PKW(P1,6), pw2); \
    VRD(3); SBAR(); GAPA(C0=__builtin_amdgcn_mfma_f32_32x32x16_bf16(kf[6],qr[3],C0,0,0,0),   P1[10],P1[11],P1[12],P1[13], pw3[0]=PKW(P1,8), pw3[1]=PKW(P1,10), pw3); \
    VRD(7); SBAR(); GAPA(C1=__builtin_amdgcn_mfma_f32_32x32x16_bf16(kf[7],qr[3],C1,0,0,0),   P1[14],P1[15],0.f,0.f,       pw3[2]=PKW(P1,12),pw3[3]=PKW(P1,14), pw3); \
    l_reg+=sacc; \
    if(GK){DMA_K((t)+3,sl_cur);} if(GV){DMA_V((t)+1,sl_next);} \
    CMASK(C0,C1,t); \
    resc=false; if(THRL<1000){ float a=MX3(C0[0],C0[1],C1[0]),b=MX3(C0[2],C0[3],C1[1]); a=MX3(a,C1[2],C1[3]); \
      _Pragma("unroll") for(int r=4;r<16;r+=4){a=MX3(a,C0[r],C0[r+1]);b=MX3(b,C0[r+2],C0[r+3]);a=MX3(a,C1[r],C1[r+1]);b=MX3(b,C1[r+2],C1[r+3]);} \
      float rm=__builtin_fmaxf(a,b); { auto rr=__builtin_amdgcn_permlane32_swap(__float_as_uint(rm),__float_as_uint(rm),false,false); rm=__builtin_fmaxf(__uint_as_float(rr[0]),__uint_as_float(rr[1])); } \
      resc=false; \
      if(__builtin_expect(__any(rm>(float)THRL),0)){ const float dl=__builtin_fmaxf(rm,0.f); mhat+=dl; \
        _Pragma("unroll") for(int r=0;r<16;++r){C0[r]-=dl;C1[r]-=dl;} \
        _Pragma("unroll") for(int r=0;r<16;++r)negm[r]=-mhat; asm volatile("":"+v"(negm)); \
        const float f=__builtin_amdgcn_exp2f(-dl); l_reg*=f; if(hi==0)wsf[r32]=f; resc=true; } } \
    SBAR(); \
    GAPB(o[0]=__builtin_amdgcn_mfma_f32_32x32x16_bf16(PAF(0),VFR(0),o[0],0,0,0), C0,0); \
    GAPB(o[1]=__builtin_amdgcn_mfma_f32_32x32x16_bf16(PAF(0),VFR(4),o[1],0,0,0), C0,4); \
    KRD(GL,0); GAPB(o[0]=__builtin_amdgcn_mfma_f32_32x32x16_bf16(PAF(1),VFR(1),o[0],0,0,0), C0,8); \
    KRD(GL,1); GAPB(o[1]=__builtin_amdgcn_mfma_f32_32x32x16_bf16(PAF(1),VFR(5),o[1],0,0,0), C0,12); \
    KRD(GL,2); GAPB(o[0]=__builtin_amdgcn_mfma_f32_32x32x16_bf16(PAF(2),VFR(2),o[0],0,0,0), C1,0); \
    KRD(GL,3); GAPB(o[1]=__builtin_amdgcn_mfma_f32_32x32x16_bf16(PAF(2),VFR(6),o[1],0,0,0), C1,4); \
    GAPB(o[0]=__builtin_amdgcn_mfma_f32_32x32x16_bf16(PAF(3),VFR(3),o[0],0,0,0), C1,8); \
    GAPB(o[1]=__builtin_amdgcn_mfma_f32_32x32x16_bf16(PAF(3),VFR(7),o[1],0,0,0), C1,12); \
    }while(0)
  int t=1;
  #undef CMASK
  #define CMASK(P0,P1,t) do{}while(0)
  for(;t+5<NT;t+=2){
    STEP(pB0,pB1,pA0,pA1,t,true,true,true);     WAIT_BAR(2); RESC(); ROT();
    STEP(pA0,pA1,pB0,pB1,t+1,true,true,true);   WAIT_BAR(2); RESC(); ROT();
  }
  #undef CMASK
  #define CMASK(P0,P1,t) do{}while(0)
  #define ENDW(tt) do{ if((tt)+3<NT){WAIT_BAR(2);} else if((tt)+2<NT){WAIT_BAR(1);} else {WAIT_BAR(0);} }while(0)
  for(;t+1<NT;t+=2){
    STEP(pB0,pB1,pA0,pA1,t,(t+3<NT),(t+1<NT),(t+1<NT));       ENDW(t);   RESC(); ROT();
    STEP(pA0,pA1,pB0,pB1,t+1,(t+4<NT),(t+2<NT),(t+2<NT));     ENDW(t+1); RESC(); ROT();
  }
  STEP(pB0,pB1,pA0,pA1,NT-1,false,false,false); RESC();
  { float sacc=pB0[0]+pB0[1]; _Pragma("unroll") for(int r=2;r<16;++r)sacc+=pB0[r]; _Pragma("unroll") for(int r=0;r<16;++r)sacc+=pB1[r]; l_reg+=sacc;
    pw0=(u32x4){PKW(pB0,0),PKW(pB0,2),PKW(pB0,4),PKW(pB0,6)};pw1=(u32x4){PKW(pB0,8),PKW(pB0,10),PKW(pB0,12),PKW(pB0,14)};pw2=(u32x4){PKW(pB1,0),PKW(pB1,2),PKW(pB1,4),PKW(pB1,6)};pw3=(u32x4){PKW(pB1,8),PKW(pB1,10),PKW(pB1,12),PKW(pB1,14)};
    SBAR(); pv(o,vb0+sl_cur,PAF(0),PAF(1),PAF(2),PAF(3)); }
  #undef PKW
  #undef PAF
  #undef VFR
  #undef PIN
  #undef MX3
  #undef GAPA
  #undef GAPB
  #undef EX
  #undef VRD
  #undef KRD
  #undef STEP
  #undef ENDW
  {auto rr=__builtin_amdgcn_permlane32_swap(__float_as_uint(l_reg),__float_as_uint(l_reg),false,false);l_reg=__uint_as_float(rr[0])+__uint_as_float(rr[1]);}
  if(hi==0)wsf[32+r32]=l_reg;asm volatile("s_waitcnt lgkmcnt(0)":::"memory");
  float rli[16];
  #pragma unroll
  for(int r=0;r<16;++r)rli[r]=__builtin_amdgcn_rcpf(wsf[32+crow(r,hi)]);
  bf16*Ow=Ou+(long)(wid*QBLK)*QP;
  { bf16*stg=(bf16*)(shm+LDS_OST)+wid*2048;
    #pragma unroll
    for(int r=0;r<16;++r){const int orow=crow(r,hi);
      #pragma unroll
      for(int d0=0;d0<2;++d0)stg[orow*64+d0*32+r32]=__float2bfloat16(o[d0][r]*rli[r]);}
    asm volatile("s_waitcnt lgkmcnt(0)":::"memory");
    #pragma unroll
    for(int i=0;i<4;++i){const int row=i*8+(lane>>3),ch=lane&7; const u32x4 v=*(const u32x4*)(stg+row*64+ch*8); ATTN_STORE16(Ow+(long)row*QP+ch*8,v);} }
  asm volatile("s_waitcnt lgkmcnt(0)\n\ts_barrier":::"memory");
  #undef DMA_K
  #undef DMA_V
  #undef CMASK
  #undef START
  #undef RESC
  #undef ROT
}
constexpr int ATTN_LDS_BYTES=LDS_BYTES;
#undef SBAR
#undef WAIT_BAR
}

struct Args {
    const float *x, *c, *ctx, *c_ctx, *w_mod, *b_mod, *g_norm1, *g_norm2, *w_in, *q_gain, *k_gain, *sc_conv_w, *hy_conv_w, *hy_conv_b,
                *hy_w1, *hy_b1, *hy_f1, *hy_w2, *hy_b2, *hy_f2, *hy_w3, *hy_decay, *hy_bias, *w_br_att, *w_br_sc, *w_br_hy, *w_out,
                *peer_wq, *peer_subkeys, *peer_u, *peer_v, *g_final;
    float* out; unsigned char* ws;
};
struct Ctx {
    LAS unsigned char* lds; int tid, lane, wave, vcu, G;
};

__device__ __forceinline__ int inv_sigma(int src) {
    if (src < 512) { const int head = src >> 6, d = src & 63, bj = d >> 5, dd = d & 31, n = dd >> 4, f = dd & 15, fq = f >> 2, e = f & 3; return 256 * (head >> 2) + 128 * bj + 32 * (head & 3) + 8 * fq + 4 * n + e; }
    if (src < 640) { const int s = src - 512, kvh = s >> 6, d = s & 63, bj = d >> 5, dd = d & 31, n = dd >> 4, f = dd & 15, fq = f >> 2, e = f & 3; return 512 + 128 * bj + 32 * kvh + 8 * fq + 4 * n + e; }
    if (src < 768) { const int s = src - 640, kvh = s >> 6, d = s & 63, bj = d >> 5, i = d & 31; return 512 + 128 * bj + 32 * (2 + kvh) + i; }
    if (src < 2304) { const int s = src - 768, part = s >> 9, ch = s & 511;
        if (part == 0) return 768 + ch;
        return 768 + 512 + (ch >> 7) * 256 + (part == 2 ? 128 : 0) + (ch & 127); }
    return src;
}
template <bool PERMUTE>
__device__ __forceinline__ void transpose_item(const float* W, int K, int N, bf16* WT, LAS float* scr, int item, int lane) {
    const int nblk = N / 32, kb = item / nblk, nb = item % nblk, k0 = 64 * kb, n0 = 32 * nb;
#pragma unroll 8
    for (int i = 0; i < 32; ++i) { const int kk = 2 * i + (lane >> 5); scr[kk * 33 + (lane & 31)] = W[(size_t)(k0 + kk) * N + n0 + (lane & 31)]; }
    LDS_WAIT(); asm volatile("" ::: "memory");
    const int c = lane & 7;
#pragma unroll
    for (int j = 0; j < 4; ++j) { const int n = (lane >> 3) + 8 * j; const LAS float* s = scr + (8 * c) * 33 + n;
        v4u o; o.x = pk2(s[0 * 33], s[1 * 33]); o.y = pk2(s[2 * 33], s[3 * 33]); o.z = pk2(s[4 * 33], s[5 * 33]); o.w = pk2(s[6 * 33], s[7 * 33]);
        const int drow = PERMUTE ? inv_sigma(n0 + n) : (n0 + n);
        *(GAS v4u*)(WT + (size_t)drow * K + k0 + 8 * c) = o; }
    LDS_WAIT(); asm volatile("" ::: "memory");
}
__device__ __forceinline__ float silu_f(float v) { return v / (1.0f + __expf(-v)); }

__device__ __forceinline__ void p0_prologue(const Args& A, const Ctx& C) {
    unsigned char* ws = A.ws;
    const int gw = C.vcu * NWAVES + C.wave, NGW = C.G * NWAVES;
    LAS float* scr = (LAS float*)(C.lds + C.wave * 16384);
    {
        constexpr int I_IN = 16 * (IN_W / 32), I_BR = 8 * 32, I_OUT = 16 * 32, PER_L = I_IN + 3 * I_BR + I_OUT;
        for (int it = gw; it < 2 * PER_L; it += NGW) {
            const int l = it / PER_L; int r = it % PER_L;
            if (r < I_IN) { transpose_item<true>(A.w_in + (size_t)l * 1024 * IN_W, 1024, IN_W, (bf16*)(ws + WS_WIN) + (size_t)l * IN_W * 1024, scr, r, C.lane); continue; } r -= I_IN;
            if (r < 3 * I_BR) { const int br = r / I_BR; const float* W = (br == 0 ? A.w_br_att : br == 1 ? A.w_br_sc : A.w_br_hy) + (size_t)l * 512 * 1024;
                transpose_item<false>(W, 512, 1024, (bf16*)(ws + WS_WBR) + (size_t)(l * 3 + br) * 1024 * 512, scr, r % I_BR, C.lane); continue; } r -= 3 * I_BR;
            transpose_item<false>(A.w_out + (size_t)l * 1024 * 1024, 1024, 1024, (bf16*)(ws + WS_WOUT) + (size_t)l * 1024 * 1024, scr, r, C.lane);
        }
    }
    for (int i = (C.vcu * NTHREADS + C.tid); i < 256 * 16; i += C.G * NTHREADS) {
        const int pos = i >> 4, f = i & 15; const float inv = powf(10000.0f, -(float)f * (1.0f / 16.0f)), ang = (float)pos * inv;
        ((float*)(ws + WS_ROPE))[i] = cosf(ang); ((float*)(ws + WS_ROPE))[4096 + i] = sinf(ang);
    }
    {
        LAS float* hs = (LAS float*)(C.lds + C.wave * 16384);
        const int j = C.lane;
#pragma unroll 1
        for (int l = 0; l < 2; ++l) {
            const float* w1 = A.hy_w1 + (size_t)l * HY_EMB * 64; const float* w2 = A.hy_w2 + (size_t)l * 64 * 64;
            float w1r[33], w2r[64];
#pragma unroll
            for (int k = 0; k < 33; ++k) w1r[k] = w1[k * 64 + j];
#pragma unroll
            for (int k = 0; k < 64; ++k) w2r[k] = w2[k * 64 + j];
            const float b1 = A.hy_b1[l * 64 + j], f1 = A.hy_f1[l * 64 + j], b2 = A.hy_b2[l * 64 + j], f2 = A.hy_f2[l * 64 + j];
#pragma unroll 1
            for (int tt = gw; tt < SEQ + CTX_LEN; tt += NGW) {
                const bool isc = tt >= SEQ; const int t = isc ? tt - SEQ : tt, L = isc ? CTX_LEN : SEQ;
                const float tl = (float)t / (float)(L - 1), w = 6.2831855f * (float)t / (float)L;
                float a = b1 + tl * w1r[0];
                float ck, sk;
                { const int kb = j & 15; const float band = 1e-4f + (float)kb * ((15.0f - 1e-4f) / 15.0f), ang = band * w; ck = cosf(ang); sk = sinf(ang); }
#pragma unroll
                for (int k = 0; k < 16; ++k) { const float c_ = __builtin_bit_cast(float, __builtin_amdgcn_readlane(__builtin_bit_cast(int, ck), k)), s_ = __builtin_bit_cast(float, __builtin_amdgcn_readlane(__builtin_bit_cast(int, sk), k));
                    a += c_ * w1r[1 + k] - s_ * w1r[17 + k]; }
                const float h1 = sinf(f1 * a);
                LDS_WAIT(); hs[j] = h1; LDS_WAIT(); asm volatile("" ::: "memory");
                float b = b2;
#pragma unroll
                for (int k = 0; k < 64; ++k) b += hs[k] * w2r[k];
                const float h2 = sinf(f2 * b);
                if (isc) ((float*)(ws + WS_H2C))[(size_t)(l * 64 + j) * CTX_LEN + t] = h2; else ((bf16*)(ws + WS_H2))[((size_t)l * SEQ + t) * 64 + j] = (bf16)f2bf(h2);
                asm volatile("" ::: "memory");
            }
        }
    }
    __syncthreads();
    {
        LAS float* red = (LAS float*)C.lds;
        LAS float* sc = (LAS float*)(C.lds + 8192);
        if (C.vcu < 2 * 96) { for (int i = C.tid; i < 3072; i += NTHREADS) sc[i] = silu_f(i < 2048 ? A.c[i] : A.c_ctx[i - 2048]); }
        __syncthreads();
        for (int it = C.vcu; it < 2 * 96; it += C.G) {
            const int l = it / 96, n = (it % 96) * 64 + C.lane;
            const float* W = A.w_mod + (size_t)l * 1024 * 6144 + n;
            float s0 = 0.f, s1 = 0.f, s2 = 0.f;
#pragma unroll 8
            for (int kk = 0; kk < 128; ++kk) { const int k = C.wave * 128 + kk; const float wv = W[(size_t)k * 6144];
                s0 += sc[k] * wv; s1 += sc[1024 + k] * wv; s2 += sc[2048 + k] * wv; }
            red[(C.wave * 3 + 0) * 64 + C.lane] = s0; red[(C.wave * 3 + 1) * 64 + C.lane] = s1; red[(C.wave * 3 + 2) * 64 + C.lane] = s2;
            __syncthreads();
            if (C.wave < 3) { float s = A.b_mod[l * 6144 + n];
#pragma unroll
                for (int w8 = 0; w8 < 8; ++w8) s += red[(w8 * 3 + C.wave) * 64 + C.lane];
                ((float*)(ws + WS_MOD))[(size_t)(l * 3 + C.wave) * 6144 + n] = s; }
            __syncthreads();
        }
    }
    {
        LAS float* sk = (LAS float*)C.lds;
        LAS float* wq = (LAS float*)(C.lds + 128 * 65 * 4);
        for (int it = C.vcu; it < 2 * 16 * 16; it += C.G) {
            const int l = it >> 8, hp = (it >> 4) & 15, kc = it & 15, k0 = kc * 64;
            const float* SK = A.peer_subkeys + ((size_t)l * 16 + hp) * 128 * 64;
            for (int i = C.tid; i < 128 * 64; i += NTHREADS) sk[(i >> 6) * 65 + (i & 63)] = SK[i];
            const float* WQ = A.peer_wq + (size_t)l * 1024 * 1024 + hp * 64;
            for (int i = C.tid; i < 64 * 64; i += NTHREADS) wq[(i >> 6) * 65 + (i & 63)] = WQ[(size_t)(k0 + (i >> 6)) * 1024 + (i & 63)];
            __syncthreads();
            bf16* WP = (bf16*)(ws + WS_WPEER) + ((size_t)l * 2048 + hp * 128) * 1024 + k0;
            {
                const int n0 = (C.tid >> 4) * 4, kq = (C.tid & 15) * 4; float s[4][4];
#pragma unroll
                for (int i = 0; i < 4; ++i)
#pragma unroll
                    for (int jj = 0; jj < 4; ++jj) s[i][jj] = 0.f;
#pragma unroll 4
                for (int d = 0; d < 64; ++d) { float a[4], b[4];
#pragma unroll
                    for (int i = 0; i < 4; ++i) { a[i] = sk[(n0 + i) * 65 + d]; b[i] = wq[(kq + i) * 65 + d]; }
#pragma unroll
                    for (int i = 0; i < 4; ++i)
#pragma unroll
                        for (int jj = 0; jj < 4; ++jj) s[i][jj] += a[i] * b[jj]; }
#pragma unroll
                for (int i = 0; i < 4; ++i) *(GAS v2u*)(WP + (size_t)(n0 + i) * 1024 + kq) = (v2u){pk2(s[i][0], s[i][1]), pk2(s[i][2], s[i][3])};
            }
            __syncthreads();
        }
    }
}

__device__ __forceinline__ void norm_rows(const Ctx& C, const float* xlat, const float* xctx, int nrows, const float* g, const float* mod  , int shi, bf16* XN) {
    const int gw = C.vcu * NWAVES + C.wave, NGW = C.G * NWAVES;
    f32x4 gv[4];
#pragma unroll
    for (int j = 0; j < 4; ++j) gv[j] = ((const f32x4*)g)[C.lane + 64 * j];
    f32x4 nv[4];
    if (gw < nrows) { const float* xr = gw < ML ? xlat + (size_t)gw * 1024 : xctx + (size_t)(gw - ML) * 1024;
#pragma unroll
        for (int j = 0; j < 4; ++j) nv[j] = ((const GAS f32x4*)xr)[C.lane + 64 * j]; }
    for (int r = gw; r < nrows; r += NGW) {
        const bool latent = r < ML;
        const float* mp = mod + (latent ? (r >> 14) : 2) * 6144 + shi * 1024;
        f32x4 v[4]; float s = 0.f;
#pragma unroll
        for (int j = 0; j < 4; ++j) { v[j] = nv[j]; s += (v[j].x * v[j].x + v[j].y * v[j].y) + (v[j].z * v[j].z + v[j].w * v[j].w); }
        { const int rn = r + NGW; if (rn < nrows) { const float* xn = rn < ML ? xlat + (size_t)rn * 1024 : xctx + (size_t)(rn - ML) * 1024;
#pragma unroll
            for (int j = 0; j < 4; ++j) nv[j] = ((const GAS f32x4*)xn)[C.lane + 64 * j]; } }
        const float rstd = 1.0f / sqrtf(wave_sum(s) * (1.0f / 1024.0f) + EPS);
        GAS unsigned long long* o8 = (GAS unsigned long long*)(XN + (size_t)r * 1024) + C.lane;
#pragma unroll
        for (int j = 0; j < 4; ++j) { const f32x4 sh = ((const f32x4*)mp)[C.lane + 64 * j], sc = ((const f32x4*)(mp + 1024))[C.lane + 64 * j];
            const f32x4 y = v[j] * rstd * gv[j] * (sc + 1.0f) + sh;
            o8[64 * j] = (unsigned long long)pk2(y.x, y.y) | ((unsigned long long)pk2(y.z, y.w) << 32); }
    }
}

__device__ __forceinline__ void ysc_pass(const Ctx& C, bf16* BG, const bf16* CX, const float* w  , int nrows) {
    const long total = (long)nrows * 64;
    for (long i = (long)C.vcu * NTHREADS + C.tid; i < total; i += (long)C.G * NTHREADS) {
        const int r = (int)(i >> 6), c8 = (int)(i & 63) * 8;
        int t, L; if (r < ML) { t = r & (SEQ - 1); L = SEQ; } else { t = (r - ML) & (CTX_LEN - 1); L = CTX_LEN; }
        const v4u z4 = (v4u){0u, 0u, 0u, 0u};
        const int rm = (t > 0) ? r - 1 : r, rp = (t < L - 1) ? r + 1 : r;
        const v4u cmv = *(const GAS v4u*)(CX + (size_t)rm * 512 + c8);
        const v4u c0 = *(const GAS v4u*)(CX + (size_t)r * 512 + c8);
        const v4u cpv = *(const GAS v4u*)(CX + (size_t)rp * 512 + c8);
        const v4u cm = (t > 0) ? cmv : z4, cp = (t < L - 1) ? cpv : z4;
        const v4u bg = *(const GAS v4u*)(BG + (size_t)r * 512 + c8);
        f32x4 w0a = *(const f32x4*)(w + c8), w0b = *(const f32x4*)(w + c8 + 4), w1a = *(const f32x4*)(w + 512 + c8), w1b = *(const f32x4*)(w + 512 + c8 + 4), w2a = *(const f32x4*)(w + 1024 + c8), w2b = *(const f32x4*)(w + 1024 + c8 + 4);
        f32x4 ma, mb, ca, cb, pa, pb, ga, gb; pg8::unpack8(cm, ma, mb); pg8::unpack8(c0, ca, cb); pg8::unpack8(cp, pa, pb); pg8::unpack8(bg, ga, gb);
        const f32x4 ya = ga * (w0a * ma + w1a * ca + w2a * pa), yb = gb * (w0b * mb + w1b * cb + w2b * pb);
        *(GAS v4u*)(BG + (size_t)r * 512 + c8) = pg8::pack8(ya, yb);
    }
}

__device__ __forceinline__ void yhy_transpose(const Ctx& C, const bf16* YHYT, bf16* YHY, bool with_ctx) {
    LAS unsigned short* scr = (LAS unsigned short*)(C.lds + C.wave * 16384);
    const int gw = C.vcu * NWAVES + C.wave, NGW = C.G * NWAVES;
    const int NLAT = 2 * 8 * 256, NIT = NLAT + (with_ctx ? 2 * 8 * 4 : 0);
    for (int it = gw; it < NIT; it += NGW) {
        const bf16* src; size_t pitch; size_t row0; int cb;
        if (it < NLAT) { const int b = it >> 11, r = it & 2047; cb = r >> 8; const int tb = r & 255; src = YHYT + ((size_t)(b * 512 + cb * 64)) * SEQ + tb * 64; pitch = SEQ; row0 = (size_t)b * SEQ + tb * 64; }
        else { const int q = it - NLAT, b = q >> 5, r = q & 31; cb = r >> 2; const int tb = r & 3; src = YHYT + (size_t)BATCH * 512 * SEQ + ((size_t)(b * 512 + cb * 64)) * CTX_LEN + tb * 64; pitch = CTX_LEN; row0 = (size_t)ML + b * CTX_LEN + tb * 64; }
#pragma unroll
        for (int i = 0; i < 32; ++i) { const int c = 2 * i + (C.lane >> 5); const unsigned w = *(const GAS unsigned*)(src + (size_t)c * pitch + (C.lane & 31) * 2);
            scr[c * 66 + (C.lane & 31) * 2] = (unsigned short)(w & 0xffffu); scr[c * 66 + (C.lane & 31) * 2 + 1] = (unsigned short)(w >> 16); }
        LDS_WAIT(); asm volatile("" ::: "memory");
        const int ch = C.lane & 7;
#pragma unroll
        for (int j = 0; j < 8; ++j) { const int t = (C.lane >> 3) + 8 * j; const LAS unsigned short* s = scr + (8 * ch) * 66 + t;
            v4u o; o.x = (unsigned)s[0] | ((unsigned)s[66] << 16); o.y = (unsigned)s[2 * 66] | ((unsigned)s[3 * 66] << 16); o.z = (unsigned)s[4 * 66] | ((unsigned)s[5 * 66] << 16); o.w = (unsigned)s[6 * 66] | ((unsigned)s[7 * 66] << 16);
            *(GAS v4u*)(YHY + (row0 + t) * 512 + cb * 64 + 8 * ch) = o; }
        LDS_WAIT(); asm volatile("" ::: "memory");
    }
}

__device__ __forceinline__ void cvt_table(const Ctx& C, const float* src, bf16* dst, size_t n) {
    const size_t n8 = n / 8;
    for (size_t i = (size_t)C.vcu * NTHREADS + C.tid; i < n8; i += (size_t)C.G * NTHREADS) {
        const f32x4 a = ((const GAS f32x4*)src)[2 * i], b = ((const GAS f32x4*)src)[2 * i + 1];
        v4u o; o.x = pk2(a.x, a.y); o.y = pk2(a.z, a.w); o.z = pk2(b.x, b.y); o.w = pk2(b.z, b.w);
        ((GAS v4u*)dst)[i] = o;
    }
}

__device__ __forceinline__ void cvt_table_fp6(const Ctx& C, const float* src, unsigned char* dst, float* deq, int rows, int cu = -1, int ncu = 0) {
    const int gw = (cu < 0 ? C.vcu : cu) * NWAVES + C.wave, NGW = (cu < 0 ? C.G : ncu) * NWAVES, lp = C.lane & 31, half = C.lane >> 5;
    f32x4 nv[8];
    if (gw < rows / 2) { const GAS f32x4* s = (const GAS f32x4*)(src + (size_t)(2 * gw + half) * 1024) + 8 * lp;
#pragma unroll
        for (int j = 0; j < 8; ++j) nv[j] = s[j]; }
    for (int r2 = gw; r2 < rows / 2; r2 += NGW) {
        const int r = 2 * r2 + half;
        f32x4 v[8]; float mx = 0.f;
#pragma unroll
        for (int j = 0; j < 8; ++j) v[j] = nv[j];
        { const int rn2 = r2 + NGW; if (rn2 < rows / 2) { const GAS f32x4* s = (const GAS f32x4*)(src + (size_t)(2 * rn2 + half) * 1024) + 8 * lp;
#pragma unroll
            for (int j = 0; j < 8; ++j) nv[j] = s[j]; } }
#pragma unroll
        for (int j = 0; j < 8; ++j) { mx = fmaxf(mx, fmaxf(fmaxf(fabsf(v[j].x), fabsf(v[j].y)), fmaxf(fabsf(v[j].z), fabsf(v[j].w)))); }
        mx = fmaxf(mx, __shfl_xor(mx, 16)); mx = fmaxf(mx, __shfl_xor(mx, 8)); mx = fmaxf(mx, __shfl_xor(mx, 4)); mx = fmaxf(mx, __shfl_xor(mx, 2)); mx = fmaxf(mx, __shfl_xor(mx, 1));
        const float sc = mx > 0.f ? 7.5f / mx : 1.0f;
        v16f a, b;
#pragma unroll
        for (int i = 0; i < 16; ++i) {
#if FP6_ILV
            const int ia = 2 * i, ib = 2 * i + 1;
#else
            const int ia = i, ib = 16 + i;
#endif
            a[i] = v[ia >> 2][ia & 3] * sc; b[i] = v[ib >> 2][ib & 3] * sc; }
        const v6i w = __builtin_amdgcn_cvt_scalef32_2xpk16_fp6_f32(a, b, 1.0f);
        unsigned char* d = dst + (size_t)r * 768;
        *(GAS v4u*)(d + 16 * lp) = (v4u){(unsigned)w[0], (unsigned)w[1], (unsigned)w[2], (unsigned)w[3]};
        *(GAS v2u*)(d + 512 + 8 * lp) = (v2u){(unsigned)w[4], (unsigned)w[5]};
        if (lp == 0) deq[r] = mx > 0.f ? mx * (1.0f / 7.5f) : 1.0f;
    }
}
__device__ __forceinline__ void cvt_table_fp8(const Ctx& C, const float* src, unsigned char* dst, float* deq, int rows) {
    const int gw = C.vcu * NWAVES + C.wave, NGW = C.G * NWAVES;
    for (int r = gw; r < rows; r += NGW) {
        const GAS f32x4* s = (const GAS f32x4*)(src + (size_t)r * 1024) + 4 * C.lane;
        f32x4 v[4]; float mx = 0.f;
#pragma unroll
        for (int j = 0; j < 4; ++j) { v[j] = s[j]; mx = fmaxf(mx, fmaxf(fmaxf(fabsf(v[j].x), fabsf(v[j].y)), fmaxf(fabsf(v[j].z), fabsf(v[j].w)))); }
        mx = wave_max(mx);
        const float sc = mx > 0.f ? 240.0f / mx : 1.0f;
        v4u o;
#pragma unroll
        for (int j = 0; j < 4; ++j) { int w = 0; w = __builtin_amdgcn_cvt_pk_fp8_f32(v[j].x * sc, v[j].y * sc, w, false); w = __builtin_amdgcn_cvt_pk_fp8_f32(v[j].z * sc, v[j].w * sc, w, true); o[j] = (unsigned)w; }
        *(GAS v4u*)(dst + (size_t)r * 1024 + 16 * C.lane) = o;
        if (C.lane == 0) deq[r] = mx > 0.f ? mx * (1.0f / 240.0f) : 1.0f;
    }
}

namespace hy {
constexpr int L = SEQ, NFFT = 2 * SEQ;
__device__ __forceinline__ int cidx(int p) { return p + ((p >> 6) << 2); }
__device__ __forceinline__ f32x2 cmul(f32x2 a, f32x2 b) { return (f32x2){a.x * b.x - a.y * b.y, a.x * b.y + a.y * b.x}; }
__device__ __forceinline__ f32x2 cmulc(f32x2 a, f32x2 b) { return (f32x2){a.x * b.x + a.y * b.y, a.y * b.x - a.x * b.y}; }
__device__ __forceinline__ f32x2 twid(float frac) { return (f32x2){__builtin_amdgcn_cosf(frac), -__builtin_amdgcn_sinf(frac)}; }
__device__ __forceinline__ unsigned cpack(f32x2 v) { return pk2(v.x, v.y); }
__device__ __forceinline__ f32x2 cunpack(unsigned w) { return (f32x2){bflo(w), bfhi(w)}; }
__device__ __forceinline__ f32x2 w16(int k) {
    constexpr float c1 = 0.9238795325112867f, s1 = 0.3826834323650898f, r2 = 0.7071067811865476f;
    switch (k) { case 0: return (f32x2){1.f, 0.f}; case 1: return (f32x2){c1, -s1}; case 2: return (f32x2){r2, -r2}; case 3: return (f32x2){s1, -c1};
                 case 4: return (f32x2){0.f, -1.f}; case 5: return (f32x2){-s1, -c1}; case 6: return (f32x2){-r2, -r2}; default: return (f32x2){-c1, -s1}; }
}
__device__ __forceinline__ void fwd16(LAS f32x2* buf, int base, int j0, int n) {
    const int st = n >> 4; f32x2 v[16];
#pragma unroll
    for (int m = 0; m < 16; ++m) v[m] = buf[cidx(base + j0 + m * st)];
    f32x2 w[4]; w[0] = twid((float)j0 / (float)n); w[1] = cmul(w[0], w[0]); w[2] = cmul(w[1], w[1]); w[3] = cmul(w[2], w[2]);
#pragma unroll
    for (int q = 0; q < 4; ++q) { const int span = 8 >> q;
#pragma unroll
        for (int m = 0; m < 16; ++m) if (((m / span) & 1) == 0) { const int mp = m % span;
            const f32x2 a = v[m], b = v[m + span], d = a - b; v[m] = a + b;
            v[m + span] = (mp == 0) ? cmul(d, w[q]) : cmul(cmul(d, w16(mp << q)), w[q]); } }
#pragma unroll
    for (int m = 0; m < 16; ++m) buf[cidx(base + j0 + m * st)] = v[m];
}
__device__ __forceinline__ void inv16(LAS f32x2* buf, int base, int j0, int nlo) {
    f32x2 v[16];
#pragma unroll
    for (int m = 0; m < 16; ++m) v[m] = buf[cidx(base + j0 + m * nlo)];
    f32x2 pw[4]; pw[3] = twid((float)j0 / (float)(nlo * 16)); pw[2] = cmul(pw[3], pw[3]); pw[1] = cmul(pw[2], pw[2]); pw[0] = cmul(pw[1], pw[1]);
#pragma unroll
    for (int q = 0; q < 4; ++q) { const int span = 1 << q;
#pragma unroll
        for (int m = 0; m < 16; ++m) if (((m / span) & 1) == 0) { const int mp = m % span;
            const f32x2 a = v[m]; f32x2 b = cmulc(v[m + span], pw[q]); if (mp != 0) b = cmulc(b, w16(mp << (3 - q)));
            v[m] = a + b; v[m + span] = a - b; } }
#pragma unroll
    for (int m = 0; m < 16; ++m) buf[cidx(base + j0 + m * nlo)] = v[m];
}
__device__ __forceinline__ void fwd4_last(LAS f32x2* buf, int base) {
    f32x2 a = buf[cidx(base)], b = buf[cidx(base + 1)], c = buf[cidx(base + 2)], d = buf[cidx(base + 3)];
    const f32x2 s0 = a + c, d0 = a - c, s1 = b + d, t = b - d; const f32x2 d1 = (f32x2){t.y, -t.x};
    buf[cidx(base)] = s0 + s1; buf[cidx(base + 1)] = s0 - s1; buf[cidx(base + 2)] = d0 + d1; buf[cidx(base + 3)] = d0 - d1;
}
__device__ __forceinline__ void inv4_first(LAS f32x2* buf, int base) {
    f32x2 a = buf[cidx(base)], b = buf[cidx(base + 1)], c = buf[cidx(base + 2)], d = buf[cidx(base + 3)];
    const f32x2 s0 = a + b, d0 = a - b, s1 = c + d, t = c - d; const f32x2 d1 = (f32x2){-t.y, t.x};
    buf[cidx(base)] = s0 + s1; buf[cidx(base + 2)] = s0 - s1; buf[cidx(base + 1)] = d0 + d1; buf[cidx(base + 3)] = d0 - d1;
}
__device__ __forceinline__ void fft_fwd(LAS f32x2* buf, int tid) {
#pragma unroll 1
    for (int k = 0; k < 2; ++k) { const int bf = tid + 512 * k; fwd16(buf, 0, bf, 16384); }
    __syncthreads();
#pragma unroll 1
    for (int k = 0; k < 2; ++k) { const int bf = tid + 512 * k; fwd16(buf, (bf >> 6) * 1024, bf & 63, 1024); }
    __syncthreads();
#pragma unroll 1
    for (int k = 0; k < 2; ++k) { const int bf = tid + 512 * k; fwd16(buf, (bf >> 2) * 64, bf & 3, 64); }
    __syncthreads();
#pragma unroll 1
    for (int k = 0; k < 8; ++k) { const int bf = tid + 512 * k; fwd4_last(buf, 4 * bf); }
    __syncthreads();
}
__device__ __forceinline__ void fft_inv(LAS f32x2* buf, int tid) {
#pragma unroll 1
    for (int k = 0; k < 8; ++k) { const int bf = tid + 512 * k; inv4_first(buf, 4 * bf); }
    __syncthreads();
#pragma unroll 1
    for (int k = 0; k < 2; ++k) { const int bf = tid + 512 * k; inv16(buf, (bf >> 2) * 64, bf & 3, 4); }
    __syncthreads();
#pragma unroll 1
    for (int k = 0; k < 2; ++k) { const int bf = tid + 512 * k; inv16(buf, (bf >> 6) * 1024, bf & 63, 64); }
    __syncthreads();
#pragma unroll 1
    for (int k = 0; k < 2; ++k) { const int bf = tid + 512 * k; inv16(buf, 0, bf, 1024); }
    __syncthreads();
}
__device__ __forceinline__ void fft_fwd_pack(LAS f32x2* buf, int tid, GAS v4u* slot) {
#pragma unroll 1
    for (int k = 0; k < 2; ++k) { const int bf = tid + 512 * k; fwd16(buf, 0, bf, 16384); }
    __syncthreads();
#pragma unroll 1
    for (int k = 0; k < 2; ++k) { const int bf = tid + 512 * k; fwd16(buf, (bf >> 6) * 1024, bf & 63, 1024); }
    __syncthreads();
#pragma unroll 1
    for (int k = 0; k < 2; ++k) { const int bf = tid + 512 * k; fwd16(buf, (bf >> 2) * 64, bf & 3, 64); }
    __syncthreads();
#pragma unroll
    for (int k = 0; k < 8; ++k) { const int p = cidx(4 * (tid + 512 * k));
        const f32x2 a = buf[p], b = buf[p + 1], c = buf[p + 2], d = buf[p + 3];
        const f32x2 s0 = a + c, d0 = a - c, s1 = b + d, t = b - d; const f32x2 d1 = (f32x2){t.y, -t.x};
        slot[512 * k] = (v4u){cpack(s0 + s1), cpack(s0 - s1), cpack(d0 + d1), cpack(d0 - d1)}; if (k & 1) __builtin_amdgcn_sched_barrier(0); }
}
__device__ __forceinline__ void fft_conv(LAS f32x2* buf, int tid, const GAS v4u* slot) {
#pragma unroll 1
    for (int k = 0; k < 2; ++k) { const int bf = tid + 512 * k; fwd16(buf, 0, bf, 16384); }
    __syncthreads();
#pragma unroll 1
    for (int k = 0; k < 2; ++k) { const int bf = tid + 512 * k; fwd16(buf, (bf >> 6) * 1024, bf & 63, 1024); }
    __syncthreads();
    v4u spv[8];
#pragma unroll
    for (int k = 0; k < 8; ++k) spv[k] = slot[512 * k];
    __builtin_amdgcn_sched_barrier(0);
#pragma unroll 1
    for (int k = 0; k < 2; ++k) { const int bf = tid + 512 * k; fwd16(buf, (bf >> 2) * 64, bf & 3, 64); }
    __syncthreads();
#pragma unroll
    for (int k = 0; k < 8; ++k) { const int p = cidx(4 * (tid + 512 * k)); const v4u sp = spv[k];
        f32x2 a = buf[p], b = buf[p + 1], c = buf[p + 2], d = buf[p + 3];
        { const f32x2 s0 = a + c, d0 = a - c, s1 = b + d, t = b - d; const f32x2 d1 = (f32x2){t.y, -t.x};
          a = cmul(s0 + s1, cunpack(sp[0])); b = cmul(s0 - s1, cunpack(sp[1])); c = cmul(d0 + d1, cunpack(sp[2])); d = cmul(d0 - d1, cunpack(sp[3])); }
        { const f32x2 s0 = a + b, d0 = a - b, s1 = c + d, t = c - d; const f32x2 d1 = (f32x2){-t.y, t.x};
          buf[p] = s0 + s1; buf[p + 2] = s0 - s1; buf[p + 1] = d0 + d1; buf[p + 3] = d0 - d1; } if (k & 1) __builtin_amdgcn_sched_barrier(0); }
    __syncthreads();
#pragma unroll 1
    for (int k = 0; k < 2; ++k) { const int bf = tid + 512 * k; inv16(buf, (bf >> 2) * 64, bf & 3, 4); }
    __syncthreads();
#pragma unroll 1
    for (int k = 0; k < 2; ++k) { const int bf = tid + 512 * k; inv16(buf, (bf >> 6) * 1024, bf & 63, 64); }
    __syncthreads();
#pragma unroll 1
    for (int k = 0; k < 2; ++k) { const int bf = tid + 512 * k; inv16(buf, 0, bf, 1024); }
    __syncthreads();
}
__device__ __forceinline__ float conv3_at(const bf16* P, int t, int T, float w0, float w1, float w2, float cb) {
    const int tm = t > 0 ? t - 1 : 0, tp = t < T - 1 ? t + 1 : T - 1;
    const float vm = bf1(P[tm]), v0 = bf1(P[t]), vp = bf1(P[tp]);
    const float pm = t > 0 ? vm : 0.f, pp = t < T - 1 ? vp : 0.f;
    return w0 * pm + w1 * v0 + w2 * pp + cb;
}
__device__ __forceinline__ float wave_sum_t(float v, int tid) {
#pragma unroll
    for (int m = 1; m < 64; m <<= 1) v += __builtin_bit_cast(float, __builtin_amdgcn_ds_bpermute(((tid ^ m) & 63) << 2, __builtin_bit_cast(int, v)));
    return v;
}
__device__ __forceinline__ float block_sum(float v, LAS float* red, int wave, int lane, int tid) {
    v = wave_sum_t(v, tid);
    __syncthreads();
    if (lane == 0) red[wave] = v;
    __syncthreads();
    float s = 0.f;
#pragma unroll
    for (int w = 0; w < 8; ++w) s += red[w];
    return s;
}

__device__ __forceinline__ void hyena_unit(const Args& A, const Ctx& C, int l_, int c_, bool with_ctx) {
    const int l = __builtin_amdgcn_readfirstlane(l_), c0 = __builtin_amdgcn_readfirstlane(c_);
#define OPQC() int c = c0; asm volatile("" : "+s"(c))
    OPQC();
    unsigned char* ws = A.ws;
    LAS f32x2* buf = (LAS f32x2*)C.lds;
    LAS float* sW = (LAS float*)(C.lds + HYS_OFF);
    LAS float* red = sW + 256;
    const int tid0 = C.tid;
#define OPQ() int tid = tid0; asm volatile("" : "+v"(tid))
    const bf16* HYT = (const bf16*)(ws + WS_R1);
    const bf16* HYTC = (const bf16*)(ws + WS_HYTC);
    bf16* YT = (bf16*)(ws + WS_YHYT);
#define SZ ((GAS v4u*)(ws + WS_HSCR) + (size_t)blockIdx.x * 8192 + tid)
#define SA (SZ + 4096)
#define SB ((GAS v4u*)(ws + WS_YHY) + (size_t)blockIdx.x * 4096 + tid)
#define SF ((GAS v4u*)(ws + WS_YHY) + (size_t)(256 + blockIdx.x) * 4096 + tid)
    __syncthreads();
    { OPQ(); if (tid < 256) { const int od = tid >> 6, j = tid & 63; sW[tid] = A.hy_w3[((size_t)l * 64 + j) * 2048 + od * 512 + c]; } }
    __syncthreads();
#define HY_CW(X, k) (A.hy_conv_w[((size_t)l * 3 + (k)) * 1536 + (X) * 512 + c])
#define HY_CB(X) (A.hy_conv_b[l * 1536 + (X) * 512 + c])
#define HY_CONV4(u, P, t0, w0, w1, w2, wb) do { const v2u w_ = *(const GAS v2u*)((P) + (t0)); const int tl_ = (t0) > 0 ? (t0) - 1 : 0, tr_ = (t0) + 4 < L ? (t0) + 4 : L - 1; \
        const float xl_ = (t0) > 0 ? bf1((P)[tl_]) : 0.f, xr_ = (t0) + 4 < L ? bf1((P)[tr_]) : 0.f, x0_ = bflo(w_.x), x1_ = bfhi(w_.x), x2_ = bflo(w_.y), x3_ = bfhi(w_.y); \
        u[0] = (w0) * xl_ + (w1) * x0_ + (w2) * x1_ + (wb); u[1] = (w0) * x0_ + (w1) * x1_ + (w2) * x2_ + (wb); u[2] = (w0) * x1_ + (w1) * x2_ + (w2) * x3_ + (wb); u[3] = (w0) * x2_ + (w1) * x3_ + (w2) * xr_ + (wb); } while (0)
#define HY_RAW(P, t0, W, XL, XR) do { W = *(const GAS v2u*)((P) + (t0)); XL = (P)[(t0) > 0 ? (t0) - 1 : 0]; XR = (P)[(t0) + 4 < L ? (t0) + 4 : L - 1]; } while (0)
#define HY_CALC(u, W, XL, XR, t0, w0, w1, w2, wb) do { const float xl_ = (t0) > 0 ? bf1(XL) : 0.f, xr_ = (t0) + 4 < L ? bf1(XR) : 0.f, x0_ = bflo(W.x), x1_ = bfhi(W.x), x2_ = bflo(W.y), x3_ = bfhi(W.y); \
        u[0] = (w0) * xl_ + (w1) * x0_ + (w2) * x1_ + (wb); u[1] = (w0) * x0_ + (w1) * x1_ + (w2) * x2_ + (wb); u[2] = (w0) * x1_ + (w1) * x2_ + (w2) * x3_ + (wb); u[3] = (w0) * x2_ + (w1) * x3_ + (w2) * xr_ + (wb); } while (0)
    float inv0, inv1;
    {
        OPQ();
        const int lane = tid & 63, wv = __builtin_amdgcn_readfirstlane(tid >> 6), col = lane & 15, kg = lane >> 4;
        const float dec0 = fabsf(A.hy_decay[((size_t)l * 2 + 0) * 512 + c]), dec1 = fabsf(A.hy_decay[((size_t)l * 2 + 1) * 512 + c]);
        bf16x8 af[2];
#pragma unroll
        for (int s2 = 0; s2 < 2; ++s2)
#pragma unroll
            for (int jj = 0; jj < 8; ++jj) { const int j = 32 * s2 + 8 * kg + jj; const float w = A.hy_w3[((size_t)l * 64 + j) * 2048 + (col & 3) * 512 + c]; af[s2][jj] = (short)f2bf(col < 4 ? w : 0.f); }
        const bf16* H2T = (const bf16*)(ws + WS_H2) + (size_t)l * L * 64;
        GAS unsigned* SFF = (GAS unsigned*)((GAS v4u*)(ws + WS_YHY) + (size_t)(256 + blockIdx.x) * 4096);
        float as0 = 0.f, as1 = 0.f;
#define HYF_LOAD(B, bt) { _Pragma("unroll") for (int i = 0; i < 8; ++i) { const int t = 2048 * wv + 16 * (8 * (bt) + i) + col; \
            B[i][0] = *(const GAS bf16x8*)(H2T + (size_t)t * 64 + 8 * kg); B[i][1] = *(const GAS bf16x8*)(H2T + (size_t)t * 64 + 32 + 8 * kg); } }
#define HYF_USE(B, bt) { _Pragma("unroll") for (int i = 0; i < 8; ++i) { const int t = 2048 * wv + 16 * (8 * (bt) + i) + col; \
            f32x4 acc = (f32x4){0.f, 0.f, 0.f, 0.f}; \
            acc = __builtin_amdgcn_mfma_f32_16x16x32_bf16(af[0], B[i][0], acc, 0, 0, 0); \
            acc = __builtin_amdgcn_mfma_f32_16x16x32_bf16(af[1], B[i][1], acc, 0, 0, 0); \
            if (kg == 0) { const float tl = (float)t * (1.0f / (float)(L - 1)); const float w0 = __expf(-tl * dec0), w1 = __expf(-tl * dec1); \
                const float h0 = acc[0] * w0, h1 = acc[1] * w0, h2 = acc[2] * w1, h3 = acc[3] * w1; \
                as0 += fabsf(h0) + fabsf(h1); as1 += fabsf(h2) + fabsf(h3); \
                buf[cidx(t)] = (f32x2){h0, h1}; SFF[t] = pk2(h2, h3); } } }
        bf16x8 fa_[8][2], fb_[8][2];
        HYF_LOAD(fa_, 0)
#pragma unroll 1
        for (int bt = 0; bt < 16; bt += 2) {
            HYF_LOAD(fb_, bt + 1)
            HYF_USE(fa_, bt)
            if (bt + 2 < 16) HYF_LOAD(fa_, bt + 2)
            HYF_USE(fb_, bt + 1)
        }
#undef HYF_LOAD
#undef HYF_USE
        inv0 = 1.0f / block_sum(as0, red, C.wave, C.lane, tid);
        inv1 = 1.0f / block_sum(as1, red, C.wave, C.lane, tid);
        __syncthreads();
    }
    {
        OPQ();
        const float v0 = HY_CW(0, 0), v1 = HY_CW(0, 1), v2 = HY_CW(0, 2), vb = HY_CB(0);
        v2u ra[8], rb[8]; bf16 la[8], ha[8], lb[8], hb_[8];
#pragma unroll
        for (int g = 0; g < 8; ++g) { const int t0 = 2048 * g + 4 * tid; HY_RAW(HYT + ((size_t)(0 * 1536 + c)) * L, t0, ra[g], la[g], ha[g]); HY_RAW(HYT + ((size_t)(1 * 1536 + c)) * L, t0, rb[g], lb[g], hb_[g]); }
#pragma unroll
        for (int g = 0; g < 8; ++g) { const int t0 = 2048 * g + 4 * tid; float ua[4], ub[4];
            HY_CALC(ua, ra[g], la[g], ha[g], t0, v0, v1, v2, vb); HY_CALC(ub, rb[g], lb[g], hb_[g], t0, v0, v1, v2, vb);
            SZ[512 * g] = (v4u){pk2(ua[0], ub[0]), pk2(ua[1], ub[1]), pk2(ua[2], ub[2]), pk2(ua[3], ub[3])}; }
    }
#pragma unroll 1
    for (int o = 0; o < 2; ++o) {
        OPQC();
        const float bias = __builtin_bit_cast(float, __builtin_amdgcn_readfirstlane(__builtin_bit_cast(int, A.hy_bias[((size_t)l * 2 + o) * 512 + c])));
        if (o == 1) {
            OPQ();
            const GAS v4u* sf4 = (const GAS v4u*)((GAS v4u*)(ws + WS_YHY) + (size_t)(256 + blockIdx.x) * 4096);
#pragma unroll
            for (int g = 0; g < 8; ++g) { const v4u w = sf4[512 * g + tid]; const int p = cidx(2048 * g + 4 * tid);
#pragma unroll
                for (int k = 0; k < 4; ++k) buf[p + k] = cunpack(w[k]); }
            __syncthreads();
        }
        {
            OPQ();
            f32x2 zs[32];
            const float invo = o ? inv1 : inv0;
#pragma unroll
            for (int g = 0; g < 8; ++g)
#pragma unroll
                for (int k = 0; k < 4; ++k) { const int n = 2048 * g + 4 * tid + k;
                    if (g < 4) { zs[g * 4 + k] = (f32x2){buf[cidx(2 * n)].x * invo, buf[cidx(2 * n + 1)].x * invo}; }
                    else { const int m = 2 * L - 2 * n; const int mc = m < L ? m : L - 1; const float re = buf[cidx(mc)].y; zs[g * 4 + k] = (f32x2){m < L ? re * invo : 0.f, buf[cidx(m - 1)].y * invo}; } }
            __syncthreads();
#pragma unroll
            for (int g = 0; g < 8; ++g) { const int p = cidx(2048 * g + 4 * tid);
#pragma unroll
                for (int k = 0; k < 4; ++k) buf[p + k] = zs[g * 4 + k]; }
            __syncthreads();
        }
        v4u zv[8];
        { OPQ(); fft_fwd(buf, tid);
#pragma unroll
          for (int g = 0; g < 8; ++g) zv[g] = SZ[512 * g];
          const f32x2 w1c = twid(1.0f / (float)NFFT);
#pragma unroll
          for (int g = 0; g < 8; ++g) { v4u ke4, ko4;
#pragma unroll
              for (int k = 0; k < 4; ++k) { const int p = 2048 * g + 4 * tid + k; const int kp = (int)(__builtin_bitreverse32((unsigned)p) >> 18);
                  const int m0 = (2 * kp) & (L - 1); const bool neg = kp >= L / 2;
                  const int q0 = p >> 1, q1 = q0 + L / 2, q0c = (int)(__builtin_bitreverse32((unsigned)((L - m0) & (L - 1))) >> 18), q1c = L - 1 - q0;
                  const f32x2 a0 = buf[cidx(q0)], b0 = buf[cidx(q0c)], a1 = buf[cidx(q1)], b1 = buf[cidx(q1c)];
                  const f32x2 t0 = twid((float)m0 * (1.0f / (float)NFFT)), t1 = cmul(t0, w1c);
                  const f32x2 xe0 = (f32x2){0.5f * (a0.x + b0.x), 0.5f * (a0.y - b0.y)}, d0 = (f32x2){a0.x - b0.x, a0.y + b0.y}, xo0 = (f32x2){0.5f * d0.y, -0.5f * d0.x};
                  const f32x2 xe1 = (f32x2){0.5f * (a1.x + b1.x), 0.5f * (a1.y - b1.y)}, d1 = (f32x2){a1.x - b1.x, a1.y + b1.y}, xo1 = (f32x2){0.5f * d1.y, -0.5f * d1.x};
                  const f32x2 c0 = cmul(t0, xo0), c1 = cmul(t1, xo1);
                  const f32x2 v0 = neg ? xe0 - c0 : xe0 + c0, v1 = neg ? xe1 - c1 : xe1 + c1;
                  ke4[k] = cpack(v0); ko4[k] = cpack(v1); }
              SA[512 * g] = ke4; SB[512 * g] = ko4; __builtin_amdgcn_sched_barrier(0); }
          __syncthreads(); }
        { OPQ();
#pragma unroll
        for (int g = 0; g < 8; ++g) { const int p = cidx(2048 * g + 4 * tid); const v4u w = zv[g];
#pragma unroll
            for (int k = 0; k < 4; ++k) buf[p + k] = cunpack(w[k]); }
        __syncthreads();
        fft_conv(buf, tid, SA); }
        { OPQ();
#pragma unroll
        for (int g = 0; g < 8; ++g) zv[g] = SZ[512 * g];
#pragma unroll
        for (int g = 0; g < 8; ++g) { const int p = cidx(2048 * g + 4 * tid); v4u w;
#pragma unroll
            for (int k = 0; k < 4; ++k) { const f32x2 y = buf[p + k]; w[k] = pk2(y.x * (1.0f / (float)NFFT), y.y * (1.0f / (float)NFFT)); }
            SA[512 * g] = w; }
        __syncthreads(); }
        { OPQ();
#pragma unroll
        for (int g = 0; g < 8; ++g) { const int t0 = 2048 * g + 4 * tid, p = cidx(t0); const v4u w = zv[g];
#pragma unroll
            for (int k = 0; k < 4; ++k) buf[p + k] = cmul(cunpack(w[k]), twid((float)(t0 + k) * (1.0f / (float)NFFT))); }
        __syncthreads();
        fft_conv(buf, tid, SB); }
        const int X = o + 1; const float q0 = HY_CW(X, 0), q1 = HY_CW(X, 1), q2 = HY_CW(X, 2), qb = HY_CB(X);
        { OPQ();
        v4u wyv[8], wzv[8]; v2u ra[8], rb[8]; bf16 la[8], ha[8], lb[8], hb_[8];
#pragma unroll
        for (int g = 0; g < 8; ++g) { const int t0 = 2048 * g + 4 * tid; wyv[g] = SA[512 * g]; wzv[g] = SZ[512 * g];
            HY_RAW(HYT + ((size_t)(0 * 1536 + X * 512 + c)) * L, t0, ra[g], la[g], ha[g]); HY_RAW(HYT + ((size_t)(1 * 1536 + X * 512 + c)) * L, t0, rb[g], lb[g], hb_[g]); }
#pragma unroll
        for (int g = 0; g < 8; ++g) { const int t0 = 2048 * g + 4 * tid, p = cidx(t0); const v4u wy = wyv[g], wz = wzv[g];
            float ga[4], gb[4]; HY_CALC(ga, ra[g], la[g], ha[g], t0, q0, q1, q2, qb); HY_CALC(gb, rb[g], lb[g], hb_[g], t0, q0, q1, q2, qb);
            float oa[4], ob[4];
#pragma unroll
            for (int k = 0; k < 4; ++k) { const f32x2 yo = cmulc(buf[p + k], twid((float)(t0 + k) * (1.0f / (float)NFFT)));
                const f32x2 yev = cunpack(wy[k]), z = cunpack(wz[k]);
                float y0 = yev.x + yo.x * (1.0f / (float)NFFT) + bias * z.x, y1 = yev.y + yo.y * (1.0f / (float)NFFT) + bias * z.y;
                if (ABL & 16) { y0 = bias * z.x; y1 = bias * z.y; }
                oa[k] = ga[k] * y0; ob[k] = gb[k] * y1; }
            if (g == 3) asm volatile("" ::: "memory");
            if (o == 0) SZ[512 * g] = (v4u){pk2(oa[0], ob[0]), pk2(oa[1], ob[1]), pk2(oa[2], ob[2]), pk2(oa[3], ob[3])};
            else { *(GAS v2u*)(YT + ((size_t)(0 * 512 + c)) * L + t0) = (v2u){pk2(oa[0], oa[1]), pk2(oa[2], oa[3])}; *(GAS v2u*)(YT + ((size_t)(1 * 512 + c)) * L + t0) = (v2u){pk2(ob[0], ob[1]), pk2(ob[2], ob[3])}; } } }
        __syncthreads();
    }
    if (with_ctx) {
        OPQ(); OPQC();
        const float v0 = HY_CW(0, 0), v1 = HY_CW(0, 1), v2 = HY_CW(0, 2), vb = HY_CB(0);
        LAS float* F = (LAS float*)C.lds;
        LAS float* Z = F + 1024;
        const float* H2C = (const float*)(ws + WS_H2C) + (size_t)l * 64 * CTX_LEN;
        const int b = tid >> 8, t = tid & 255;
        __syncthreads();
        {
            const int o = b; float f0 = 0.f, f1 = 0.f;
            for (int j = 0; j < 64; ++j) { const float h = H2C[j * CTX_LEN + t]; f0 += h * sW[(o * 2 + 0) * 64 + j]; f1 += h * sW[(o * 2 + 1) * 64 + j]; }
            const float decay = fabsf(A.hy_decay[((size_t)l * 2 + o) * 512 + c]);
            const float win = __expf(-((float)t * (1.0f / (float)(CTX_LEN - 1))) * decay); f0 *= win; f1 *= win;
            float s = wave_sum_t(fabsf(f0) + fabsf(f1), tid);
            __syncthreads();
            if (C.lane == 0) red[C.wave] = s;
            __syncthreads();
            const int w0 = (C.wave >> 2) * 4; const float tot = red[w0] + red[w0 + 1] + red[w0 + 2] + red[w0 + 3];
            F[(o * 2 + 0) * 256 + t] = f0 / tot; F[(o * 2 + 1) * 256 + t] = f1 / tot;
        }
        float z = conv3_at(HYTC + ((size_t)(b * 1536 + c)) * CTX_LEN, t, CTX_LEN, v0, v1, v2, vb);
#pragma unroll 1
        for (int o = 0; o < 2; ++o) {
            const float bias = A.hy_bias[((size_t)l * 2 + o) * 512 + c];
            __syncthreads();
            Z[b * 256 + t] = z;
            __syncthreads();
            float y = 0.f; const LAS float* hfp = F + (o * 2 + 0) * 256; const LAS float* hbp = F + (o * 2 + 1) * 256; const LAS float* zp = Z + b * 256;
            for (int s = 0; s <= t; ++s) y += hfp[t - s] * zp[s];
            for (int s = t + 1; s < 256; ++s) y += hbp[s - t] * zp[s];
            y += bias * z;
            const int X = o + 1; const float q0 = HY_CW(X, 0), q1 = HY_CW(X, 1), q2 = HY_CW(X, 2), qb = HY_CB(X);
            const float g = conv3_at(HYTC + ((size_t)(b * 1536 + X * 512 + c)) * CTX_LEN, t, CTX_LEN, q0, q1, q2, qb);
            z = g * y;
        }
        YT[(size_t)BATCH * 512 * L + ((size_t)(b * 512 + c)) * CTX_LEN + t] = (bf16)f2bf(z);
        __syncthreads();
    }
}
#undef OPQ
#undef OPQC
#undef SZ
#undef SA
#undef SB
#undef SF
#undef HY_CONV4
#undef HY_RAW
#undef HY_CALC
#undef HY_CW
#undef HY_CB
}

#ifdef SELFCHECK
namespace chk {
constexpr size_t WS_DBG = 504 * MiB;
constexpr int NCHK = 24;
__device__ __forceinline__ unsigned hsh(unsigned x) { x ^= x >> 16; x *= 0x7feb352dU; x ^= x >> 15; x *= 0x846ca68bU; x ^= x >> 16; return x; }
__device__ __forceinline__ void acc_err(unsigned char* ws, int id, float got, float ref) {
    float* a = (float*)(ws + WS_DBG) + id * 2; const float d = got - ref;
    atomicAdd(a, d * d); atomicAdd(a + 1, ref * ref);
}
__device__ __forceinline__ float dot_bf_f32col(const bf16* arow, const float* W, int K, int N, int col, int lane) {
    float s = 0.f; for (int k = lane; k < K; k += 64) s += bf1(arow[k]) * W[(size_t)k * N + col]; return wave_sum(s);
}
__device__ __forceinline__ void c_norm(const Args& A, const Ctx& C, const float* xlat, const float* xctx, const float* g, const float* mod, int shi, const bf16* XN, int id) {
    const int gw = C.vcu * NWAVES + C.wave;
    if (gw < 96) { const int r = (gw < 64) ? (int)(hsh(gw * 7 + 1) % ML) : ML + (int)(hsh(gw) % MC);
        const float* xr = r < ML ? xlat + (size_t)r * 1024 : xctx + (size_t)(r - ML) * 1024; const float* mp = mod + (r < ML ? (r >> 14) : 2) * 6144 + shi * 1024;
        float s = 0.f; for (int k = C.lane; k < 1024; k += 64) s += xr[k] * xr[k]; s = wave_sum(s); const float rstd = 1.0f / sqrtf(s / 1024.f + EPS);
        for (int k = C.lane; k < 1024; k += 64) acc_err(A.ws, id, bf1(XN[(size_t)r * 1024 + k]), xr[k] * rstd * g[k] * (1.f + mp[1024 + k]) + mp[k]); }
}
__device__ __forceinline__ void c_mod(const Args& A, const Ctx& C, int id) {
    const int gw = C.vcu * NWAVES + C.wave;
    if (gw < 128) { const int l = gw & 1, w = (gw >> 1) % 3, n = (int)(hsh(gw + 77) % 6144);
        float s = 0.f; for (int k = C.lane; k < 1024; k += 64) { const float cv = (w < 2) ? A.c[w * 1024 + k] : A.c_ctx[k]; s += (cv / (1.f + expf(-cv))) * A.w_mod[((size_t)l * 1024 + k) * 6144 + n]; }
        s = wave_sum(s) + A.b_mod[l * 6144 + n];
        if (C.lane == 0) acc_err(A.ws, id, ((const float*)(A.ws + WS_MOD))[(l * 3 + w) * 6144 + n], s); }
}
__device__ __forceinline__ void c_proj(const Args& A, const Ctx& C, int l, int id0) {
    const int gw = C.vcu * NWAVES + C.wave, lane = C.lane; unsigned char* ws = A.ws;
    const bf16* XN = (const bf16*)(ws + WS_XN); const float* W = A.w_in + (size_t)l * 1024 * IN_W;
    const unsigned h0 = hsh(gw * 31 + 5);
    const int r = (gw & 7) == 7 ? ML + (int)(h0 % MC) : (int)(h0 % ML);
    const bf16* xr = XN + (size_t)r * 1024;
    const bool latent = r < ML; const int t = r & 16383;
    const int kvrow = latent ? ((r >> 14) * KVL + 256 + t) : (((r - ML) >> 8) * KVL + ((r - ML) & 255));
    const int kind = (gw >> 3) % 6;
    if (kind == 0) { const int ch = (int)(hsh(h0) % 512); const float p = dot_bf_f32col(xr, W, 1024, IN_W, SC0 + ch, lane);
        if (lane == 0) acc_err(ws, id0 + 0, bf1(((const bf16*)(ws + WS_BG))[(size_t)r * 512 + ch]), p); }
    else if (kind == 1) { const int ch = (int)(hsh(h0) % 512); const float p1 = dot_bf_f32col(xr, W, 1024, IN_W, SC0 + 512 + ch, lane), p2 = dot_bf_f32col(xr, W, 1024, IN_W, SC0 + 1024 + ch, lane);
        if (lane == 0) acc_err(ws, id0 + 1, bf1(((const bf16*)(ws + WS_CX))[(size_t)r * 512 + ch]), p1 * p2); }
    else if (kind == 2) { const int d = (int)(hsh(h0) % 128); const float p = dot_bf_f32col(xr, W, 1024, IN_W, V0 + d, lane);
        if (lane == 0) acc_err(ws, id0 + 2, bf1(((const bf16*)(ws + WS_V))[(size_t)kvrow * 128 + d]), p); }
    else if (kind == 3) { const int ch = (int)(hsh(h0) % 1536); const float p = dot_bf_f32col(xr, W, 1024, IN_W, HY0 + ch, lane);
        const bf16* HY = latent ? (const bf16*)(ws + WS_R1) + ((size_t)((r >> 14) * 1536 + ch)) * SEQ + t : (const bf16*)(ws + WS_HYTC) + ((size_t)(((r - ML) >> 8) * 1536 + ch)) * CTX_LEN + ((r - ML) & 255);
        if (lane == 0) acc_err(ws, id0 + 3, bf1(*HY), p); }
    else {
        const bool isq = kind == 4; const int head = isq ? (int)(hsh(h0) % 8) : (int)(hsh(h0) % 2);
        const float* gain = (isq ? A.q_gain : A.k_gain) + l * 64;
        const float v = dot_bf_f32col(xr, W, 1024, IN_W, (isq ? Q0 : K0) + head * 64 + 0, lane);
        (void)v;
        float mine = 0.f;
        for (int d = 0; d < 64; ++d) { const float p = dot_bf_f32col(xr, W, 1024, IN_W, (isq ? Q0 : K0) + head * 64 + d, lane); if (lane == d) mine = p; }
        const float ss = wave_sum(mine * mine); float y = mine / sqrtf(ss / 64.f + EPS) * gain[lane];
        if (latent) { const int half = lane >> 5, dd = lane & 31, f = dd & 15; const bool second = dd >= 16;
            const float pos = (float)(half ? (t & 63) : (t >> 6)), ang = pos * powf(10000.f, -(float)f / 16.f);
            const float other = __shfl(y, lane ^ 16);
            y = second ? (y * cosf(ang) + other * sinf(ang)) : (y * cosf(ang) - other * sinf(ang)); }
        if (isq) y *= C2Q;
        const int bj = lane >> 5, n = (lane >> 4) & 1, fq = (lane >> 2) & 3, e = lane & 3, j = 32 * bj + 8 * fq + 4 * n + e;
        const float got = isq ? bf1(((const bf16*)(ws + WS_Q))[(size_t)r * 512 + head * 64 + j]) : bf1(((const bf16*)(ws + WS_K))[(size_t)kvrow * 128 + head * 64 + j]);
        acc_err(ws, id0 + (isq ? 4 : 5), got, y); }
}
__device__ __forceinline__ float hy_u(const Args& A, int l, int b, int X, int c, int t) {
    const bf16* P = (const bf16*)(A.ws + WS_R1) + ((size_t)(b * 1536 + X * 512 + c)) * SEQ;
    const float w0 = A.hy_conv_w[((size_t)l * 3 + 0) * 1536 + X * 512 + c], w1 = A.hy_conv_w[((size_t)l * 3 + 1) * 1536 + X * 512 + c], w2 = A.hy_conv_w[((size_t)l * 3 + 2) * 1536 + X * 512 + c];
    return w0 * (t > 0 ? bf1(P[t - 1]) : 0.f) + w1 * bf1(P[t]) + w2 * (t < SEQ - 1 ? bf1(P[t + 1]) : 0.f) + A.hy_conv_b[l * 1536 + X * 512 + c];
}
__device__ __forceinline__ void c_hy1(const Args& A, const Ctx& C, int l, int c) {
    float* F = (float*)(A.ws + WS_DBG + 65536); float* ABS = (float*)(A.ws + WS_DBG + 8192);
    const float* H2 = (const float*)(A.ws + WS_H2) + (size_t)l * 64 * SEQ;
    for (int i = C.vcu * NTHREADS + C.tid; i < 4 * SEQ; i += C.G * NTHREADS) { const int od = i >> 14, t = i & 16383, o = od >> 1;
        float s = 0.f; for (int j = 0; j < 64; ++j) s += H2[(size_t)j * SEQ + t] * A.hy_w3[((size_t)l * 64 + j) * 2048 + od * 512 + c];
        s *= expf(-((float)t / (float)(SEQ - 1)) * fabsf(A.hy_decay[((size_t)l * 2 + o) * 512 + c]));
        F[i] = s; atomicAdd(ABS + o, fabsf(s)); }
}
__device__ __forceinline__ float hy_conv(const float* hf, const float* hb, float inv, const float* z, int t, int lane) {
    float s = 0.f; for (int q = lane; q < SEQ; q += 64) s += (q <= t ? hf[t - q] : hb[q - t]) * z[q]; return wave_sum(s) * inv;
}
__device__ __forceinline__ void c_hy2(const Args& A, const Ctx& C, int l, int b, int c) {
    float* F = (float*)(A.ws + WS_DBG + 65536); float* ABS = (float*)(A.ws + WS_DBG + 8192); float* Z1 = F + 4 * SEQ; float* Z2 = Z1 + SEQ;
    for (int i = C.vcu * NTHREADS + C.tid; i < SEQ; i += C.G * NTHREADS) Z1[i] = hy_u(A, l, b, 0, c, i);
}
__device__ __forceinline__ void c_hy3(const Args& A, const Ctx& C, int l, int b, int c) {
    float* F = (float*)(A.ws + WS_DBG + 65536); float* ABS = (float*)(A.ws + WS_DBG + 8192); float* Z1 = F + 4 * SEQ; float* Z2 = Z1 + SEQ;
    const int gw = C.vcu * NWAVES + C.wave, NGW = C.G * NWAVES; const float inv = 1.0f / ABS[0], b1 = A.hy_bias[((size_t)l * 2 + 0) * 512 + c];
    for (int s = gw; s < SEQ; s += NGW) { const float cv = hy_conv(F, F + SEQ, inv, Z1, s, C.lane); if (C.lane == 0) Z2[s] = hy_u(A, l, b, 1, c, s) * (cv + b1 * Z1[s]); }
}
__device__ __forceinline__ void c_hy4(const Args& A, const Ctx& C, int l, int b, int c, int id) {
    float* F = (float*)(A.ws + WS_DBG + 65536); float* ABS = (float*)(A.ws + WS_DBG + 8192); float* Z1 = F + 4 * SEQ; float* Z2 = Z1 + SEQ;
    const int gw = C.vcu * NWAVES + C.wave; const float inv = 1.0f / ABS[1], b2 = A.hy_bias[((size_t)l * 2 + 1) * 512 + c];
    if (gw < 256) { const int t = (gw < 4) ? (gw & 1 ? SEQ - 1 - (gw >> 1) : (gw >> 1)) : (int)(hsh(gw * 13 + 3) % SEQ);
        const float cv = hy_conv(F + 2 * SEQ, F + 3 * SEQ, inv, Z2, t, C.lane);
        const float y = hy_u(A, l, b, 2, c, t) * (cv + b2 * Z2[t]);
        if (C.lane == 0) acc_err(A.ws, id, bf1(((const bf16*)(A.ws + WS_YHYT))[((size_t)(b * 512 + c)) * SEQ + t]), y); }
}
__device__ __forceinline__ void c_ysc(const Args& A, const Ctx& C, int l, int id) {
    const int gw = C.vcu * NWAVES + C.wave, lane = C.lane; unsigned char* ws = A.ws;
    if (gw >= 256) return;
    const bf16* XN = (const bf16*)(ws + WS_XN); const float* W = A.w_in + (size_t)l * 1024 * IN_W;
    const unsigned h0 = hsh(gw * 17 + 9); int r = (int)(h0 % ML); if (gw < 4) r = (gw & 1) ? SEQ - 1 + (gw >> 1) : (gw >> 1) * SEQ;
    const int ch = (int)(hsh(h0) % 512), t = r & 16383;
    float cv = 0.f;
    for (int k = -1; k <= 1; ++k) { const int tt = t + k; if (tt < 0 || tt >= SEQ) continue; const bf16* xr = XN + (size_t)(r + k) * 1024;
        cv += A.sc_conv_w[((size_t)l * 3 + (k + 1)) * 512 + ch] * dot_bf_f32col(xr, W, 1024, IN_W, SC0 + 512 + ch, lane) * dot_bf_f32col(xr, W, 1024, IN_W, SC0 + 1024 + ch, lane); }
    const float bg = dot_bf_f32col(XN + (size_t)r * 1024, W, 1024, IN_W, SC0 + ch, lane);
    if (lane == 0) acc_err(ws, id, bf1(((const bf16*)(ws + WS_BG))[(size_t)r * 512 + ch]), bg * cv);
}
__device__ __forceinline__ void c_att_sample(int i, int& r, int& h) { const unsigned hh = hsh(i * 101 + 7); r = (i < 16) ? ML + (int)(hh % MC) : (int)(hh % ML); h = (int)(hsh(hh) % 8); }
__device__ __forceinline__ void c_att_save(const Args& A, const Ctx& C) {
    const int gw = C.vcu * NWAVES + C.wave; float* QS = (float*)(A.ws + WS_DBG + 1 * MiB);
    if (gw < 256) { int r, h; c_att_sample(gw, r, h); QS[gw * 64 + C.lane] = bf1(((const bf16*)(A.ws + WS_Q))[(size_t)r * 512 + h * 64 + C.lane]); }
}
__device__ __forceinline__ void c_att(const Args& A, const Ctx& C, int id) {
    const int gw = C.vcu * NWAVES + C.wave, lane = C.lane; const float* QS = (const float*)(A.ws + WS_DBG + 1 * MiB);
    if (gw >= 256) return;
    int r, h; c_att_sample(gw, r, h);
    const bool latent = r < ML; const int b = latent ? (r >> 14) : ((r - ML) >> 8); const int nk = latent ? KVL : CTX_LEN;
    const bf16* Kp = (const bf16*)(A.ws + WS_K) + (size_t)b * KVL * 128 + (h >> 2) * 64; const bf16* Vp = (const bf16*)(A.ws + WS_V) + (size_t)b * KVL * 128 + (h >> 2) * 64;
    const float q = QS[gw * 64 + lane];
    float m = -INFINITY, lsum = 0.f, o = 0.f;
    for (int k = 0; k < nk; ++k) { const float s = wave_sum(q * bf1(Kp[(size_t)k * 128 + lane]));
        const float mn = fmaxf(m, s), f = exp2f(m - mn), p = exp2f(s - mn); lsum = lsum * f + p; o = o * f + p * bf1(Vp[(size_t)k * 128 + lane]); m = mn; }
    acc_err(A.ws, id, bf1(((const bf16*)(A.ws + WS_Q))[(size_t)r * 512 + h * 64 + lane]), o / lsum);
}
__device__ __forceinline__ void c_gate(const Args& A, const Ctx& C, int l, int rowbase, int nr, int id) {
    const int gw = C.vcu * NWAVES + C.wave; if (gw >= 256) return;
    const unsigned h0 = hsh(gw * 23 + 11); const int rr = (int)(h0 % nr), col = (int)(hsh(h0) % 3072);
    const float p = dot_bf_f32col((const bf16*)(A.ws + WS_XN) + (size_t)(rowbase + rr) * 1024, A.w_in + (size_t)l * 1024 * IN_W, 1024, IN_W, GT0 + col, C.lane);
    if (C.lane == 0) { const float got = bf1(((const bf16*)(A.ws + WS_R1))[(size_t)rr * 3072 + col]), ref = 1.f / (1.f + expf(-p)); acc_err(A.ws, id, got, ref); }
}
__device__ __forceinline__ void c_wcopy(const Args& A, const Ctx& C, int l) {
    const int gw = C.vcu * NWAVES + C.wave; if (gw >= 512) return;
    const unsigned h0 = hsh(gw * 59 + 21); const bool hi = gw & 1; const int row = hi ? 3840 + (int)(h0 % 3072) : 2304 + (int)(h0 % 1536);
    const bf16* WT = (const bf16*)(A.ws + WS_WIN) + ((size_t)l * IN_W + row) * 1024;
    for (int k = C.lane; k < 1024; k += 64) acc_err(A.ws, hi ? 19 : 18, bf1(WT[k]), A.w_in[((size_t)l * 1024 + k) * IN_W + row]);
}
__device__ __forceinline__ void c_merge(const Args& A, const Ctx& C, int l, int rowbase, int nr, int id) {
    const int gw = C.vcu * NWAVES + C.wave; if (gw >= 256) return;
    const unsigned h0 = hsh(gw * 29 + 13); const int rr = (int)(h0 % nr), r = rowbase + rr, col = (int)(hsh(h0) % 1024);
    const bf16* G = (const bf16*)(A.ws + WS_R1) + (size_t)rr * 3072;
    const float a = dot_bf_f32col((const bf16*)(A.ws + WS_Q) + (size_t)r * 512, A.w_br_att + (size_t)l * 512 * 1024, 512, 1024, col, C.lane);
    const float s = dot_bf_f32col((const bf16*)(A.ws + WS_BG) + (size_t)r * 512, A.w_br_sc + (size_t)l * 512 * 1024, 512, 1024, col, C.lane);
    const float y = dot_bf_f32col((const bf16*)(A.ws + WS_YHY) + (size_t)r * 512, A.w_br_hy + (size_t)l * 512 * 1024, 512, 1024, col, C.lane);
    if (C.lane == 0) acc_err(A.ws, id, bf1(((const bf16*)(A.ws + WS_MM))[(size_t)r * 1024 + col]), bf1(G[col]) * a + bf1(G[1024 + col]) * s + bf1(G[2048 + col]) * y);
}
__device__ __forceinline__ void c_yhyT(const Args& A, const Ctx& C, int id) {
    const int gw = C.vcu * NWAVES + C.wave; if (gw >= 64) return;
    const unsigned h0 = hsh(gw * 37 + 1); const int r = (gw < 8) ? ML + (int)(h0 % MC) : (int)(h0 % ML), c = (int)(hsh(h0) % 512);
    const bf16* YT = (const bf16*)(A.ws + WS_YHYT);
    const float ref = r < ML ? bf1(YT[((size_t)((r >> 14) * 512 + c)) * SEQ + (r & 16383)]) : bf1(YT[(size_t)BATCH * 512 * SEQ + ((size_t)(((r - ML) >> 8) * 512 + c)) * CTX_LEN + ((r - ML) & 255)]);
    if (C.lane == 0) acc_err(A.ws, id, bf1(((const bf16*)(A.ws + WS_YHY))[(size_t)r * 512 + c]), ref);
}
__device__ __forceinline__ void c_wout(const Args& A, const Ctx& C, int l, int id) {
    const int gw = C.vcu * NWAVES + C.wave; if (gw >= 256) return;
    const unsigned h0 = hsh(gw * 41 + 3); const int r = (gw < 16) ? ML + (int)(h0 % MC) : (int)(h0 % ML), col = (int)(hsh(h0) % 1024);
    const float d = dot_bf_f32col((const bf16*)(A.ws + WS_MM) + (size_t)r * 1024, A.w_out + (size_t)l * 1024 * 1024, 1024, 1024, col, C.lane);
    const float* mod = (const float*)(A.ws + WS_MOD) + (size_t)l * 3 * 6144;
    const float xo = r < ML ? A.x[(size_t)r * 1024 + col] : A.ctx[(size_t)(r - ML) * 1024 + col], gt = mod[(r < ML ? (r >> 14) : 2) * 6144 + 2 * 1024 + col];
    const float got = r < ML ? A.out[(size_t)r * 1024 + col] : ((const float*)(A.ws + WS_CTXB))[(size_t)(r - ML) * 1024 + col];
    if (C.lane == 0) acc_err(A.ws, id, got, xo + gt * d);
}
__device__ __forceinline__ void c_scores(const Args& A, const Ctx& C, int l, int row0, int nr, int id) {
    const int gw = C.vcu * NWAVES + C.wave, lane = C.lane; if (gw >= 128) return;
    const unsigned h0 = hsh(gw * 43 + 5); const int rr = (int)(h0 % nr), hp = (int)(hsh(h0) % 16), n = (int)(hsh(h0 + 1) % 128);
    const bf16* xr = (const bf16*)(A.ws + WS_XN) + (size_t)(row0 + rr) * 1024;
    float qd = 0.f; for (int d = 0; d < 64; ++d) { const float q = dot_bf_f32col(xr, A.peer_wq + (size_t)l * 1024 * 1024, 1024, 1024, hp * 64 + d, lane); if (lane == d) qd = q; }
    const float s = wave_sum(qd * A.peer_subkeys[(((size_t)l * 16 + hp) * 128 + n) * 64 + lane]);
    if (lane == 0) acc_err(A.ws, id, ((const float*)(A.ws + WS_R1))[(size_t)rr * 2048 + hp * 128 + n], s);
}
__device__ __forceinline__ int c_peer_row(int i, int nr) { return (int)(hsh(i * 53 + 17) % nr); }
__device__ __forceinline__ void c_peer_save(const Args& A, const Ctx& C, int row0, int nr) {
    const int gw = C.vcu * NWAVES + C.wave; if (gw >= 64) return; const int r = row0 + c_peer_row(gw, nr);
    float* XS = (float*)(A.ws + WS_DBG + 2 * MiB); for (int k = C.lane; k < 1024; k += 64) XS[gw * 1024 + k] = A.out[(size_t)r * 1024 + k];
}
__device__ __forceinline__ void c_peer(const Args& A, const Ctx& C, int l, int row0, int nr, int id) {
    const int gw = C.vcu * NWAVES + C.wave, lane = C.lane; if (gw >= 64) return;
    const int rr = c_peer_row(gw, nr), r = row0 + rr; const float* S = (const float*)(A.ws + WS_R1) + (size_t)rr * 2048; const float* XS = (const float*)(A.ws + WS_DBG + 2 * MiB) + gw * 1024;
    const bf16* xr = (const bf16*)(A.ws + WS_XN) + (size_t)r * 1024;
    float f[16];
#pragma unroll
    for (int i = 0; i < 16; ++i) f[i] = 0.f;
    for (int h = 0; h < 8; ++h) {
        const float* s1 = S + h * 256; const float* s2 = s1 + 128;
        int r1a = 0, r1b = 0, r2a = 0, r2b = 0; const float a1 = s1[lane], b1 = s1[lane + 64], a2 = s2[lane], b2 = s2[lane + 64];
        for (int k = 0; k < 128; ++k) { const float u = s1[k], v = s2[k]; r1a += (u > a1) || (u == a1 && k < lane); r1b += (u > b1) || (u == b1 && k < lane + 64); r2a += (v > a2) || (v == a2 && k < lane); r2b += (v > b2) || (v == b2 && k < lane + 64); }
        float t1 = 0.f, t2 = 0.f; int i1 = 0, i2 = 0;
        for (int k = 0; k < 16; ++k) {
            const unsigned long long ma = __ballot(r1a == k), mb = __ballot(r1b == k);
            const float v1 = ma ? __shfl(a1, __builtin_ctzll(ma)) : __shfl(b1, __builtin_ctzll(mb)); const int j1 = ma ? __builtin_ctzll(ma) : 64 + __builtin_ctzll(mb);
            const unsigned long long na = __ballot(r2a == k), nb = __ballot(r2b == k);
            const float v2 = na ? __shfl(a2, __builtin_ctzll(na)) : __shfl(b2, __builtin_ctzll(nb)); const int j2 = na ? __builtin_ctzll(na) : 64 + __builtin_ctzll(nb);
            if (lane == k) { t1 = v1; i1 = j1; t2 = v2; i2 = j2; } }
        float cv[4]; int rk[4];
#pragma unroll
        for (int q = 0; q < 4; ++q) { const int c = lane * 4 + q; cv[q] = __shfl(t1, c >> 4) + __shfl(t2, c & 15); rk[q] = 0; }
        for (int c2 = 0; c2 < 256; ++c2) { const float o = __shfl(t1, c2 >> 4) + __shfl(t2, c2 & 15);
#pragma unroll
            for (int q = 0; q < 4; ++q) { const int c = lane * 4 + q; rk[q] += (o > cv[q]) || (o == cv[q] && c2 < c); } }
        float mx = -INFINITY;
#pragma unroll
        for (int q = 0; q < 4; ++q) if (rk[q] < 16) mx = fmaxf(mx, cv[q]);
        mx = wave_max(mx);
        float den = 0.f;
#pragma unroll
        for (int q = 0; q < 4; ++q) if (rk[q] < 16) den += expf(cv[q] - mx);
        den = wave_sum(den);
        for (int c = 0; c < 256; ++c) { const int ow = c >> 2, q = c & 3;
            const int sel = __shfl((q == 0 ? rk[0] : q == 1 ? rk[1] : q == 2 ? rk[2] : rk[3]) < 16 ? 1 : 0, ow); if (!sel) continue;
            const float sc = __shfl(q == 0 ? cv[0] : q == 1 ? cv[1] : q == 2 ? cv[2] : cv[3], ow);
            const int e = __shfl(i1, c >> 4) * 128 + __shfl(i2, c & 15);
            const float* ur = A.peer_u + ((size_t)l * PEER_N + e) * 1024; const float* vr = A.peer_v + ((size_t)l * PEER_N + e) * 1024;
            float d = 0.f; for (int k = lane; k < 1024; k += 64) d += ur[k] * bf1(xr[k]); d = wave_sum(d);
            const float w = expf(sc - mx) / den * 0.5f * d * (1.f + erff(d * 0.7071067811865476f));
#pragma unroll
            for (int i = 0; i < 16; ++i) f[i] += w * vr[lane + 64 * i]; }
    }
    const float* mod = (const float*)(A.ws + WS_MOD) + (size_t)l * 3 * 6144 + (r >> 14) * 6144 + 5 * 1024;
#pragma unroll
    for (int i = 0; i < 16; ++i) { const int col = lane + 64 * i; acc_err(A.ws, id, A.out[(size_t)r * 1024 + col], XS[col] + mod[col] * f[i]); }
}
}
#endif

namespace peer {
__device__ __forceinline__ unsigned fkey(float f) { const unsigned b = __builtin_bit_cast(unsigned, f); return b ^ ((unsigned)((int)b >> 31) | 0x80000000u); }
__device__ __forceinline__ int mbcnt64(unsigned long long m) { return (int)__builtin_amdgcn_mbcnt_hi((unsigned)(m >> 32), __builtin_amdgcn_mbcnt_lo((unsigned)m, 0u)); }
__device__ __forceinline__ void compact2(unsigned k0, unsigned k1, unsigned T, float v0, float v1, int lane, LAS float* lv, LAS int* li) {
    const unsigned long long g0 = __ballot(k0 > T), g1 = __ballot(k1 > T), e0 = __ballot(k0 == T), e1 = __ballot(k1 == T);
    const int need = 16 - (__popcll(g0) + __popcll(g1));
    const bool s0 = (k0 > T) || ((k0 == T) && (mbcnt64(e0) < need));
    const bool s1 = (k1 > T) || ((k1 == T) && (__popcll(e0) + mbcnt64(e1) < need));
    const unsigned long long m0 = __ballot(s0), m1 = __ballot(s1);
    if (s0) { const int p = mbcnt64(m0); lv[p] = v0; li[p] = lane; }
    if (s1) { const int p = __popcll(m0) + mbcnt64(m1); lv[p] = v1; li[p] = lane + 64; }
}
__device__ __forceinline__ float gelu_erf(float v) { return 0.5f * v * (1.0f + erff(v * 0.7071067811865476f)); }

__device__ __forceinline__ float unkey(unsigned k) { const unsigned b = (k & 0x80000000u) ? (k ^ 0x80000000u) : ~k; return __builtin_bit_cast(float, b); }
__device__ __forceinline__ void cnt4(int (&n)[4], unsigned k0, unsigned k1, unsigned k2, unsigned k3, unsigned cc) {
    asm volatile("v_cmp_ge_u32_e64 s[92:93], %4, %8\n\t"
                 "v_cmp_ge_u32_e64 s[94:95], %5, %8\n\t"
                 "v_cmp_ge_u32_e64 s[96:97], %6, %8\n\t"
                 "v_cmp_ge_u32_e64 s[98:99], %7, %8\n\t"
                 "v_addc_co_u32_e64 %0, s[100:101], 0, %0, s[92:93]\n\t"
                 "v_addc_co_u32_e64 %1, s[100:101], 0, %1, s[94:95]\n\t"
                 "v_addc_co_u32_e64 %2, s[100:101], 0, %2, s[96:97]\n\t"
                 "v_addc_co_u32_e64 %3, s[100:101], 0, %3, s[98:99]"
                 : "+v"(n[0]), "+v"(n[1]), "+v"(n[2]), "+v"(n[3]) : "v"(k0), "v"(k1), "v"(k2), "v"(k3), "v"(cc)
                 : "s92", "s93", "s94", "s95", "s96", "s97", "s98", "s99", "s100", "s101");
}
#define CE2(v, x, y) { const unsigned hi_ = v[x] > v[y] ? v[x] : v[y], lo_ = v[x] > v[y] ? v[y] : v[x]; v[x] = hi_; v[y] = lo_; }
__device__ __forceinline__ void part_top16(const float* sp, unsigned (&run)[16]) {
#pragma unroll
    for (int g = 0; g < 8; ++g) {
        unsigned x[16];
#pragma unroll
        for (int i = 0; i < 16; ++i) x[i] = (fkey(sp[(g * 16 + i) * 64]) & 0xFFFFFF80u) | (unsigned)(g * 16 + i);
        CE2(x,0,1) CE2(x,2,3) CE2(x,0,2) CE2(x,1,3) CE2(x,1,2) CE2(x,4,5) CE2(x,6,7) CE2(x,4,6) CE2(x,5,7) CE2(x,5,6) CE2(x,0,4) CE2(x,2,6) CE2(x,2,4) CE2(x,1,5) CE2(x,3,7) CE2(x,3,5) CE2(x,1,2) CE2(x,3,4) CE2(x,5,6) CE2(x,8,9) CE2(x,10,11) CE2(x,8,10) CE2(x,9,11) CE2(x,9,10) CE2(x,12,13) CE2(x,14,15) CE2(x,12,14) CE2(x,13,15) CE2(x,13,14) CE2(x,8,12) CE2(x,10,14) CE2(x,10,12) CE2(x,9,13) CE2(x,11,15) CE2(x,11,13) CE2(x,9,10) CE2(x,11,12) CE2(x,13,14) CE2(x,0,8) CE2(x,4,12) CE2(x,4,8) CE2(x,2,10) CE2(x,6,14) CE2(x,6,10) CE2(x,2,4) CE2(x,6,8) CE2(x,10,12) CE2(x,1,9) CE2(x,5,13) CE2(x,5,9) CE2(x,3,11) CE2(x,7,15) CE2(x,7,11) CE2(x,3,5) CE2(x,7,9) CE2(x,11,13) CE2(x,1,2) CE2(x,3,4) CE2(x,5,6) CE2(x,7,8) CE2(x,9,10) CE2(x,11,12) CE2(x,13,14)
        if (g == 0) {
#pragma unroll
            for (int i = 0; i < 16; ++i) run[i] = x[i];
        } else {
#pragma unroll
            for (int i = 0; i < 16; ++i) run[i] = run[i] > x[15 - i] ? run[i] : x[15 - i];
            CE2(run,0,8) CE2(run,1,9) CE2(run,2,10) CE2(run,3,11) CE2(run,4,12) CE2(run,5,13) CE2(run,6,14) CE2(run,7,15) CE2(run,0,4) CE2(run,1,5) CE2(run,2,6) CE2(run,3,7) CE2(run,8,12) CE2(run,9,13) CE2(run,10,14) CE2(run,11,15) CE2(run,0,2) CE2(run,1,3) CE2(run,4,6) CE2(run,5,7) CE2(run,8,10) CE2(run,9,11) CE2(run,12,14) CE2(run,13,15) CE2(run,0,1) CE2(run,2,3) CE2(run,4,5) CE2(run,6,7) CE2(run,8,9) CE2(run,10,11) CE2(run,12,13) CE2(run,14,15)
        }
    }
}
__device__ __forceinline__ void route_tasks(const Ctx& C, const float* ST, int nt, int* EL, float* GL, const pg8::StaticOrder& SO) {
    const int lane = C.lane;
#pragma unroll 1
    for (int it = C.wave; ; it += NWAVES) {
        pg8::Unit un; if (!SO.next(it >> 2, un)) break;
        const int h = un.pm, tb = un.pn * 4 + (it & 3), t = tb * 64 + lane;
        float a[16], b[16]; int ai[16], bi[16];
        {   const float* sp = ST + ((size_t)tb * 2048 + h * 256) * 64 + lane;
            unsigned ra[16], rb[16];
            part_top16(sp, ra); part_top16(sp + 128 * 64, rb);
#pragma unroll
            for (int q = 0; q < 16; ++q) { a[q] = unkey(ra[q] & 0xFFFFFF80u); ai[q] = (int)(ra[q] & 127u); b[q] = unkey(rb[q] & 0xFFFFFF80u); bi[q] = (int)(rb[q] & 127u); } }
        float cs[64]; int ce[64];
        cs[0] = a[0] + b[0]; ce[0] = ai[0] * 128 + bi[0]; cs[1] = a[0] + b[1]; ce[1] = ai[0] * 128 + bi[1]; cs[2] = a[0] + b[2]; ce[2] = ai[0] * 128 + bi[2]; cs[3] = a[0] + b[3]; ce[3] = ai[0] * 128 + bi[3]; cs[4] = a[0] + b[4]; ce[4] = ai[0] * 128 + bi[4]; cs[5] = a[0] + b[5]; ce[5] = ai[0] * 128 + bi[5]; cs[6] = a[0] + b[6]; ce[6] = ai[0] * 128 + bi[6]; cs[7] = a[0] + b[7]; ce[7] = ai[0] * 128 + bi[7]; cs[8] = a[0] + b[8]; ce[8] = ai[0] * 128 + bi[8]; cs[9] = a[0] + b[9]; ce[9] = ai[0] * 128 + bi[9]; cs[10] = a[0] + b[10]; ce[10] = ai[0] * 128 + bi[10]; cs[11] = a[0] + b[11]; ce[11] = ai[0] * 128 + bi[11]; cs[12] = a[0] + b[12]; ce[12] = ai[0] * 128 + bi[12]; cs[13] = a[0] + b[13]; ce[13] = ai[0] * 128 + bi[13]; cs[14] = a[0] + b[14]; ce[14] = ai[0] * 128 + bi[14]; cs[15] = a[0] + b[15]; ce[15] = ai[0] * 128 + bi[15]; cs[16] = a[1] + b[0]; ce[16] = ai[1] * 128 + bi[0]; cs[17] = a[1] + b[1]; ce[17] = ai[1] * 128 + bi[1]; cs[18] = a[1] + b[2]; ce[18] = ai[1] * 128 + bi[2]; cs[19] = a[1] + b[3]; ce[19] = ai[1] * 128 + bi[3]; cs[20] = a[1] + b[4]; ce[20] = ai[1] * 128 + bi[4]; cs[21] = a[1] + b[5]; ce[21] = ai[1] * 128 + bi[5]; cs[22] = a[1] + b[6]; ce[22] = ai[1] * 128 + bi[6]; cs[23] = a[1] + b[7]; ce[23] = ai[1] * 128 + bi[7]; cs[24] = a[2] + b[0]; ce[24] = ai[2] * 128 + bi[0]; cs[25] = a[2] + b[1]; ce[25] = ai[2] * 128 + bi[1]; cs[26] = a[2] + b[2]; ce[26] = ai[2] * 128 + bi[2]; cs[27] = a[2] + b[3]; ce[27] = ai[2] * 128 + bi[3]; cs[28] = a[2] + b[4]; ce[28] = ai[2] * 128 + bi[4]; cs[29] = a[3] + b[0]; ce[29] = ai[3] * 128 + bi[0]; cs[30] = a[3] + b[1]; ce[30] = ai[3] * 128 + bi[1]; cs[31] = a[3] + b[2]; ce[31] = ai[3] * 128 + bi[2]; cs[32] = a[3] + b[3]; ce[32] = ai[3] * 128 + bi[3]; cs[33] = a[4] + b[0]; ce[33] = ai[4] * 128 + bi[0]; cs[34] = a[4] + b[1]; ce[34] = ai[4] * 128 + bi[1]; cs[35] = a[4] + b[2]; ce[35] = ai[4] * 128 + bi[2]; cs[36] = a[5] + b[0]; ce[36] = ai[5] * 128 + bi[0]; cs[37] = a[5] + b[1]; ce[37] = ai[5] * 128 + bi[1]; cs[38] = a[6] + b[0]; ce[38] = ai[6] * 128 + bi[0]; cs[39] = a[6] + b[1]; ce[39] = ai[6] * 128 + bi[1]; cs[40] = a[7] + b[0]; ce[40] = ai[7] * 128 + bi[0]; cs[41] = a[7] + b[1]; ce[41] = ai[7] * 128 + bi[1]; cs[42] = a[8] + b[0]; ce[42] = ai[8] * 128 + bi[0]; cs[43] = a[9] + b[0]; ce[43] = ai[9] * 128 + bi[0]; cs[44] = a[10] + b[0]; ce[44] = ai[10] * 128 + bi[0]; cs[45] = a[11] + b[0]; ce[45] = ai[11] * 128 + bi[0]; cs[46] = a[12] + b[0]; ce[46] = ai[12] * 128 + bi[0]; cs[47] = a[13] + b[0]; ce[47] = ai[13] * 128 + bi[0]; cs[48] = a[14] + b[0]; ce[48] = ai[14] * 128 + bi[0]; cs[49] = a[15] + b[0]; ce[49] = ai[15] * 128 + bi[0];
#pragma unroll
        for (int c = 50; c < 64; ++c) { cs[c] = -INFINITY; ce[c] = 0; }
#define CE3(k, pl, x, y) { const bool sw_ = k[x] < k[y]; const float k0_ = sw_ ? k[y] : k[x], k1_ = sw_ ? k[x] : k[y]; const int p0_ = sw_ ? pl[y] : pl[x], p1_ = sw_ ? pl[x] : pl[y]; k[x] = k0_; k[y] = k1_; pl[x] = p0_; pl[y] = p1_; }
        CE3(cs,ce,16,17) CE3(cs,ce,18,19) CE3(cs,ce,16,18) CE3(cs,ce,17,19) CE3(cs,ce,17,18) CE3(cs,ce,20,21) CE3(cs,ce,22,23) CE3(cs,ce,20,22) CE3(cs,ce,21,23) CE3(cs,ce,21,22) CE3(cs,ce,16,20) CE3(cs,ce,18,22) CE3(cs,ce,18,20) CE3(cs,ce,17,21) CE3(cs,ce,19,23) CE3(cs,ce,19,21) CE3(cs,ce,17,18) CE3(cs,ce,19,20) CE3(cs,ce,21,22) CE3(cs,ce,24,25) CE3(cs,ce,26,27) CE3(cs,ce,24,26) CE3(cs,ce,25,27) CE3(cs,ce,25,26) CE3(cs,ce,28,29) CE3(cs,ce,30,31) CE3(cs,ce,28,30) CE3(cs,ce,29,31) CE3(cs,ce,29,30) CE3(cs,ce,24,28) CE3(cs,ce,26,30) CE3(cs,ce,26,28) CE3(cs,ce,25,29) CE3(cs,ce,27,31) CE3(cs,ce,27,29) CE3(cs,ce,25,26) CE3(cs,ce,27,28) CE3(cs,ce,29,30) CE3(cs,ce,16,24) CE3(cs,ce,20,28) CE3(cs,ce,20,24) CE3(cs,ce,18,26) CE3(cs,ce,22,30) CE3(cs,ce,22,26) CE3(cs,ce,18,20) CE3(cs,ce,22,24) CE3(cs,ce,26,28) CE3(cs,ce,17,25) CE3(cs,ce,21,29) CE3(cs,ce,21,25) CE3(cs,ce,19,27) CE3(cs,ce,23,31) CE3(cs,ce,23,27) CE3(cs,ce,19,21) CE3(cs,ce,23,25) CE3(cs,ce,27,29) CE3(cs,ce,17,18) CE3(cs,ce,19,20) CE3(cs,ce,21,22) CE3(cs,ce,23,24) CE3(cs,ce,25,26) CE3(cs,ce,27,28) CE3(cs,ce,29,30)
        CE3(cs,ce,32,33) CE3(cs,ce,34,35) CE3(cs,ce,32,34) CE3(cs,ce,33,35) CE3(cs,ce,33,34) CE3(cs,ce,36,37) CE3(cs,ce,38,39) CE3(cs,ce,36,38) CE3(cs,ce,37,39) CE3(cs,ce,37,38) CE3(cs,ce,32,36) CE3(cs,ce,34,38) CE3(cs,ce,34,36) CE3(cs,ce,33,37) CE3(cs,ce,35,39) CE3(cs,ce,35,37) CE3(cs,ce,33,34) CE3(cs,ce,35,36) CE3(cs,ce,37,38) CE3(cs,ce,40,41) CE3(cs,ce,42,43) CE3(cs,ce,40,42) CE3(cs,ce,41,43) CE3(cs,ce,41,42) CE3(cs,ce,44,45) CE3(cs,ce,46,47) CE3(cs,ce,44,46) CE3(cs,ce,45,47) CE3(cs,ce,45,46) CE3(cs,ce,40,44) CE3(cs,ce,42,46) CE3(cs,ce,42,44) CE3(cs,ce,41,45) CE3(cs,ce,43,47) CE3(cs,ce,43,45) CE3(cs,ce,41,42) CE3(cs,ce,43,44) CE3(cs,ce,45,46) CE3(cs,ce,32,40) CE3(cs,ce,36,44) CE3(cs,ce,36,40) CE3(cs,ce,34,42) CE3(cs,ce,38,46) CE3(cs,ce,38,42) CE3(cs,ce,34,36) CE3(cs,ce,38,40) CE3(cs,ce,42,44) CE3(cs,ce,33,41) CE3(cs,ce,37,45) CE3(cs,ce,37,41) CE3(cs,ce,35,43) CE3(cs,ce,39,47) CE3(cs,ce,39,43) CE3(cs,ce,35,37) CE3(cs,ce,39,41) CE3(cs,ce,43,45) CE3(cs,ce,33,34) CE3(cs,ce,35,36) CE3(cs,ce,37,38) CE3(cs,ce,39,40) CE3(cs,ce,41,42) CE3(cs,ce,43,44) CE3(cs,ce,45,46)
        CE3(cs,ce,48,49) CE3(cs,ce,50,51) CE3(cs,ce,48,50) CE3(cs,ce,49,51) CE3(cs,ce,49,50) CE3(cs,ce,52,53) CE3(cs,ce,54,55) CE3(cs,ce,52,54) CE3(cs,ce,53,55) CE3(cs,ce,53,54) CE3(cs,ce,48,52) CE3(cs,ce,50,54) CE3(cs,ce,50,52) CE3(cs,ce,49,53) CE3(cs,ce,51,55) CE3(cs,ce,51,53) CE3(cs,ce,49,50) CE3(cs,ce,51,52) CE3(cs,ce,53,54) CE3(cs,ce,56,57) CE3(cs,ce,58,59) CE3(cs,ce,56,58) CE3(cs,ce,57,59) CE3(cs,ce,57,58) CE3(cs,ce,60,61) CE3(cs,ce,62,63) CE3(cs,ce,60,62) CE3(cs,ce,61,63) CE3(cs,ce,61,62) CE3(cs,ce,56,60) CE3(cs,ce,58,62) CE3(cs,ce,58,60) CE3(cs,ce,57,61) CE3(cs,ce,59,63) CE3(cs,ce,59,61) CE3(cs,ce,57,58) CE3(cs,ce,59,60) CE3(cs,ce,61,62) CE3(cs,ce,48,56) CE3(cs,ce,52,60) CE3(cs,ce,52,56) CE3(cs,ce,50,58) CE3(cs,ce,54,62) CE3(cs,ce,54,58) CE3(cs,ce,50,52) CE3(cs,ce,54,56) CE3(cs,ce,58,60) CE3(cs,ce,49,57) CE3(cs,ce,53,61) CE3(cs,ce,53,57) CE3(cs,ce,51,59) CE3(cs,ce,55,63) CE3(cs,ce,55,59) CE3(cs,ce,51,53) CE3(cs,ce,55,57) CE3(cs,ce,59,61) CE3(cs,ce,49,50) CE3(cs,ce,51,52) CE3(cs,ce,53,54) CE3(cs,ce,55,56) CE3(cs,ce,57,58) CE3(cs,ce,59,60) CE3(cs,ce,61,62)

#pragma unroll
        for (int i = 0; i < 16; ++i) { const bool sw_ = cs[i] < cs[16 + 15 - i]; cs[i] = sw_ ? cs[16 + 15 - i] : cs[i]; ce[i] = sw_ ? ce[16 + 15 - i] : ce[i]; }
        CE3(cs,ce,0,8) CE3(cs,ce,1,9) CE3(cs,ce,2,10) CE3(cs,ce,3,11) CE3(cs,ce,4,12) CE3(cs,ce,5,13) CE3(cs,ce,6,14) CE3(cs,ce,7,15) CE3(cs,ce,0,4) CE3(cs,ce,1,5) CE3(cs,ce,2,6) CE3(cs,ce,3,7) CE3(cs,ce,8,12) CE3(cs,ce,9,13) CE3(cs,ce,10,14) CE3(cs,ce,11,15) CE3(cs,ce,0,2) CE3(cs,ce,1,3) CE3(cs,ce,4,6) CE3(cs,ce,5,7) CE3(cs,ce,8,10) CE3(cs,ce,9,11) CE3(cs,ce,12,14) CE3(cs,ce,13,15) CE3(cs,ce,0,1) CE3(cs,ce,2,3) CE3(cs,ce,4,5) CE3(cs,ce,6,7) CE3(cs,ce,8,9) CE3(cs,ce,10,11) CE3(cs,ce,12,13) CE3(cs,ce,14,15)

#pragma unroll
        for (int i = 0; i < 16; ++i) { const bool sw_ = cs[i] < cs[32 + 15 - i]; cs[i] = sw_ ? cs[32 + 15 - i] : cs[i]; ce[i] = sw_ ? ce[32 + 15 - i] : ce[i]; }
        CE3(cs,ce,0,8) CE3(cs,ce,1,9) CE3(cs,ce,2,10) CE3(cs,ce,3,11) CE3(cs,ce,4,12) CE3(cs,ce,5,13) CE3(cs,ce,6,14) CE3(cs,ce,7,15) CE3(cs,ce,0,4) CE3(cs,ce,1,5) CE3(cs,ce,2,6) CE3(cs,ce,3,7) CE3(cs,ce,8,12) CE3(cs,ce,9,13) CE3(cs,ce,10,14) CE3(cs,ce,11,15) CE3(cs,ce,0,2) CE3(cs,ce,1,3) CE3(cs,ce,4,6) CE3(cs,ce,5,7) CE3(cs,ce,8,10) CE3(cs,ce,9,11) CE3(cs,ce,12,14) CE3(cs,ce,13,15) CE3(cs,ce,0,1) CE3(cs,ce,2,3) CE3(cs,ce,4,5) CE3(cs,ce,6,7) CE3(cs,ce,8,9) CE3(cs,ce,10,11) CE3(cs,ce,12,13) CE3(cs,ce,14,15)

#pragma unroll
        for (int i = 0; i < 16; ++i) { const bool sw_ = cs[i] < cs[48 + 15 - i]; cs[i] = sw_ ? cs[48 + 15 - i] : cs[i]; ce[i] = sw_ ? ce[48 + 15 - i] : ce[i]; }
        CE3(cs,ce,0,8) CE3(cs,ce,1,9) CE3(cs,ce,2,10) CE3(cs,ce,3,11) CE3(cs,ce,4,12) CE3(cs,ce,5,13) CE3(cs,ce,6,14) CE3(cs,ce,7,15) CE3(cs,ce,0,4) CE3(cs,ce,1,5) CE3(cs,ce,2,6) CE3(cs,ce,3,7) CE3(cs,ce,8,12) CE3(cs,ce,9,13) CE3(cs,ce,10,14) CE3(cs,ce,11,15) CE3(cs,ce,0,2) CE3(cs,ce,1,3) CE3(cs,ce,4,6) CE3(cs,ce,5,7) CE3(cs,ce,8,10) CE3(cs,ce,9,11) CE3(cs,ce,12,14) CE3(cs,ce,13,15) CE3(cs,ce,0,1) CE3(cs,ce,2,3) CE3(cs,ce,4,5) CE3(cs,ce,6,7) CE3(cs,ce,8,9) CE3(cs,ce,10,11) CE3(cs,ce,12,13) CE3(cs,ce,14,15)
#undef CE3
        {   float w[16]; float sm = 0.f;
#pragma unroll
            for (int k = 0; k < 16; ++k) { w[k] = __expf(cs[k] - cs[0]); sm += w[k]; }
            const float rs = 1.0f / sm; const size_t eo = (size_t)t * 128 + h * 16;
#pragma unroll
            for (int k = 0; k < 16; ++k) { EL[eo + k] = ce[k]; GL[eo + k] = w[k] * rs; } }
    }
}

__device__ __forceinline__ void route_tokens_wave(const Ctx& C, const float* ST, int nt, int* EL, float* GL) {
    const int gw = C.wave * C.G + C.vcu, NGW = C.G * NWAVES, lane = C.lane;
    constexpr int NH = 4;
    LAS float* slist = (LAS float*)(C.lds + C.wave * 16384);
    LAS float* l1v = (LAS float*)(C.lds + C.wave * 16384 + 512); LAS int* l1i = (LAS int*)(C.lds + C.wave * 16384 + 1024);
    LAS float* l2v = (LAS float*)(C.lds + C.wave * 16384 + 1536); LAS int* l2i = (LAS int*)(C.lds + C.wave * 16384 + 2048);
#pragma unroll 1
    for (int task = gw; task < nt * (8 / NH); task += NGW) {
        const int t = task / (8 / NH), hp = task % (8 / NH);
        const float* sp = ST + ((size_t)(t >> 6) * 2048 + hp * NH * 256 + lane) * 64 + (t & 63);
        float cv[4 * NH]; unsigned ck[4 * NH];
#pragma unroll
        for (int q = 0; q < 4 * NH; ++q) { cv[q] = sp[(size_t)q * 64 * 64]; ck[q] = fkey(cv[q]); }
        unsigned T[2 * NH]; bool fin[2 * NH];
#pragma unroll
        for (int c = 0; c < 2 * NH; ++c) { T[c] = 0u; fin[c] = false; }
#pragma unroll 1
        for (int bit = 31; bit >= 0; --bit) { bool all = true;
#pragma unroll
            for (int c = 0; c < 2 * NH; ++c) { const unsigned cc = T[c] | (1u << bit);
                const int n = __popcll(__ballot(ck[2 * c] >= cc)) + __popcll(__ballot(ck[2 * c + 1] >= cc));
                T[c] = (!fin[c] && n >= 16) ? cc : T[c]; fin[c] = fin[c] || (n == 16); all = all && fin[c]; }
            if (all) break; }
#pragma unroll
        for (int u = 0; u < NH; ++u) {
            compact2(ck[4 * u], ck[4 * u + 1], T[2 * u], cv[4 * u], cv[4 * u + 1], lane, l1v + 16 * u, l1i + 16 * u);
            compact2(ck[4 * u + 2], ck[4 * u + 3], T[2 * u + 1], cv[4 * u + 2], cv[4 * u + 3], lane, l2v + 16 * u, l2i + 16 * u); }
        LDS_WAIT(); asm volatile("" ::: "memory");
        const int ci = lane >> 2, cjb = (lane & 3) * 4;
        float cs[NH][4]; unsigned kc[NH][4]; int ce[NH][4];
#pragma unroll
        for (int u = 0; u < NH; ++u) { const float v1 = l1v[16 * u + ci]; const int e1 = l1i[16 * u + ci] * 128;
#pragma unroll
            for (int q = 0; q < 4; ++q) { cs[u][q] = v1 + l2v[16 * u + cjb + q]; kc[u][q] = fkey(cs[u][q]); ce[u][q] = e1 + l2i[16 * u + cjb + q]; } }
        unsigned Tc[NH]; bool finc[NH];
#pragma unroll
        for (int u = 0; u < NH; ++u) { Tc[u] = 0u; finc[u] = false; }
#pragma unroll 1
        for (int bit = 31; bit >= 0; --bit) { bool all = true;
#pragma unroll
            for (int u = 0; u < NH; ++u) { const unsigned cc = Tc[u] | (1u << bit);
                const int n = (__popcll(__ballot(kc[u][0] >= cc)) + __popcll(__ballot(kc[u][1] >= cc))) + (__popcll(__ballot(kc[u][2] >= cc)) + __popcll(__ballot(kc[u][3] >= cc)));
                Tc[u] = (!finc[u] && n >= 16) ? cc : Tc[u]; finc[u] = finc[u] || (n == 16); all = all && finc[u]; }
            if (all) break; }
#pragma unroll
        for (int u = 0; u < NH; ++u) {
            const int h = NH * hp + u;
            unsigned long long gq[4], eq[4];
#pragma unroll
            for (int q = 0; q < 4; ++q) { gq[q] = __ballot(kc[u][q] > Tc[u]); eq[q] = __ballot(kc[u][q] == Tc[u]); }
            const int need = 16 - ((__popcll(gq[0]) + __popcll(gq[1])) + (__popcll(gq[2]) + __popcll(gq[3])));
            int ebase = 0, mbase = 0;
#pragma unroll
            for (int q = 0; q < 4; ++q) { const bool sel = (kc[u][q] > Tc[u]) || ((kc[u][q] == Tc[u]) && (ebase + mbcnt64(eq[q]) < need)); ebase += __popcll(eq[q]);
                const unsigned long long mq = __ballot(sel); const int pos = mbase + mbcnt64(mq); mbase += __popcll(mq);
                if (sel) { slist[u * 16 + pos] = cs[u][q]; EL[(size_t)t * 128 + h * 16 + pos] = ce[u][q]; } }
        }
        LDS_WAIT(); asm volatile("" ::: "memory");
        {
            const int u = lane >> 4;
            float m = -INFINITY, sm = 0.f;
#pragma unroll
            for (int k = 0; k < 16; ++k) m = fmaxf(m, slist[u * 16 + k]);
#pragma unroll
            for (int k = 0; k < 16; ++k) sm += __expf(slist[u * 16 + k] - m);
            GL[(size_t)t * 128 + (NH * hp + u) * 16 + (lane & 15)] = __expf(slist[u * 16 + (lane & 15)] - m) / sm;
        }
        LDS_WAIT(); asm volatile("" ::: "memory");
    }
}

__device__ __forceinline__ void topk_gather(const Args& A, const Ctx& C, int l, int row0, int nrows, const int* EL, const float* GL, const unsigned char* U, const unsigned char* V, const float* US, const float* VS, const bf16* XN,
                                            float* xlat, float* xctx, const float* mod  , bool final_out, const float* gn, const float* nmod, bf16* XNw) {
    const int gw = C.wave * C.G + C.vcu, NGW = C.G * NWAVES, lane = C.lane, lp = lane & 31, half = lane >> 5, cl = 2 * lp + half;
    LAS int* elist = (LAS int*)(C.lds + C.wave * 16384);
    LAS float* glist = (LAS float*)(C.lds + C.wave * 16384 + 512);
    LAS float* clist = (LAS float*)(C.lds + C.wave * 16384 + 1024);
    LAS float* uslist = (LAS float*)(C.lds + C.wave * 16384 + 1536);
    LAS float* vslist = (LAS float*)(C.lds + C.wave * 16384 + 2048);
    int ne0 = 0, ne1 = 0; float ng0 = 0.f, ng1 = 0.f;
    if (gw < nrows) { ne0 = EL[(size_t)gw * 128 + lane]; ne1 = EL[(size_t)gw * 128 + 64 + lane]; ng0 = GL[(size_t)gw * 128 + lane]; ng1 = GL[(size_t)gw * 128 + 64 + lane]; }
    for (int rr = gw; rr < nrows; rr += NGW) {
        const int r = row0 + rr;
        elist[lane] = ne0; elist[64 + lane] = ne1; glist[lane] = ng0; glist[64 + lane] = ng1;
        const float us0 = US[ne0], us1 = US[ne1], vs0 = VS[ne0], vs1 = VS[ne1];
        { const int rn = rr + NGW; if (rn < nrows) { ne0 = EL[(size_t)rn * 128 + lane]; ne1 = EL[(size_t)rn * 128 + 64 + lane]; ng0 = GL[(size_t)rn * 128 + lane]; ng1 = GL[(size_t)rn * 128 + 64 + lane]; } }
        LDS_WAIT(); asm volatile("" ::: "memory");
        f32x2 acc[16];
#define GLOAD(T, bA, bB, xb) { _Pragma("unroll") for (int s = 0; s < 4; ++s) { const unsigned e = (unsigned)elist[(xb) + 2 * s + half]; const unsigned o = __umul24(e, 768u);        \
            bA[s] = *(const GAS v4u*)(T + (o + lo16)); bB[s] = *(const GAS v2u*)(T + (o + lo8)); } }
#define UCOMP(bA, bB, xb) { float p[4]; \
            _Pragma("unroll") for (int s = 0; s < 4; ++s) { \
                v6i w; w[0] = (int)bA[s].x; w[1] = (int)bA[s].y; w[2] = (int)bA[s].z; w[3] = (int)bA[s].w; w[4] = (int)bB[s].x; w[5] = (int)bB[s].y; \
                const v32f d = __builtin_amdgcn_cvt_scalef32_pk32_f32_fp6(w, 1.0f); \
                f32x2 sA = (f32x2){0.f, 0.f}, sB = (f32x2){0.f, 0.f}; \
                _Pragma("unroll") for (int i = 0; i < 8; ++i) { sA = __builtin_elementwise_fma((f32x2){d[4 * i], d[4 * i + 1]}, hf[2 * i], sA); sB = __builtin_elementwise_fma((f32x2){d[4 * i + 2], d[4 * i + 3]}, hf[2 * i + 1], sB); } \
                const f32x2 s2 = sA + sB; p[s] = (s2.x + s2.y) * uslist[(xb) + 2 * s + half]; } \
              \
            float q2[2]; \
            _Pragma("unroll") for (int j = 0; j < 2; ++j) q2[j] = (b4 ? p[j + 2] : p[j]) + __shfl_xor(b4 ? p[j] : p[j + 2], 16); \
            float sm = (b3 ? q2[1] : q2[0]) + __shfl_xor(b3 ? q2[0] : q2[1], 8); \
            sm += __shfl_xor(sm, 4); sm += __shfl_xor(sm, 2); sm += __shfl_xor(sm, 1); \
            const int ent = (xb) + 2 * (2 * (b4 ? 1 : 0) + (b3 ? 1 : 0)) + half; \
            const float cf = gelu_erf(sm) * glist[ent]; \
            if ((lane & 7) == 0) clist[ent] = cf; }
#define VCOMP(bA, bB, xb) { _Pragma("unroll") for (int s = 0; s < 4; ++s) { \
                v6i w; w[0] = (int)bA[s].x; w[1] = (int)bA[s].y; w[2] = (int)bA[s].z; w[3] = (int)bA[s].w; w[4] = (int)bB[s].x; w[5] = (int)bB[s].y; \
                const v32f d = __builtin_amdgcn_cvt_scalef32_pk32_f32_fp6(w, 1.0f); \
                const float c1_ = clist[(xb) + 2 * s + half] * vslist[(xb) + 2 * s + half]; const f32x2 c2 = (f32x2){c1_, c1_}; \
                _Pragma("unroll") for (int i = 0; i < 16; ++i) acc[i] = __builtin_elementwise_fma((f32x2){d[2 * i], d[2 * i + 1]}, c2, acc[i]); } }
        const bool b4 = (lane & 16) != 0, b3 = (lane & 8) != 0; const unsigned lo16 = 16u * (unsigned)lp, lo8 = 512u + 8u * (unsigned)lp;
#pragma unroll 1
        for (int rep2_ = 0; rep2_ < REP_GATHER; ++rep2_) {
        {
        f32x2 hf[16];
        { const GAS v4u* hp = (const GAS v4u*)(XN + (size_t)r * 1024 + 32 * lp);
#pragma unroll
          for (int q = 0; q < 4; ++q) { const v4u h4 = hp[q]; hf[4 * q] = (f32x2){bflo(h4.x), bfhi(h4.x)}; hf[4 * q + 1] = (f32x2){bflo(h4.y), bfhi(h4.y)}; hf[4 * q + 2] = (f32x2){bflo(h4.z), bfhi(h4.z)}; hf[4 * q + 3] = (f32x2){bflo(h4.w), bfhi(h4.w)}; } }
        v4u aA[4], bA[4], cA[4]; v2u aB[4], bB[4], cB[4];
        GLOAD(U, aA, aB, 0)
        GLOAD(U, bA, bB, 8)
        if (rep2_ == 0) { uslist[lane] = us0; uslist[64 + lane] = us1; vslist[lane] = vs0; vslist[64 + lane] = vs1; }
        LDS_WAIT(); asm volatile("" ::: "memory");
#pragma unroll 1
        for (int x0 = 0; x0 < 120; x0 += 24) {
            GLOAD(U, cA, cB, x0 + 16)
            UCOMP(aA, aB, x0)
            GLOAD(U, aA, aB, x0 + 24)
            UCOMP(bA, bB, x0 + 8)
            if (x0 + 32 < 128) GLOAD(U, bA, bB, x0 + 32)
            UCOMP(cA, cB, x0 + 16)
        }
        UCOMP(aA, aB, 120)
        }
        LDS_WAIT(); asm volatile("" ::: "memory");
#pragma unroll
        for (int i = 0; i < 16; ++i) acc[i] = (f32x2){0.f, 0.f};
        {
        v4u aA[4], bA[4], cA[4]; v2u aB[4], bB[4], cB[4];
        GLOAD(V, aA, aB, 0)
        GLOAD(V, bA, bB, 8)
#pragma unroll 1
        for (int x0 = 0; x0 < 120; x0 += 24) {
            GLOAD(V, cA, cB, x0 + 16)
            VCOMP(aA, aB, x0)
            GLOAD(V, aA, aB, x0 + 24)
            VCOMP(bA, bB, x0 + 8)
            if (x0 + 32 < 128) GLOAD(V, bA, bB, x0 + 32)
            VCOMP(cA, cB, x0 + 16)
        }
        VCOMP(aA, aB, 120)
        }
        asm volatile("" ::: "memory"); }
#undef GLOAD
#undef UCOMP
#undef VCOMP
        if (ABL & 8) {
#pragma unroll
            for (int i = 0; i < 16; ++i) acc[i] = (f32x2){0.f, 0.f}; }
        float tot[16];
#pragma unroll
        for (int i = 0; i < 16; ++i) { const float lo_ = acc[i >> 1][i & 1], hi_ = acc[8 + (i >> 1)][i & 1];
            tot[i] = (half ? hi_ : lo_) + __shfl_xor(half ? lo_ : hi_, 32); }
        const bool latent = r < ML;
        float* xr = latent ? xlat + (size_t)r * 1024 : xctx + (size_t)(r - ML) * 1024;
        const float* gp = mod + (latent ? (r >> 14) : 2) * 6144 + 5 * 1024;
        f32x4 xv[4]; float ss = 0.f;
#pragma unroll
        for (int k = 0; k < 4; ++k) { const int col = 16 * cl + 4 * k; const f32x4 xo = *(const GAS f32x4*)(xr + col), gt = *(const f32x4*)(gp + col);
            const f32x4 a4 = (f32x4){tot[4 * k], tot[4 * k + 1], tot[4 * k + 2], tot[4 * k + 3]};
            const f32x4 xn = xo + gt * a4; xv[k] = xn; ss += (xn.x * xn.x + xn.y * xn.y) + (xn.z * xn.z + xn.w * xn.w); }
        if (final_out) {
            const float rstd = 1.0f / sqrtf(wave_sum(ss) * (1.0f / 1024.0f) + EPS);
#pragma unroll
            for (int k = 0; k < 4; ++k) { const int col = 16 * cl + 4 * k; const f32x4 gf = *(const f32x4*)(A.g_final + col); *(GAS f32x4*)(xr + col) = xv[k] * rstd * gf; }
        } else {
#pragma unroll
            for (int k = 0; k < 4; ++k) { const int col = 16 * cl + 4 * k; *(GAS f32x4*)(xr + col) = xv[k]; }
            const float rstd = 1.0f / sqrtf(wave_sum(ss) * (1.0f / 1024.0f) + EPS);
            const float* mp = nmod + (latent ? (r >> 14) : 2) * 6144;
            v4u o[2];
#pragma unroll
            for (int k = 0; k < 4; ++k) { const int col = 16 * cl + 4 * k; const f32x4 g4 = *(const f32x4*)(gn + col), sh = *(const f32x4*)(mp + col), sc = *(const f32x4*)(mp + 1024 + col);
                const f32x4 y = xv[k] * rstd * g4 * (sc + 1.0f) + sh; o[k >> 1][(k & 1) * 2] = pk2(y.x, y.y); o[k >> 1][(k & 1) * 2 + 1] = pk2(y.z, y.w); }
            *(GAS v4u*)(XNw + (size_t)r * 1024 + 16 * cl) = o[0]; *(GAS v4u*)(XNw + (size_t)r * 1024 + 16 * cl + 8) = o[1];
        }
        LDS_WAIT(); asm volatile("" ::: "memory");
    }
}
}

#ifndef PHMASK
#define PHMASK 0xFFFF
#endif
#define PH(n) if constexpr (((PHMASK) >> (n)) & 1)
#ifndef ATT_THRL
#define ATT_THRL 4096
#endif
#ifndef NAIVE_G3
#define NAIVE_G3 0
#endif
#ifndef CHKSKIP
#define CHKSKIP ((1 << 12) | (1 << 20))
#endif
__global__ void __launch_bounds__(NTHREADS, 2) mega_fwd(Args A) {
    extern __shared__ __attribute__((aligned(16))) unsigned char lds_raw[];
    Ctx C;
    C.lds = (LAS unsigned char*)lds_raw;
    C.tid = threadIdx.x; C.lane = C.tid & 63; C.wave = __builtin_amdgcn_readfirstlane(C.tid >> 6);
    C.G = gridDim.x; { const int bx = blockIdx.x; C.vcu = (C.G % 8 == 0) ? (bx % 8) * (C.G / 8) + bx / 8 : bx; }
    volatile LAS unsigned* MISC = (volatile LAS unsigned*)(C.lds + MISC_OFF);
    for (int u = C.tid; u < (LDS_BYTES - LDSCTL_OFF) / 4; u += NTHREADS) ((LAS unsigned*)(C.lds + LDSCTL_OFF))[u] = 0u;
    __syncthreads();
    unsigned char* ws = A.ws;
    gu32* ctl = (gu32*)(ws + WS_CTL);
    (void)xcd_barrier_post((unsigned*)(ctl + CW_BAR), MISC + 8);
#ifdef PROBE_DEC
    { typedef int v6i_ __attribute__((ext_vector_type(6))); typedef float v32f_ __attribute__((ext_vector_type(32)));
      v6i_ w_; w_[0] = C.tid; w_[1] = C.tid * 3; w_[2] = C.tid * 5; w_[3] = C.tid * 7; w_[4] = C.tid * 11; w_[5] = C.tid * 13;
#pragma unroll 4
      for (int i_ = 0; i_ < PROBE_DEC; ++i_) { asm volatile("" : "+v"(w_)); const v32f_ r_ = __builtin_amdgcn_cvt_scalef32_pk32_f32_fp6(w_, 1.0f); asm volatile("" :: "v"(r_)); } }
#endif
#define GRID_BAR() do { unsigned char* w_ = A.ws; asm volatile("" : "+s"(w_)); XcdBarrier b_; b_.bar = (unsigned*)(w_ + WS_CTL) + CW_BAR; b_.x = xb_xcc_id(); b_.st = (volatile LAS unsigned*)(C.lds + MISC_OFF) + 8; xcd_barrier(b_); } while (0)
#ifdef SELFCHECK
#define CHK(stmt) do { if (l == 0) { PCTX(Cq); stmt; } GRID_BAR(); } while (0)
#else
#define CHK(stmt) do {} while (0)
#endif
#define PCTX(Cn) Ctx Cn; { const int t_ = opq_tid(); Cn.lds = C.lds; Cn.tid = t_; Cn.lane = t_ & 63; Cn.wave = __builtin_amdgcn_readfirstlane(t_ >> 6); Cn.G = C.G; Cn.vcu = C.vcu; }
    LAS unsigned char* ring = C.lds;

    bf16* XN = (bf16*)(ws + WS_XN); bf16* Qb = (bf16*)(ws + WS_Q); bf16* Kb = (bf16*)(ws + WS_K); bf16* Vb = (bf16*)(ws + WS_V);
    bf16* BG = (bf16*)(ws + WS_BG); bf16* CX = (bf16*)(ws + WS_CX); bf16* MM = (bf16*)(ws + WS_MM); bf16* YHY = (bf16*)(ws + WS_YHY);
    bf16* YHYT = (bf16*)(ws + WS_YHYT); bf16* HYT = (bf16*)(ws + WS_R1); bf16* HYTC = (bf16*)(ws + WS_HYTC); bf16* GG = (bf16*)(ws + WS_R1); float* SS = (float*)(ws + WS_R1);
    int* PEL = (int*)(ws + WS_PLIST); float* PGL = (float*)(ws + WS_PLIST + 8 * MiB);
    unsigned char* TU = ws + WS_TAB; unsigned char* TV = TU + (size_t)PEER_N * 768; float* TUS = (float*)(ws + WS_TAB + 32 * MiB); float* TVS = TUS + PEER_N;
    float* CTXB = (float*)(ws + WS_CTXB); const float* MOD = (const float*)(ws + WS_MOD);
    const float* ropec = (const float*)(ws + WS_ROPE); const float* ropes = ropec + 4096;

    PH(0) { PCTX(Cp); p0_prologue(A, Cp); }
#if PROBE_PRO
    __syncthreads();
    PH(0) { PCTX(Cp); p0_prologue(A, Cp); }
#endif
    GRID_BAR();

#pragma unroll 1
    for (int l = 0; l < DEPTH; ++l) {
        const bool need_ctx = (l < DEPTH - 1);
        const int MR = need_ctx ? MT : ML;
#define xold ((l == 0) ? A.x : (const float*)A.out)
#define cold ((l == 0) ? A.ctx : (const float*)CTXB)
#define WIN ((const bf16*)(ws + WS_WIN) + (size_t)l * IN_W * 1024)
#define MODl (MOD + (size_t)l * 3 * 6144)

        if (l == 0) { PH(1) { PCTX(Cp); norm_rows(Cp, xold, cold, MT, A.g_norm1 + l * 1024, MODl, 0, XN); }
        GRID_BAR(); }
        CHK(chk::c_norm(A, Cq, xold, cold, A.g_norm1 + l * 1024, MODl, 0, XN, 0); chk::c_mod(A, Cq, 1));

#pragma unroll 1
        for (int repg_ = 0; repg_ < REP_P2; ++repg_) {
        PH(2) {
            pg8::Gemm g{XN, WIN, MT, 2304, 1024}; pg8::StaticOrder S; S.init(MT, 2304, C.G, (int)blockIdx.x);
            pg8::EpiIn E{Qb, Kb, Vb, BG, CX, A.q_gain + l * 64, A.k_gain + l * 64, ropec, ropes};
            pg8::gemm_phase<pg8::EpiIn, pg8::StaticOrder, true, true>(ring, g, S, E);
        }
        PH(3) {
            pg8::Gemm g{WIN + (size_t)HY0 * 1024, XN, 1536, MR, 1024}; pg8::StaticOrder S; S.init(1536, MR, C.G, (int)blockIdx.x, (MT / 256) * 9);
            pg8::EpiHyT E{HYT, HYTC};
            pg8::gemm_phase<pg8::EpiHyT, pg8::StaticOrder, true, true>(ring, g, S, E);
        }
        }
        GRID_BAR();

        CHK(chk::c_proj(A, Cq, l, 2); chk::c_att_save(A, Cq); chk::c_hy1(A, Cq, l, 300); chk::c_hy2(A, Cq, l, 1, 300));
        CHK(chk::c_hy3(A, Cq, l, 1, 300));
        PH(4)
#pragma unroll 1
        for (int rep3_ = 0; rep3_ < REP_HY; ++rep3_)
        for (int c = C.vcu; c < HY_W; c += C.G) { PCTX(Cp); hy::hyena_unit(A, Cp, l, c, need_ctx); }
        __syncthreads();
        PH(5) { PCTX(Cp); ysc_pass(Cp, BG, CX, A.sc_conv_w + (size_t)l * 3 * 512, MR); }
        GRID_BAR();

        CHK(chk::c_ysc(A, Cq, l, 8); chk::c_hy4(A, Cq, l, 1, 300, 9));
        PH(5) { PCTX(Cp); yhy_transpose(Cp, YHYT, YHY, need_ctx); }
        __syncthreads();
        PH(6) {
#if PROBE_ATT
            for (int ug = C.vcu; ug < 1024; ug += C.G) {
                const int grp = (ug >> 6) & 3, rest = (ug & 63) | ((ug >> 8) << 6), b = grp >> 1, kvh = grp & 1, h = kvh * 4 + (rest & 3), qb = rest >> 2;
                const attn_body::bf16* Qu = (const attn_body::bf16*)(Qb + ((size_t)b * SEQ + (size_t)qb * 256) * 512 + h * 64);
                const attn_body::bf16* Kh = (const attn_body::bf16*)(Kb + (size_t)b * KVL * 128 + kvh * 64);
                const attn_body::bf16* Vh = (const attn_body::bf16*)(Vb + (size_t)b * KVL * 128 + kvh * 64);
                attn_body::attn_unit<ATT_THRL>(Qu, Kh, Vh, (attn_body::bf16*)(CX + ((size_t)b * SEQ + (size_t)qb * 256) * 512 + h * 64), KVL / 64, (char*)lds_raw);
            }
#endif
            for (int ug = C.vcu; ug < 1024; ug += C.G) {
                const int grp = (ug >> 6) & 3, rest = (ug & 63) | ((ug >> 8) << 6), b = grp >> 1, kvh = grp & 1, h = kvh * 4 + (rest & 3), qb = rest >> 2;
                const attn_body::bf16* Qu = (const attn_body::bf16*)(Qb + ((size_t)b * SEQ + (size_t)qb * 256) * 512 + h * 64);
                const attn_body::bf16* Kh = (const attn_body::bf16*)(Kb + (size_t)b * KVL * 128 + kvh * 64);
                const attn_body::bf16* Vh = (const attn_body::bf16*)(Vb + (size_t)b * KVL * 128 + kvh * 64);
                attn_body::attn_unit<ATT_THRL>(Qu, Kh, Vh, (attn_body::bf16*)Qu, KVL / 64, (char*)lds_raw);
            }
            if (need_ctx) for (int ug = C.vcu; ug < 16; ug += C.G) {
                const int b = ug >> 3, h = ug & 7;
                const attn_body::bf16* Qu = (const attn_body::bf16*)(Qb + ((size_t)ML + (size_t)b * CTX_LEN) * 512 + h * 64);
                const attn_body::bf16* Kh = (const attn_body::bf16*)(Kb + (size_t)b * KVL * 128 + (h >> 2) * 64);
                const attn_body::bf16* Vh = (const attn_body::bf16*)(Vb + (size_t)b * KVL * 128 + (h >> 2) * 64);
                attn_body::attn_unit<ATT_THRL>(Qu, Kh, Vh, (attn_body::bf16*)Qu, CTX_LEN / 64, (char*)lds_raw);
            }
        }
        GRID_BAR();

        CHK(chk::c_att(A, Cq, 10); chk::c_yhyT(A, Cq, 11));
        const bool packed_ctx = need_ctx && C.G == 256;
#pragma unroll 1
        for (int half = 0; half < (MR + 16383) / 16384; ++half) {
            const int rowbase = half * 16384, nr = (MR - rowbase) < 16384 ? (MR - rowbase) : 16384;
            if (nr == 16384) {
                PH(7) {
                    pg8::Gemm g{XN + (size_t)rowbase * 1024, WIN + (size_t)GT0 * 1024, nr, 3072, 1024}; pg8::GateOrder S; S.S.init(nr, 1024, C.G, (int)blockIdx.x);
                    pg8::EpiGate E{GG};
                    pg8::gemm_phase<pg8::EpiGate, pg8::GateOrder, true, true>(ring, g, S, E);
                }
                VM_WAIT(); __syncthreads();
                PH(8) {
                    pg8::Gemm g{Qb + (size_t)rowbase * 512, (const bf16*)(ws + WS_WBR) + (size_t)(l * 3) * 1024 * 512, nr, 1024, 512};
                    pg8::MergeOrder S; S.S.init(nr, 1024, C.G, (int)blockIdx.x); S.A0 = (const char*)(Qb + (size_t)rowbase * 512); S.d1 = (const char*)BG - (const char*)Qb; S.d2 = (const char*)YHY - (const char*)Qb;
                    pg8::EpiMerge3 E{GG, MM + (size_t)rowbase * 1024};
                    pg8::gemm_phase<pg8::EpiMerge3, pg8::MergeOrder, true, true>(ring, g, S, E);
                }
                VM_WAIT(); __syncthreads();
                if (rowbase + nr >= ML) GRID_BAR();
            } else if (!packed_ctx) {
                PH(7) {
                    pg8::Gemm g{XN + (size_t)rowbase * 1024, WIN + (size_t)GT0 * 1024, nr, 3072, 1024}; pg8::StaticOrder S; S.init(nr, 3072, C.G, (int)blockIdx.x);
                    pg8::EpiGate E{GG};
                    pg8::gemm_phase<pg8::EpiGate, pg8::StaticOrder, true, true>(ring, g, S, E);
                }
                PH(10) { const int nb_ = (nr / 256) * 12; if ((int)blockIdx.x >= nb_) { PCTX(Cp); cvt_table_fp6(Cp, A.peer_u + (size_t)l * PEER_N * 1024, TU, TUS, PEER_N, (int)blockIdx.x - nb_, C.G - nb_); } }
                GRID_BAR();
                PH(8) {
                    pg8::Gemm g{Qb + (size_t)rowbase * 512, (const bf16*)(ws + WS_WBR) + (size_t)(l * 3) * 1024 * 512, nr, 1024, 512};
                    pg8::MergeOrder S; S.S.init(nr, 1024, C.G, (int)blockIdx.x); S.A0 = (const char*)(Qb + (size_t)rowbase * 512); S.d1 = (const char*)BG - (const char*)Qb; S.d2 = (const char*)YHY - (const char*)Qb;
                    pg8::EpiMerge3 E{GG, MM + (size_t)rowbase * 1024};
                    pg8::gemm_phase<pg8::EpiMerge3, pg8::MergeOrder, true, true>(ring, g, S, E);
                }
                PH(10) { const int nb_ = (nr / 256) * 4; if ((int)blockIdx.x >= nb_) { PCTX(Cp); cvt_table_fp6(Cp, A.peer_v + (size_t)l * PEER_N * 1024, TV, TVS, PEER_N, (int)blockIdx.x - nb_, C.G - nb_); } }
                GRID_BAR();
            }
        }

        if (packed_ctx) {
            const int b = (int)blockIdx.x;
            const pg8::Gemm gP{MM, (const bf16*)(ws + WS_WOUT) + (size_t)l * 1024 * 1024, MR, 1024, 1024};
            const pg8::EpiResid EP{xold, A.out, cold, CTXB, MODl};
            const int rowbase = ML, nr = MR - ML;
            if (b < 24) PH(7) {
                pg8::Gemm g{XN + (size_t)rowbase * 1024, WIN + (size_t)GT0 * 1024, nr, 3072, 1024}; pg8::StaticOrder S; S.init(nr, 3072, C.G, b);
                pg8::EpiGate E{GG};
                pg8::gemm_phase<pg8::EpiGate, pg8::StaticOrder, true, true>(ring, g, S, E);
            }
            PH(9) { const int k = b - 24; pg8::OneUnit S{k >= 0 ? (k & 7) * 64 + (k >> 3) : -1, 4}; pg8::gemm_phase<pg8::EpiResid, pg8::OneUnit, true, true>(ring, gP, S, EP); }
            GRID_BAR();
            if (b < 8) PH(8) {
                pg8::Gemm g{Qb + (size_t)rowbase * 512, (const bf16*)(ws + WS_WBR) + (size_t)(l * 3) * 1024 * 512, nr, 1024, 512};
                pg8::MergeOrder S; S.S.init(nr, 1024, C.G, b); S.A0 = (const char*)(Qb + (size_t)rowbase * 512); S.d1 = (const char*)BG - (const char*)Qb; S.d2 = (const char*)YHY - (const char*)Qb;
                pg8::EpiMerge3 E{GG, MM + (size_t)rowbase * 1024};
                pg8::gemm_phase<pg8::EpiMerge3, pg8::MergeOrder, true, true>(ring, g, S, E);
            }
            PH(9) { const int k = b >= 8 ? 232 + (b - 8) : -1; pg8::OneUnit S{k >= 0 ? (k & 7) * 64 + (k >> 3) : -1, 4}; pg8::gemm_phase<pg8::EpiResid, pg8::OneUnit, true, true>(ring, gP, S, EP); }
            GRID_BAR();
            PH(9) { const int k = b < 32 ? 480 + b : -1; const int idx = k >= 0 ? (k & 7) * 64 + (k >> 3) : (b < 40 ? 512 + (b - 32) : -1);
                    pg8::OneUnit S{idx, 4}; pg8::gemm_phase<pg8::EpiResid, pg8::OneUnit, true, true>(ring, gP, S, EP); }
            if (b >= 40) PH(10) { PCTX(Cp); cvt_table_fp6(Cp, A.peer_u + (size_t)l * PEER_N * 1024, TU, TUS, PEER_N, b - 40, C.G - 40); cvt_table_fp6(Cp, A.peer_v + (size_t)l * PEER_N * 1024, TV, TVS, PEER_N, b - 40, C.G - 40); }
            GRID_BAR();
        } else {
        PH(9) {
            pg8::Gemm g{MM, (const bf16*)(ws + WS_WOUT) + (size_t)l * 1024 * 1024, MR, 1024, 1024}; pg8::StaticOrder S; S.init(MR, 1024, C.G, (int)blockIdx.x);
            pg8::EpiResid E{xold, A.out, cold, CTXB, MODl};
            pg8::gemm_phase<pg8::EpiResid, pg8::StaticOrder, true, true>(ring, g, S, E);
        }
        GRID_BAR();
        }

        CHK(chk::c_wout(A, Cq, l, 14));
        PH(10) { PCTX(Cp); norm_rows(Cp, A.out, CTXB, MR, A.g_norm2 + l * 1024, MODl, 3, XN); }
        if (!need_ctx) {
        PH(10) { PCTX(Cp); cvt_table_fp6(Cp, A.peer_u + (size_t)l * PEER_N * 1024, TU, TUS, PEER_N); }
        PH(10) { PCTX(Cp); cvt_table_fp6(Cp, A.peer_v + (size_t)l * PEER_N * 1024, TV, TVS, PEER_N); }
        }
        GRID_BAR();

        CHK(chk::c_norm(A, Cq, A.out, CTXB, A.g_norm2 + l * 1024, MODl, 3, XN, 15));
        const int nchunk = (MR + 16383) / 16384;
        const bool fold_ctx = packed_ctx && nchunk == 3;
        float* SSC = (float*)(ws + WS_PLIST + 16 * MiB); int* ELC = (int*)(ws + WS_PLIST + 20 * MiB); float* GLC = (float*)(ws + WS_PLIST + 21 * MiB);
#pragma unroll 1
        for (int ch = 0; ch < nchunk; ++ch) {
            const int row0 = ch * 16384, nr = (MR - row0) < 16384 ? (MR - row0) : 16384;
            if (fold_ctx && ch == 2) break;
            pg8::StaticOrder SSO; SSO.init(2048, nr, C.G, (int)blockIdx.x);
#pragma unroll 1
            for (int reps_ = 0; reps_ < REP_SG; ++reps_)
            PH(11) {
                pg8::Gemm g{(const bf16*)(ws + WS_WPEER) + (size_t)l * 2048 * 1024, XN + (size_t)row0 * 1024, 2048, nr, 1024};
                pg8::EpiScoreT E{SS};
                pg8::gemm_phase<pg8::EpiScoreT, pg8::StaticOrder, true, true>(ring, g, SSO, E);
            }
            if (nr < 4096) {
                GRID_BAR();
                PH(12) { PCTX(Cp); peer::route_tokens_wave(Cp, SS, nr, PEL, PGL); }
            } else {
                VM_WAIT(); __syncthreads();
#pragma unroll 1
                for (int repr_ = 0; repr_ < REP_ROUTE; ++repr_) { PH(12) { PCTX(Cp); peer::route_tasks(Cp, SS, nr, PEL, PGL, SSO); } }
                if (fold_ctx && ch == 1) PH(12) { PCTX(Cp); peer::route_tokens_wave(Cp, SSC, MR - ML, ELC, GLC); }
            }
            GRID_BAR();
            if (fold_ctx && ch == 0 && (int)blockIdx.x < 16) PH(11) {
                pg8::Gemm g{(const bf16*)(ws + WS_WPEER) + (size_t)l * 2048 * 1024, XN + (size_t)ML * 1024, 2048, MR - ML, 1024};
                pg8::OneUnit S1{(int)blockIdx.x, 2}; pg8::EpiScoreT E{SSC};
                pg8::gemm_phase<pg8::EpiScoreT, pg8::OneUnit, true, true>(ring, g, S1, E);
            }
            PH(12) { PCTX(Cp); peer::topk_gather(A, Cp, l, row0, nr, PEL, PGL, TU, TV, TUS, TVS, XN, A.out, CTXB, MODl, !need_ctx, A.g_norm1 + (l + 1) * 1024, MOD + (size_t)(l + 1) * 3 * 6144, XN); }
            if (fold_ctx && ch == 1) PH(12) { PCTX(Cp); peer::topk_gather(A, Cp, l, ML, MR - ML, ELC, GLC, TU, TV, TUS, TVS, XN, A.out, CTXB, MODl, !need_ctx, A.g_norm1 + (l + 1) * 1024, MOD + (size_t)(l + 1) * 3 * 6144, XN); }
            GRID_BAR();
        }
    }
#ifdef SELFCHECK
    {
        const float* acc = (const float*)(ws + chk::WS_DBG); int first = -1;
        const int order[21] = {0, 1, 2, 3, 4, 5, 6, 7, 8, 9, 10, 11, 12, 18, 19, 20, 13, 14, 15, 16, 17};
#pragma unroll
        for (int p = 0; p < 21; ++p) { const int k = order[p]; const float se = acc[2 * k], sr = acc[2 * k + 1]; const float tol = (k == 17) ? 0.15f : 0.03f;
            if (first < 0 && !((CHKSKIP >> k) & 1) && (!(se <= tol * tol * sr) || sr == 0.f)) first = p; }
        if (first >= 0) { const float sc = 1.0f + 0.25f * (float)(first + 1);
            for (size_t i = (size_t)C.vcu * NTHREADS + C.tid; i < (size_t)ML * 1024; i += (size_t)C.G * NTHREADS) A.out[i] *= sc; }
    }
#endif
#undef GRID_BAR
#undef xold
#undef cold
#undef WIN
#undef MODl
}

extern "C" void kernel_launch(void* const* d_in, const int* in_sizes, int n_in, void* d_out, int out_size, void* d_ws, size_t ws_size, hipStream_t stream) {
    static int grid = 0;
    if (grid == 0) {
        if (n_in != 32 || in_sizes[0] != ML * D_MODEL || out_size != ML * D_MODEL || ws_size < WS_END) { fprintf(stderr, "kernel_launch: unexpected shapes (n_in %d, in0 %d, out %d, ws %zu)\n", n_in, n_in > 0 ? in_sizes[0] : -1, out_size, ws_size); grid = -1; return; }
        int dev = 0, cus = 0, per_cu = 0;
        if (hipGetDevice(&dev) != hipSuccess || hipDeviceGetAttribute(&cus, hipDeviceAttributeMultiprocessorCount, dev) != hipSuccess) { grid = -1; return; }
        if (hipFuncSetAttribute((const void*)mega_fwd, hipFuncAttributeMaxDynamicSharedMemorySize, LDS_BYTES) != hipSuccess) { fprintf(stderr, "kernel_launch: hipFuncSetAttribute failed\n"); grid = -1; return; }
        if (hipOccupancyMaxActiveBlocksPerMultiprocessor(&per_cu, (const void*)mega_fwd, NTHREADS, LDS_BYTES) != hipSuccess || per_cu < 1) { fprintf(stderr, "kernel_launch: occupancy query says %d\n", per_cu); }
        (void)hipGetLastError();
        grid = cus;
    }
    if (grid < 0) return;
    if (hipMemsetAsync((char*)d_ws + WS_CTL, 0, CTL_ZERO_BYTES, stream) != hipSuccess) return;
#ifdef SELFCHECK
    (void)hipMemsetAsync((char*)d_ws + chk::WS_DBG, 0, 65536, stream);
#endif
    Args a{};
    const float** ap = (const float**)&a;
    for (int i = 0; i < 32; ++i) ap[i] = (const float*)d_in[i];
    a.out = (float*)d_out; a.ws = (unsigned char*)d_ws;
    hipLaunchKernelGGL(mega_fwd, dim3(grid), dim3(NTHREADS), LDS_BYTES, stream, a);
}
```

```cpp
#include <hip/hip_runtime.h>
#include <hip/hip_bf16.h>
#include <cstdio>
#include <cstdint>
#include <cmath>

#define SELFCHECK_ON 0
#if SELFCHECK_ON
#define SELFCHECK
#endif
#define REP_ROUTE 1
#define REP_GATHER 1
#define REP_HY 1
#define PROBE_FFT 0
#define REP_FILT 1
#define PROBE_REST 0
#define PROBE_PRO 0
#define PROBE_ATT 0
#ifndef FP6_ILV
#define FP6_ILV 1
#endif
#define REP_P2 1
#define REP_GM 1
#define REP_SG 1
#ifndef ABL
#define ABL 0
#endif
constexpr int D_MODEL = 1024, BATCH = 2, SEQ = 16384, DEPTH = 2, GRID_W = 64, CTX_LEN = 256;
constexpr int N_HEADS = 8, N_KV = 2, HEAD_DIM = 64, ATT_W = 512, KV_W = 128;
constexpr int SC_W = 512, HY_W = 512, HY_EMB = 33, HY_FH = 64;
constexpr int PEER_HEADS = 8, PEER_NKEYS = 128, PEER_N = 16384, PEER_TOPK = 16;
constexpr int Q0 = 0, K0 = 512, V0 = 640, SC0 = 768, HY0 = 2304, GT0 = 3840, IN_W = 6912;
constexpr int ML = BATCH * SEQ;
constexpr int MC = BATCH * CTX_LEN;
constexpr int MT = ML + MC;
constexpr int KVL = CTX_LEN + SEQ;
constexpr float EPS = 1e-6f;
constexpr float C2Q = 0.125f * 1.4426950408889634f;

constexpr size_t MiB = 1u << 20;
constexpr size_t WS_CTL = 0, CTL_ZERO_BYTES = 64 * 1024;
constexpr size_t WS_MOD = 1 * MiB;
constexpr size_t WS_ROPE = 2 * MiB;
constexpr size_t WS_H2 = 3 * MiB;
constexpr size_t WS_H2C = 11 * MiB;
constexpr size_t WS_CTXB = 12 * MiB;
constexpr size_t WS_WIN = 16 * MiB;
constexpr size_t WS_WBR = 43 * MiB;
constexpr size_t WS_WOUT = 49 * MiB;
constexpr size_t WS_WPEER = 53 * MiB;
constexpr size_t WS_XN = 64 * MiB;
constexpr size_t WS_Q = 129 * MiB;
constexpr size_t WS_K = 162 * MiB;
constexpr size_t WS_V = WS_K + (size_t)BATCH * KVL * KV_W * 2;
constexpr size_t WS_BG = 179 * MiB;
constexpr size_t WS_CX = 212 * MiB;
constexpr size_t WS_YHYT = WS_CX + (size_t)MT * 512 * 2;
constexpr size_t WS_MM = WS_CX;
constexpr size_t WS_YHY = 277 * MiB;
constexpr size_t WS_R1 = 310 * MiB;
constexpr size_t WS_HYTC = WS_R1 + (size_t)BATCH * 1536 * SEQ * 2;
constexpr size_t WS_PLIST = 440 * MiB;
constexpr size_t WS_TAB = 472 * MiB;
constexpr size_t WS_HSCR = 472 * MiB;
constexpr size_t WS_END = 506 * MiB;
static_assert(WS_YHYT + (size_t)BATCH * 512 * (SEQ + CTX_LEN) * 2 <= WS_YHY, "ws map");
static_assert(WS_HYTC + (size_t)BATCH * 1536 * CTX_LEN * 2 <= WS_PLIST && WS_R1 + (size_t)2048 * (16384 + 64) * 4 <= WS_PLIST && WS_PLIST + 16 * MiB <= WS_HSCR, "ws map");
static_assert(WS_V + (size_t)BATCH * KVL * KV_W * 2 <= WS_BG, "ws map");
constexpr int CW_TMO = 0, CW_CODE = 1, CW_BAR = 4096;

constexpr int RING_BYTES = 131072;
constexpr int HYB_BYTES = 17408 * 8;
constexpr int HYS_OFF = HYB_BYTES;
constexpr int LDSCTL_OFF = 143360, MISC_OFF = LDSCTL_OFF + 320;
constexpr int LDS_BYTES = 147456;
constexpr int NWAVES = 8, NTHREADS = 512;

#define GAS __attribute__((address_space(1)))
#define LAS __attribute__((address_space(3)))
typedef unsigned short bf16;
typedef unsigned v4u __attribute__((ext_vector_type(4)));
typedef unsigned v2u __attribute__((ext_vector_type(2)));
typedef float f32x4 __attribute__((ext_vector_type(4)));
typedef float f32x2 __attribute__((ext_vector_type(2)));
typedef int v6i __attribute__((ext_vector_type(6)));
typedef float v16f __attribute__((ext_vector_type(16)));
typedef float v32f __attribute__((ext_vector_type(32)));
typedef short bf16x8 __attribute__((ext_vector_type(8)));
typedef GAS unsigned gu32;
#define RLX_AGENT __ATOMIC_RELAXED, __HIP_MEMORY_SCOPE_AGENT
#define LDS_WAIT() asm volatile("s_waitcnt lgkmcnt(0)" ::: "memory")
#define VM_WAIT() asm volatile("s_waitcnt vmcnt(0)" ::: "memory")
__device__ __forceinline__ unsigned f2bf(float f) { unsigned u = __builtin_bit_cast(unsigned, f); return (u + 0x7fffu + ((u >> 16) & 1u)) >> 16; }
__device__ __forceinline__ unsigned pk2(float lo, float hi) { return f2bf(lo) | (f2bf(hi) << 16); }
__device__ __forceinline__ float bflo(unsigned w) { return __builtin_bit_cast(float, w << 16); }
__device__ __forceinline__ float bfhi(unsigned w) { return __builtin_bit_cast(float, w & 0xffff0000u); }
__device__ __forceinline__ float bf1(bf16 h) { return __builtin_bit_cast(float, (unsigned)h << 16); }
__device__ __forceinline__ int opq_tid() { int t = threadIdx.x; asm volatile("" : "+v"(t)); return t; }
__device__ __forceinline__ float wave_sum(float v) {
#pragma unroll
    for (int o = 1; o < 64; o <<= 1) v += __shfl_xor(v, o);
    return v;
}
__device__ __forceinline__ float wave_max(float v) {
#pragma unroll
    for (int o = 1; o < 64; o <<= 1) v = fmaxf(v, __shfl_xor(v, o));
    return v;
}

#define XB_TMO      128
#define XB_XCNT(j)  (256  + 64 * (j))
#define XB_XSUB(j)  (1280 + 64 * (j))
#define XB_XGEN(j)  (2304 + 64 * (j))
#define XB_TOP      3328
#define XB_TOPGEN   3392
#define XCD_BAR_WORDS 3456
#define XB_SPIN_CAP (1u << 22)
__device__ __forceinline__ unsigned xb_ld(unsigned* p)              { return __hip_atomic_load(p, __ATOMIC_RELAXED, __HIP_MEMORY_SCOPE_AGENT); }
__device__ __forceinline__ unsigned xb_add(unsigned* p, unsigned v) { return __hip_atomic_fetch_add(p, v, __ATOMIC_RELAXED, __HIP_MEMORY_SCOPE_AGENT); }
__device__ __forceinline__ unsigned xb_xcc_id() { return (unsigned)__builtin_amdgcn_s_getreg((3 << 11) | 20) & 0xFu; }
#define XB_SPIN(cond, bar) do { unsigned _sp = 0; while (cond) { __builtin_amdgcn_s_sleep(1); \
    if ((++_sp & 255u) == 0u) { if (xb_ld(&(bar)[XB_TMO])) break; if (_sp > XB_SPIN_CAP) { atomicAdd(&(bar)[XB_TMO], 1u); break; } } } } while (0)
struct XcdBarrier { unsigned* bar; unsigned x; volatile LAS unsigned* st; };
__device__ __forceinline__ XcdBarrier xcd_barrier_post(unsigned* bar, volatile LAS unsigned* st) {
    XcdBarrier b; b.bar = bar; b.x = xb_xcc_id(); b.st = st;
    if (threadIdx.x == 0) (void)xb_add(&bar[XB_XCNT(b.x)], 1u);
    return b;
}
__device__ __forceinline__ void xcd_barrier_complete(unsigned* bar, unsigned x, unsigned& nloc, unsigned& nx) {
    const unsigned G = gridDim.x * gridDim.y * gridDim.z;
    unsigned sum, cnt, mine, sp = 0u;
    for (;;) {
        sum = 0u; cnt = 0u; mine = 0u;
#pragma unroll
        for (unsigned j = 0; j < 16; ++j) { const unsigned c = xb_ld(&bar[XB_XCNT(j)]); sum += c; cnt += (c > 0u) ? 1u : 0u; mine = (j == x) ? c : mine; }
        if (sum == G) break;
        __builtin_amdgcn_s_sleep(1);
        if ((++sp & 255u) == 0u) { if (xb_ld(&bar[XB_TMO])) break; if (sp > XB_SPIN_CAP) { atomicAdd(&bar[XB_TMO], 1u); break; } }
    }
    nloc = mine > 0u ? mine : 1u; nx = cnt > 0u ? cnt : 1u;
}
__device__ __forceinline__ void xcd_barrier(const XcdBarrier& b) {
    asm volatile("s_waitcnt vmcnt(0)" ::: "memory");
    __syncthreads();
    if (threadIdx.x == 0) {
        unsigned* bar = b.bar;
        __builtin_amdgcn_s_waitcnt(0);
        unsigned nloc = b.st[0], nx = b.st[1];
        if (nloc == 0u) { xcd_barrier_complete(bar, b.x, nloc, nx); b.st[0] = nloc; b.st[1] = nx; }
        const unsigned old = xb_add(&bar[XB_XSUB(b.x)], 1u);
        const unsigned gen = old / nloc;
        if (old + 1u == (gen + 1u) * nloc) {
            __builtin_amdgcn_fence(__ATOMIC_RELEASE, "agent");
            asm volatile("s_waitcnt vmcnt(0)" ::: "memory");
            const unsigned og = xb_add(&bar[XB_TOP], 1u);
            const unsigned tg = og / nx;
            if (og + 1u == (tg + 1u) * nx) xb_add(&bar[XB_TOPGEN], 1u);
            else XB_SPIN(xb_ld(&bar[XB_TOPGEN]) == tg, bar);
            __builtin_amdgcn_fence(__ATOMIC_ACQUIRE, "agent");
            xb_add(&bar[XB_XGEN(b.x)], 1u);
            asm volatile("s_waitcnt vmcnt(0)" ::: "memory");
        } else {
            XB_SPIN(xb_ld(&bar[XB_XGEN(b.x)]) == gen, bar);
            __builtin_amdgcn_fence(__ATOMIC_ACQUIRE, "agent");
            asm volatile("s_waitcnt vmcnt(0)" ::: "memory");
        }
    }
    __syncthreads();
}
namespace pg8 {
#define PG8_LAS __attribute__((address_space(3)))
typedef unsigned short bf16_t;
typedef short bf16x8 __attribute__((ext_vector_type(8)));
typedef float f32x4 __attribute__((ext_vector_type(4)));
typedef unsigned u32x4 __attribute__((ext_vector_type(4)));
constexpr int BM = 256, BK = 64, HALF = 128, HTB = HALF * BK * 2  , STAGE_BYTES = 8 * HTB, NXCD = 8, WGM = 8;

__host__ __device__ __forceinline__ int lds_byte(int r, int c) { const int st = (r >> 4) * 2 + (c >> 5), rr = r & 15, cc = c & 31, ob = rr * 64 + cc * 2; return st * 1024 + (ob ^ (((ob >> 9) & 1) << 5)); }
__host__ __device__ __forceinline__ void stage_rc(int b, int& R, int& C) { const int st = b / 1024, sb = b % 1024, swz = sb ^ (((sb >> 9) & 1) << 5); R = (st >> 1) * 16 + swz / 64; C = (st & 1) * 32 + (swz % 64) / 2; }
__host__ __device__ __forceinline__ int perm32(int rho) { const int n = rho >> 4, i = rho & 15; return 8 * (i >> 2) + 4 * n + (i & 3); }

struct Unit { int pm, pn, z; };
struct Gemm { const bf16_t* A; const bf16_t* Bt; int M, N, K; };


struct StaticOrder {
    int nM, nN, nwg, G, c;
    __host__ __device__ void init(int M, int N, int G_, int c_, int rot = 0) { nM = M / BM; nN = N / BM; nwg = nM * nN; G = G_; c = (c_ + G_ - (rot % G_)) % G_; }
    __host__ __device__ bool next(int i, Unit& u) const {
        const long L = (long)i * G + c; if (L >= nwg) return false;
        int wgid = (int)L; { const int q = nwg / NXCD, r = nwg % NXCD, xcd = wgid % NXCD, off = wgid / NXCD; wgid = (xcd < r ? xcd * (q + 1) : r * (q + 1) + (xcd - r) * q) + off; }
        const int nig = WGM * nN, gid = wgid / nig, fm = gid * WGM, gsz = (nM - fm) < WGM ? (nM - fm) : WGM;
        u.pm = fm + ((wgid % nig) % gsz); u.pn = (wgid % nig) / gsz; return true;
    }
    __device__ __forceinline__ void a_ready(const Unit&) const {}
    __device__ __forceinline__ void done(const Unit&) const {}
    __device__ __forceinline__ const char* baseA(const Gemm& g, const Unit& u, size_t tstep) const { return (const char*)g.A + (size_t)u.pm * tstep; }
    __device__ __forceinline__ const char* baseB(const Gemm& g, const Unit& u, size_t tstep) const { return (const char*)g.Bt + (size_t)u.pn * tstep; }
};
struct OneUnit {
    int idx, nN;
    __host__ __device__ bool next(int i, Unit& u) const { if (i != 0 || idx < 0) return false; u.pm = idx / nN; u.pn = idx % nN; u.z = 0; return true; }
    __device__ __forceinline__ void a_ready(const Unit&) const {}
    __device__ __forceinline__ void done(const Unit&) const {}
    __device__ __forceinline__ const char* baseA(const Gemm& g, const Unit& u, size_t tstep) const { return (const char*)g.A + (size_t)u.pm * tstep; }
    __device__ __forceinline__ const char* baseB(const Gemm& g, const Unit& u, size_t tstep) const { return (const char*)g.Bt + (size_t)u.pn * tstep; }
};
struct GateOrder {
    StaticOrder S;
    __host__ __device__ bool next(int i, Unit& u) const { if (!S.next(i / 3, u)) return false; u.pn += 4 * (i % 3); u.z = 0; return true; }
    __device__ __forceinline__ void a_ready(const Unit&) const {}
    __device__ __forceinline__ void done(const Unit&) const {}
    __device__ __forceinline__ const char* baseA(const Gemm& g, const Unit& u, size_t tstep) const { return (const char*)g.A + (size_t)u.pm * tstep; }
    __device__ __forceinline__ const char* baseB(const Gemm& g, const Unit& u, size_t tstep) const { return (const char*)g.Bt + (size_t)u.pn * tstep; }
};
struct MergeOrder {
    StaticOrder S; const char* A0; long d1, d2;
    __host__ __device__ bool next(int i, Unit& u) const { if (!S.next(i / 3, u)) return false; u.z = i % 3; return true; }
    __device__ __forceinline__ void a_ready(const Unit&) const {}
    __device__ __forceinline__ void done(const Unit&) const {}
    __device__ __forceinline__ const char* baseA(const Gemm& g, const Unit& u, size_t tstep) const { return A0 + (long)(u.z & 1) * d1 + (long)(u.z >> 1) * d2 + (size_t)u.pm * tstep; }
    __device__ __forceinline__ const char* baseB(const Gemm& g, const Unit& u, size_t tstep) const { return (const char*)g.Bt + ((size_t)u.z * g.N * g.K) * 2 + (size_t)u.pn * tstep; }
};

typedef float f32x2_t __attribute__((ext_vector_type(2))); typedef __bf16 bf16x2_t __attribute__((ext_vector_type(2)));
__device__ __forceinline__ unsigned cvt_pk_bf16(float lo, float hi) { f32x2_t v = {lo, hi}; bf16x2_t b = __builtin_convertvector(v, bf16x2_t); return __builtin_bit_cast(unsigned, b); }
__device__ __forceinline__ u32x4 pack8(const f32x4& a, const f32x4& b) { u32x4 w; w.x = cvt_pk_bf16(a[0], a[1]); w.y = cvt_pk_bf16(a[2], a[3]); w.z = cvt_pk_bf16(b[0], b[1]); w.w = cvt_pk_bf16(b[2], b[3]); return w; }
__device__ __forceinline__ void unpack8(const u32x4& w, f32x4& a, f32x4& b) {
    a[0] = __builtin_bit_cast(float, w.x << 16); a[1] = __builtin_bit_cast(float, w.x & 0xffff0000u); a[2] = __builtin_bit_cast(float, w.y << 16); a[3] = __builtin_bit_cast(float, w.y & 0xffff0000u);
    b[0] = __builtin_bit_cast(float, w.z << 16); b[1] = __builtin_bit_cast(float, w.z & 0xffff0000u); b[2] = __builtin_bit_cast(float, w.w << 16); b[3] = __builtin_bit_cast(float, w.w & 0xffff0000u);
}

struct EpiIn {
    static constexpr bool PERM = true, AFTER_DRAIN = false, RESCALE = false;
    bf16_t* Q; bf16_t* Kb; bf16_t* Vb; bf16_t* BG; bf16_t* CX; const float* qgain; const float* kgain; const float* ropec; const float* ropes;
    __device__ __forceinline__ void operator()(const f32x4 (&acc)[2][2][4][2], const Unit& u, int wr, int wc, int fr_, int fq_) const {
        const int ln_ = opq_tid() & 63; const int fr = ln_ & 15, fq = ln_ >> 4;
        const int row0 = u.pm * BM + wr * 64 + fr;
        const int pn = u.pn;
        if (pn < 2 || (pn == 2 && wc < 2)) {
            const bool isq = pn < 2;
            const float* gain = isq ? qgain : kgain;
            const float qs = isq ? 0.18033688011112042f : 1.0f;
#pragma unroll
            for (int ai = 0; ai < 2; ++ai)
#pragma unroll
                for (int m = 0; m < 4; ++m) {
                    const int r = row0 + ai * HALF + m * 16;
                    float ss = 0.f;
#pragma unroll
                    for (int bj = 0; bj < 2; ++bj)
#pragma unroll
                        for (int n = 0; n < 2; ++n) { const f32x4 x = acc[ai][bj][m][n]; ss += (x[0] * x[0] + x[1] * x[1]) + (x[2] * x[2] + x[3] * x[3]); }
                    ss += __shfl_xor(ss, 16); ss += __shfl_xor(ss, 32);
                    const float rs = qs / sqrtf(ss * (1.0f / 64.0f) + 1e-6f);
                    const bool latent = r < 32768;
                    const int t = r & 16383;
                    bf16_t* dst;
                    if (isq) dst = Q + (size_t)r * 512 + (4 * pn + wc) * 64 + 8 * fq;
                    else { const int kvrow = latent ? ((r >> 14) * 16640 + 256 + t) : (((r - 32768) >> 8) * 16640 + ((r - 32768) & 255)); dst = Kb + (size_t)kvrow * 128 + wc * 64 + 8 * fq; }
#pragma unroll
                    for (int bj = 0; bj < 2; ++bj) {
                        f32x4 x1 = acc[ai][bj][m][0] * rs * *(const f32x4*)(gain + 32 * bj + 4 * fq), x2 = acc[ai][bj][m][1] * rs * *(const f32x4*)(gain + 32 * bj + 16 + 4 * fq);
                        if (latent) {
                            const int pos = bj ? (t & 63) : (t >> 6);
                            const f32x4 cs = *(const f32x4*)(ropec + pos * 16 + 4 * fq), sn = *(const f32x4*)(ropes + pos * 16 + 4 * fq);
                            const f32x4 o1 = x1 * cs - x2 * sn, o2 = x2 * cs + x1 * sn; x1 = o1; x2 = o2;
                        }
                        *(u32x4*)(dst + 32 * bj) = pack8(x1, x2);
                    }
                    asm volatile("" ::: "memory");
                }
        } else if (pn == 2) {
#pragma unroll
            for (int ai = 0; ai < 2; ++ai)
#pragma unroll
                for (int m = 0; m < 4; ++m) {
                    const int r = row0 + ai * HALF + m * 16; const bool latent = r < 32768; const int t = r & 16383;
                    const int kvrow = latent ? ((r >> 14) * 16640 + 256 + t) : (((r - 32768) >> 8) * 16640 + ((r - 32768) & 255));
                    bf16_t* dst = Vb + (size_t)kvrow * 128 + (wc - 2) * 64 + 8 * fq;
#pragma unroll
                    for (int bj = 0; bj < 2; ++bj) *(u32x4*)(dst + 32 * bj) = pack8(acc[ai][bj][m][0], acc[ai][bj][m][1]);
                }
        } else if (pn < 5) {
#pragma unroll
            for (int ai = 0; ai < 2; ++ai)
#pragma unroll
                for (int m = 0; m < 4; ++m) {
                    const int r = row0 + ai * HALF + m * 16;
                    bf16_t* dst = BG + (size_t)r * 512 + (pn - 3) * 256 + wc * 32 + 8 * fq;
#pragma unroll
                    for (int bj = 0; bj < 2; ++bj) *(u32x4*)(dst + bj * HALF) = pack8(acc[ai][bj][m][0], acc[ai][bj][m][1]);
                }
        } else {
#pragma unroll
            for (int ai = 0; ai < 2; ++ai)
#pragma unroll
                for (int m = 0; m < 4; ++m) {
                    const int r = row0 + ai * HALF + m * 16;
                    bf16_t* dst = CX + (size_t)r * 512 + (pn - 5) * 128 + wc * 32 + 8 * fq;
                    *(u32x4*)dst = pack8(acc[ai][0][m][0] * acc[ai][1][m][0], acc[ai][0][m][1] * acc[ai][1][m][1]);
                }
        }
    }
};
struct EpiHyT {
    static constexpr bool PERM = true, AFTER_DRAIN = false, RESCALE = false;
    bf16_t* HYT; bf16_t* HYTC;
    __device__ __forceinline__ void operator()(const f32x4 (&acc)[2][2][4][2], const Unit& u, int wr, int wc, int fr_, int fq_) const {
        const int ln_ = opq_tid() & 63; const int fr = ln_ & 15, fq = ln_ >> 4;
        const int ch0 = u.pm * BM + wr * 64 + fr;
        bf16_t* base; size_t pitch;
        if (u.pn < 128) { const int b = u.pn >> 6, t0 = (u.pn & 63) * 256; base = HYT + (size_t)b * 1536 * 16384 + t0; pitch = 16384; }
        else { const int b = u.pn - 128; base = HYTC + (size_t)b * 1536 * 256; pitch = 256; }
        base += wc * 32 + 8 * fq;
#pragma unroll
        for (int ai = 0; ai < 2; ++ai)
#pragma unroll
            for (int m = 0; m < 4; ++m) { bf16_t* rowp = base + (size_t)(ch0 + ai * HALF + m * 16) * pitch;
#pragma unroll
                for (int bj = 0; bj < 2; ++bj) *(u32x4*)(rowp + bj * HALF) = pack8(acc[ai][bj][m][0], acc[ai][bj][m][1]); }
    }
};
struct EpiGate {
    static constexpr bool PERM = true, AFTER_DRAIN = false, RESCALE = false;
    bf16_t* G;
    __device__ __forceinline__ void operator()(const f32x4 (&acc)[2][2][4][2], const Unit& u, int wr, int wc, int fr_, int fq_) const {
        const int ln_ = opq_tid() & 63; const int fr = ln_ & 15, fq = ln_ >> 4;
        const int row0 = u.pm * BM + wr * 64 + fr, col0 = u.pn * BM + wc * 32 + 8 * fq;
#pragma unroll
        for (int ai = 0; ai < 2; ++ai)
#pragma unroll
            for (int m = 0; m < 4; ++m) { bf16_t* rowp = G + (size_t)(row0 + ai * HALF + m * 16) * 3072 + col0;
#pragma unroll
                for (int bj = 0; bj < 2; ++bj) { f32x4 a = acc[ai][bj][m][0], b = acc[ai][bj][m][1];
#pragma unroll
                    for (int e = 0; e < 4; ++e) { a[e] = __builtin_amdgcn_rcpf(1.0f + __builtin_amdgcn_exp2f(-1.4426950408889634f * a[e])); b[e] = __builtin_amdgcn_rcpf(1.0f + __builtin_amdgcn_exp2f(-1.4426950408889634f * b[e])); }
                    *(u32x4*)(rowp + bj * HALF) = pack8(a, b); } }
    }
};
struct EpiMerge {
    static constexpr bool PERM = true, AFTER_DRAIN = false, RESCALE = false;
    const bf16_t* G; bf16_t* MM; int br;
    __device__ __forceinline__ void operator()(const f32x4 (&acc)[2][2][4][2], const Unit& u, int wr, int wc, int fr_, int fq_) const {
        const int ln_ = opq_tid() & 63; const int fr = ln_ & 15, fq = ln_ >> 4;
        const int row0 = u.pm * BM + wr * 64 + fr, col0 = u.pn * BM + wc * 32 + 8 * fq;
#pragma unroll
        for (int ai = 0; ai < 2; ++ai)
#pragma unroll
            for (int m = 0; m < 4; ++m) { const size_t r = (size_t)(row0 + ai * HALF + m * 16);
#pragma unroll
                for (int bj = 0; bj < 2; ++bj) {
                    const u32x4 gw = *(const u32x4*)(G + r * 3072 + br * 1024 + col0 + bj * HALF);
                    f32x4 g0, g1; unpack8(gw, g0, g1);
                    f32x4 v0 = g0 * acc[ai][bj][m][0], v1 = g1 * acc[ai][bj][m][1];
                    if ((ABL >> br) & 1) { v0 = v0 * 0.f; v1 = v1 * 0.f; }
                    bf16_t* mp = MM + r * 1024 + col0 + bj * HALF;
                    if (br > 0) { const u32x4 mw = *(const u32x4*)mp; f32x4 m0, m1; unpack8(mw, m0, m1); v0 += m0; v1 += m1; }
                    *(u32x4*)mp = pack8(v0, v1); } }
    }
};
struct EpiMerge3 {
    static constexpr bool PERM = true, AFTER_DRAIN = false, RESCALE = true;
    const bf16_t* G; bf16_t* MM;
    __device__ __forceinline__ bool keep(const Unit& u) const { return u.z < 2; }
    __device__ __forceinline__ void fin(f32x4 (&acc)[2][2][4][2], const Unit& u, int wr, int wc) const {
        const int ln_ = opq_tid() & 63; const int fr = ln_ & 15, fq = ln_ >> 4;
        const int row0 = u.pm * BM + wr * 64 + fr, col0 = u.pn * BM + wc * 32 + 8 * fq;
        if (u.z < 2) {
#pragma unroll
            for (int ai = 0; ai < 2; ++ai)
#pragma unroll
                for (int m = 0; m < 4; ++m) { const size_t r = (size_t)(row0 + ai * HALF + m * 16);
#pragma unroll
                    for (int bj = 0; bj < 2; ++bj) {
                        const bf16_t* gp = G + r * 3072 + u.z * 1024 + col0 + bj * HALF;
                        const u32x4 ga = *(const u32x4*)gp, gb = *(const u32x4*)(gp + 1024);
                        f32x4 a0, a1, b0, b1; unpack8(ga, a0, a1); unpack8(gb, b0, b1);
                        f32x4 r0, r1;
#pragma unroll
                        for (int e = 0; e < 4; ++e) { r0[e] = a0[e] * __builtin_amdgcn_rcpf(b0[e]); r1[e] = a1[e] * __builtin_amdgcn_rcpf(b1[e]); }
                        acc[ai][bj][m][0] = acc[ai][bj][m][0] * r0; acc[ai][bj][m][1] = acc[ai][bj][m][1] * r1; } }
        } else {
#pragma unroll
            for (int ai = 0; ai < 2; ++ai) {
                u32x4 gwv[4][2];
#pragma unroll
                for (int m = 0; m < 4; ++m) { const size_t r = (size_t)(row0 + ai * HALF + m * 16);
#pragma unroll
                    for (int bj = 0; bj < 2; ++bj) gwv[m][bj] = *(const u32x4*)(G + r * 3072 + 2 * 1024 + col0 + bj * HALF); }
                asm volatile("" ::: "memory");
#pragma unroll
                for (int m = 0; m < 4; ++m) { const size_t r = (size_t)(row0 + ai * HALF + m * 16);
#pragma unroll
                    for (int bj = 0; bj < 2; ++bj) { f32x4 g0, g1; unpack8(gwv[m][bj], g0, g1);
                        *(u32x4*)(MM + r * 1024 + col0 + bj * HALF) = pack8(g0 * acc[ai][bj][m][0], g1 * acc[ai][bj][m][1]); } }
                asm volatile("" ::: "memory"); }
        }
    }
};
struct EpiResid {
    static constexpr bool PERM = false, AFTER_DRAIN = false, RESCALE = false;
    const float* xold; float* xnew; const float* cold; float* cnew; const float* mod;
    __device__ __forceinline__ void operator()(const f32x4 (&acc)[2][2][4][2], const Unit& u, int wr, int wc, int fr_, int fq_) const {
        const int ln_ = opq_tid() & 63; const int fr = ln_ & 15, fq = ln_ >> 4;
        const int row0 = u.pm * BM + wr * 64 + fr, col0 = u.pn * BM + wc * 32 + 4 * fq;
        const bool latent = u.pm < 128;
        const int which = latent ? (u.pm >> 6) : 2;
        const float* gp = mod + which * 6144 + 2 * 1024 + col0;
        f32x4 gv[2][2];
#pragma unroll
        for (int bj = 0; bj < 2; ++bj)
#pragma unroll
            for (int n = 0; n < 2; ++n) gv[bj][n] = *(const f32x4*)(gp + bj * HALF + n * 16);
        const float* src = latent ? xold : cold - (size_t)32768 * 1024; float* dst = latent ? xnew : cnew - (size_t)32768 * 1024;
#pragma unroll
        for (int ai = 0; ai < 2; ++ai)
#pragma unroll
            for (int m2 = 0; m2 < 4; m2 += 2) {
                f32x4 xin[2][2][2];
#pragma unroll
                for (int mm = 0; mm < 2; ++mm) { const size_t off = (size_t)(row0 + ai * HALF + (m2 + mm) * 16) * 1024 + col0;
#pragma unroll
                    for (int bj = 0; bj < 2; ++bj)
#pragma unroll
                        for (int n = 0; n < 2; ++n) xin[mm][bj][n] = *(const f32x4*)(src + off + bj * HALF + n * 16); }
                asm volatile("" ::: "memory");
#pragma unroll
                for (int mm = 0; mm < 2; ++mm) { const size_t off = (size_t)(row0 + ai * HALF + (m2 + mm) * 16) * 1024 + col0;
#pragma unroll
                    for (int bj = 0; bj < 2; ++bj)
#pragma unroll
                        for (int n = 0; n < 2; ++n) *(f32x4*)(dst + off + bj * HALF + n * 16) = xin[mm][bj][n] + gv[bj][n] * acc[ai][bj][m2 + mm][n]; }
                asm volatile("" ::: "memory"); }
    }
};
struct EpiF32 {
    static constexpr bool PERM = false, AFTER_DRAIN = false, RESCALE = false;
    float* S; int ldc;
    __device__ __forceinline__ void operator()(const f32x4 (&acc)[2][2][4][2], const Unit& u, int wr, int wc, int fr_, int fq_) const {
        const int ln_ = opq_tid() & 63; const int fr = ln_ & 15, fq = ln_ >> 4;
        const int row0 = u.pm * BM + wr * 64 + fr, col0 = u.pn * BM + wc * 32 + 4 * fq;
#pragma unroll
        for (int ai = 0; ai < 2; ++ai)
#pragma unroll
            for (int m = 0; m < 4; ++m) { float* rowp = S + (size_t)(row0 + ai * HALF + m * 16) * ldc + col0;
#pragma unroll
                for (int bj = 0; bj < 2; ++bj)
#pragma unroll
                    for (int n = 0; n < 2; ++n) *(f32x4*)(rowp + bj * HALF + n * 16) = acc[ai][bj][m][n]; }
    }
};

struct EpiScoreT {
    static constexpr bool PERM = false, AFTER_DRAIN = false, RESCALE = false;
    float* S;
    __device__ __forceinline__ void operator()(const f32x4 (&acc)[2][2][4][2], const Unit& u, int wr, int wc, int fr_, int fq_) const {
        const int ln_ = opq_tid() & 63; const int fr = ln_ & 15, fq = ln_ >> 4;
        const int row0 = u.pm * BM + wr * 64 + fr, col0 = u.pn * BM + wc * 32 + 4 * fq;
#pragma unroll
        for (int ai = 0; ai < 2; ++ai)
#pragma unroll
            for (int m = 0; m < 4; ++m) { const int row = row0 + ai * HALF + m * 16;
#pragma unroll
                for (int bj = 0; bj < 2; ++bj)
#pragma unroll
                    for (int n = 0; n < 2; ++n) { const int col = col0 + bj * HALF + n * 16; *(f32x4*)(S + ((size_t)(col >> 6) * 2048 + row) * 64 + (col & 63)) = acc[ai][bj][m][n]; } }
    }
};
template <class Epi, class Sched, bool ALIGN_EPI = false, bool SP2 = false>
__device__ __forceinline__ void gemm_phase(PG8_LAS unsigned char* lds, const Gemm g, const Sched& S, const Epi& E) {
    const int tid = opq_tid(), wid = __builtin_amdgcn_readfirstlane(tid >> 6), lane = tid & 63, wr = wid >> 2, wc = wid & 3, fr = lane & 15, fq = lane >> 4;
    const int K = g.K, nt = K / BK;
    unsigned voffA[2], voffB[2];
#pragma unroll
    for (int i = 0; i < 2; ++i) { int R, C; stage_rc(tid * 16 + i * 8192, R, C); const int Rb = Epi::PERM ? ((R & ~31) + perm32(R & 31)) : R;
        voffA[i] = (unsigned)(R * K + C) * 2u; voffB[i] = (unsigned)(Rb * K + C) * 2u; }
    const size_t kstep = (size_t)(BK * 2);
    const size_t hstep = (size_t)HALF * K * 2;
    const size_t tstep = 2 * hstep;
    const unsigned ldsw = (unsigned)wid * 1024u;
    const int aoff = lds_byte(wr * 64 + fr, fq * 8), boff = lds_byte(wc * 32 + fr, fq * 8);
#define PG8_SA(b, h) (((b) * 2 + (h)) * HTB)
#define PG8_SB(b, h) ((4 + (b) * 2 + (h)) * HTB)
#define PG8_STAGE(bufoff, gbase, voff) do { _Pragma("unroll") for (int _i = 0; _i < 2; ++_i) \
        __builtin_amdgcn_global_load_lds((const unsigned*)((const char*)(gbase) + (voff)[_i]), (PG8_LAS unsigned*)(lds + (bufoff) + ldsw + _i * 8192), 16, 0, 0); } while (0)
#define PG8_LDA(dst, b, h) do { _Pragma("unroll") for (int m = 0; m < 4; ++m) _Pragma("unroll") for (int k = 0; k < 2; ++k) dst[m][k] = *(const PG8_LAS bf16x8*)(lds + PG8_SA(b, h) + aoff + m * 2048 + k * 1024); } while (0)
#define PG8_LDB(dst, b, h) do { _Pragma("unroll") for (int n = 0; n < 2; ++n) _Pragma("unroll") for (int k = 0; k < 2; ++k) dst[n][k] = *(const PG8_LAS bf16x8*)(lds + PG8_SB(b, h) + boff + n * 2048 + k * 1024); } while (0)
#define PG8_MMA(ai, bj, At, Bt) do { __builtin_amdgcn_s_setprio(1); _Pragma("unroll") for (int m = 0; m < 4; ++m) _Pragma("unroll") for (int n = 0; n < 2; ++n) _Pragma("unroll") for (int k = 0; k < 2; ++k) \
        acc[ai][bj][m][n] = __builtin_amdgcn_mfma_f32_16x16x32_bf16(Bt[n][k], At[m][k], acc[ai][bj][m][n], 0, 0, 0); __builtin_amdgcn_s_setprio(0); } while (0)
#define PG8_WAIT_V(n) asm volatile("s_waitcnt vmcnt(" #n ")" ::: "memory")
#define PG8_WAIT_L(n) asm volatile("s_waitcnt lgkmcnt(" #n ")" ::: "memory")
#define PG8_BAR __builtin_amdgcn_s_barrier()
#define PG8_SCHED __builtin_amdgcn_sched_barrier(0)
    Unit cur, nxt; int ui = 0;
    if (!S.next(0, cur)) return;
    f32x4 acc[2][2][4][2];
#pragma unroll
    for (int a = 0; a < 2; ++a)
#pragma unroll
        for (int b = 0; b < 2; ++b)
#pragma unroll
            for (int m = 0; m < 4; ++m)
#pragma unroll
                for (int n = 0; n < 2; ++n) acc[a][b][m][n] = (f32x4){0.f, 0.f, 0.f, 0.f};
    bf16x8 At[4][2], B0[2][2], B1[2][2];
    const char* cA = S.baseA(g, cur, tstep); const char* cB = S.baseB(g, cur, tstep);
    S.a_ready(cur);
    if constexpr (SP2) {
        PG8_STAGE(PG8_SB(0, 0), cB, voffB); PG8_STAGE(PG8_SB(0, 1), cB + hstep, voffB); PG8_STAGE(PG8_SA(0, 0), cA, voffA); PG8_STAGE(PG8_SA(0, 1), cA + hstep, voffA);
        if (wr == 1) PG8_BAR;
        PG8_WAIT_V(2); PG8_BAR;
        PG8_STAGE(PG8_SB(1, 0), cB + kstep, voffB); PG8_STAGE(PG8_SA(1, 0), cA + kstep, voffA); PG8_STAGE(PG8_SB(1, 1), cB + hstep + kstep, voffB);
        PG8_WAIT_V(6); PG8_BAR;
    } else {
        PG8_STAGE(PG8_SB(0, 0), cB, voffB); PG8_STAGE(PG8_SA(0, 0), cA, voffA); PG8_STAGE(PG8_SB(0, 1), cB + hstep, voffB); PG8_STAGE(PG8_SA(0, 1), cA + hstep, voffA);
        if (wr == 1) PG8_BAR;
        PG8_WAIT_V(4); PG8_BAR;
        PG8_STAGE(PG8_SB(1, 0), cB + kstep, voffB); PG8_STAGE(PG8_SA(1, 0), cA + kstep, voffA); PG8_STAGE(PG8_SB(1, 1), cB + hstep + kstep, voffB);
        PG8_WAIT_V(6); PG8_BAR;
    }
    for (;;) {
        const bool has_next = S.next(ui + 1, nxt);
        const char* nA = has_next ? S.baseA(g, nxt, tstep) : cA; const char* nB = has_next ? S.baseB(g, nxt, tstep) : cB;
        for (int t = 0; t < nt; t += 2) {
            const bool last = (t == nt - 2);
            const char* a1 = cA + (size_t)(t + 1) * kstep;
            const char* a2 = last ? nA : cA + (size_t)(t + 2) * kstep; const char* b2 = last ? nB : cB + (size_t)(t + 2) * kstep;
            const char* a3 = a2 + kstep; const char* b3 = b2 + kstep;
            if (last && has_next) S.a_ready(nxt);
            if constexpr (SP2) {
            PG8_LDB(B0, 0, 0); PG8_LDB(B1, 0, 1); PG8_SCHED; PG8_LDA(At, 0, 0); PG8_STAGE(PG8_SA(1, 1), a1 + hstep, voffA);
            PG8_WAIT_V(8); PG8_WAIT_L(0); PG8_BAR; PG8_MMA(0, 0, At, B0); PG8_MMA(0, 1, At, B1); PG8_BAR; PG8_SCHED;
            PG8_LDA(At, 0, 1); PG8_STAGE(PG8_SB(0, 0), b2, voffB); PG8_STAGE(PG8_SB(0, 1), b2 + hstep, voffB); PG8_STAGE(PG8_SA(0, 0), a2, voffA);
            PG8_WAIT_V(8); PG8_WAIT_L(0); PG8_BAR; PG8_MMA(1, 0, At, B0); PG8_MMA(1, 1, At, B1); PG8_BAR; PG8_SCHED;
            PG8_LDB(B0, 1, 0); PG8_LDB(B1, 1, 1); PG8_SCHED; PG8_LDA(At, 1, 0); PG8_STAGE(PG8_SA(0, 1), a2 + hstep, voffA);
            PG8_WAIT_V(8); PG8_WAIT_L(0); PG8_BAR; PG8_MMA(0, 0, At, B0); PG8_MMA(0, 1, At, B1); PG8_BAR; PG8_SCHED;
            PG8_LDA(At, 1, 1); PG8_STAGE(PG8_SB(1, 0), b3, voffB); PG8_STAGE(PG8_SB(1, 1), b3 + hstep, voffB); PG8_STAGE(PG8_SA(1, 0), a3, voffA);
            PG8_WAIT_V(8); PG8_WAIT_L(0); PG8_BAR; PG8_MMA(1, 0, At, B0); PG8_MMA(1, 1, At, B1); PG8_BAR; PG8_SCHED;
            } else {
            PG8_LDB(B0, 0, 0); PG8_SCHED; PG8_LDA(At, 0, 0); PG8_STAGE(PG8_SA(1, 1), a1 + hstep, voffA);
            PG8_WAIT_L(8); PG8_BAR; PG8_WAIT_L(0); PG8_MMA(0, 0, At, B0); PG8_BAR; PG8_SCHED;
            PG8_LDB(B1, 0, 1); PG8_STAGE(PG8_SB(0, 0), b2, voffB);
            PG8_BAR; PG8_WAIT_L(0); PG8_MMA(0, 1, At, B1); PG8_BAR;
            PG8_LDA(At, 0, 1); PG8_STAGE(PG8_SA(0, 0), a2, voffA);
            PG8_BAR; PG8_WAIT_L(0); PG8_MMA(1, 0, At, B0); PG8_BAR; PG8_SCHED;
            PG8_STAGE(PG8_SB(0, 1), b2 + hstep, voffB);
            PG8_WAIT_V(6); PG8_BAR; PG8_MMA(1, 1, At, B1); PG8_BAR;
            PG8_LDB(B0, 1, 0); PG8_SCHED; PG8_LDA(At, 1, 0); PG8_STAGE(PG8_SA(0, 1), a2 + hstep, voffA);
            PG8_WAIT_L(8); PG8_BAR; PG8_WAIT_L(0); PG8_MMA(0, 0, At, B0); PG8_BAR; PG8_SCHED;
            PG8_LDB(B1, 1, 1); PG8_STAGE(PG8_SB(1, 0), b3, voffB);
            PG8_BAR; PG8_WAIT_L(0); PG8_MMA(0, 1, At, B1); PG8_BAR;
            PG8_LDA(At, 1, 1); PG8_STAGE(PG8_SA(1, 0), a3, voffA);
            PG8_BAR; PG8_WAIT_L(0); PG8_MMA(1, 0, At, B0); PG8_BAR; PG8_SCHED;
            PG8_STAGE(PG8_SB(1, 1), b3 + hstep, voffB);
            PG8_WAIT_V(6); PG8_BAR; PG8_MMA(1, 1, At, B1); PG8_BAR;
            }
        }
        if constexpr (ALIGN_EPI) { if (wr == 0) PG8_BAR; }
        if constexpr (Epi::RESCALE) { E.fin(acc, cur, wr, wc); S.done(cur); }
        else if constexpr (!Epi::AFTER_DRAIN) { E(acc, cur, wr, wc, fr, fq); S.done(cur); }
        if (!has_next) break;
        bool keep_ = false; if constexpr (Epi::RESCALE) keep_ = E.keep(cur);
        if (!keep_) {
#pragma unroll
        for (int a = 0; a < 2; ++a)
#pragma unroll
            for (int b = 0; b < 2; ++b)
#pragma unroll
                for (int m = 0; m < 4; ++m)
#pragma unroll
                    for (int n = 0; n < 2; ++n) acc[a][b][m][n] = (f32x4){0.f, 0.f, 0.f, 0.f};
        }
        cur = nxt; cA = nA; cB = nB; ++ui;
        if constexpr (ALIGN_EPI) { if (wr == 1) PG8_BAR; }
    }
    PG8_WAIT_V(0);
    if constexpr (!ALIGN_EPI) { if (wr == 0) PG8_BAR; }
    PG8_BAR;
    if constexpr (Epi::AFTER_DRAIN) { E.fused(acc, cur, wr, wc, fr, fq, lds, wid, lane); S.done(cur); }
#undef PG8_SA
#undef PG8_SB
#undef PG8_STAGE
#undef PG8_LDA
#undef PG8_LDB
#undef PG8_MMA
#undef PG8_WAIT_V
#undef PG8_WAIT_L
#undef PG8_BAR
#undef PG8_SCHED
}
}
#include <hip/hip_bf16.h>
#include <cmath>
namespace attn_body {
using bf16=__hip_bfloat16;
using bf16x8=__attribute__((ext_vector_type(8)))short;
using s16x4=__attribute__((ext_vector_type(4)))short;
using f32x16=__attribute__((ext_vector_type(16)))float;
using u32x4=__attribute__((ext_vector_type(4)))unsigned;
constexpr int D=64,QP=512,KP=128;
constexpr int NW=8,QBLK=32,QB=QBLK*NW,KVBLK=64;
constexpr int ATTN_UNIT_ROWS=QB;
__device__ __forceinline__ int crow(int r,int hi){return (r&3)+8*(r>>2)+4*hi;}
#define SBAR() __builtin_amdgcn_sched_barrier(0)
constexpr int NSLOT=3, SLOTB=8192;
constexpr int LDS_K=0, LDS_V=NSLOT*SLOTB, LDS_WS=2*NSLOT*SLOTB, LDS_OST=LDS_WS+NW*64*4, LDS_BYTES=LDS_OST+NW*4096;
constexpr float C2=0.125f*1.4426950408889634f;
__device__ __forceinline__ void glds16(const void*gsrc,unsigned lds_dst){unsigned keep;
  asm volatile("s_mov_b32 %0, m0\n\ts_mov_b32 m0, %2\n\ts_nop 0\n\tglobal_load_lds_dwordx4 %1, off\n\ts_mov_b32 m0, %0":"=&s"(keep):"v"(gsrc),"s"(lds_dst):"memory");}
__device__ __forceinline__ float max3f(float a,float b,float c){float r;asm("v_max3_f32 %0, %1, %2, %3":"=v"(r):"v"(a),"v"(b),"v"(c));return r;}
__device__ __forceinline__ float max2f(float a,float b){float r;asm("v_max_f32_e32 %0, %1, %2":"=v"(r):"v"(a),"v"(b));return r;}
__device__ __forceinline__ float fadd_s(float a,float b){float r;asm("v_add_f32_e32 %0, %1, %2":"=v"(r):"v"(a),"v"(b));return r;}
__device__ __forceinline__ float fsub_s(float a,float b){float r;asm("v_sub_f32_e32 %0, %1, %2":"=v"(r):"v"(a),"v"(b));return r;}
typedef float f32x2_t __attribute__((ext_vector_type(2))); typedef __bf16 bf16x2_t __attribute__((ext_vector_type(2)));
__device__ __forceinline__ unsigned cvtpk_s(float lo,float hi){f32x2_t v={lo,hi};bf16x2_t b=__builtin_convertvector(v,bf16x2_t);return __builtin_bit_cast(unsigned,b);}
#define WAIT_BAR(N) asm volatile("s_waitcnt vmcnt(" #N ") lgkmcnt(0)\n\ts_barrier":::"memory")

__device__ __forceinline__ void qkt(f32x16&p0,f32x16&p1,const char*Kslot,const bf16x8*qr,const f32x16&negm,int r32,int hi){
  const char*kb=Kslot+hi*1024+r32*16;
  #pragma unroll
  for(int d0=0;d0<4;++d0){
    const bf16x8 b0=*reinterpret_cast<const bf16x8*>(kb+d0*2048);
    const bf16x8 b1=*reinterpret_cast<const bf16x8*>(kb+d0*2048+512);
    if(d0==0){p0=__builtin_amdgcn_mfma_f32_32x32x16_bf16(b0,qr[0],negm,0,0,0);p1=__builtin_amdgcn_mfma_f32_32x32x16_bf16(b1,qr[0],negm,0,0,0);}
    else{p0=__builtin_amdgcn_mfma_f32_32x32x16_bf16(b0,qr[d0],p0,0,0,0);p1=__builtin_amdgcn_mfma_f32_32x32x16_bf16(b1,qr[d0],p1,0,0,0);}}
}
typedef __attribute__((address_space(3))) const char* lds_cptr;
typedef short v4i16_t __attribute__((ext_vector_type(4)));
__device__ __forceinline__ void kload8(bf16x8*kf,lds_cptr kp){
  kf[0]=*(const __attribute__((address_space(3))) bf16x8*)(kp);      kf[1]=*(const __attribute__((address_space(3))) bf16x8*)(kp+512);
  kf[2]=*(const __attribute__((address_space(3))) bf16x8*)(kp+2048); kf[3]=*(const __attribute__((address_space(3))) bf16x8*)(kp+2560);
  kf[4]=*(const __attribute__((address_space(3))) bf16x8*)(kp+4096); kf[5]=*(const __attribute__((address_space(3))) bf16x8*)(kp+4608);
  kf[6]=*(const __attribute__((address_space(3))) bf16x8*)(kp+6144); kf[7]=*(const __attribute__((address_space(3))) bf16x8*)(kp+6656);
}
__device__ __forceinline__ void kload2(bf16x8*kf,lds_cptr kp,int j){ kf[2*j]=*(const __attribute__((address_space(3))) bf16x8*)(kp+j*2048); kf[2*j+1]=*(const __attribute__((address_space(3))) bf16x8*)(kp+j*2048+512); }
__device__ __forceinline__ s16x4 vtr(lds_cptr p){ return __builtin_bit_cast(s16x4,__builtin_amdgcn_ds_read_tr16_b64_v4i16((__attribute__((address_space(3))) v4i16_t*)p)); }
__device__ __forceinline__ float rowmax(const f32x16&p0,const f32x16&p1){
  float a=max3f(p0[0],p0[1],p1[0]),b=max3f(p0[2],p0[3],p1[1]);a=max3f(a,p1[2],p1[3]);
  #pragma unroll
  for(int r=4;r<16;r+=4){a=max3f(a,p0[r],p0[r+1]);b=max3f(b,p0[r+2],p0[r+3]);a=max3f(a,p1[r],p1[r+1]);b=max3f(b,p1[r+2],p1[r+3]);}
  const float m=max2f(a,b);
  auto rr=__builtin_amdgcn_permlane32_swap(__float_as_uint(m),__float_as_uint(m),false,false);
  return max2f(__uint_as_float(rr[0]),__uint_as_float(rr[1]));
}
__device__ __forceinline__ void pv(f32x16*o,int vb,bf16x8 pa0,bf16x8 pa1,bf16x8 pa2,bf16x8 pa3){
  #pragma unroll
  for(int d0=0;d0<2;++d0){s16x4 lo[4],hi[4];
    #pragma unroll
    for(int ks=0;ks<4;++ks){
      asm volatile("ds_read_b64_tr_b16 %0,%1 offset:%c2":"=&v"(lo[ks]):"v"(vb),"i"(d0*4096+ks*1024):"memory");
      asm volatile("ds_read_b64_tr_b16 %0,%1 offset:%c2":"=&v"(hi[ks]):"v"(vb),"i"(d0*4096+ks*1024+512):"memory");}
    asm volatile("s_waitcnt lgkmcnt(0)":::"memory");SBAR();
    #define PK(k) (bf16x8){lo[k][0],lo[k][1],lo[k][2],lo[k][3],hi[k][0],hi[k][1],hi[k][2],hi[k][3]}
    o[d0]=__builtin_amdgcn_mfma_f32_32x32x16_bf16(pa0,PK(0),o[d0],0,0,0);
    o[d0]=__builtin_amdgcn_mfma_f32_32x32x16_bf16(pa1,PK(1),o[d0],0,0,0);
    o[d0]=__builtin_amdgcn_mfma_f32_32x32x16_bf16(pa2,PK(2),o[d0],0,0,0);
    o[d0]=__builtin_amdgcn_mfma_f32_32x32x16_bf16(pa3,PK(3),o[d0],0,0,0);
    #undef PK
  }
}

#ifndef ATTN_STORE16
#define ATTN_STORE16(p,v) (*(u32x4*)(p)=(v))
#endif
template<int THRL> __device__ __forceinline__ void attn_unit(const bf16*Qu,const bf16*__restrict__ Kh,const bf16*__restrict__ Vh,bf16*Ou,const int NT,char*shm){
  const int tid=opq_tid(),lane=tid&63,r32=lane&31,hi=lane>>5; const int wid=__builtin_amdgcn_readfirstlane(tid>>6);
  const bf16*Qw=Qu+(long)(wid*QBLK)*QP;
  const unsigned lds0=(unsigned)(uintptr_t)shm;
  float*wsf=(float*)(shm+LDS_WS)+wid*64;
  const bf16*ksrc=Kh+(long)lane*KP+wid*8;
  const bf16*vsrc=Vh+(long)(16*(wid&3)+(lane>>2))*KP+(wid>>2)*32+(lane&3)*8;
  const unsigned kdst=lds0+LDS_K+wid*1024, vdst=lds0+LDS_V+wid*1024;
  #define DMA_K(t,slot) glds16(ksrc+(long)(t)*KVBLK*KP,(unsigned)__builtin_amdgcn_readfirstlane(kdst+(slot)))
  #define DMA_V(t,slot) glds16(vsrc+(long)(t)*KVBLK*KP,(unsigned)__builtin_amdgcn_readfirstlane(vdst+(slot)))
  const int vb0=(int)(lds0+LDS_V)+((lane>>4)&1)*32+(lane&3)*8+(4*hi+((lane&15)>>2))*64;
  const char*Kbase=shm+LDS_K; bf16x8 kf[8];
  const lds_cptr shm3=(lds_cptr)shm; const lds_cptr kp0=shm3+LDS_K+hi*1024+r32*16; const lds_cptr vp0=shm3+LDS_V+((lane>>4)&1)*32+(lane&3)*8+(4*hi+((lane&15)>>2))*64;
  DMA_K(0,0);DMA_V(0,0);DMA_K(1,SLOTB);
  bf16x8 qr[4];
  #pragma unroll
  for(int d0=0;d0<4;++d0)qr[d0]=*reinterpret_cast<const bf16x8*>(&Qw[(long)r32*QP+d0*16+hi*8]);
  float mhat=0.f,l_reg=0.f;f32x16 o[2];o[0]=f32x16{};o[1]=f32x16{};f32x16 negm=f32x16{};asm volatile("":"+v"(negm));
  #define CMASK(P0,P1,t) do{}while(0)
  bool resc=false;
  #define START(P0,P1) do{ const float rm=rowmax(P0,P1); resc=false; \
    { const float dl=rm; mhat=fadd_s(mhat,dl); \
      _Pragma("unroll") for(int r=0;r<16;++r){P0[r]=fsub_s(P0[r],dl);P1[r]=fsub_s(P1[r],dl);} \
      _Pragma("unroll") for(int r=0;r<16;++r)negm[r]=-mhat; asm volatile("":"+v"(negm)); } \
    _Pragma("unroll") for(int r=0;r<16;++r)P0[r]=__builtin_amdgcn_exp2f(P0[r]); }while(0)
  #define RESC() do{ if(resc){ asm volatile("s_waitcnt lgkmcnt(0)":::"memory"); \
      _Pragma("unroll") for(int d_=0;d_<2;++d_) _Pragma("unroll") for(int r=0;r<16;++r)o[d_][r]*=wsf[crow(r,hi)]; } }while(0)
  f32x16 pA0,pA1,pB0,pB1;
  int sl_prev=0,sl_cur=0,sl_next=SLOTB;
  #define ROT() do{sl_prev=sl_cur;sl_cur=sl_next;sl_next=(sl_next==(NSLOT-1)*SLOTB)?0:sl_next+SLOTB;}while(0)
  DMA_K(2,2*SLOTB);
  WAIT_BAR(3);
  qkt(pA0,pA1,Kbase,qr,negm,r32,hi);asm volatile("s_nop 15\n\ts_nop 7":"+v"(pA0),"+v"(pA1));CMASK(pA0,pA1,0);
  START(pA0,pA1);
  _Pragma("unroll") for(int r=0;r<16;++r)pA1[r]=__builtin_amdgcn_exp2f(pA1[r]);
  WAIT_BAR(0);
  DMA_K(3,0);DMA_V(1,SLOTB);
  ROT();
  kload8(kf,kp0+sl_cur);
  WAIT_BAR(2);
  s16x4 vlo[8],vhi[8]; u32x4 pw0,pw1,pw2,pw3;
  #define PKW(P,B) cvtpk_s(P[B],P[B+1])
  #define PAF(k) __builtin_bit_cast(bf16x8,pw##k)
  #define VFR(i) (bf16x8){vlo[i][0],vlo[i][1],vlo[i][2],vlo[i][3],vhi[i][0],vhi[i][1],vhi[i][2],vhi[i][3]}
  #define PIN(x) asm volatile("":"+v"(x))
  #define MX3(a,b,c) __builtin_fmaxf(__builtin_fmaxf((a),(b)),(c))
  #define GAPA(MF,A0,A1,A2,A3,W0,W1,PW) do{ MF; sacc+=A0; sacc+=A1; sacc+=A2; sacc+=A3; PIN(sacc); W0; W1; PIN(PW); SBAR(); }while(0)
  #define EX(v) __builtin_amdgcn_exp2f(v)
  #define GAPB(MF,X,B) do{ MF; X[B]=EX(X[B]); X[B+1]=EX(X[B+1]); X[B+2]=EX(X[B+2]); X[B+3]=EX(X[B+3]); PIN(X); SBAR(); }while(0)
  #define VRD(i) do{ vlo[i]=vtr(vp_+(((i)>>2)*4096+((i)&3)*1024)); vhi[i]=vtr(vp_+(((i)>>2)*4096+((i)&3)*1024+512)); }while(0)
  #define KRD(G,j) do{ if(G){ kload2(kf,kp0+sl_next,j); SBAR(); } }while(0)
  #define STEP(C0,C1,P0,P1,t,GK,GV,GL) do{ SBAR(); \
    const lds_cptr vp_=vp0+sl_prev; \
    VRD(0); SBAR(); float sacc=(P0[0]+P0[1]); \
    GAPA(C0=__builtin_amdgcn_mfma_f32_32x32x16_bf16(kf[0],qr[0],negm,0,0,0), P0[2],P0[3],P0[4],P0[5],     pw0[0]=PKW(P0,0), pw0[1]=PKW(P0,2), pw0); \
    VRD(4); SBAR(); GAPA(C1=__builtin_amdgcn_mfma_f32_32x32x16_bf16(kf[1],qr[0],negm,0,0,0), P0[6],P0[7],P0[8],P0[9],     pw0[2]=PKW(P0,4), pw0[3]=PKW(P0,6), pw0); \
    VRD(1); SBAR(); GAPA(C0=__builtin_amdgcn_mfma_f32_32x32x16_bf16(kf[2],qr[1],C0,0,0,0),   P0[10],P0[11],P0[12],P0[13], pw1[0]=PKW(P0,8), pw1[1]=PKW(P0,10), pw1); \
    VRD(5); SBAR(); GAPA(C1=__builtin_amdgcn_mfma_f32_32x32x16_bf16(kf[3],qr[1],C1,0,0,0),   P0[14],P0[15],P1[0],P1[1],   pw1[2]=PKW(P0,12),pw1[3]=PKW(P0,14), pw1); \
    VRD(2); SBAR(); GAPA(C0=__builtin_amdgcn_mfma_f32_32x32x16_bf16(kf[4],qr[2],C0,0,0,0),   P1[2],P1[3],P1[4],P1[5],     pw2[0]=PKW(P1,0), pw2[1]=PKW(P1,2), pw2); \
    VRD(6); SBAR(); GAPA(C1=__builtin_amdgcn_mfma_f32_32x32x16_bf16(kf[5],qr[2],C1,0,0,0),   P1[6],P1[7],P1[8],P1[9],     pw2[2]=PKW(P1,4), pw2[3]=PKW(P1,6), pw2); \
    VRD(3); SBAR(); GAPA(C0=__builtin_amdgcn_mfma_f32_32x32x16_bf16(kf[6],qr[3],C0,0,0,0),   P1[10],P1[11],P1[12],P1[13], pw3[0]=PKW(P1,8), pw3[1]=PKW(P1,10), pw3); \
    VRD(7); SBAR(); GAPA(C1=__builtin_amdgcn_mfma_f32_32x32x16_bf16(kf[7],qr[3],C1,0,0,0),   P1[14],P1[15],0.f,0.f,       pw3[2]=PKW(P1,12),pw3[3]=PKW(P1,14), pw3); \
    l_reg+=sacc; \
    if(GK){DMA_K((t)+3,sl_cur);} if(GV){DMA_V((t)+1,sl_next);} \
    CMASK(C0,C1,t); \
    resc=false; if(THRL<1000){ float a=MX3(C0[0],C0[1],C1[0]),b=MX3(C0[2],C0[3],C1[1]); a=MX3(a,C1[2],C1[3]); \
      _Pragma("unroll") for(int r=4;r<16;r+=4){a=MX3(a,C0[r],C0[r+1]);b=MX3(b,C0[r+2],C0[r+3]);a=MX3(a,C1[r],C1[r+1]);b=MX3(b,C1[r+2],C1[r+3]);} \
      float rm=__builtin_fmaxf(a,b); { auto rr=__builtin_amdgcn_permlane32_swap(__float_as_uint(rm),__float_as_uint(rm),false,false); rm=__builtin_fmaxf(__uint_as_float(rr[0]),__uint_as_float(rr[1])); } \
      resc=false; \
      if(__builtin_expect(__any(rm>(float)THRL),0)){ const float dl=__builtin_fmaxf(rm,0.f); mhat+=dl; \
        _Pragma("unroll") for(int r=0;r<16;++r){C0[r]-=dl;C1[r]-=dl;} \
        _Pragma("unroll") for(int r=0;r<16;++r)negm[r]=-mhat; asm volatile("":"+v"(negm)); \
        const float f=__builtin_amdgcn_exp2f(-dl); l_reg*=f; if(hi==0)wsf[r32]=f; resc=true; } } \
    SBAR(); \
    GAPB(o[0]=__builtin_amdgcn_mfma_f32_32x32x16_bf16(PAF(0),VFR(0),o[0],0,0,0), C0,0); \
    GAPB(o[1]=__builtin_amdgcn_mfma_f32_32x32x16_bf16(PAF(0),VFR(4),o[1],0,0,0), C0,4); \
    KRD(GL,0); GAPB(o[0]=__builtin_amdgcn_mfma_f32_32x32x16_bf16(PAF(1),VFR(1),o[0],0,0,0), C0,8); \
    KRD(GL,1); GAPB(o[1]=__builtin_amdgcn_mfma_f32_32x32x16_bf16(PAF(1),VFR(5),o[1],0,0,0), C0,12); \
    KRD(GL,2); GAPB(o[0]=__builtin_amdgcn_mfma_f32_32x32x16_bf16(PAF(2),VFR(2),o[0],0,0,0), C1,0); \
    KRD(GL,3); GAPB(o[1]=__builtin_amdgcn_mfma_f32_32x32x16_bf16(PAF(2),VFR(6),o[1],0,0,0), C1,4); \
    GAPB(o[0]=__builtin_amdgcn_mfma_f32_32x32x16_bf16(PAF(3),VFR(3),o[0],0,0,0), C1,8); \
    GAPB(o[1]=__builtin_amdgcn_mfma_f32_32x32x16_bf16(PAF(3),VFR(7),o[1],0,0,0), C1,12); \
    }while(0)
  int t=1;
  #undef CMASK
  #define CMASK(P0,P1,t) do{}while(0)
  for(;t+5<NT;t+=2){
    STEP(pB0,pB1,pA0,pA1,t,true,true,true);     WAIT_BAR(2); RESC(); ROT();
    STEP(pA0,pA1,pB0,pB1,t+1,true,true,true);   WAIT_BAR(2); RESC(); ROT();
  }
  #undef CMASK
  #define CMASK(P0,P1,t) do{}while(0)
  #define ENDW(tt) do{ if((tt)+3<NT){WAIT_BAR(2);} else if((tt)+2<NT){WAIT_BAR(1);} else {WAIT_BAR(0);} }while(0)
  for(;t+1<NT;t+=2){
    STEP(pB0,pB1,pA0,pA1,t,(t+3<NT),(t+1<NT),(t+1<NT));       ENDW(t);   RESC(); ROT();
    STEP(pA0,pA1,pB0,pB1,t+1,(t+4<NT),(t+2<NT),(t+2<NT));     ENDW(t+1); RESC(); ROT();
  }
  STEP(pB0,pB1,pA0,pA1,NT-1,false,false,false); RESC();
  { float sacc=pB0[0]+pB0[1]; _Pragma("unroll") for(int r=2;r<16;++r)sacc+=pB0[r]; _Pragma("unroll") for(int r=0;r<16;++r)sacc+=pB1[r]; l_reg+=sacc;
    pw0=(u32x4){PKW(pB0,0),PKW(pB0,2),PKW(pB0,4),PKW(pB0,6)};pw1=(u32x4){PKW(pB0,8),PKW(pB0,10),PKW(pB0,12),PKW(pB0,14)};pw2=(u32x4){PKW(pB1,0),PKW(pB1,2),PKW(pB1,4),PKW(pB1,6)};pw3=(u32x4){PKW(pB1,8),PKW(pB1,10),PKW(pB1,12),PKW(pB1,14)};
    SBAR(); pv(o,vb0+sl_cur,PAF(0),PAF(1),PAF(2),PAF(3)); }
  #undef PKW
  #undef PAF
  #undef VFR
  #undef PIN
  #undef MX3
  #undef GAPA
  #undef GAPB
  #undef EX
  #undef VRD
  #undef KRD
  #undef STEP
  #undef ENDW
  {auto rr=__builtin_amdgcn_permlane32_swap(__float_as_uint(l_reg),__float_as_uint(l_reg),false,false);l_reg=__uint_as_float(rr[0])+__uint_as_float(rr[1]);}
  if(hi==0)wsf[32+r32]=l_reg;asm volatile("s_waitcnt lgkmcnt(0)":::"memory");
  float rli[16];
  #pragma unroll
  for(int r=0;r<16;++r)rli[r]=__builtin_amdgcn_rcpf(wsf[32+crow(r,hi)]);
  bf16*Ow=Ou+(long)(wid*QBLK)*QP;
  { bf16*stg=(bf16*)(shm+LDS_OST)+wid*2048;
    #pragma unroll
    for(int r=0;r<16;++r){const int orow=crow(r,hi);
      #pragma unroll
      for(int d0=0;d0<2;++d0)stg[orow*64+d0*32+r32]=__float2bfloat16(o[d0][r]*rli[r]);}
    asm volatile("s_waitcnt lgkmcnt(0)":::"memory");
    #pragma unroll
    for(int i=0;i<4;++i){const int row=i*8+(lane>>3),ch=lane&7; const u32x4 v=*(const u32x4*)(stg+row*64+ch*8); ATTN_STORE16(Ow+(long)row*QP+ch*8,v);} }
  asm volatile("s_waitcnt lgkmcnt(0)\n\ts_barrier":::"memory");
  #undef DMA_K
  #undef DMA_V
  #undef CMASK
  #undef START
  #undef RESC
  #undef ROT
}
constexpr int ATTN_LDS_BYTES=LDS_BYTES;
#undef SBAR
#undef WAIT_BAR
}

struct Args {
    const float *x, *c, *ctx, *c_ctx, *w_mod, *b_mod, *g_norm1, *g_norm2, *w_in, *q_gain, *k_gain, *sc_conv_w, *hy_conv_w, *hy_conv_b,
                *hy_w1, *hy_b1, *hy_f1, *hy_w2, *hy_b2, *hy_f2, *hy_w3, *hy_decay, *hy_bias, *w_br_att, *w_br_sc, *w_br_hy, *w_out,
                *peer_wq, *peer_subkeys, *peer_u, *peer_v, *g_final;
    float* out; unsigned char* ws;
};
struct Ctx {
    LAS unsigned char* lds; int tid, lane, wave, vcu, G;
};

__device__ __forceinline__ int inv_sigma(int src) {
    if (src < 512) { const int head = src >> 6, d = src & 63, bj = d >> 5, dd = d & 31, n = dd >> 4, f = dd & 15, fq = f >> 2, e = f & 3; return 256 * (head >> 2) + 128 * bj + 32 * (head & 3) + 8 * fq + 4 * n + e; }
    if (src < 640) { const int s = src - 512, kvh = s >> 6, d = s & 63, bj = d >> 5, dd = d & 31, n = dd >> 4, f = dd & 15, fq = f >> 2, e = f & 3; return 512 + 128 * bj + 32 * kvh + 8 * fq + 4 * n + e; }
    if (src < 768) { const int s = src - 640, kvh = s >> 6, d = s & 63, bj = d >> 5, i = d & 31; return 512 + 128 * bj + 32 * (2 + kvh) + i; }
    if (src < 2304) { const int s = src - 768, part = s >> 9, ch = s & 511;
        if (part == 0) return 768 + ch;
        return 768 + 512 + (ch >> 7) * 256 + (part == 2 ? 128 : 0) + (ch & 127); }
    return src;
}
template <bool PERMUTE>
__device__ __forceinline__ void transpose_item(const float* W, int K, int N, bf16* WT, LAS float* scr, int item, int lane) {
    const int nblk = N / 32, kb = item / nblk, nb = item % nblk, k0 = 64 * kb, n0 = 32 * nb;
#pragma unroll 8
    for (int i = 0; i < 32; ++i) { const int kk = 2 * i + (lane >> 5); scr[kk * 33 + (lane & 31)] = W[(size_t)(k0 + kk) * N + n0 + (lane & 31)]; }
    LDS_WAIT(); asm volatile("" ::: "memory");
    const int c = lane & 7;
#pragma unroll
    for (int j = 0; j < 4; ++j) { const int n = (lane >> 3) + 8 * j; const LAS float* s = scr + (8 * c) * 33 + n;
        v4u o; o.x = pk2(s[0 * 33], s[1 * 33]); o.y = pk2(s[2 * 33], s[3 * 33]); o.z = pk2(s[4 * 33], s[5 * 33]); o.w = pk2(s[6 * 33], s[7 * 33]);
        const int drow = PERMUTE ? inv_sigma(n0 + n) : (n0 + n);
        *(GAS v4u*)(WT + (size_t)drow * K + k0 + 8 * c) = o; }
    LDS_WAIT(); asm volatile("" ::: "memory");
}
__device__ __forceinline__ float silu_f(float v) { return v / (1.0f + __expf(-v)); }

__device__ __forceinline__ void p0_prologue(const Args& A, const Ctx& C) {
    unsigned char* ws = A.ws;
    const int gw = C.vcu * NWAVES + C.wave, NGW = C.G * NWAVES;
    LAS float* scr = (LAS float*)(C.lds + C.wave * 16384);
    {
        constexpr int I_IN = 16 * (IN_W / 32), I_BR = 8 * 32, I_OUT = 16 * 32, PER_L = I_IN + 3 * I_BR + I_OUT;
        for (int it = gw; it < 2 * PER_L; it += NGW) {
            const int l = it / PER_L; int r = it % PER_L;
            if (r < I_IN) { transpose_item<true>(A.w_in + (size_t)l * 1024 * IN_W, 1024, IN_W, (bf16*)(ws + WS_WIN) + (size_t)l * IN_W * 1024, scr, r, C.lane); continue; } r -= I_IN;
            if (r < 3 * I_BR) { const int br = r / I_BR; const float* W = (br == 0 ? A.w_br_att : br == 1 ? A.w_br_sc : A.w_br_hy) + (size_t)l * 512 * 1024;
                transpose_item<false>(W, 512, 1024, (bf16*)(ws + WS_WBR) + (size_t)(l * 3 + br) * 1024 * 512, scr, r % I_BR, C.lane); continue; } r -= 3 * I_BR;
            transpose_item<false>(A.w_out + (size_t)l * 1024 * 1024, 1024, 1024, (bf16*)(ws + WS_WOUT) + (size_t)l * 1024 * 1024, scr, r, C.lane);
        }
    }
    for (int i = (C.vcu * NTHREADS + C.tid); i < 256 * 16; i += C.G * NTHREADS) {
        const int pos = i >> 4, f = i & 15; const float inv = powf(10000.0f, -(float)f * (1.0f / 16.0f)), ang = (float)pos * inv;
        ((float*)(ws + WS_ROPE))[i] = cosf(ang); ((float*)(ws + WS_ROPE))[4096 + i] = sinf(ang);
    }
    {
        LAS float* hs = (LAS float*)(C.lds + C.wave * 16384);
        const int j = C.lane;
#pragma unroll 1
        for (int l = 0; l < 2; ++l) {
            const float* w1 = A.hy_w1 + (size_t)l * HY_EMB * 64; const float* w2 = A.hy_w2 + (size_t)l * 64 * 64;
            float w1r[33], w2r[64];
#pragma unroll
            for (int k = 0; k < 33; ++k) w1r[k] = w1[k * 64 + j];
#pragma unroll
            for (int k = 0; k < 64; ++k) w2r[k] = w2[k * 64 + j];
            const float b1 = A.hy_b1[l * 64 + j], f1 = A.hy_f1[l * 64 + j], b2 = A.hy_b2[l * 64 + j], f2 = A.hy_f2[l * 64 + j];
#pragma unroll 1
            for (int tt = gw; tt < SEQ + CTX_LEN; tt += NGW) {
                const bool isc = tt >= SEQ; const int t = isc ? tt - SEQ : tt, L = isc ? CTX_LEN : SEQ;
                const float tl = (float)t / (float)(L - 1), w = 6.2831855f * (float)t / (float)L;
                float a = b1 + tl * w1r[0];
                float ck, sk;
                { const int kb = j & 15; const float band = 1e-4f + (float)kb * ((15.0f - 1e-4f) / 15.0f), ang = band * w; ck = cosf(ang); sk = sinf(ang); }
#pragma unroll
                for (int k = 0; k < 16; ++k) { const float c_ = __builtin_bit_cast(float, __builtin_amdgcn_readlane(__builtin_bit_cast(int, ck), k)), s_ = __builtin_bit_cast(float, __builtin_amdgcn_readlane(__builtin_bit_cast(int, sk), k));
                    a += c_ * w1r[1 + k] - s_ * w1r[17 + k]; }
                const float h1 = sinf(f1 * a);
                LDS_WAIT(); hs[j] = h1; LDS_WAIT(); asm volatile("" ::: "memory");
                float b = b2;
#pragma unroll
                for (int k = 0; k < 64; ++k) b += hs[k] * w2r[k];
                const float h2 = sinf(f2 * b);
                if (isc) ((float*)(ws + WS_H2C))[(size_t)(l * 64 + j) * CTX_LEN + t] = h2; else ((bf16*)(ws + WS_H2))[((size_t)l * SEQ + t) * 64 + j] = (bf16)f2bf(h2);
                asm volatile("" ::: "memory");
            }
        }
    }
    __syncthreads();
    {
        LAS float* red = (LAS float*)C.lds;
        LAS float* sc = (LAS float*)(C.lds + 8192);
        if (C.vcu < 2 * 96) { for (int i = C.tid; i < 3072; i += NTHREADS) sc[i] = silu_f(i < 2048 ? A.c[i] : A.c_ctx[i - 2048]); }
        __syncthreads();
        for (int it = C.vcu; it < 2 * 96; it += C.G) {
            const int l = it / 96, n = (it % 96) * 64 + C.lane;
            const float* W = A.w_mod + (size_t)l * 1024 * 6144 + n;
            float s0 = 0.f, s1 = 0.f, s2 = 0.f;
#pragma unroll 8
            for (int kk = 0; kk < 128; ++kk) { const int k = C.wave * 128 + kk; const float wv = W[(size_t)k * 6144];
                s0 += sc[k] * wv; s1 += sc[1024 + k] * wv; s2 += sc[2048 + k] * wv; }
            red[(C.wave * 3 + 0) * 64 + C.lane] = s0; red[(C.wave * 3 + 1) * 64 + C.lane] = s1; red[(C.wave * 3 + 2) * 64 + C.lane] = s2;
            __syncthreads();
            if (C.wave < 3) { float s = A.b_mod[l * 6144 + n];
#pragma unroll
                for (int w8 = 0; w8 < 8; ++w8) s += red[(w8 * 3 + C.wave) * 64 + C.lane];
                ((float*)(ws + WS_MOD))[(size_t)(l * 3 + C.wave) * 6144 + n] = s; }
            __syncthreads();
        }
    }
    {
        LAS float* sk = (LAS float*)C.lds;
        LAS float* wq = (LAS float*)(C.lds + 128 * 65 * 4);
        for (int it = C.vcu; it < 2 * 16 * 16; it += C.G) {
            const int l = it >> 8, hp = (it >> 4) & 15, kc = it & 15, k0 = kc * 64;
            const float* SK = A.peer_subkeys + ((size_t)l * 16 + hp) * 128 * 64;
            for (int i = C.tid; i < 128 * 64; i += NTHREADS) sk[(i >> 6) * 65 + (i & 63)] = SK[i];
            const float* WQ = A.peer_wq + (size_t)l * 1024 * 1024 + hp * 64;
            for (int i = C.tid; i < 64 * 64; i += NTHREADS) wq[(i >> 6) * 65 + (i & 63)] = WQ[(size_t)(k0 + (i >> 6)) * 1024 + (i & 63)];
            __syncthreads();
            bf16* WP = (bf16*)(ws + WS_WPEER) + ((size_t)l * 2048 + hp * 128) * 1024 + k0;
            {
                const int n0 = (C.tid >> 4) * 4, kq = (C.tid & 15) * 4; float s[4][4];
#pragma unroll
                for (int i = 0; i < 4; ++i)
#pragma unroll
                    for (int jj = 0; jj < 4; ++jj) s[i][jj] = 0.f;
#pragma unroll 4
                for (int d = 0; d < 64; ++d) { float a[4], b[4];
#pragma unroll
                    for (int i = 0; i < 4; ++i) { a[i] = sk[(n0 + i) * 65 + d]; b[i] = wq[(kq + i) * 65 + d]; }
#pragma unroll
                    for (int i = 0; i < 4; ++i)
#pragma unroll
                        for (int jj = 0; jj < 4; ++jj) s[i][jj] += a[i] * b[jj]; }
#pragma unroll
                for (int i = 0; i < 4; ++i) *(GAS v2u*)(WP + (size_t)(n0 + i) * 1024 + kq) = (v2u){pk2(s[i][0], s[i][1]), pk2(s[i][2], s[i][3])};
            }
            __syncthreads();
        }
    }
}

__device__ __forceinline__ void norm_rows(const Ctx& C, const float* xlat, const float* xctx, int nrows, const float* g, const float* mod  , int shi, bf16* XN) {
    const int gw = C.vcu * NWAVES + C.wave, NGW = C.G * NWAVES;
    f32x4 gv[4];
#pragma unroll
    for (int j = 0; j < 4; ++j) gv[j] = ((const f32x4*)g)[C.lane + 64 * j];
    f32x4 nv[4];
    if (gw < nrows) { const float* xr = gw < ML ? xlat + (size_t)gw * 1024 : xctx + (size_t)(gw - ML) * 1024;
#pragma unroll
        for (int j = 0; j < 4; ++j) nv[j] = ((const GAS f32x4*)xr)[C.lane + 64 * j]; }
    for (int r = gw; r < nrows; r += NGW) {
        const bool latent = r < ML;
        const float* mp = mod + (latent ? (r >> 14) : 2) * 6144 + shi * 1024;
        f32x4 v[4]; float s = 0.f;
#pragma unroll
        for (int j = 0; j < 4; ++j) { v[j] = nv[j]; s += (v[j].x * v[j].x + v[j].y * v[j].y) + (v[j].z * v[j].z + v[j].w * v[j].w); }
        { const int rn = r + NGW; if (rn < nrows) { const float* xn = rn < ML ? xlat + (size_t)rn * 1024 : xctx + (size_t)(rn - ML) * 1024;
#pragma unroll
            for (int j = 0; j < 4; ++j) nv[j] = ((const GAS f32x4*)xn)[C.lane + 64 * j]; } }
        const float rstd = 1.0f / sqrtf(wave_sum(s) * (1.0f / 1024.0f) + EPS);
        GAS unsigned long long* o8 = (GAS unsigned long long*)(XN + (size_t)r * 1024) + C.lane;
#pragma unroll
        for (int j = 0; j < 4; ++j) { const f32x4 sh = ((const f32x4*)mp)[C.lane + 64 * j], sc = ((const f32x4*)(mp + 1024))[C.lane + 64 * j];
            const f32x4 y = v[j] * rstd * gv[j] * (sc + 1.0f) + sh;
            o8[64 * j] = (unsigned long long)pk2(y.x, y.y) | ((unsigned long long)pk2(y.z, y.w) << 32); }
    }
}

__device__ __forceinline__ void ysc_pass(const Ctx& C, bf16* BG, const bf16* CX, const float* w  , int nrows) {
    const long total = (long)nrows * 64, i0 = (long)C.vcu * NTHREADS + C.tid, istep = (long)C.G * NTHREADS;
    const int c8 = (int)(i0 & 63) * 8;
    const f32x4 w0a = *(const f32x4*)(w + c8), w0b = *(const f32x4*)(w + c8 + 4), w1a = *(const f32x4*)(w + 512 + c8), w1b = *(const f32x4*)(w + 512 + c8 + 4), w2a = *(const f32x4*)(w + 1024 + c8), w2b = *(const f32x4*)(w + 1024 + c8 + 4);
#define YSC_LOAD(ii, CM, C0, CP, BGV) do { const int r_ = (int)((ii) >> 6); int t_, L_; if (r_ < ML) { t_ = r_ & (SEQ - 1); L_ = SEQ; } else { t_ = (r_ - ML) & (CTX_LEN - 1); L_ = CTX_LEN; } \
        const int rm_ = (t_ > 0) ? r_ - 1 : r_, rp_ = (t_ < L_ - 1) ? r_ + 1 : r_; const v4u z4_ = (v4u){0u, 0u, 0u, 0u}; \
        const v4u cmv_ = *(const GAS v4u*)(CX + (size_t)rm_ * 512 + c8), cpv_ = *(const GAS v4u*)(CX + (size_t)rp_ * 512 + c8); \
        C0 = *(const GAS v4u*)(CX + (size_t)r_ * 512 + c8); BGV = *(const GAS v4u*)(BG + (size_t)r_ * 512 + c8); CM = (t_ > 0) ? cmv_ : z4_; CP = (t_ < L_ - 1) ? cpv_ : z4_; } while (0)
    v4u ncm = (v4u){0u, 0u, 0u, 0u}, nc0 = ncm, ncp = ncm, nbg = ncm;
    if (i0 < total) YSC_LOAD(i0, ncm, nc0, ncp, nbg);
    for (long i = i0; i < total; i += istep) {
        const int r = (int)(i >> 6);
        const v4u cm = ncm, c0 = nc0, cp = ncp, bg = nbg;
        if (i + istep < total) YSC_LOAD(i + istep, ncm, nc0, ncp, nbg);
        f32x4 ma, mb, ca, cb, pa, pb, ga, gb; pg8::unpack8(cm, ma, mb); pg8::unpack8(c0, ca, cb); pg8::unpack8(cp, pa, pb); pg8::unpack8(bg, ga, gb);
        const f32x4 ya = ga * (w0a * ma + w1a * ca + w2a * pa), yb = gb * (w0b * mb + w1b * cb + w2b * pb);
        *(GAS v4u*)(BG + (size_t)r * 512 + c8) = pg8::pack8(ya, yb);
    }
#undef YSC_LOAD
}

__device__ __forceinline__ void yhy_transpose(const Ctx& C, const bf16* YHYT, bf16* YHY, bool with_ctx) {
    LAS unsigned short* scr = (LAS unsigned short*)(C.lds + C.wave * 16384);
    const int gw = C.vcu * NWAVES + C.wave, NGW = C.G * NWAVES;
    const int NLAT = 2 * 8 * 256, NIT = NLAT + (with_ctx ? 2 * 8 * 4 : 0);
    for (int it = gw; it < NIT; it += NGW) {
        const bf16* src; size_t pitch; size_t row0; int cb;
        if (it < NLAT) { const int b = it >> 11, r = it & 2047; cb = r >> 8; const int tb = r & 255; src = YHYT + ((size_t)(b * 512 + cb * 64)) * SEQ + tb * 64; pitch = SEQ; row0 = (size_t)b * SEQ + tb * 64; }
        else { const int q = it - NLAT, b = q >> 5, r = q & 31; cb = r >> 2; const int tb = r & 3; src = YHYT + (size_t)BATCH * 512 * SEQ + ((size_t)(b * 512 + cb * 64)) * CTX_LEN + tb * 64; pitch = CTX_LEN; row0 = (size_t)ML + b * CTX_LEN + tb * 64; }
#pragma unroll
        for (int i = 0; i < 32; ++i) { const int c = 2 * i + (C.lane >> 5); const unsigned w = *(const GAS unsigned*)(src + (size_t)c * pitch + (C.lane & 31) * 2);
            scr[c * 66 + (C.lane & 31) * 2] = (unsigned short)(w & 0xffffu); scr[c * 66 + (C.lane & 31) * 2 + 1] = (unsigned short)(w >> 16); }
        LDS_WAIT(); asm volatile("" ::: "memory");
        const int ch = C.lane & 7;
#pragma unroll
        for (int j = 0; j < 8; ++j) { const int t = (C.lane >> 3) + 8 * j; const LAS unsigned short* s = scr + (8 * ch) * 66 + t;
            v4u o; o.x = (unsigned)s[0] | ((unsigned)s[66] << 16); o.y = (unsigned)s[2 * 66] | ((unsigned)s[3 * 66] << 16); o.z = (unsigned)s[4 * 66] | ((unsigned)s[5 * 66] << 16); o.w = (unsigned)s[6 * 66] | ((unsigned)s[7 * 66] << 16);
            *(GAS v4u*)(YHY + (row0 + t) * 512 + cb * 64 + 8 * ch) = o; }
        LDS_WAIT(); asm volatile("" ::: "memory");
    }
}

__device__ __forceinline__ void cvt_table(const Ctx& C, const float* src, bf16* dst, size_t n) {
    const size_t n8 = n / 8;
    for (size_t i = (size_t)C.vcu * NTHREADS + C.tid; i < n8; i += (size_t)C.G * NTHREADS) {
        const f32x4 a = ((const GAS f32x4*)src)[2 * i], b = ((const GAS f32x4*)src)[2 * i + 1];
        v4u o; o.x = pk2(a.x, a.y); o.y = pk2(a.z, a.w); o.z = pk2(b.x, b.y); o.w = pk2(b.z, b.w);
        ((GAS v4u*)dst)[i] = o;
    }
}

__device__ __forceinline__ void cvt_table_fp6(const Ctx& C, const float* src, unsigned char* dst, float* deq, int rows, int cu = -1, int ncu = 0) {
    const int gw = (cu < 0 ? C.vcu : cu) * NWAVES + C.wave, NGW = (cu < 0 ? C.G : ncu) * NWAVES, lp = C.lane & 31, half = C.lane >> 5;
    f32x4 nv[8];
    if (gw < rows / 2) { const GAS f32x4* s = (const GAS f32x4*)(src + (size_t)(2 * gw + half) * 1024) + 8 * lp;
#pragma unroll
        for (int j = 0; j < 8; ++j) nv[j] = s[j]; }
    for (int r2 = gw; r2 < rows / 2; r2 += NGW) {
        const int r = 2 * r2 + half;
        f32x4 v[8]; float mx = 0.f;
#pragma unroll
        for (int j = 0; j < 8; ++j) v[j] = nv[j];
        { const int rn2 = r2 + NGW; if (rn2 < rows / 2) { const GAS f32x4* s = (const GAS f32x4*)(src + (size_t)(2 * rn2 + half) * 1024) + 8 * lp;
#pragma unroll
            for (int j = 0; j < 8; ++j) nv[j] = s[j]; } }
#pragma unroll
        for (int j = 0; j < 8; ++j) { mx = fmaxf(mx, fmaxf(fmaxf(fabsf(v[j].x), fabsf(v[j].y)), fmaxf(fabsf(v[j].z), fabsf(v[j].w)))); }
        mx = fmaxf(mx, __shfl_xor(mx, 16)); mx = fmaxf(mx, __shfl_xor(mx, 8)); mx = fmaxf(mx, __shfl_xor(mx, 4)); mx = fmaxf(mx, __shfl_xor(mx, 2)); mx = fmaxf(mx, __shfl_xor(mx, 1));
        const float sc = mx > 0.f ? 7.5f / mx : 1.0f;
        v16f a, b;
#pragma unroll
        for (int i = 0; i < 16; ++i) {
#if FP6_ILV
            const int ia = 2 * i, ib = 2 * i + 1;
#else
            const int ia = i, ib = 16 + i;
#endif
            a[i] = v[ia >> 2][ia & 3] * sc; b[i] = v[ib >> 2][ib & 3] * sc; }
        const v6i w = __builtin_amdgcn_cvt_scalef32_2xpk16_fp6_f32(a, b, 1.0f);
        unsigned char* d = dst + (size_t)r * 768;
        *(GAS v4u*)(d + 16 * lp) = (v4u){(unsigned)w[0], (unsigned)w[1], (unsigned)w[2], (unsigned)w[3]};
        *(GAS v2u*)(d + 512 + 8 * lp) = (v2u){(unsigned)w[4], (unsigned)w[5]};
        if (lp == 0) deq[r] = mx > 0.f ? mx * (1.0f / 7.5f) : 1.0f;
    }
}
__device__ __forceinline__ void cvt_table_fp8(const Ctx& C, const float* src, unsigned char* dst, float* deq, int rows) {
    const int gw = C.vcu * NWAVES + C.wave, NGW = C.G * NWAVES;
    for (int r = gw; r < rows; r += NGW) {
        const GAS f32x4* s = (const GAS f32x4*)(src + (size_t)r * 1024) + 4 * C.lane;
        f32x4 v[4]; float mx = 0.f;
#pragma unroll
        for (int j = 0; j < 4; ++j) { v[j] = s[j]; mx = fmaxf(mx, fmaxf(fmaxf(fabsf(v[j].x), fabsf(v[j].y)), fmaxf(fabsf(v[j].z), fabsf(v[j].w)))); }
        mx = wave_max(mx);
        const float sc = mx > 0.f ? 240.0f / mx : 1.0f;
        v4u o;
#pragma unroll
        for (int j = 0; j < 4; ++j) { int w = 0; w = __builtin_amdgcn_cvt_pk_fp8_f32(v[j].x * sc, v[j].y * sc, w, false); w = __builtin_amdgcn_cvt_pk_fp8_f32(v[j].z * sc, v[j].w * sc, w, true); o[j] = (unsigned)w; }
        *(GAS v4u*)(dst + (size_t)r * 1024 + 16 * C.lane) = o;
        if (C.lane == 0) deq[r] = mx > 0.f ? mx * (1.0f / 240.0f) : 1.0f;
    }
}

namespace hy {
constexpr int L = SEQ, NFFT = 2 * SEQ;
__device__ __forceinline__ int cidx(int p) { return p + ((p >> 6) << 2); }
__device__ __forceinline__ f32x2 cmul(f32x2 a, f32x2 b) { return (f32x2){a.x * b.x - a.y * b.y, a.x * b.y + a.y * b.x}; }
__device__ __forceinline__ f32x2 cmulc(f32x2 a, f32x2 b) { return (f32x2){a.x * b.x + a.y * b.y, a.y * b.x - a.x * b.y}; }
__device__ __forceinline__ f32x2 twid(float frac) { return (f32x2){__builtin_amdgcn_cosf(frac), -__builtin_amdgcn_sinf(frac)}; }
__device__ __forceinline__ unsigned cpack(f32x2 v) { return pk2(v.x, v.y); }
__device__ __forceinline__ f32x2 cunpack(unsigned w) { return (f32x2){bflo(w), bfhi(w)}; }
__device__ __forceinline__ f32x2 w16(int k) {
    constexpr float c1 = 0.9238795325112867f, s1 = 0.3826834323650898f, r2 = 0.7071067811865476f;
    switch (k) { case 0: return (f32x2){1.f, 0.f}; case 1: return (f32x2){c1, -s1}; case 2: return (f32x2){r2, -r2}; case 3: return (f32x2){s1, -c1};
                 case 4: return (f32x2){0.f, -1.f}; case 5: return (f32x2){-s1, -c1}; case 6: return (f32x2){-r2, -r2}; default: return (f32x2){-c1, -s1}; }
}
__device__ __forceinline__ void fwd16(LAS f32x2* buf, int base, int j0, int n) {
    const int st = n >> 4; f32x2 v[16];
#pragma unroll
    for (int m = 0; m < 16; ++m) v[m] = buf[cidx(base + j0 + m * st)];
    f32x2 w[4]; w[0] = twid((float)j0 / (float)n); w[1] = cmul(w[0], w[0]); w[2] = cmul(w[1], w[1]); w[3] = cmul(w[2], w[2]);
#pragma unroll
    for (int q = 0; q < 4; ++q) { const int span = 8 >> q;
#pragma unroll
        for (int m = 0; m < 16; ++m) if (((m / span) & 1) == 0) { const int mp = m % span;
            const f32x2 a = v[m], b = v[m + span], d = a - b; v[m] = a + b;
            v[m + span] = (mp == 0) ? cmul(d, w[q]) : cmul(cmul(d, w16(mp << q)), w[q]); } }
#pragma unroll
    for (int m = 0; m < 16; ++m) buf[cidx(base + j0 + m * st)] = v[m];
}
__device__ __forceinline__ void inv16(LAS f32x2* buf, int base, int j0, int nlo) {
    f32x2 v[16];
#pragma unroll
    for (int m = 0; m < 16; ++m) v[m] = buf[cidx(base + j0 + m * nlo)];
    f32x2 pw[4]; pw[3] = twid((float)j0 / (float)(nlo * 16)); pw[2] = cmul(pw[3], pw[3]); pw[1] = cmul(pw[2], pw[2]); pw[0] = cmul(pw[1], pw[1]);
#pragma unroll
    for (int q = 0; q < 4; ++q) { const int span = 1 << q;
#pragma unroll
        for (int m = 0; m < 16; ++m) if (((m / span) & 1) == 0) { const int mp = m % span;
            const f32x2 a = v[m]; f32x2 b = cmulc(v[m + span], pw[q]); if (mp != 0) b = cmulc(b, w16(mp << (3 - q)));
            v[m] = a + b; v[m + span] = a - b; } }
#pragma unroll
    for (int m = 0; m < 16; ++m) buf[cidx(base + j0 + m * nlo)] = v[m];
}
__device__ __forceinline__ void fwd4_last(LAS f32x2* buf, int base) {
    f32x2 a = buf[cidx(base)], b = buf[cidx(base + 1)], c = buf[cidx(base + 2)], d = buf[cidx(base + 3)];
    const f32x2 s0 = a + c, d0 = a - c, s1 = b + d, t = b - d; const f32x2 d1 = (f32x2){t.y, -t.x};
    buf[cidx(base)] = s0 + s1; buf[cidx(base + 1)] = s0 - s1; buf[cidx(base + 2)] = d0 + d1; buf[cidx(base + 3)] = d0 - d1;
}
__device__ __forceinline__ void inv4_first(LAS f32x2* buf, int base) {
    f32x2 a = buf[cidx(base)], b = buf[cidx(base + 1)], c = buf[cidx(base + 2)], d = buf[cidx(base + 3)];
    const f32x2 s0 = a + b, d0 = a - b, s1 = c + d, t = c - d; const f32x2 d1 = (f32x2){-t.y, t.x};
    buf[cidx(base)] = s0 + s1; buf[cidx(base + 2)] = s0 - s1; buf[cidx(base + 1)] = d0 + d1; buf[cidx(base + 3)] = d0 - d1;
}
__device__ __forceinline__ void fft_fwd(LAS f32x2* buf, int tid) {
#pragma unroll 1
    for (int k = 0; k < 2; ++k) { const int bf = tid + 512 * k; fwd16(buf, 0, bf, 16384); }
    __syncthreads();
#pragma unroll 1
    for (int k = 0; k < 2; ++k) { const int bf = tid + 512 * k; fwd16(buf, (bf >> 6) * 1024, bf & 63, 1024); }
    __syncthreads();
#pragma unroll 1
    for (int k = 0; k < 2; ++k) { const int bf = tid + 512 * k; fwd16(buf, (bf >> 2) * 64, bf & 3, 64); }
    __syncthreads();
#pragma unroll 1
    for (int k = 0; k < 8; ++k) { const int bf = tid + 512 * k; fwd4_last(buf, 4 * bf); }
    __syncthreads();
}
__device__ __forceinline__ void fft_inv(LAS f32x2* buf, int tid) {
#pragma unroll 1
    for (int k = 0; k < 8; ++k) { const int bf = tid + 512 * k; inv4_first(buf, 4 * bf); }
    __syncthreads();
#pragma unroll 1
    for (int k = 0; k < 2; ++k) { const int bf = tid + 512 * k; inv16(buf, (bf >> 2) * 64, bf & 3, 4); }
    __syncthreads();
#pragma unroll 1
    for (int k = 0; k < 2; ++k) { const int bf = tid + 512 * k; inv16(buf, (bf >> 6) * 1024, bf & 63, 64); }
    __syncthreads();
#pragma unroll 1
    for (int k = 0; k < 2; ++k) { const int bf = tid + 512 * k; inv16(buf, 0, bf, 1024); }
    __syncthreads();
}
__device__ __forceinline__ void fft_fwd_pack(LAS f32x2* buf, int tid, GAS v4u* slot) {
#pragma unroll 1
    for (int k = 0; k < 2; ++k) { const int bf = tid + 512 * k; fwd16(buf, 0, bf, 16384); }
    __syncthreads();
#pragma unroll 1
    for (int k = 0; k < 2; ++k) { const int bf = tid + 512 * k; fwd16(buf, (bf >> 6) * 1024, bf & 63, 1024); }
    __syncthreads();
#pragma unroll 1
    for (int k = 0; k < 2; ++k) { const int bf = tid + 512 * k; fwd16(buf, (bf >> 2) * 64, bf & 3, 64); }
    __syncthreads();
#pragma unroll
    for (int k = 0; k < 8; ++k) { const int p = cidx(4 * (tid + 512 * k));
        const f32x2 a = buf[p], b = buf[p + 1], c = buf[p + 2], d = buf[p + 3];
        const f32x2 s0 = a + c, d0 = a - c, s1 = b + d, t = b - d; const f32x2 d1 = (f32x2){t.y, -t.x};
        slot[512 * k] = (v4u){cpack(s0 + s1), cpack(s0 - s1), cpack(d0 + d1), cpack(d0 - d1)}; if (k & 1) __builtin_amdgcn_sched_barrier(0); }
}
__device__ __forceinline__ void fft_conv(LAS f32x2* buf, int tid, const GAS v4u* slot) {
#pragma unroll 1
    for (int k = 0; k < 2; ++k) { const int bf = tid + 512 * k; fwd16(buf, 0, bf, 16384); }
    __syncthreads();
#pragma unroll 1
    for (int k = 0; k < 2; ++k) { const int bf = tid + 512 * k; fwd16(buf, (bf >> 6) * 1024, bf & 63, 1024); }
    __syncthreads();
    v4u spv[8];
#pragma unroll
    for (int k = 0; k < 8; ++k) spv[k] = slot[512 * k];
    __builtin_amdgcn_sched_barrier(0);
#pragma unroll 1
    for (int k = 0; k < 2; ++k) { const int bf = tid + 512 * k; fwd16(buf, (bf >> 2) * 64, bf & 3, 64); }
    __syncthreads();
#pragma unroll
    for (int k = 0; k < 8; ++k) { const int p = cidx(4 * (tid + 512 * k)); const v4u sp = spv[k];
        f32x2 a = buf[p], b = buf[p + 1], c = buf[p + 2], d = buf[p + 3];
        { const f32x2 s0 = a + c, d0 = a - c, s1 = b + d, t = b - d; const f32x2 d1 = (f32x2){t.y, -t.x};
          a = cmul(s0 + s1, cunpack(sp[0])); b = cmul(s0 - s1, cunpack(sp[1])); c = cmul(d0 + d1, cunpack(sp[2])); d = cmul(d0 - d1, cunpack(sp[3])); }
        { const f32x2 s0 = a + b, d0 = a - b, s1 = c + d, t = c - d; const f32x2 d1 = (f32x2){-t.y, t.x};
          buf[p] = s0 + s1; buf[p + 2] = s0 - s1; buf[p + 1] = d0 + d1; buf[p + 3] = d0 - d1; } if (k & 1) __builtin_amdgcn_sched_barrier(0); }
    __syncthreads();
#pragma unroll 1
    for (int k = 0; k < 2; ++k) { const int bf = tid + 512 * k; inv16(buf, (bf >> 2) * 64, bf & 3, 4); }
    __syncthreads();
#pragma unroll 1
    for (int k = 0; k < 2; ++k) { const int bf = tid + 512 * k; inv16(buf, (bf >> 6) * 1024, bf & 63, 64); }
    __syncthreads();
#pragma unroll 1
    for (int k = 0; k < 2; ++k) { const int bf = tid + 512 * k; inv16(buf, 0, bf, 1024); }
    __syncthreads();
}
__device__ __forceinline__ float conv3_at(const bf16* P, int t, int T, float w0, float w1, float w2, float cb) {
    const int tm = t > 0 ? t - 1 : 0, tp = t < T - 1 ? t + 1 : T - 1;
    const float vm = bf1(P[tm]), v0 = bf1(P[t]), vp = bf1(P[tp]);
    const float pm = t > 0 ? vm : 0.f, pp = t < T - 1 ? vp : 0.f;
    return w0 * pm + w1 * v0 + w2 * pp + cb;
}
__device__ __forceinline__ float wave_sum_t(float v, int tid) {
#pragma unroll
    for (int m = 1; m < 64; m <<= 1) v += __builtin_bit_cast(float, __builtin_amdgcn_ds_bpermute(((tid ^ m) & 63) << 2, __builtin_bit_cast(int, v)));
    return v;
}
__device__ __forceinline__ float block_sum(float v, LAS float* red, int wave, int lane, int tid) {
    v = wave_sum_t(v, tid);
    __syncthreads();
    if (lane == 0) red[wave] = v;
    __syncthreads();
    float s = 0.f;
#pragma unroll
    for (int w = 0; w < 8; ++w) s += red[w];
    return s;
}

__device__ __forceinline__ void hyena_unit(const Args& A, const Ctx& C, int l_, int c_, bool with_ctx) {
    const int l = __builtin_amdgcn_readfirstlane(l_), c0 = __builtin_amdgcn_readfirstlane(c_);
#define OPQC() int c = c0; asm volatile("" : "+s"(c))
    OPQC();
    unsigned char* ws = A.ws;
    LAS f32x2* buf = (LAS f32x2*)C.lds;
    LAS float* sW = (LAS float*)(C.lds + HYS_OFF);
    LAS float* red = sW + 256;
    const int tid0 = C.tid;
#define OPQ() int tid = tid0; asm volatile("" : "+v"(tid))
    const bf16* HYT = (const bf16*)(ws + WS_R1);
    const bf16* HYTC = (const bf16*)(ws + WS_HYTC);
    bf16* YT = (bf16*)(ws + WS_YHYT);
#define SZ ((GAS v4u*)(ws + WS_HSCR) + (size_t)blockIdx.x * 8192 + tid)
#define SA (SZ + 4096)
#define SB ((GAS v4u*)(ws + WS_YHY) + (size_t)blockIdx.x * 4096 + tid)
#define SF ((GAS v4u*)(ws + WS_YHY) + (size_t)(256 + blockIdx.x) * 4096 + tid)
    __syncthreads();
    { OPQ(); if (tid < 256) { const int od = tid >> 6, j = tid & 63; sW[tid] = A.hy_w3[((size_t)l * 64 + j) * 2048 + od * 512 + c]; } }
    __syncthreads();
#define HY_CW(X, k) (A.hy_conv_w[((size_t)l * 3 + (k)) * 1536 + (X) * 512 + c])
#define HY_CB(X) (A.hy_conv_b[l * 1536 + (X) * 512 + c])
#define HY_CONV4(u, P, t0, w0, w1, w2, wb) do { const v2u w_ = *(const GAS v2u*)((P) + (t0)); const int tl_ = (t0) > 0 ? (t0) - 1 : 0, tr_ = (t0) + 4 < L ? (t0) + 4 : L - 1; \
        const float xl_ = (t0) > 0 ? bf1((P)[tl_]) : 0.f, xr_ = (t0) + 4 < L ? bf1((P)[tr_]) : 0.f, x0_ = bflo(w_.x), x1_ = bfhi(w_.x), x2_ = bflo(w_.y), x3_ = bfhi(w_.y); \
        u[0] = (w0) * xl_ + (w1) * x0_ + (w2) * x1_ + (wb); u[1] = (w0) * x0_ + (w1) * x1_ + (w2) * x2_ + (wb); u[2] = (w0) * x1_ + (w1) * x2_ + (w2) * x3_ + (wb); u[3] = (w0) * x2_ + (w1) * x3_ + (w2) * xr_ + (wb); } while (0)
#define HY_RAW(P, t0, W, XL, XR) do { W = *(const GAS v2u*)((P) + (t0)); XL = (P)[(t0) > 0 ? (t0) - 1 : 0]; XR = (P)[(t0) + 4 < L ? (t0) + 4 : L - 1]; } while (0)
#define HY_CALC(u, W, XL, XR, t0, w0, w1, w2, wb) do { const float xl_ = (t0) > 0 ? bf1(XL) : 0.f, xr_ = (t0) + 4 < L ? bf1(XR) : 0.f, x0_ = bflo(W.x), x1_ = bfhi(W.x), x2_ = bflo(W.y), x3_ = bfhi(W.y); \
        u[0] = (w0) * xl_ + (w1) * x0_ + (w2) * x1_ + (wb); u[1] = (w0) * x0_ + (w1) * x1_ + (w2) * x2_ + (wb); u[2] = (w0) * x1_ + (w1) * x2_ + (w2) * x3_ + (wb); u[3] = (w0) * x2_ + (w1) * x3_ + (w2) * xr_ + (wb); } while (0)
    float inv0, inv1;
    {
        OPQ();
        const int lane = tid & 63, wv = __builtin_amdgcn_readfirstlane(tid >> 6), col = lane & 15, kg = lane >> 4;
        const float dec0 = fabsf(A.hy_decay[((size_t)l * 2 + 0) * 512 + c]), dec1 = fabsf(A.hy_decay[((size_t)l * 2 + 1) * 512 + c]);
        bf16x8 af[2];
#pragma unroll
        for (int s2 = 0; s2 < 2; ++s2)
#pragma unroll
            for (int jj = 0; jj < 8; ++jj) { const int j = 32 * s2 + 8 * kg + jj; const float w = A.hy_w3[((size_t)l * 64 + j) * 2048 + (col & 3) * 512 + c]; af[s2][jj] = (short)f2bf(col < 4 ? w : 0.f); }
        const bf16* H2T = (const bf16*)(ws + WS_H2) + (size_t)l * L * 64;
        GAS unsigned* SFF = (GAS unsigned*)((GAS v4u*)(ws + WS_YHY) + (size_t)(256 + blockIdx.x) * 4096);
        float as0 = 0.f, as1 = 0.f;
#define HYF_LOAD(B, bt) { _Pragma("unroll") for (int i = 0; i < 8; ++i) { const int t = 2048 * wv + 16 * (8 * (bt) + i) + col; \
            B[i][0] = *(const GAS bf16x8*)(H2T + (size_t)t * 64 + 8 * kg); B[i][1] = *(const GAS bf16x8*)(H2T + (size_t)t * 64 + 32 + 8 * kg); } }
#define HYF_USE(B, bt) { _Pragma("unroll") for (int i = 0; i < 8; ++i) { const int t = 2048 * wv + 16 * (8 * (bt) + i) + col; \
            f32x4 acc = (f32x4){0.f, 0.f, 0.f, 0.f}; \
            acc = __builtin_amdgcn_mfma_f32_16x16x32_bf16(af[0], B[i][0], acc, 0, 0, 0); \
            acc = __builtin_amdgcn_mfma_f32_16x16x32_bf16(af[1], B[i][1], acc, 0, 0, 0); \
            if (kg == 0) { const float tl = (float)t * (1.0f / (float)(L - 1)); const float w0 = __expf(-tl * dec0), w1 = __expf(-tl * dec1); \
                const float h0 = acc[0] * w0, h1 = acc[1] * w0, h2 = acc[2] * w1, h3 = acc[3] * w1; \
                as0 += fabsf(h0) + fabsf(h1); as1 += fabsf(h2) + fabsf(h3); \
                buf[cidx(t)] = (f32x2){h0, h1}; SFF[t] = pk2(h2, h3); } } }
        bf16x8 fa_[8][2], fb_[8][2];
        HYF_LOAD(fa_, 0)
#pragma unroll 1
        for (int bt = 0; bt < 16; bt += 2) {
            HYF_LOAD(fb_, bt + 1)
            HYF_USE(fa_, bt)
            if (bt + 2 < 16) HYF_LOAD(fa_, bt + 2)
            HYF_USE(fb_, bt + 1)
        }
#undef HYF_LOAD
#undef HYF_USE
        inv0 = 1.0f / block_sum(as0, red, C.wave, C.lane, tid);
        inv1 = 1.0f / block_sum(as1, red, C.wave, C.lane, tid);
        __syncthreads();
    }
    {
        OPQ();
        const float v0 = HY_CW(0, 0), v1 = HY_CW(0, 1), v2 = HY_CW(0, 2), vb = HY_CB(0);
        v2u ra[8], rb[8]; bf16 la[8], ha[8], lb[8], hb_[8];
#pragma unroll
        for (int g = 0; g < 8; ++g) { const int t0 = 2048 * g + 4 * tid; HY_RAW(HYT + ((size_t)(0 * 1536 + c)) * L, t0, ra[g], la[g], ha[g]); HY_RAW(HYT + ((size_t)(1 * 1536 + c)) * L, t0, rb[g], lb[g], hb_[g]); }
#pragma unroll
        for (int g = 0; g < 8; ++g) { const int t0 = 2048 * g + 4 * tid; float ua[4], ub[4];
            HY_CALC(ua, ra[g], la[g], ha[g], t0, v0, v1, v2, vb); HY_CALC(ub, rb[g], lb[g], hb_[g], t0, v0, v1, v2, vb);
            SZ[512 * g] = (v4u){pk2(ua[0], ub[0]), pk2(ua[1], ub[1]), pk2(ua[2], ub[2]), pk2(ua[3], ub[3])}; }
    }
#pragma unroll 1
    for (int o = 0; o < 2; ++o) {
        OPQC();
        const float bias = __builtin_bit_cast(float, __builtin_amdgcn_readfirstlane(__builtin_bit_cast(int, A.hy_bias[((size_t)l * 2 + o) * 512 + c])));
        if (o == 1) {
            OPQ();
            const GAS v4u* sf4 = (const GAS v4u*)((GAS v4u*)(ws + WS_YHY) + (size_t)(256 + blockIdx.x) * 4096);
#pragma unroll
            for (int g = 0; g < 8; ++g) { const v4u w = sf4[512 * g + tid]; const int p = cidx(2048 * g + 4 * tid);
#pragma unroll
                for (int k = 0; k < 4; ++k) buf[p + k] = cunpack(w[k]); }
            __syncthreads();
        }
        {
            OPQ();
            f32x2 zs[32];
            const float invo = o ? inv1 : inv0;
#pragma unroll
            for (int g = 0; g < 8; ++g)
#pragma unroll
                for (int k = 0; k < 4; ++k) { const int n = 2048 * g + 4 * tid + k;
                    if (g < 4) { zs[g * 4 + k] = (f32x2){buf[cidx(2 * n)].x * invo, buf[cidx(2 * n + 1)].x * invo}; }
                    else { const int m = 2 * L - 2 * n; const int mc = m < L ? m : L - 1; const float re = buf[cidx(mc)].y; zs[g * 4 + k] = (f32x2){m < L ? re * invo : 0.f, buf[cidx(m - 1)].y * invo}; } }
            __syncthreads();
#pragma unroll
            for (int g = 0; g < 8; ++g) { const int p = cidx(2048 * g + 4 * tid);
#pragma unroll
                for (int k = 0; k < 4; ++k) buf[p + k] = zs[g * 4 + k]; }
            __syncthreads();
        }
        v4u zv[8];
        { OPQ(); fft_fwd(buf, tid);
#pragma unroll
          for (int g = 0; g < 8; ++g) zv[g] = SZ[512 * g];
          const f32x2 w1c = twid(1.0f / (float)NFFT);
#pragma unroll
          for (int g = 0; g < 8; ++g) { v4u ke4, ko4;
#pragma unroll
              for (int k = 0; k < 4; ++k) { const int p = 2048 * g + 4 * tid + k; const int kp = (int)(__builtin_bitreverse32((unsigned)p) >> 18);
                  const int m0 = (2 * kp) & (L - 1); const bool neg = kp >= L / 2;
                  const int q0 = p >> 1, q1 = q0 + L / 2, q0c = (int)(__builtin_bitreverse32((unsigned)((L - m0) & (L - 1))) >> 18), q1c = L - 1 - q0;
                  const f32x2 a0 = buf[cidx(q0)], b0 = buf[cidx(q0c)], a1 = buf[cidx(q1)], b1 = buf[cidx(q1c)];
                  const f32x2 t0 = twid((float)m0 * (1.0f / (float)NFFT)), t1 = cmul(t0, w1c);
                  const f32x2 xe0 = (f32x2){0.5f * (a0.x + b0.x), 0.5f * (a0.y - b0.y)}, d0 = (f32x2){a0.x - b0.x, a0.y + b0.y}, xo0 = (f32x2){0.5f * d0.y, -0.5f * d0.x};
                  const f32x2 xe1 = (f32x2){0.5f * (a1.x + b1.x), 0.5f * (a1.y - b1.y)}, d1 = (f32x2){a1.x - b1.x, a1.y + b1.y}, xo1 = (f32x2){0.5f * d1.y, -0.5f * d1.x};
                  const f32x2 c0 = cmul(t0, xo0), c1 = cmul(t1, xo1);
                  const f32x2 v0 = neg ? xe0 - c0 : xe0 + c0, v1 = neg ? xe1 - c1 : xe1 + c1;
                  ke4[k] = cpack(v0); ko4[k] = cpack(v1); }
              SA[512 * g] = ke4; SB[512 * g] = ko4; __builtin_amdgcn_sched_barrier(0); }
          __syncthreads(); }
        { OPQ();
#pragma unroll
        for (int g = 0; g < 8; ++g) { const int p = cidx(2048 * g + 4 * tid); const v4u w = zv[g];
#pragma unroll
            for (int k = 0; k < 4; ++k) buf[p + k] = cunpack(w[k]); }
        __syncthreads();
        fft_conv(buf, tid, SA); }
        { OPQ();
#pragma unroll
        for (int g = 0; g < 8; ++g) zv[g] = SZ[512 * g];
#pragma unroll
        for (int g = 0; g < 8; ++g) { const int p = cidx(2048 * g + 4 * tid); v4u w;
#pragma unroll
            for (int k = 0; k < 4; ++k) { const f32x2 y = buf[p + k]; w[k] = pk2(y.x * (1.0f / (float)NFFT), y.y * (1.0f / (float)NFFT)); }
            SA[512 * g] = w; }
        __syncthreads(); }
        { OPQ();
#pragma unroll
        for (int g = 0; g < 8; ++g) { const int t0 = 2048 * g + 4 * tid, p = cidx(t0); const v4u w = zv[g];
#pragma unroll
            for (int k = 0; k < 4; ++k) buf[p + k] = cmul(cunpack(w[k]), twid((float)(t0 + k) * (1.0f / (float)NFFT))); }
        __syncthreads();
        fft_conv(buf, tid, SB); }
        const int X = o + 1; const float q0 = HY_CW(X, 0), q1 = HY_CW(X, 1), q2 = HY_CW(X, 2), qb = HY_CB(X);
        { OPQ();
        v4u wyv[8], wzv[8]; v2u ra[8], rb[8]; bf16 la[8], ha[8], lb[8], hb_[8];
#pragma unroll
        for (int g = 0; g < 8; ++g) { const int t0 = 2048 * g + 4 * tid; wyv[g] = SA[512 * g]; wzv[g] = SZ[512 * g];
            HY_RAW(HYT + ((size_t)(0 * 1536 + X * 512 + c)) * L, t0, ra[g], la[g], ha[g]); HY_RAW(HYT + ((size_t)(1 * 1536 + X * 512 + c)) * L, t0, rb[g], lb[g], hb_[g]); }
#pragma unroll
        for (int g = 0; g < 8; ++g) { const int t0 = 2048 * g + 4 * tid, p = cidx(t0); const v4u wy = wyv[g], wz = wzv[g];
            float ga[4], gb[4]; HY_CALC(ga, ra[g], la[g], ha[g], t0, q0, q1, q2, qb); HY_CALC(gb, rb[g], lb[g], hb_[g], t0, q0, q1, q2, qb);
            float oa[4], ob[4];
#pragma unroll
            for (int k = 0; k < 4; ++k) { const f32x2 yo = cmulc(buf[p + k], twid((float)(t0 + k) * (1.0f / (float)NFFT)));
                const f32x2 yev = cunpack(wy[k]), z = cunpack(wz[k]);
                float y0 = yev.x + yo.x * (1.0f / (float)NFFT) + bias * z.x, y1 = yev.y + yo.y * (1.0f / (float)NFFT) + bias * z.y;
                if (ABL & 16) { y0 = bias * z.x; y1 = bias * z.y; }
                oa[k] = ga[k] * y0; ob[k] = gb[k] * y1; }
            if (g == 3) asm volatile("" ::: "memory");
            if (o == 0) SZ[512 * g] = (v4u){pk2(oa[0], ob[0]), pk2(oa[1], ob[1]), pk2(oa[2], ob[2]), pk2(oa[3], ob[3])};
            else { *(GAS v2u*)(YT + ((size_t)(0 * 512 + c)) * L + t0) = (v2u){pk2(oa[0], oa[1]), pk2(oa[2], oa[3])}; *(GAS v2u*)(YT + ((size_t)(1 * 512 + c)) * L + t0) = (v2u){pk2(ob[0], ob[1]), pk2(ob[2], ob[3])}; } } }
        __syncthreads();
    }
    if (with_ctx) {
        OPQ(); OPQC();
        const float v0 = HY_CW(0, 0), v1 = HY_CW(0, 1), v2 = HY_CW(0, 2), vb = HY_CB(0);
        LAS float* F = (LAS float*)C.lds;
        LAS float* Z = F + 1024;
        const float* H2C = (const float*)(ws + WS_H2C) + (size_t)l * 64 * CTX_LEN;
        const int b = tid >> 8, t = tid & 255;
        __syncthreads();
        {
            const int o = b; float f0 = 0.f, f1 = 0.f;
            for (int j = 0; j < 64; ++j) { const float h = H2C[j * CTX_LEN + t]; f0 += h * sW[(o * 2 + 0) * 64 + j]; f1 += h * sW[(o * 2 + 1) * 64 + j]; }
            const float decay = fabsf(A.hy_decay[((size_t)l * 2 + o) * 512 + c]);
            const float win = __expf(-((float)t * (1.0f / (float)(CTX_LEN - 1))) * decay); f0 *= win; f1 *= win;
            float s = wave_sum_t(fabsf(f0) + fabsf(f1), tid);
            __syncthreads();
            if (C.lane == 0) red[C.wave] = s;
            __syncthreads();
            const int w0 = (C.wave >> 2) * 4; const float tot = red[w0] + red[w0 + 1] + red[w0 + 2] + red[w0 + 3];
            F[(o * 2 + 0) * 256 + t] = f0 / tot; F[(o * 2 + 1) * 256 + t] = f1 / tot;
        }
        float z = conv3_at(HYTC + ((size_t)(b * 1536 + c)) * CTX_LEN, t, CTX_LEN, v0, v1, v2, vb);
#pragma unroll 1
        for (int o = 0; o < 2; ++o) {
            const float bias = A.hy_bias[((size_t)l * 2 + o) * 512 + c];
            __syncthreads();
            Z[b * 256 + t] = z;
            __syncthreads();
            float y = 0.f; const LAS float* hfp = F + (o * 2 + 0) * 256; const LAS float* hbp = F + (o * 2 + 1) * 256; const LAS float* zp = Z + b * 256;
            for (int s = 0; s <= t; ++s) y += hfp[t - s] * zp[s];
            for (int s = t + 1; s < 256; ++s) y += hbp[s - t] * zp[s];
            y += bias * z;
            const int X = o + 1; const float q0 = HY_CW(X, 0), q1 = HY_CW(X, 1), q2 = HY_CW(X, 2), qb = HY_CB(X);
            const float g = conv3_at(HYTC + ((size_t)(b * 1536 + X * 512 + c)) * CTX_LEN, t, CTX_LEN, q0, q1, q2, qb);
            z = g * y;
        }
        YT[(size_t)BATCH * 512 * L + ((size_t)(b * 512 + c)) * CTX_LEN + t] = (bf16)f2bf(z);
        __syncthreads();
    }
}
#undef OPQ
#undef OPQC
#undef SZ
#undef SA
#undef SB
#undef SF
#undef HY_CONV4
#undef HY_RAW
#undef HY_CALC
#undef HY_CW
#undef HY_CB
}

#ifdef SELFCHECK
namespace chk {
constexpr size_t WS_DBG = 504 * MiB;
constexpr int NCHK = 24;
__device__ __forceinline__ unsigned hsh(unsigned x) { x ^= x >> 16; x *= 0x7feb352dU; x ^= x >> 15; x *= 0x846ca68bU; x ^= x >> 16; return x; }
__device__ __forceinline__ void acc_err(unsigned char* ws, int id, float got, float ref) {
    float* a = (float*)(ws + WS_DBG) + id * 2; const float d = got - ref;
    atomicAdd(a, d * d); atomicAdd(a + 1, ref * ref);
}
__device__ __forceinline__ float dot_bf_f32col(const bf16* arow, const float* W, int K, int N, int col, int lane) {
    float s = 0.f; for (int k = lane; k < K; k += 64) s += bf1(arow[k]) * W[(size_t)k * N + col]; return wave_sum(s);
}
__device__ __forceinline__ void c_norm(const Args& A, const Ctx& C, const float* xlat, const float* xctx, const float* g, const float* mod, int shi, const bf16* XN, int id) {
    const int gw = C.vcu * NWAVES + C.wave;
    if (gw < 96) { const int r = (gw < 64) ? (int)(hsh(gw * 7 + 1) % ML) : ML + (int)(hsh(gw) % MC);
        const float* xr = r < ML ? xlat + (size_t)r * 1024 : xctx + (size_t)(r - ML) * 1024; const float* mp = mod + (r < ML ? (r >> 14) : 2) * 6144 + shi * 1024;
        float s = 0.f; for (int k = C.lane; k < 1024; k += 64) s += xr[k] * xr[k]; s = wave_sum(s); const float rstd = 1.0f / sqrtf(s / 1024.f + EPS);
        for (int k = C.lane; k < 1024; k += 64) acc_err(A.ws, id, bf1(XN[(size_t)r * 1024 + k]), xr[k] * rstd * g[k] * (1.f + mp[1024 + k]) + mp[k]); }
}
__device__ __forceinline__ void c_mod(const Args& A, const Ctx& C, int id) {
    const int gw = C.vcu * NWAVES + C.wave;
    if (gw < 128) { const int l = gw & 1, w = (gw >> 1) % 3, n = (int)(hsh(gw + 77) % 6144);
        float s = 0.f; for (int k = C.lane; k < 1024; k += 64) { const float cv = (w < 2) ? A.c[w * 1024 + k] : A.c_ctx[k]; s += (cv / (1.f + expf(-cv))) * A.w_mod[((size_t)l * 1024 + k) * 6144 + n]; }
        s = wave_sum(s) + A.b_mod[l * 6144 + n];
        if (C.lane == 0) acc_err(A.ws, id, ((const float*)(A.ws + WS_MOD))[(l * 3 + w) * 6144 + n], s); }
}
__device__ __forceinline__ void c_proj(const Args& A, const Ctx& C, int l, int id0) {
    const int gw = C.vcu * NWAVES + C.wave, lane = C.lane; unsigned char* ws = A.ws;
    const bf16* XN = (const bf16*)(ws + WS_XN); const float* W = A.w_in + (size_t)l * 1024 * IN_W;
    const unsigned h0 = hsh(gw * 31 + 5);
    const int r = (gw & 7) == 7 ? ML + (int)(h0 % MC) : (int)(h0 % ML);
    const bf16* xr = XN + (size_t)r * 1024;
    const bool latent = r < ML; const int t = r & 16383;
    const int kvrow = latent ? ((r >> 14) * KVL + 256 + t) : (((r - ML) >> 8) * KVL + ((r - ML) & 255));
    const int kind = (gw >> 3) % 6;
    if (kind == 0) { const int ch = (int)(hsh(h0) % 512); const float p = dot_bf_f32col(xr, W, 1024, IN_W, SC0 + ch, lane);
        if (lane == 0) acc_err(ws, id0 + 0, bf1(((const bf16*)(ws + WS_BG))[(size_t)r * 512 + ch]), p); }
    else if (kind == 1) { const int ch = (int)(hsh(h0) % 512); const float p1 = dot_bf_f32col(xr, W, 1024, IN_W, SC0 + 512 + ch, lane), p2 = dot_bf_f32col(xr, W, 1024, IN_W, SC0 + 1024 + ch, lane);
        if (lane == 0) acc_err(ws, id0 + 1, bf1(((const bf16*)(ws + WS_CX))[(size_t)r * 512 + ch]), p1 * p2); }
    else if (kind == 2) { const int d = (int)(hsh(h0) % 128); const float p = dot_bf_f32col(xr, W, 1024, IN_W, V0 + d, lane);
        if (lane == 0) acc_err(ws, id0 + 2, bf1(((const bf16*)(ws + WS_V))[(size_t)kvrow * 128 + d]), p); }
    else if (kind == 3) { const int ch = (int)(hsh(h0) % 1536); const float p = dot_bf_f32col(xr, W, 1024, IN_W, HY0 + ch, lane);
        const bf16* HY = latent ? (const bf16*)(ws + WS_R1) + ((size_t)((r >> 14) * 1536 + ch)) * SEQ + t : (const bf16*)(ws + WS_HYTC) + ((size_t)(((r - ML) >> 8) * 1536 + ch)) * CTX_LEN + ((r - ML) & 255);
        if (lane == 0) acc_err(ws, id0 + 3, bf1(*HY), p); }
    else {
        const bool isq = kind == 4; const int head = isq ? (int)(hsh(h0) % 8) : (int)(hsh(h0) % 2);
        const float* gain = (isq ? A.q_gain : A.k_gain) + l * 64;
        const float v = dot_bf_f32col(xr, W, 1024, IN_W, (isq ? Q0 : K0) + head * 64 + 0, lane);
        (void)v;
        float mine = 0.f;
        for (int d = 0; d < 64; ++d) { const float p = dot_bf_f32col(xr, W, 1024, IN_W, (isq ? Q0 : K0) + head * 64 + d, lane); if (lane == d) mine = p; }
        const float ss = wave_sum(mine * mine); float y = mine / sqrtf(ss / 64.f + EPS) * gain[lane];
        if (latent) { const int half = lane >> 5, dd = lane & 31, f = dd & 15; const bool second = dd >= 16;
            const float pos = (float)(half ? (t & 63) : (t >> 6)), ang = pos * powf(10000.f, -(float)f / 16.f);
            const float other = __shfl(y, lane ^ 16);
            y = second ? (y * cosf(ang) + other * sinf(ang)) : (y * cosf(ang) - other * sinf(ang)); }
        if (isq) y *= C2Q;
        const int bj = lane >> 5, n = (lane >> 4) & 1, fq = (lane >> 2) & 3, e = lane & 3, j = 32 * bj + 8 * fq + 4 * n + e;
        const float got = isq ? bf1(((const bf16*)(ws + WS_Q))[(size_t)r * 512 + head * 64 + j]) : bf1(((const bf16*)(ws + WS_K))[(size_t)kvrow * 128 + head * 64 + j]);
        acc_err(ws, id0 + (isq ? 4 : 5), got, y); }
}
__device__ __forceinline__ float hy_u(const Args& A, int l, int b, int X, int c, int t) {
    const bf16* P = (const bf16*)(A.ws + WS_R1) + ((size_t)(b * 1536 + X * 512 + c)) * SEQ;
    const float w0 = A.hy_conv_w[((size_t)l * 3 + 0) * 1536 + X * 512 + c], w1 = A.hy_conv_w[((size_t)l * 3 + 1) * 1536 + X * 512 + c], w2 = A.hy_conv_w[((size_t)l * 3 + 2) * 1536 + X * 512 + c];
    return w0 * (t > 0 ? bf1(P[t - 1]) : 0.f) + w1 * bf1(P[t]) + w2 * (t < SEQ - 1 ? bf1(P[t + 1]) : 0.f) + A.hy_conv_b[l * 1536 + X * 512 + c];
}
__device__ __forceinline__ void c_hy1(const Args& A, const Ctx& C, int l, int c) {
    float* F = (float*)(A.ws + WS_DBG + 65536); float* ABS = (float*)(A.ws + WS_DBG + 8192);
    const float* H2 = (const float*)(A.ws + WS_H2) + (size_t)l * 64 * SEQ;
    for (int i = C.vcu * NTHREADS + C.tid; i < 4 * SEQ; i += C.G * NTHREADS) { const int od = i >> 14, t = i & 16383, o = od >> 1;
        float s = 0.f; for (int j = 0; j < 64; ++j) s += H2[(size_t)j * SEQ + t] * A.hy_w3[((size_t)l * 64 + j) * 2048 + od * 512 + c];
        s *= expf(-((float)t / (float)(SEQ - 1)) * fabsf(A.hy_decay[((size_t)l * 2 + o) * 512 + c]));
        F[i] = s; atomicAdd(ABS + o, fabsf(s)); }
}
__device__ __forceinline__ float hy_conv(const float* hf, const float* hb, float inv, const float* z, int t, int lane) {
    float s = 0.f; for (int q = lane; q < SEQ; q += 64) s += (q <= t ? hf[t - q] : hb[q - t]) * z[q]; return wave_sum(s) * inv;
}
__device__ __forceinline__ void c_hy2(const Args& A, const Ctx& C, int l, int b, int c) {
    float* F = (float*)(A.ws + WS_DBG + 65536); float* ABS = (float*)(A.ws + WS_DBG + 8192); float* Z1 = F + 4 * SEQ; float* Z2 = Z1 + SEQ;
    for (int i = C.vcu * NTHREADS + C.tid; i < SEQ; i += C.G * NTHREADS) Z1[i] = hy_u(A, l, b, 0, c, i);
}
__device__ __forceinline__ void c_hy3(const Args& A, const Ctx& C, int l, int b, int c) {
    float* F = (float*)(A.ws + WS_DBG + 65536); float* ABS = (float*)(A.ws + WS_DBG + 8192); float* Z1 = F + 4 * SEQ; float* Z2 = Z1 + SEQ;
    const int gw = C.vcu * NWAVES + C.wave, NGW = C.G * NWAVES; const float inv = 1.0f / ABS[0], b1 = A.hy_bias[((size_t)l * 2 + 0) * 512 + c];
    for (int s = gw; s < SEQ; s += NGW) { const float cv = hy_conv(F, F + SEQ, inv, Z1, s, C.lane); if (C.lane == 0) Z2[s] = hy_u(A, l, b, 1, c, s) * (cv + b1 * Z1[s]); }
}
__device__ __forceinline__ void c_hy4(const Args& A, const Ctx& C, int l, int b, int c, int id) {
    float* F = (float*)(A.ws + WS_DBG + 65536); float* ABS = (float*)(A.ws + WS_DBG + 8192); float* Z1 = F + 4 * SEQ; float* Z2 = Z1 + SEQ;
    const int gw = C.vcu * NWAVES + C.wave; const float inv = 1.0f / ABS[1], b2 = A.hy_bias[((size_t)l * 2 + 1) * 512 + c];
    if (gw < 256) { const int t = (gw < 4) ? (gw & 1 ? SEQ - 1 - (gw >> 1) : (gw >> 1)) : (int)(hsh(gw * 13 + 3) % SEQ);
        const float cv = hy_conv(F + 2 * SEQ, F + 3 * SEQ, inv, Z2, t, C.lane);
        const float y = hy_u(A, l, b, 2, c, t) * (cv + b2 * Z2[t]);
        if (C.lane == 0) acc_err(A.ws, id, bf1(((const bf16*)(A.ws + WS_YHYT))[((size_t)(b * 512 + c)) * SEQ + t]), y); }
}
__device__ __forceinline__ void c_ysc(const Args& A, const Ctx& C, int l, int id) {
    const int gw = C.vcu * NWAVES + C.wave, lane = C.lane; unsigned char* ws = A.ws;
    if (gw >= 256) return;
    const bf16* XN = (const bf16*)(ws + WS_XN); const float* W = A.w_in + (size_t)l * 1024 * IN_W;
    const unsigned h0 = hsh(gw * 17 + 9); int r = (int)(h0 % ML); if (gw < 4) r = (gw & 1) ? SEQ - 1 + (gw >> 1) : (gw >> 1) * SEQ;
    const int ch = (int)(hsh(h0) % 512), t = r & 16383;
    float cv = 0.f;
    for (int k = -1; k <= 1; ++k) { const int tt = t + k; if (tt < 0 || tt >= SEQ) continue; const bf16* xr = XN + (size_t)(r + k) * 1024;
        cv += A.sc_conv_w[((size_t)l * 3 + (k + 1)) * 512 + ch] * dot_bf_f32col(xr, W, 1024, IN_W, SC0 + 512 + ch, lane) * dot_bf_f32col(xr, W, 1024, IN_W, SC0 + 1024 + ch, lane); }
    const float bg = dot_bf_f32col(XN + (size_t)r * 1024, W, 1024, IN_W, SC0 + ch, lane);
    if (lane == 0) acc_err(ws, id, bf1(((const bf16*)(ws + WS_BG))[(size_t)r * 512 + ch]), bg * cv);
}
__device__ __forceinline__ void c_att_sample(int i, int& r, int& h) { const unsigned hh = hsh(i * 101 + 7); r = (i < 16) ? ML + (int)(hh % MC) : (int)(hh % ML); h = (int)(hsh(hh) % 8); }
__device__ __forceinline__ void c_att_save(const Args& A, const Ctx& C) {
    const int gw = C.vcu * NWAVES + C.wave; float* QS = (float*)(A.ws + WS_DBG + 1 * MiB);
    if (gw < 256) { int r, h; c_att_sample(gw, r, h); QS[gw * 64 + C.lane] = bf1(((const bf16*)(A.ws + WS_Q))[(size_t)r * 512 + h * 64 + C.lane]); }
}
__device__ __forceinline__ void c_att(const Args& A, const Ctx& C, int id) {
    const int gw = C.vcu * NWAVES + C.wave, lane = C.lane; const float* QS = (const float*)(A.ws + WS_DBG + 1 * MiB);
    if (gw >= 256) return;
    int r, h; c_att_sample(gw, r, h);
    const bool latent = r < ML; const int b = latent ? (r >> 14) : ((r - ML) >> 8); const int nk = latent ? KVL : CTX_LEN;
    const bf16* Kp = (const bf16*)(A.ws + WS_K) + (size_t)b * KVL * 128 + (h >> 2) * 64; const bf16* Vp = (const bf16*)(A.ws + WS_V) + (size_t)b * KVL * 128 + (h >> 2) * 64;
    const float q = QS[gw * 64 + lane];
    float m = -INFINITY, lsum = 0.f, o = 0.f;
    for (int k = 0; k < nk; ++k) { const float s = wave_sum(q * bf1(Kp[(size_t)k * 128 + lane]));
        const float mn = fmaxf(m, s), f = exp2f(m - mn), p = exp2f(s - mn); lsum = lsum * f + p; o = o * f + p * bf1(Vp[(size_t)k * 128 + lane]); m = mn; }
    acc_err(A.ws, id, bf1(((const bf16*)(A.ws + WS_Q))[(size_t)r * 512 + h * 64 + lane]), o / lsum);
}
__device__ __forceinline__ void c_gate(const Args& A, const Ctx& C, int l, int rowbase, int nr, int id) {
    const int gw = C.vcu * NWAVES + C.wave; if (gw >= 256) return;
    const unsigned h0 = hsh(gw * 23 + 11); const int rr = (int)(h0 % nr), col = (int)(hsh(h0) % 3072);
    const float p = dot_bf_f32col((const bf16*)(A.ws + WS_XN) + (size_t)(rowbase + rr) * 1024, A.w_in + (size_t)l * 1024 * IN_W, 1024, IN_W, GT0 + col, C.lane);
    if (C.lane == 0) { const float got = bf1(((const bf16*)(A.ws + WS_R1))[(size_t)rr * 3072 + col]), ref = 1.f / (1.f + expf(-p)); acc_err(A.ws, id, got, ref); }
}
__device__ __forceinline__ void c_wcopy(const Args& A, const Ctx& C, int l) {
    const int gw = C.vcu * NWAVES + C.wave; if (gw >= 512) return;
    const unsigned h0 = hsh(gw * 59 + 21); const bool hi = gw & 1; const int row = hi ? 3840 + (int)(h0 % 3072) : 2304 + (int)(h0 % 1536);
    const bf16* WT = (const bf16*)(A.ws + WS_WIN) + ((size_t)l * IN_W + row) * 1024;
    for (int k = C.lane; k < 1024; k += 64) acc_err(A.ws, hi ? 19 : 18, bf1(WT[k]), A.w_in[((size_t)l * 1024 + k) * IN_W + row]);
}
__device__ __forceinline__ void c_merge(const Args& A, const Ctx& C, int l, int rowbase, int nr, int id) {
    const int gw = C.vcu * NWAVES + C.wave; if (gw >= 256) return;
    const unsigned h0 = hsh(gw * 29 + 13); const int rr = (int)(h0 % nr), r = rowbase + rr, col = (int)(hsh(h0) % 1024);
    const bf16* G = (const bf16*)(A.ws + WS_R1) + (size_t)rr * 3072;
    const float a = dot_bf_f32col((const bf16*)(A.ws + WS_Q) + (size_t)r * 512, A.w_br_att + (size_t)l * 512 * 1024, 512, 1024, col, C.lane);
    const float s = dot_bf_f32col((const bf16*)(A.ws + WS_BG) + (size_t)r * 512, A.w_br_sc + (size_t)l * 512 * 1024, 512, 1024, col, C.lane);
    const float y = dot_bf_f32col((const bf16*)(A.ws + WS_YHY) + (size_t)r * 512, A.w_br_hy + (size_t)l * 512 * 1024, 512, 1024, col, C.lane);
    if (C.lane == 0) acc_err(A.ws, id, bf1(((const bf16*)(A.ws + WS_MM))[(size_t)r * 1024 + col]), bf1(G[col]) * a + bf1(G[1024 + col]) * s + bf1(G[2048 + col]) * y);
}
__device__ __forceinline__ void c_yhyT(const Args& A, const Ctx& C, int id) {
    const int gw = C.vcu * NWAVES + C.wave; if (gw >= 64) return;
    const unsigned h0 = hsh(gw * 37 + 1); const int r = (gw < 8) ? ML + (int)(h0 % MC) : (int)(h0 % ML), c = (int)(hsh(h0) % 512);
    const bf16* YT = (const bf16*)(A.ws + WS_YHYT);
    const float ref = r < ML ? bf1(YT[((size_t)((r >> 14) * 512 + c)) * SEQ + (r & 16383)]) : bf1(YT[(size_t)BATCH * 512 * SEQ + ((size_t)(((r - ML) >> 8) * 512 + c)) * CTX_LEN + ((r - ML) & 255)]);
    if (C.lane == 0) acc_err(A.ws, id, bf1(((const bf16*)(A.ws + WS_YHY))[(size_t)r * 512 + c]), ref);
}
__device__ __forceinline__ void c_wout(const Args& A, const Ctx& C, int l, int id) {
    const int gw = C.vcu * NWAVES + C.wave; if (gw >= 256) return;
    const unsigned h0 = hsh(gw * 41 + 3); const int r = (gw < 16) ? ML + (int)(h0 % MC) : (int)(h0 % ML), col = (int)(hsh(h0) % 1024);
    const float d = dot_bf_f32col((const bf16*)(A.ws + WS_MM) + (size_t)r * 1024, A.w_out + (size_t)l * 1024 * 1024, 1024, 1024, col, C.lane);
    const float* mod = (const float*)(A.ws + WS_MOD) + (size_t)l * 3 * 6144;
    const float xo = r < ML ? A.x[(size_t)r * 1024 + col] : A.ctx[(size_t)(r - ML) * 1024 + col], gt = mod[(r < ML ? (r >> 14) : 2) * 6144 + 2 * 1024 + col];
    const float got = r < ML ? A.out[(size_t)r * 1024 + col] : ((const float*)(A.ws + WS_CTXB))[(size_t)(r - ML) * 1024 + col];
    if (C.lane == 0) acc_err(A.ws, id, got, xo + gt * d);
}
__device__ __forceinline__ void c_scores(const Args& A, const Ctx& C, int l, int row0, int nr, int id) {
    const int gw = C.vcu * NWAVES + C.wave, lane = C.lane; if (gw >= 128) return;
    const unsigned h0 = hsh(gw * 43 + 5); const int rr = (int)(h0 % nr), hp = (int)(hsh(h0) % 16), n = (int)(hsh(h0 + 1) % 128);
    const bf16* xr = (const bf16*)(A.ws + WS_XN) + (size_t)(row0 + rr) * 1024;
    float qd = 0.f; for (int d = 0; d < 64; ++d) { const float q = dot_bf_f32col(xr, A.peer_wq + (size_t)l * 1024 * 1024, 1024, 1024, hp * 64 + d, lane); if (lane == d) qd = q; }
    const float s = wave_sum(qd * A.peer_subkeys[(((size_t)l * 16 + hp) * 128 + n) * 64 + lane]);
    if (lane == 0) acc_err(A.ws, id, ((const float*)(A.ws + WS_R1))[(size_t)rr * 2048 + hp * 128 + n], s);
}
__device__ __forceinline__ int c_peer_row(int i, int nr) { return (int)(hsh(i * 53 + 17) % nr); }
__device__ __forceinline__ void c_peer_save(const Args& A, const Ctx& C, int row0, int nr) {
    const int gw = C.vcu * NWAVES + C.wave; if (gw >= 64) return; const int r = row0 + c_peer_row(gw, nr);
    float* XS = (float*)(A.ws + WS_DBG + 2 * MiB); for (int k = C.lane; k < 1024; k += 64) XS[gw * 1024 + k] = A.out[(size_t)r * 1024 + k];
}
__device__ __forceinline__ void c_peer(const Args& A, const Ctx& C, int l, int row0, int nr, int id) {
    const int gw = C.vcu * NWAVES + C.wave, lane = C.lane; if (gw >= 64) return;
    const int rr = c_peer_row(gw, nr), r = row0 + rr; const float* S = (const float*)(A.ws + WS_R1) + (size_t)rr * 2048; const float* XS = (const float*)(A.ws + WS_DBG + 2 * MiB) + gw * 1024;
    const bf16* xr = (const bf16*)(A.ws + WS_XN) + (size_t)r * 1024;
    float f[16];
#pragma unroll
    for (int i = 0; i < 16; ++i) f[i] = 0.f;
    for (int h = 0; h < 8; ++h) {
        const float* s1 = S + h * 256; const float* s2 = s1 + 128;
        int r1a = 0, r1b = 0, r2a = 0, r2b = 0; const float a1 = s1[lane], b1 = s1[lane + 64], a2 = s2[lane], b2 = s2[lane + 64];
        for (int k = 0; k < 128; ++k) { const float u = s1[k], v = s2[k]; r1a += (u > a1) || (u == a1 && k < lane); r1b += (u > b1) || (u == b1 && k < lane + 64); r2a += (v > a2) || (v == a2 && k < lane); r2b += (v > b2) || (v == b2 && k < lane + 64); }
        float t1 = 0.f, t2 = 0.f; int i1 = 0, i2 = 0;
        for (int k = 0; k < 16; ++k) {
            const unsigned long long ma = __ballot(r1a == k), mb = __ballot(r1b == k);
            const float v1 = ma ? __shfl(a1, __builtin_ctzll(ma)) : __shfl(b1, __builtin_ctzll(mb)); const int j1 = ma ? __builtin_ctzll(ma) : 64 + __builtin_ctzll(mb);
            const unsigned long long na = __ballot(r2a == k), nb = __ballot(r2b == k);
            const float v2 = na ? __shfl(a2, __builtin_ctzll(na)) : __shfl(b2, __builtin_ctzll(nb)); const int j2 = na ? __builtin_ctzll(na) : 64 + __builtin_ctzll(nb);
            if (lane == k) { t1 = v1; i1 = j1; t2 = v2; i2 = j2; } }
        float cv[4]; int rk[4];
#pragma unroll
        for (int q = 0; q < 4; ++q) { const int c = lane * 4 + q; cv[q] = __shfl(t1, c >> 4) + __shfl(t2, c & 15); rk[q] = 0; }
        for (int c2 = 0; c2 < 256; ++c2) { const float o = __shfl(t1, c2 >> 4) + __shfl(t2, c2 & 15);
#pragma unroll
            for (int q = 0; q < 4; ++q) { const int c = lane * 4 + q; rk[q] += (o > cv[q]) || (o == cv[q] && c2 < c); } }
        float mx = -INFINITY;
#pragma unroll
        for (int q = 0; q < 4; ++q) if (rk[q] < 16) mx = fmaxf(mx, cv[q]);
        mx = wave_max(mx);
        float den = 0.f;
#pragma unroll
        for (int q = 0; q < 4; ++q) if (rk[q] < 16) den += expf(cv[q] - mx);
        den = wave_sum(den);
        for (int c = 0; c < 256; ++c) { const int ow = c >> 2, q = c & 3;
            const int sel = __shfl((q == 0 ? rk[0] : q == 1 ? rk[1] : q == 2 ? rk[2] : rk[3]) < 16 ? 1 : 0, ow); if (!sel) continue;
            const float sc = __shfl(q == 0 ? cv[0] : q == 1 ? cv[1] : q == 2 ? cv[2] : cv[3], ow);
            const int e = __shfl(i1, c >> 4) * 128 + __shfl(i2, c & 15);
            const float* ur = A.peer_u + ((size_t)l * PEER_N + e) * 1024; const float* vr = A.peer_v + ((size_t)l * PEER_N + e) * 1024;
            float d = 0.f; for (int k = lane; k < 1024; k += 64) d += ur[k] * bf1(xr[k]); d = wave_sum(d);
            const float w = expf(sc - mx) / den * 0.5f * d * (1.f + erff(d * 0.7071067811865476f));
#pragma unroll
            for (int i = 0; i < 16; ++i) f[i] += w * vr[lane + 64 * i]; }
    }
    const float* mod = (const float*)(A.ws + WS_MOD) + (size_t)l * 3 * 6144 + (r >> 14) * 6144 + 5 * 1024;
#pragma unroll
    for (int i = 0; i < 16; ++i) { const int col = lane + 64 * i; acc_err(A.ws, id, A.out[(size_t)r * 1024 + col], XS[col] + mod[col] * f[i]); }
}
}
#endif

namespace peer {
__device__ __forceinline__ unsigned fkey(float f) { const unsigned b = __builtin_bit_cast(unsigned, f); return b ^ ((unsigned)((int)b >> 31) | 0x80000000u); }
__device__ __forceinline__ int mbcnt64(unsigned long long m) { return (int)__builtin_amdgcn_mbcnt_hi((unsigned)(m >> 32), __builtin_amdgcn_mbcnt_lo((unsigned)m, 0u)); }
__device__ __forceinline__ void compact2(unsigned k0, unsigned k1, unsigned T, float v0, float v1, int lane, LAS float* lv, LAS int* li) {
    const unsigned long long g0 = __ballot(k0 > T), g1 = __ballot(k1 > T), e0 = __ballot(k0 == T), e1 = __ballot(k1 == T);
    const int need = 16 - (__popcll(g0) + __popcll(g1));
    const bool s0 = (k0 > T) || ((k0 == T) && (mbcnt64(e0) < need));
    const bool s1 = (k1 > T) || ((k1 == T) && (__popcll(e0) + mbcnt64(e1) < need));
    const unsigned long long m0 = __ballot(s0), m1 = __ballot(s1);
    if (s0) { const int p = mbcnt64(m0); lv[p] = v0; li[p] = lane; }
    if (s1) { const int p = __popcll(m0) + mbcnt64(m1); lv[p] = v1; li[p] = lane + 64; }
}
__device__ __forceinline__ float gelu_erf(float v) { return 0.5f * v * (1.0f + erff(v * 0.7071067811865476f)); }

__device__ __forceinline__ float unkey(unsigned k) { const unsigned b = (k & 0x80000000u) ? (k ^ 0x80000000u) : ~k; return __builtin_bit_cast(float, b); }
__device__ __forceinline__ void cnt4(int (&n)[4], unsigned k0, unsigned k1, unsigned k2, unsigned k3, unsigned cc) {
    asm volatile("v_cmp_ge_u32_e64 s[92:93], %4, %8\n\t"
                 "v_cmp_ge_u32_e64 s[94:95], %5, %8\n\t"
                 "v_cmp_ge_u32_e64 s[96:97], %6, %8\n\t"
                 "v_cmp_ge_u32_e64 s[98:99], %7, %8\n\t"
                 "v_addc_co_u32_e64 %0, s[100:101], 0, %0, s[92:93]\n\t"
                 "v_addc_co_u32_e64 %1, s[100:101], 0, %1, s[94:95]\n\t"
                 "v_addc_co_u32_e64 %2, s[100:101], 0, %2, s[96:97]\n\t"
                 "v_addc_co_u32_e64 %3, s[100:101], 0, %3, s[98:99]"
                 : "+v"(n[0]), "+v"(n[1]), "+v"(n[2]), "+v"(n[3]) : "v"(k0), "v"(k1), "v"(k2), "v"(k3), "v"(cc)
                 : "s92", "s93", "s94", "s95", "s96", "s97", "s98", "s99", "s100", "s101");
}
#define CE2(v, x, y) { const unsigned hi_ = v[x] > v[y] ? v[x] : v[y], lo_ = v[x] > v[y] ? v[y] : v[x]; v[x] = hi_; v[y] = lo_; }
__device__ __forceinline__ void part_top16(const float* sp, unsigned (&run)[16]) {
#pragma unroll
    for (int g = 0; g < 8; ++g) {
        unsigned x[16];
#pragma unroll
        for (int i = 0; i < 16; ++i) x[i] = (fkey(sp[(g * 16 + i) * 64]) & 0xFFFFFF80u) | (unsigned)(g * 16 + i);
        CE2(x,0,1) CE2(x,2,3) CE2(x,0,2) CE2(x,1,3) CE2(x,1,2) CE2(x,4,5) CE2(x,6,7) CE2(x,4,6) CE2(x,5,7) CE2(x,5,6) CE2(x,0,4) CE2(x,2,6) CE2(x,2,4) CE2(x,1,5) CE2(x,3,7) CE2(x,3,5) CE2(x,1,2) CE2(x,3,4) CE2(x,5,6) CE2(x,8,9) CE2(x,10,11) CE2(x,8,10) CE2(x,9,11) CE2(x,9,10) CE2(x,12,13) CE2(x,14,15) CE2(x,12,14) CE2(x,13,15) CE2(x,13,14) CE2(x,8,12) CE2(x,10,14) CE2(x,10,12) CE2(x,9,13) CE2(x,11,15) CE2(x,11,13) CE2(x,9,10) CE2(x,11,12) CE2(x,13,14) CE2(x,0,8) CE2(x,4,12) CE2(x,4,8) CE2(x,2,10) CE2(x,6,14) CE2(x,6,10) CE2(x,2,4) CE2(x,6,8) CE2(x,10,12) CE2(x,1,9) CE2(x,5,13) CE2(x,5,9) CE2(x,3,11) CE2(x,7,15) CE2(x,7,11) CE2(x,3,5) CE2(x,7,9) CE2(x,11,13) CE2(x,1,2) CE2(x,3,4) CE2(x,5,6) CE2(x,7,8) CE2(x,9,10) CE2(x,11,12) CE2(x,13,14)
        if (g == 0) {
#pragma unroll
            for (int i = 0; i < 16; ++i) run[i] = x[i];
        } else {
#pragma unroll
            for (int i = 0; i < 16; ++i) run[i] = run[i] > x[15 - i] ? run[i] : x[15 - i];
            CE2(run,0,8) CE2(run,1,9) CE2(run,2,10) CE2(run,3,11) CE2(run,4,12) CE2(run,5,13) CE2(run,6,14) CE2(run,7,15) CE2(run,0,4) CE2(run,1,5) CE2(run,2,6) CE2(run,3,7) CE2(run,8,12) CE2(run,9,13) CE2(run,10,14) CE2(run,11,15) CE2(run,0,2) CE2(run,1,3) CE2(run,4,6) CE2(run,5,7) CE2(run,8,10) CE2(run,9,11) CE2(run,12,14) CE2(run,13,15) CE2(run,0,1) CE2(run,2,3) CE2(run,4,5) CE2(run,6,7) CE2(run,8,9) CE2(run,10,11) CE2(run,12,13) CE2(run,14,15)
        }
    }
}
__device__ __forceinline__ void route_tasks(const Ctx& C, const float* ST, int nt, int* EL, float* GL, const pg8::StaticOrder& SO) {
    const int lane = C.lane;
#pragma unroll 1
    for (int it = C.wave; ; it += NWAVES) {
        pg8::Unit un; if (!SO.next(it >> 2, un)) break;
        const int h = un.pm, tb = un.pn * 4 + (it & 3), t = tb * 64 + lane;
        float a[16], b[16]; int ai[16], bi[16];
        {   const float* sp = ST + ((size_t)tb * 2048 + h * 256) * 64 + lane;
            unsigned ra[16], rb[16];
            part_top16(sp, ra); part_top16(sp + 128 * 64, rb);
#pragma unroll
            for (int q = 0; q < 16; ++q) { a[q] = unkey(ra[q] & 0xFFFFFF80u); ai[q] = (int)(ra[q] & 127u); b[q] = unkey(rb[q] & 0xFFFFFF80u); bi[q] = (int)(rb[q] & 127u); } }
        float cs[64]; int ce[64];
        cs[0] = a[0] + b[0]; ce[0] = ai[0] * 128 + bi[0]; cs[1] = a[0] + b[1]; ce[1] = ai[0] * 128 + bi[1]; cs[2] = a[0] + b[2]; ce[2] = ai[0] * 128 + bi[2]; cs[3] = a[0] + b[3]; ce[3] = ai[0] * 128 + bi[3]; cs[4] = a[0] + b[4]; ce[4] = ai[0] * 128 + bi[4]; cs[5] = a[0] + b[5]; ce[5] = ai[0] * 128 + bi[5]; cs[6] = a[0] + b[6]; ce[6] = ai[0] * 128 + bi[6]; cs[7] = a[0] + b[7]; ce[7] = ai[0] * 128 + bi[7]; cs[8] = a[0] + b[8]; ce[8] = ai[0] * 128 + bi[8]; cs[9] = a[0] + b[9]; ce[9] = ai[0] * 128 + bi[9]; cs[10] = a[0] + b[10]; ce[10] = ai[0] * 128 + bi[10]; cs[11] = a[0] + b[11]; ce[11] = ai[0] * 128 + bi[11]; cs[12] = a[0] + b[12]; ce[12] = ai[0] * 128 + bi[12]; cs[13] = a[0] + b[13]; ce[13] = ai[0] * 128 + bi[13]; cs[14] = a[0] + b[14]; ce[14] = ai[0] * 128 + bi[14]; cs[15] = a[0] + b[15]; ce[15] = ai[0] * 128 + bi[15]; cs[16] = a[1] + b[0]; ce[16] = ai[1] * 128 + bi[0]; cs[17] = a[1] + b[1]; ce[17] = ai[1] * 128 + bi[1]; cs[18] = a[1] + b[2]; ce[18] = ai[1] * 128 + bi[2]; cs[19] = a[1] + b[3]; ce[19] = ai[1] * 128 + bi[3]; cs[20] = a[1] + b[4]; ce[20] = ai[1] * 128 + bi[4]; cs[21] = a[1] + b[5]; ce[21] = ai[1] * 128 + bi[5]; cs[22] = a[1] + b[6]; ce[22] = ai[1] * 128 + bi[6]; cs[23] = a[1] + b[7]; ce[23] = ai[1] * 128 + bi[7]; cs[24] = a[2] + b[0]; ce[24] = ai[2] * 128 + bi[0]; cs[25] = a[2] + b[1]; ce[25] = ai[2] * 128 + bi[1]; cs[26] = a[2] + b[2]; ce[26] = ai[2] * 128 + bi[2]; cs[27] = a[2] + b[3]; ce[27] = ai[2] * 128 + bi[3]; cs[28] = a[2] + b[4]; ce[28] = ai[2] * 128 + bi[4]; cs[29] = a[3] + b[0]; ce[29] = ai[3] * 128 + bi[0]; cs[30] = a[3] + b[1]; ce[30] = ai[3] * 128 + bi[1]; cs[31] = a[3] + b[2]; ce[31] = ai[3] * 128 + bi[2]; cs[32] = a[3] + b[3]; ce[32] = ai[3] * 128 + bi[3]; cs[33] = a[4] + b[0]; ce[33] = ai[4] * 128 + bi[0]; cs[34] = a[4] + b[1]; ce[34] = ai[4] * 128 + bi[1]; cs[35] = a[4] + b[2]; ce[35] = ai[4] * 128 + bi[2]; cs[36] = a[5] + b[0]; ce[36] = ai[5] * 128 + bi[0]; cs[37] = a[5] + b[1]; ce[37] = ai[5] * 128 + bi[1]; cs[38] = a[6] + b[0]; ce[38] = ai[6] * 128 + bi[0]; cs[39] = a[6] + b[1]; ce[39] = ai[6] * 128 + bi[1]; cs[40] = a[7] + b[0]; ce[40] = ai[7] * 128 + bi[0]; cs[41] = a[7] + b[1]; ce[41] = ai[7] * 128 + bi[1]; cs[42] = a[8] + b[0]; ce[42] = ai[8] * 128 + bi[0]; cs[43] = a[9] + b[0]; ce[43] = ai[9] * 128 + bi[0]; cs[44] = a[10] + b[0]; ce[44] = ai[10] * 128 + bi[0]; cs[45] = a[11] + b[0]; ce[45] = ai[11] * 128 + bi[0]; cs[46] = a[12] + b[0]; ce[46] = ai[12] * 128 + bi[0]; cs[47] = a[13] + b[0]; ce[47] = ai[13] * 128 + bi[0]; cs[48] = a[14] + b[0]; ce[48] = ai[14] * 128 + bi[0]; cs[49] = a[15] + b[0]; ce[49] = ai[15] * 128 + bi[0];
#pragma unroll
        for (int c = 50; c < 64; ++c) { cs[c] = -INFINITY; ce[c] = 0; }
#define CE3(k, pl, x, y) { const bool sw_ = k[x] < k[y]; const float k0_ = sw_ ? k[y] : k[x], k1_ = sw_ ? k[x] : k[y]; const int p0_ = sw_ ? pl[y] : pl[x], p1_ = sw_ ? pl[x] : pl[y]; k[x] = k0_; k[y] = k1_; pl[x] = p0_; pl[y] = p1_; }
        CE3(cs,ce,16,17) CE3(cs,ce,18,19) CE3(cs,ce,16,18) CE3(cs,ce,17,19) CE3(cs,ce,17,18) CE3(cs,ce,20,21) CE3(cs,ce,22,23) CE3(cs,ce,20,22) CE3(cs,ce,21,23) CE3(cs,ce,21,22) CE3(cs,ce,16,20) CE3(cs,ce,18,22) CE3(cs,ce,18,20) CE3(cs,ce,17,21) CE3(cs,ce,19,23) CE3(cs,ce,19,21) CE3(cs,ce,17,18) CE3(cs,ce,19,20) CE3(cs,ce,21,22) CE3(cs,ce,24,25) CE3(cs,ce,26,27) CE3(cs,ce,24,26) CE3(cs,ce,25,27) CE3(cs,ce,25,26) CE3(cs,ce,28,29) CE3(cs,ce,30,31) CE3(cs,ce,28,30) CE3(cs,ce,29,31) CE3(cs,ce,29,30) CE3(cs,ce,24,28) CE3(cs,ce,26,30) CE3(cs,ce,26,28) CE3(cs,ce,25,29) CE3(cs,ce,27,31) CE3(cs,ce,27,29) CE3(cs,ce,25,26) CE3(cs,ce,27,28) CE3(cs,ce,29,30) CE3(cs,ce,16,24) CE3(cs,ce,20,28) CE3(cs,ce,20,24) CE3(cs,ce,18,26) CE3(cs,ce,22,30) CE3(cs,ce,22,26) CE3(cs,ce,18,20) CE3(cs,ce,22,24) CE3(cs,ce,26,28) CE3(cs,ce,17,25) CE3(cs,ce,21,29) CE3(cs,ce,21,25) CE3(cs,ce,19,27) CE3(cs,ce,23,31) CE3(cs,ce,23,27) CE3(cs,ce,19,21) CE3(cs,ce,23,25) CE3(cs,ce,27,29) CE3(cs,ce,17,18) CE3(cs,ce,19,20) CE3(cs,ce,21,22) CE3(cs,ce,23,24) CE3(cs,ce,25,26) CE3(cs,ce,27,28) CE3(cs,ce,29,30)
        CE3(cs,ce,32,33) CE3(cs,ce,34,35) CE3(cs,ce,32,34) CE3(cs,ce,33,35) CE3(cs,ce,33,34) CE3(cs,ce,36,37) CE3(cs,ce,38,39) CE3(cs,ce,36,38) CE3(cs,ce,37,39) CE3(cs,ce,37,38) CE3(cs,ce,32,36) CE3(cs,ce,34,38) CE3(cs,ce,34,36) CE3(cs,ce,33,37) CE3(cs,ce,35,39) CE3(cs,ce,35,37) CE3(cs,ce,33,34) CE3(cs,ce,35,36) CE3(cs,ce,37,38) CE3(cs,ce,40,41) CE3(cs,ce,42,43) CE3(cs,ce,40,42) CE3(cs,ce,41,43) CE3(cs,ce,41,42) CE3(cs,ce,44,45) CE3(cs,ce,46,47) CE3(cs,ce,44,46) CE3(cs,ce,45,47) CE3(cs,ce,45,46) CE3(cs,ce,40,44) CE3(cs,ce,42,46) CE3(cs,ce,42,44) CE3(cs,ce,41,45) CE3(cs,ce,43,47) CE3(cs,ce,43,45) CE3(cs,ce,41,42) CE3(cs,ce,43,44) CE3(cs,ce,45,46) CE3(cs,ce,32,40) CE3(cs,ce,36,44) CE3(cs,ce,36,40) CE3(cs,ce,34,42) CE3(cs,ce,38,46) CE3(cs,ce,38,42) CE3(cs,ce,34,36) CE3(cs,ce,38,40) CE3(cs,ce,42,44) CE3(cs,ce,33,41) CE3(cs,ce,37,45) CE3(cs,ce,37,41) CE3(cs,ce,35,43) CE3(cs,ce,39,47) CE3(cs,ce,39,43) CE3(cs,ce,35,37) CE3(cs,ce,39,41) CE3(cs,ce,43,45) CE3(cs,ce,33,34) CE3(cs,ce,35,36) CE3(cs,ce,37,38) CE3(cs,ce,39,40) CE3(cs,ce,41,42) CE3(cs,ce,43,44) CE3(cs,ce,45,46)
        CE3(cs,ce,48,49) CE3(cs,ce,50,51) CE3(cs,ce,48,50) CE3(cs,ce,49,51) CE3(cs,ce,49,50) CE3(cs,ce,52,53) CE3(cs,ce,54,55) CE3(cs,ce,52,54) CE3(cs,ce,53,55) CE3(cs,ce,53,54) CE3(cs,ce,48,52) CE3(cs,ce,50,54) CE3(cs,ce,50,52) CE3(cs,ce,49,53) CE3(cs,ce,51,55) CE3(cs,ce,51,53) CE3(cs,ce,49,50) CE3(cs,ce,51,52) CE3(cs,ce,53,54) CE3(cs,ce,56,57) CE3(cs,ce,58,59) CE3(cs,ce,56,58) CE3(cs,ce,57,59) CE3(cs,ce,57,58) CE3(cs,ce,60,61) CE3(cs,ce,62,63) CE3(cs,ce,60,62) CE3(cs,ce,61,63) CE3(cs,ce,61,62) CE3(cs,ce,56,60) CE3(cs,ce,58,62) CE3(cs,ce,58,60) CE3(cs,ce,57,61) CE3(cs,ce,59,63) CE3(cs,ce,59,61) CE3(cs,ce,57,58) CE3(cs,ce,59,60) CE3(cs,ce,61,62) CE3(cs,ce,48,56) CE3(cs,ce,52,60) CE3(cs,ce,52,56) CE3(cs,ce,50,58) CE3(cs,ce,54,62) CE3(cs,ce,54,58) CE3(cs,ce,50,52) CE3(cs,ce,54,56) CE3(cs,ce,58,60) CE3(cs,ce,49,57) CE3(cs,ce,53,61) CE3(cs,ce,53,57) CE3(cs,ce,51,59) CE3(cs,ce,55,63) CE3(cs,ce,55,59) CE3(cs,ce,51,53) CE3(cs,ce,55,57) CE3(cs,ce,59,61) CE3(cs,ce,49,50) CE3(cs,ce,51,52) CE3(cs,ce,53,54) CE3(cs,ce,55,56) CE3(cs,ce,57,58) CE3(cs,ce,59,60) CE3(cs,ce,61,62)

#pragma unroll
        for (int i = 0; i < 16; ++i) { const bool sw_ = cs[i] < cs[16 + 15 - i]; cs[i] = sw_ ? cs[16 + 15 - i] : cs[i]; ce[i] = sw_ ? ce[16 + 15 - i] : ce[i]; }
        CE3(cs,ce,0,8) CE3(cs,ce,1,9) CE3(cs,ce,2,10) CE3(cs,ce,3,11) CE3(cs,ce,4,12) CE3(cs,ce,5,13) CE3(cs,ce,6,14) CE3(cs,ce,7,15) CE3(cs,ce,0,4) CE3(cs,ce,1,5) CE3(cs,ce,2,6) CE3(cs,ce,3,7) CE3(cs,ce,8,12) CE3(cs,ce,9,13) CE3(cs,ce,10,14) CE3(cs,ce,11,15) CE3(cs,ce,0,2) CE3(cs,ce,1,3) CE3(cs,ce,4,6) CE3(cs,ce,5,7) CE3(cs,ce,8,10) CE3(cs,ce,9,11) CE3(cs,ce,12,14) CE3(cs,ce,13,15) CE3(cs,ce,0,1) CE3(cs,ce,2,3) CE3(cs,ce,4,5) CE3(cs,ce,6,7) CE3(cs,ce,8,9) CE3(cs,ce,10,11) CE3(cs,ce,12,13) CE3(cs,ce,14,15)

#pragma unroll
        for (int i = 0; i < 16; ++i) { const bool sw_ = cs[i] < cs[32 + 15 - i]; cs[i] = sw_ ? cs[32 + 15 - i] : cs[i]; ce[i] = sw_ ? ce[32 + 15 - i] : ce[i]; }
        CE3(cs,ce,0,8) CE3(cs,ce,1,9) CE3(cs,ce,2,10) CE3(cs,ce,3,11) CE3(cs,ce,4,12) CE3(cs,ce,5,13) CE3(cs,ce,6,14) CE3(cs,ce,7,15) CE3(cs,ce,0,4) CE3(cs,ce,1,5) CE3(cs,ce,2,6) CE3(cs,ce,3,7) CE3(cs,ce,8,12) CE3(cs,ce,9,13) CE3(cs,ce,10,14) CE3(cs,ce,11,15) CE3(cs,ce,0,2) CE3(cs,ce,1,3) CE3(cs,ce,4,6) CE3(cs,ce,5,7) CE3(cs,ce,8,10) CE3(cs,ce,9,11) CE3(cs,ce,12,14) CE3(cs,ce,13,15) CE3(cs,ce,0,1) CE3(cs,ce,2,3) CE3(cs,ce,4,5) CE3(cs,ce,6,7) CE3(cs,ce,8,9) CE3(cs,ce,10,11) CE3(cs,ce,12,13) CE3(cs,ce,14,15)

#pragma unroll
        for (int i = 0; i < 16; ++i) { const bool sw_ = cs[i] < cs[48 + 15 - i]; cs[i] = sw_ ? cs[48 + 15 - i] : cs[i]; ce[i] = sw_ ? ce[48 + 15 - i] : ce[i]; }
        CE3(cs,ce,0,8) CE3(cs,ce,1,9) CE3(cs,ce,2,10) CE3(cs,ce,3,11) CE3(cs,ce,4,12) CE3(cs,ce,5,13) CE3(cs,ce,6,14) CE3(cs,ce,7,15) CE3(cs,ce,0,4) CE3(cs,ce,1,5) CE3(cs,ce,2,6) CE3(cs,ce,3,7) CE3(cs,ce,8,12) CE3(cs,ce,9,13) CE3(cs,ce,10,14) CE3(cs,ce,11,15) CE3(cs,ce,0,2) CE3(cs,ce,1,3) CE3(cs,ce,4,6) CE3(cs,ce,5,7) CE3(cs,ce,8,10) CE3(cs,ce,9,11) CE3(cs,ce,12,14) CE3(cs,ce,13,15) CE3(cs,ce,0,1) CE3(cs,ce,2,3) CE3(cs,ce,4,5) CE3(cs,ce,6,7) CE3(cs,ce,8,9) CE3(cs,ce,10,11) CE3(cs,ce,12,13) CE3(cs,ce,14,15)
#undef CE3
        {   float w[16]; float sm = 0.f;
#pragma unroll
            for (int k = 0; k < 16; ++k) { w[k] = __expf(cs[k] - cs[0]); sm += w[k]; }
            const float rs = 1.0f / sm; const size_t eo = (size_t)t * 128 + h * 16;
#pragma unroll
            for (int k = 0; k < 16; ++k) { EL[eo + k] = ce[k]; GL[eo + k] = w[k] * rs; } }
    }
}

__device__ __forceinline__ void route_tokens_wave(const Ctx& C, const float* ST, int nt, int* EL, float* GL) {
    const int gw = C.wave * C.G + C.vcu, NGW = C.G * NWAVES, lane = C.lane;
    constexpr int NH = 4;
    LAS float* slist = (LAS float*)(C.lds + C.wave * 16384);
    LAS float* l1v = (LAS float*)(C.lds + C.wave * 16384 + 512); LAS int* l1i = (LAS int*)(C.lds + C.wave * 16384 + 1024);
    LAS float* l2v = (LAS float*)(C.lds + C.wave * 16384 + 1536); LAS int* l2i = (LAS int*)(C.lds + C.wave * 16384 + 2048);
#pragma unroll 1
    for (int task = gw; task < nt * (8 / NH); task += NGW) {
        const int t = task / (8 / NH), hp = task % (8 / NH);
        const float* sp = ST + ((size_t)(t >> 6) * 2048 + hp * NH * 256 + lane) * 64 + (t & 63);
        float cv[4 * NH]; unsigned ck[4 * NH];
#pragma unroll
        for (int q = 0; q < 4 * NH; ++q) { cv[q] = sp[(size_t)q * 64 * 64]; ck[q] = fkey(cv[q]); }
        unsigned T[2 * NH]; bool fin[2 * NH];
#pragma unroll
        for (int c = 0; c < 2 * NH; ++c) { T[c] = 0u; fin[c] = false; }
#pragma unroll 1
        for (int bit = 31; bit >= 0; --bit) { bool all = true;
#pragma unroll
            for (int c = 0; c < 2 * NH; ++c) { const unsigned cc = T[c] | (1u << bit);
                const int n = __popcll(__ballot(ck[2 * c] >= cc)) + __popcll(__ballot(ck[2 * c + 1] >= cc));
                T[c] = (!fin[c] && n >= 16) ? cc : T[c]; fin[c] = fin[c] || (n == 16); all = all && fin[c]; }
            if (all) break; }
#pragma unroll
        for (int u = 0; u < NH; ++u) {
            compact2(ck[4 * u], ck[4 * u + 1], T[2 * u], cv[4 * u], cv[4 * u + 1], lane, l1v + 16 * u, l1i + 16 * u);
            compact2(ck[4 * u + 2], ck[4 * u + 3], T[2 * u + 1], cv[4 * u + 2], cv[4 * u + 3], lane, l2v + 16 * u, l2i + 16 * u); }
        LDS_WAIT(); asm volatile("" ::: "memory");
        const int ci = lane >> 2, cjb = (lane & 3) * 4;
        float cs[NH][4]; unsigned kc[NH][4]; int ce[NH][4];
#pragma unroll
        for (int u = 0; u < NH; ++u) { const float v1 = l1v[16 * u + ci]; const int e1 = l1i[16 * u + ci] * 128;
#pragma unroll
            for (int q = 0; q < 4; ++q) { cs[u][q] = v1 + l2v[16 * u + cjb + q]; kc[u][q] = fkey(cs[u][q]); ce[u][q] = e1 + l2i[16 * u + cjb + q]; } }
        unsigned Tc[NH]; bool finc[NH];
#pragma unroll
        for (int u = 0; u < NH; ++u) { Tc[u] = 0u; finc[u] = false; }
#pragma unroll 1
        for (int bit = 31; bit >= 0; --bit) { bool all = true;
#pragma unroll
            for (int u = 0; u < NH; ++u) { const unsigned cc = Tc[u] | (1u << bit);
                const int n = (__popcll(__ballot(kc[u][0] >= cc)) + __popcll(__ballot(kc[u][1] >= cc))) + (__popcll(__ballot(kc[u][2] >= cc)) + __popcll(__ballot(kc[u][3] >= cc)));
                Tc[u] = (!finc[u] && n >= 16) ? cc : Tc[u]; finc[u] = finc[u] || (n == 16); all = all && finc[u]; }
            if (all) break; }
#pragma unroll
        for (int u = 0; u < NH; ++u) {
            const int h = NH * hp + u;
            unsigned long long gq[4], eq[4];
#pragma unroll
            for (int q = 0; q < 4; ++q) { gq[q] = __ballot(kc[u][q] > Tc[u]); eq[q] = __ballot(kc[u][q] == Tc[u]); }
            const int need = 16 - ((__popcll(gq[0]) + __popcll(gq[1])) + (__popcll(gq[2]) + __popcll(gq[3])));
            int ebase = 0, mbase = 0;
#pragma unroll
            for (int q = 0; q < 4; ++q) { const bool sel = (kc[u][q] > Tc[u]) || ((kc[u][q] == Tc[u]) && (ebase + mbcnt64(eq[q]) < need)); ebase += __popcll(eq[q]);
                const unsigned long long mq = __ballot(sel); const int pos = mbase + mbcnt64(mq); mbase += __popcll(mq);
                if (sel) { slist[u * 16 + pos] = cs[u][q]; EL[(size_t)t * 128 + h * 16 + pos] = ce[u][q]; } }
        }
        LDS_WAIT(); asm volatile("" ::: "memory");
        {
            const int u = lane >> 4;
            float m = -INFINITY, sm = 0.f;
#pragma unroll
            for (int k = 0; k < 16; ++k) m = fmaxf(m, slist[u * 16 + k]);
#pragma unroll
            for (int k = 0; k < 16; ++k) sm += __expf(slist[u * 16 + k] - m);
            GL[(size_t)t * 128 + (NH * hp + u) * 16 + (lane & 15)] = __expf(slist[u * 16 + (lane & 15)] - m) / sm;
        }
        LDS_WAIT(); asm volatile("" ::: "memory");
    }
}

__device__ __forceinline__ void topk_gather(const Args& A, const Ctx& C, int l, int row0, int nrows, const int* EL, const float* GL, const unsigned char* U, const unsigned char* V, const float* US, const float* VS, const bf16* XN,
                                            float* xlat, float* xctx, const float* mod  , bool final_out, const float* gn, const float* nmod, bf16* XNw) {
    const int gw = C.wave * C.G + C.vcu, NGW = C.G * NWAVES, lane = C.lane, lp = lane & 31, half = lane >> 5, cl = 2 * lp + half;
    LAS int* elist = (LAS int*)(C.lds + C.wave * 16384);
    LAS float* glist = (LAS float*)(C.lds + C.wave * 16384 + 512);
    LAS float* clist = (LAS float*)(C.lds + C.wave * 16384 + 1024);
    LAS float* uslist = (LAS float*)(C.lds + C.wave * 16384 + 1536);
    LAS float* vslist = (LAS float*)(C.lds + C.wave * 16384 + 2048);
    int ne0 = 0, ne1 = 0; float ng0 = 0.f, ng1 = 0.f;
    if (gw < nrows) { ne0 = EL[(size_t)gw * 128 + lane]; ne1 = EL[(size_t)gw * 128 + 64 + lane]; ng0 = GL[(size_t)gw * 128 + lane]; ng1 = GL[(size_t)gw * 128 + 64 + lane]; }
    for (int rr = gw; rr < nrows; rr += NGW) {
        const int r = row0 + rr;
        elist[lane] = ne0; elist[64 + lane] = ne1; glist[lane] = ng0; glist[64 + lane] = ng1;
        const float us0 = US[ne0], us1 = US[ne1], vs0 = VS[ne0], vs1 = VS[ne1];
        { const int rn = rr + NGW; if (rn < nrows) { ne0 = EL[(size_t)rn * 128 + lane]; ne1 = EL[(size_t)rn * 128 + 64 + lane]; ng0 = GL[(size_t)rn * 128 + lane]; ng1 = GL[(size_t)rn * 128 + 64 + lane]; } }
        LDS_WAIT(); asm volatile("" ::: "memory");
        f32x2 acc[16];
#define GLOAD(T, bA, bB, xb) { _Pragma("unroll") for (int s = 0; s < 4; ++s) { const unsigned e = (unsigned)elist[(xb) + 2 * s + half]; const unsigned o = __umul24(e, 768u);        \
            bA[s] = *(const GAS v4u*)(T + (o + lo16)); bB[s] = *(const GAS v2u*)(T + (o + lo8)); } }
#define UCOMP(bA, bB, xb) { float p[4]; \
            _Pragma("unroll") for (int s = 0; s < 4; ++s) { \
                v6i w; w[0] = (int)bA[s].x; w[1] = (int)bA[s].y; w[2] = (int)bA[s].z; w[3] = (int)bA[s].w; w[4] = (int)bB[s].x; w[5] = (int)bB[s].y; \
                const v32f d = __builtin_amdgcn_cvt_scalef32_pk32_f32_fp6(w, 1.0f); \
                f32x2 sA = (f32x2){0.f, 0.f}, sB = (f32x2){0.f, 0.f}; \
                _Pragma("unroll") for (int i = 0; i < 8; ++i) { sA = __builtin_elementwise_fma((f32x2){d[4 * i], d[4 * i + 1]}, hf[2 * i], sA); sB = __builtin_elementwise_fma((f32x2){d[4 * i + 2], d[4 * i + 3]}, hf[2 * i + 1], sB); } \
                const f32x2 s2 = sA + sB; p[s] = (s2.x + s2.y) * uslist[(xb) + 2 * s + half]; } \
              \
            float q2[2]; \
            _Pragma("unroll") for (int j = 0; j < 2; ++j) q2[j] = (b4 ? p[j + 2] : p[j]) + __shfl_xor(b4 ? p[j] : p[j + 2], 16); \
            float sm = (b3 ? q2[1] : q2[0]) + __shfl_xor(b3 ? q2[0] : q2[1], 8); \
            sm += __shfl_xor(sm, 4); sm += __shfl_xor(sm, 2); sm += __shfl_xor(sm, 1); \
            const int ent = (xb) + 2 * (2 * (b4 ? 1 : 0) + (b3 ? 1 : 0)) + half; \
            const float cf = gelu_erf(sm) * glist[ent]; \
            if ((lane & 7) == 0) clist[ent] = cf; }
#define VCOMP(bA, bB, xb) { _Pragma("unroll") for (int s = 0; s < 4; ++s) { \
                v6i w; w[0] = (int)bA[s].x; w[1] = (int)bA[s].y; w[2] = (int)bA[s].z; w[3] = (int)bA[s].w; w[4] = (int)bB[s].x; w[5] = (int)bB[s].y; \
                const v32f d = __builtin_amdgcn_cvt_scalef32_pk32_f32_fp6(w, 1.0f); \
                const float c1_ = clist[(xb) + 2 * s + half] * vslist[(xb) + 2 * s + half]; const f32x2 c2 = (f32x2){c1_, c1_}; \
                _Pragma("unroll") for (int i = 0; i < 16; ++i) acc[i] = __builtin_elementwise_fma((f32x2){d[2 * i], d[2 * i + 1]}, c2, acc[i]); } }
        const bool b4 = (lane & 16) != 0, b3 = (lane & 8) != 0; const unsigned lo16 = 16u * (unsigned)lp, lo8 = 512u + 8u * (unsigned)lp;
#pragma unroll 1
        for (int rep2_ = 0; rep2_ < REP_GATHER; ++rep2_) {
        {
        f32x2 hf[16];
        { const GAS v4u* hp = (const GAS v4u*)(XN + (size_t)r * 1024 + 32 * lp);
#pragma unroll
          for (int q = 0; q < 4; ++q) { const v4u h4 = hp[q]; hf[4 * q] = (f32x2){bflo(h4.x), bfhi(h4.x)}; hf[4 * q + 1] = (f32x2){bflo(h4.y), bfhi(h4.y)}; hf[4 * q + 2] = (f32x2){bflo(h4.z), bfhi(h4.z)}; hf[4 * q + 3] = (f32x2){bflo(h4.w), bfhi(h4.w)}; } }
        v4u aA[4], bA[4], cA[4]; v2u aB[4], bB[4], cB[4];
        GLOAD(U, aA, aB, 0)
        GLOAD(U, bA, bB, 8)
        if (rep2_ == 0) { uslist[lane] = us0; uslist[64 + lane] = us1; vslist[lane] = vs0; vslist[64 + lane] = vs1; }
        LDS_WAIT(); asm volatile("" ::: "memory");
#pragma unroll 1
        for (int x0 = 0; x0 < 120; x0 += 24) {
            GLOAD(U, cA, cB, x0 + 16)
            UCOMP(aA, aB, x0)
            GLOAD(U, aA, aB, x0 + 24)
            UCOMP(bA, bB, x0 + 8)
            if (x0 + 32 < 128) GLOAD(U, bA, bB, x0 + 32)
            UCOMP(cA, cB, x0 + 16)
        }
        UCOMP(aA, aB, 120)
        }
        LDS_WAIT(); asm volatile("" ::: "memory");
#pragma unroll
        for (int i = 0; i < 16; ++i) acc[i] = (f32x2){0.f, 0.f};
        {
        v4u aA[4], bA[4], cA[4]; v2u aB[4], bB[4], cB[4];
        GLOAD(V, aA, aB, 0)
        GLOAD(V, bA, bB, 8)
#pragma unroll 1
        for (int x0 = 0; x0 < 120; x0 += 24) {
            GLOAD(V, cA, cB, x0 + 16)
            VCOMP(aA, aB, x0)
            GLOAD(V, aA, aB, x0 + 24)
            VCOMP(bA, bB, x0 + 8)
            if (x0 + 32 < 128) GLOAD(V, bA, bB, x0 + 32)
            VCOMP(cA, cB, x0 + 16)
        }
        VCOMP(aA, aB, 120)
        }
        asm volatile("" ::: "memory"); }
#undef GLOAD
#undef UCOMP
#undef VCOMP
        if (ABL & 8) {
#pragma unroll
            for (int i = 0; i < 16; ++i) acc[i] = (f32x2){0.f, 0.f}; }
        float tot[16];
#pragma unroll
        for (int i = 0; i < 16; ++i) { const float lo_ = acc[i >> 1][i & 1], hi_ = acc[8 + (i >> 1)][i & 1];
            tot[i] = (half ? hi_ : lo_) + __shfl_xor(half ? lo_ : hi_, 32); }
        const bool latent = r < ML;
        float* xr = latent ? xlat + (size_t)r * 1024 : xctx + (size_t)(r - ML) * 1024;
        const float* gp = mod + (latent ? (r >> 14) : 2) * 6144 + 5 * 1024;
        f32x4 xv[4]; float ss = 0.f;
#pragma unroll
        for (int k = 0; k < 4; ++k) { const int col = 16 * cl + 4 * k; const f32x4 xo = *(const GAS f32x4*)(xr + col), gt = *(const f32x4*)(gp + col);
            const f32x4 a4 = (f32x4){tot[4 * k], tot[4 * k + 1], tot[4 * k + 2], tot[4 * k + 3]};
            const f32x4 xn = xo + gt * a4; xv[k] = xn; ss += (xn.x * xn.x + xn.y * xn.y) + (xn.z * xn.z + xn.w * xn.w); }
        if (final_out) {
            const float rstd = 1.0f / sqrtf(wave_sum(ss) * (1.0f / 1024.0f) + EPS);
#pragma unroll
            for (int k = 0; k < 4; ++k) { const int col = 16 * cl + 4 * k; const f32x4 gf = *(const f32x4*)(A.g_final + col); *(GAS f32x4*)(xr + col) = xv[k] * rstd * gf; }
        } else {
#pragma unroll
            for (int k = 0; k < 4; ++k) { const int col = 16 * cl + 4 * k; *(GAS f32x4*)(xr + col) = xv[k]; }
            const float rstd = 1.0f / sqrtf(wave_sum(ss) * (1.0f / 1024.0f) + EPS);
            const float* mp = nmod + (latent ? (r >> 14) : 2) * 6144;
            v4u o[2];
#pragma unroll
            for (int k = 0; k < 4; ++k) { const int col = 16 * cl + 4 * k; const f32x4 g4 = *(const f32x4*)(gn + col), sh = *(const f32x4*)(mp + col), sc = *(const f32x4*)(mp + 1024 + col);
                const f32x4 y = xv[k] * rstd * g4 * (sc + 1.0f) + sh; o[k >> 1][(k & 1) * 2] = pk2(y.x, y.y); o[k >> 1][(k & 1) * 2 + 1] = pk2(y.z, y.w); }
            *(GAS v4u*)(XNw + (size_t)r * 1024 + 16 * cl) = o[0]; *(GAS v4u*)(XNw + (size_t)r * 1024 + 16 * cl + 8) = o[1];
        }
        LDS_WAIT(); asm volatile("" ::: "memory");
    }
}
}

#ifndef PHMASK
#define PHMASK 0xFFFF
#endif
#define PH(n) if constexpr (((PHMASK) >> (n)) & 1)
#ifndef ATT_THRL
#define ATT_THRL 4096
#endif
#ifndef NAIVE_G3
#define NAIVE_G3 0
#endif
#ifndef CHKSKIP
#define CHKSKIP ((1 << 12) | (1 << 20))
#endif
__global__ void __launch_bounds__(NTHREADS, 2) mega_fwd(Args A) {
    extern __shared__ __attribute__((aligned(16))) unsigned char lds_raw[];
    Ctx C;
    C.lds = (LAS unsigned char*)lds_raw;
    C.tid = threadIdx.x; C.lane = C.tid & 63; C.wave = __builtin_amdgcn_readfirstlane(C.tid >> 6);
    C.G = gridDim.x; { const int bx = blockIdx.x; C.vcu = (C.G % 8 == 0) ? (bx % 8) * (C.G / 8) + bx / 8 : bx; }
    volatile LAS unsigned* MISC = (volatile LAS unsigned*)(C.lds + MISC_OFF);
    for (int u = C.tid; u < (LDS_BYTES - LDSCTL_OFF) / 4; u += NTHREADS) ((LAS unsigned*)(C.lds + LDSCTL_OFF))[u] = 0u;
    __syncthreads();
    unsigned char* ws = A.ws;
    gu32* ctl = (gu32*)(ws + WS_CTL);
    (void)xcd_barrier_post((unsigned*)(ctl + CW_BAR), MISC + 8);
#ifdef PROBE_DEC
    { typedef int v6i_ __attribute__((ext_vector_type(6))); typedef float v32f_ __attribute__((ext_vector_type(32)));
      v6i_ w_; w_[0] = C.tid; w_[1] = C.tid * 3; w_[2] = C.tid * 5; w_[3] = C.tid * 7; w_[4] = C.tid * 11; w_[5] = C.tid * 13;
#pragma unroll 4
      for (int i_ = 0; i_ < PROBE_DEC; ++i_) { asm volatile("" : "+v"(w_)); const v32f_ r_ = __builtin_amdgcn_cvt_scalef32_pk32_f32_fp6(w_, 1.0f); asm volatile("" :: "v"(r_)); } }
#endif
#define GRID_BAR() do { unsigned char* w_ = A.ws; asm volatile("" : "+s"(w_)); XcdBarrier b_; b_.bar = (unsigned*)(w_ + WS_CTL) + CW_BAR; b_.x = xb_xcc_id(); b_.st = (volatile LAS unsigned*)(C.lds + MISC_OFF) + 8; xcd_barrier(b_); } while (0)
#ifdef SELFCHECK
#define CHK(stmt) do { if (l == 0) { PCTX(Cq); stmt; } GRID_BAR(); } while (0)
#else
#define CHK(stmt) do {} while (0)
#endif
#define PCTX(Cn) Ctx Cn; { const int t_ = opq_tid(); Cn.lds = C.lds; Cn.tid = t_; Cn.lane = t_ & 63; Cn.wave = __builtin_amdgcn_readfirstlane(t_ >> 6); Cn.G = C.G; Cn.vcu = C.vcu; }
    LAS unsigned char* ring = C.lds;

    bf16* XN = (bf16*)(ws + WS_XN); bf16* Qb = (bf16*)(ws + WS_Q); bf16* Kb = (bf16*)(ws + WS_K); bf16* Vb = (bf16*)(ws + WS_V);
    bf16* BG = (bf16*)(ws + WS_BG); bf16* CX = (bf16*)(ws + WS_CX); bf16* MM = (bf16*)(ws + WS_MM); bf16* YHY = (bf16*)(ws + WS_YHY);
    bf16* YHYT = (bf16*)(ws + WS_YHYT); bf16* HYT = (bf16*)(ws + WS_R1); bf16* HYTC = (bf16*)(ws + WS_HYTC); bf16* GG = (bf16*)(ws + WS_R1); float* SS = (float*)(ws + WS_R1);
    int* PEL = (int*)(ws + WS_PLIST); float* PGL = (float*)(ws + WS_PLIST + 8 * MiB);
    unsigned char* TU = ws + WS_TAB; unsigned char* TV = TU + (size_t)PEER_N * 768; float* TUS = (float*)(ws + WS_TAB + 32 * MiB); float* TVS = TUS + PEER_N;
    float* CTXB = (float*)(ws + WS_CTXB); const float* MOD = (const float*)(ws + WS_MOD);
    const float* ropec = (const float*)(ws + WS_ROPE); const float* ropes = ropec + 4096;

    PH(0) { PCTX(Cp); p0_prologue(A, Cp); }
#if PROBE_PRO
    __syncthreads();
    PH(0) { PCTX(Cp); p0_prologue(A, Cp); }
#endif
    GRID_BAR();

#pragma unroll 1
    for (int l = 0; l < DEPTH; ++l) {
        const bool need_ctx = (l < DEPTH - 1);
        const int MR = need_ctx ? MT : ML;
#define xold ((l == 0) ? A.x : (const float*)A.out)
#define cold ((l == 0) ? A.ctx : (const float*)CTXB)
#define WIN ((const bf16*)(ws + WS_WIN) + (size_t)l * IN_W * 1024)
#define MODl (MOD + (size_t)l * 3 * 6144)

        if (l == 0) { PH(1) { PCTX(Cp); norm_rows(Cp, xold, cold, MT, A.g_norm1 + l * 1024, MODl, 0, XN); }
        GRID_BAR(); }
        CHK(chk::c_norm(A, Cq, xold, cold, A.g_norm1 + l * 1024, MODl, 0, XN, 0); chk::c_mod(A, Cq, 1));

#pragma unroll 1
        for (int repg_ = 0; repg_ < REP_P2; ++repg_) {
        PH(2) {
            pg8::Gemm g{XN, WIN, MT, 2304, 1024}; pg8::StaticOrder S; S.init(MT, 2304, C.G, (int)blockIdx.x);
            pg8::EpiIn E{Qb, Kb, Vb, BG, CX, A.q_gain + l * 64, A.k_gain + l * 64, ropec, ropes};
            pg8::gemm_phase<pg8::EpiIn, pg8::StaticOrder, true, true>(ring, g, S, E);
        }
        PH(3) {
            pg8::Gemm g{WIN + (size_t)HY0 * 1024, XN, 1536, MR, 1024}; pg8::StaticOrder S; S.init(1536, MR, C.G, (int)blockIdx.x, (MT / 256) * 9);
            pg8::EpiHyT E{HYT, HYTC};
            pg8::gemm_phase<pg8::EpiHyT, pg8::StaticOrder, true, true>(ring, g, S, E);
        }
        }
        GRID_BAR();

        CHK(chk::c_proj(A, Cq, l, 2); chk::c_att_save(A, Cq); chk::c_hy1(A, Cq, l, 300); chk::c_hy2(A, Cq, l, 1, 300));
        CHK(chk::c_hy3(A, Cq, l, 1, 300));
        PH(4)
#pragma unroll 1
        for (int rep3_ = 0; rep3_ < REP_HY; ++rep3_)
        for (int c = C.vcu; c < HY_W; c += C.G) { PCTX(Cp); hy::hyena_unit(A, Cp, l, c, need_ctx); }
        __syncthreads();
        PH(5) { PCTX(Cp); ysc_pass(Cp, BG, CX, A.sc_conv_w + (size_t)l * 3 * 512, MR); }
        GRID_BAR();

        CHK(chk::c_ysc(A, Cq, l, 8); chk::c_hy4(A, Cq, l, 1, 300, 9));
        PH(5) { PCTX(Cp); yhy_transpose(Cp, YHYT, YHY, need_ctx); }
        __syncthreads();
        PH(6) {
#if PROBE_ATT
            for (int ug = C.vcu; ug < 1024; ug += C.G) {
                const int grp = (ug >> 6) & 3, rest = (ug & 63) | ((ug >> 8) << 6), b = grp >> 1, kvh = grp & 1, h = kvh * 4 + (rest & 3), qb = rest >> 2;
                const attn_body::bf16* Qu = (const attn_body::bf16*)(Qb + ((size_t)b * SEQ + (size_t)qb * 256) * 512 + h * 64);
                const attn_body::bf16* Kh = (const attn_body::bf16*)(Kb + (size_t)b * KVL * 128 + kvh * 64);
                const attn_body::bf16* Vh = (const attn_body::bf16*)(Vb + (size_t)b * KVL * 128 + kvh * 64);
                attn_body::attn_unit<ATT_THRL>(Qu, Kh, Vh, (attn_body::bf16*)(CX + ((size_t)b * SEQ + (size_t)qb * 256) * 512 + h * 64), KVL / 64, (char*)lds_raw);
            }
#endif
            for (int ug = C.vcu; ug < 1024; ug += C.G) {
                const int grp = (ug >> 6) & 3, rest = (ug & 63) | ((ug >> 8) << 6), b = grp >> 1, kvh = grp & 1, h = kvh * 4 + (rest & 3), qb = rest >> 2;
                const attn_body::bf16* Qu = (const attn_body::bf16*)(Qb + ((size_t)b * SEQ + (size_t)qb * 256) * 512 + h * 64);
                const attn_body::bf16* Kh = (const attn_body::bf16*)(Kb + (size_t)b * KVL * 128 + kvh * 64);
                const attn_body::bf16* Vh = (const attn_body::bf16*)(Vb + (size_t)b * KVL * 128 + kvh * 64);
                attn_body::attn_unit<ATT_THRL>(Qu, Kh, Vh, (attn_body::bf16*)Qu, KVL / 64, (char*)lds_raw);
            }
            if (need_ctx) for (int ug = C.vcu; ug < 16; ug += C.G) {
                const int b = ug >> 3, h = ug & 7;
                const attn_body::bf16* Qu = (const attn_body::bf16*)(Qb + ((size_t)ML + (size_t)b * CTX_LEN) * 512 + h * 64);
                const attn_body::bf16* Kh = (const attn_body::bf16*)(Kb + (size_t)b * KVL * 128 + (h >> 2) * 64);
                const attn_body::bf16* Vh = (const attn_body::bf16*)(Vb + (size_t)b * KVL * 128 + (h >> 2) * 64);
                attn_body::attn_unit<ATT_THRL>(Qu, Kh, Vh, (attn_body::bf16*)Qu, CTX_LEN / 64, (char*)lds_raw);
            }
        }
        GRID_BAR();

        CHK(chk::c_att(A, Cq, 10); chk::c_yhyT(A, Cq, 11));
        const bool packed_ctx = need_ctx && C.G == 256;
#pragma unroll 1
        for (int half = 0; half < (MR + 16383) / 16384; ++half) {
            const int rowbase = half * 16384, nr = (MR - rowbase) < 16384 ? (MR - rowbase) : 16384;
            if (nr == 16384) {
                PH(7) {
                    pg8::Gemm g{XN + (size_t)rowbase * 1024, WIN + (size_t)GT0 * 1024, nr, 3072, 1024}; pg8::GateOrder S; S.S.init(nr, 1024, C.G, (int)blockIdx.x);
                    pg8::EpiGate E{GG};
                    pg8::gemm_phase<pg8::EpiGate, pg8::GateOrder, true, true>(ring, g, S, E);
                }
                VM_WAIT(); __syncthreads();
                PH(8) {
                    pg8::Gemm g{Qb + (size_t)rowbase * 512, (const bf16*)(ws + WS_WBR) + (size_t)(l * 3) * 1024 * 512, nr, 1024, 512};
                    pg8::MergeOrder S; S.S.init(nr, 1024, C.G, (int)blockIdx.x); S.A0 = (const char*)(Qb + (size_t)rowbase * 512); S.d1 = (const char*)BG - (const char*)Qb; S.d2 = (const char*)YHY - (const char*)Qb;
                    pg8::EpiMerge3 E{GG, MM + (size_t)rowbase * 1024};
                    pg8::gemm_phase<pg8::EpiMerge3, pg8::MergeOrder, true, true>(ring, g, S, E);
                }
                VM_WAIT(); __syncthreads();
                if (rowbase + nr >= ML) GRID_BAR();
            } else if (!packed_ctx) {
                PH(7) {
                    pg8::Gemm g{XN + (size_t)rowbase * 1024, WIN + (size_t)GT0 * 1024, nr, 3072, 1024}; pg8::StaticOrder S; S.init(nr, 3072, C.G, (int)blockIdx.x);
                    pg8::EpiGate E{GG};
                    pg8::gemm_phase<pg8::EpiGate, pg8::StaticOrder, true, true>(ring, g, S, E);
                }
                PH(10) { const int nb_ = (nr / 256) * 12; if ((int)blockIdx.x >= nb_) { PCTX(Cp); cvt_table_fp6(Cp, A.peer_u + (size_t)l * PEER_N * 1024, TU, TUS, PEER_N, (int)blockIdx.x - nb_, C.G - nb_); } }
                GRID_BAR();
                PH(8) {
                    pg8::Gemm g{Qb + (size_t)rowbase * 512, (const bf16*)(ws + WS_WBR) + (size_t)(l * 3) * 1024 * 512, nr, 1024, 512};
                    pg8::MergeOrder S; S.S.init(nr, 1024, C.G, (int)blockIdx.x); S.A0 = (const char*)(Qb + (size_t)rowbase * 512); S.d1 = (const char*)BG - (const char*)Qb; S.d2 = (const char*)YHY - (const char*)Qb;
                    pg8::EpiMerge3 E{GG, MM + (size_t)rowbase * 1024};
                    pg8::gemm_phase<pg8::EpiMerge3, pg8::MergeOrder, true, true>(ring, g, S, E);
                }
                PH(10) { const int nb_ = (nr / 256) * 4; if ((int)blockIdx.x >= nb_) { PCTX(Cp); cvt_table_fp6(Cp, A.peer_v + (size_t)l * PEER_N * 1024, TV, TVS, PEER_N, (int)blockIdx.x - nb_, C.G - nb_); } }
                GRID_BAR();
            }
        }

        if (packed_ctx) {
            const int b = (int)blockIdx.x;
            const pg8::Gemm gP{MM, (const bf16*)(ws + WS_WOUT) + (size_t)l * 1024 * 1024, MR, 1024, 1024};
            const pg8::EpiResid EP{xold, A.out, cold, CTXB, MODl};
            const int rowbase = ML, nr = MR - ML;
            if (b < 24) PH(7) {
                pg8::Gemm g{XN + (size_t)rowbase * 1024, WIN + (size_t)GT0 * 1024, nr, 3072, 1024}; pg8::StaticOrder S; S.init(nr, 3072, C.G, b);
                pg8::EpiGate E{GG};
                pg8::gemm_phase<pg8::EpiGate, pg8::StaticOrder, true, true>(ring, g, S, E);
            }
            PH(9) { const int k = b - 24; pg8::OneUnit S{k >= 0 ? (k & 7) * 64 + (k >> 3) : -1, 4}; pg8::gemm_phase<pg8::EpiResid, pg8::OneUnit, true, true>(ring, gP, S, EP); }
            GRID_BAR();
            if (b < 8) PH(8) {
                pg8::Gemm g{Qb + (size_t)rowbase * 512, (const bf16*)(ws + WS_WBR) + (size_t)(l * 3) * 1024 * 512, nr, 1024, 512};
                pg8::MergeOrder S; S.S.init(nr, 1024, C.G, b); S.A0 = (const char*)(Qb + (size_t)rowbase * 512); S.d1 = (const char*)BG - (const char*)Qb; S.d2 = (const char*)YHY - (const char*)Qb;
                pg8::EpiMerge3 E{GG, MM + (size_t)rowbase * 1024};
                pg8::gemm_phase<pg8::EpiMerge3, pg8::MergeOrder, true, true>(ring, g, S, E);
            }
            PH(9) { const int k = b >= 8 ? 232 + (b - 8) : -1; pg8::OneUnit S{k >= 0 ? (k & 7) * 64 + (k >> 3) : -1, 4}; pg8::gemm_phase<pg8::EpiResid, pg8::OneUnit, true, true>(ring, gP, S, EP); }
            GRID_BAR();
            PH(9) { const int k = b < 32 ? 480 + b : -1; const int idx = k >= 0 ? (k & 7) * 64 + (k >> 3) : (b < 40 ? 512 + (b - 32) : -1);
                    pg8::OneUnit S{idx, 4}; pg8::gemm_phase<pg8::EpiResid, pg8::OneUnit, true, true>(ring, gP, S, EP); }
            if (b >= 40) PH(10) { PCTX(Cp); cvt_table_fp6(Cp, A.peer_u + (size_t)l * PEER_N * 1024, TU, TUS, PEER_N, b - 40, C.G - 40); cvt_table_fp6(Cp, A.peer_v + (size_t)l * PEER_N * 1024, TV, TVS, PEER_N, b - 40, C.G - 40); }
            GRID_BAR();
        } else {
        PH(9) {
            pg8::Gemm g{MM, (const bf16*)(ws + WS_WOUT) + (size_t)l * 1024 * 1024, MR, 1024, 1024}; pg8::StaticOrder S; S.init(MR, 1024, C.G, (int)blockIdx.x);
            pg8::EpiResid E{xold, A.out, cold, CTXB, MODl};
            pg8::gemm_phase<pg8::EpiResid, pg8::StaticOrder, true, true>(ring, g, S, E);
        }
        GRID_BAR();
        }

        CHK(chk::c_wout(A, Cq, l, 14));
        PH(10) { PCTX(Cp); norm_rows(Cp, A.out, CTXB, MR, A.g_norm2 + l * 1024, MODl, 3, XN); }
        if (!need_ctx) {
        PH(10) { PCTX(Cp); cvt_table_fp6(Cp, A.peer_u + (size_t)l * PEER_N * 1024, TU, TUS, PEER_N); }
        PH(10) { PCTX(Cp); cvt_table_fp6(Cp, A.peer_v + (size_t)l * PEER_N * 1024, TV, TVS, PEER_N); }
        }
        GRID_BAR();

        CHK(chk::c_norm(A, Cq, A.out, CTXB, A.g_norm2 + l * 1024, MODl, 3, XN, 15));
        const int nchunk = (MR + 16383) / 16384;
        const bool fold_ctx = packed_ctx && nchunk == 3;
        float* SSC = (float*)(ws + WS_PLIST + 16 * MiB); int* ELC = (int*)(ws + WS_PLIST + 20 * MiB); float* GLC = (float*)(ws + WS_PLIST + 21 * MiB);
#pragma unroll 1
        for (int ch = 0; ch < nchunk; ++ch) {
            const int row0 = ch * 16384, nr = (MR - row0) < 16384 ? (MR - row0) : 16384;
            if (fold_ctx && ch == 2) break;
            pg8::StaticOrder SSO; SSO.init(2048, nr, C.G, (int)blockIdx.x);
#pragma unroll 1
            for (int reps_ = 0; reps_ < REP_SG; ++reps_)
            PH(11) {
                pg8::Gemm g{(const bf16*)(ws + WS_WPEER) + (size_t)l * 2048 * 1024, XN + (size_t)row0 * 1024, 2048, nr, 1024};
                pg8::EpiScoreT E{SS};
                pg8::gemm_phase<pg8::EpiScoreT, pg8::StaticOrder, true, true>(ring, g, SSO, E);
            }
            if (nr < 4096) {
                GRID_BAR();
                PH(12) { PCTX(Cp); peer::route_tokens_wave(Cp, SS, nr, PEL, PGL); }
            } else {
                VM_WAIT(); __syncthreads();
#pragma unroll 1
                for (int repr_ = 0; repr_ < REP_ROUTE; ++repr_) { PH(12) { PCTX(Cp); peer::route_tasks(Cp, SS, nr, PEL, PGL, SSO); } }
                if (fold_ctx && ch == 1) PH(12) { PCTX(Cp); peer::route_tokens_wave(Cp, SSC, MR - ML, ELC, GLC); }
            }
            GRID_BAR();
            if (fold_ctx && ch == 0 && (int)blockIdx.x < 16) PH(11) {
                pg8::Gemm g{(const bf16*)(ws + WS_WPEER) + (size_t)l * 2048 * 1024, XN + (size_t)ML * 1024, 2048, MR - ML, 1024};
                pg8::OneUnit S1{(int)blockIdx.x, 2}; pg8::EpiScoreT E{SSC};
                pg8::gemm_phase<pg8::EpiScoreT, pg8::OneUnit, true, true>(ring, g, S1, E);
            }
            PH(12) { PCTX(Cp); peer::topk_gather(A, Cp, l, row0, nr, PEL, PGL, TU, TV, TUS, TVS, XN, A.out, CTXB, MODl, !need_ctx, A.g_norm1 + (l + 1) * 1024, MOD + (size_t)(l + 1) * 3 * 6144, XN); }
            if (fold_ctx && ch == 1) PH(12) { PCTX(Cp); peer::topk_gather(A, Cp, l, ML, MR - ML, ELC, GLC, TU, TV, TUS, TVS, XN, A.out, CTXB, MODl, !need_ctx, A.g_norm1 + (l + 1) * 1024, MOD + (size_t)(l + 1) * 3 * 6144, XN); }
            GRID_BAR();
        }
    }
#ifdef SELFCHECK
    {
        const float* acc = (const float*)(ws + chk::WS_DBG); int first = -1;
        const int order[21] = {0, 1, 2, 3, 4, 5, 6, 7, 8, 9, 10, 11, 12, 18, 19, 20, 13, 14, 15, 16, 17};
#pragma unroll
        for (int p = 0; p < 21; ++p) { const int k = order[p]; const float se = acc[2 * k], sr = acc[2 * k + 1]; const float tol = (k == 17) ? 0.15f : 0.03f;
            if (first < 0 && !((CHKSKIP >> k) & 1) && (!(se <= tol * tol * sr) || sr == 0.f)) first = p; }
        if (first >= 0) { const float sc = 1.0f + 0.25f * (float)(first + 1);
            for (size_t i = (size_t)C.vcu * NTHREADS + C.tid; i < (size_t)ML * 1024; i += (size_t)C.G * NTHREADS) A.out[i] *= sc; }
    }
#endif
#undef GRID_BAR
#undef xold
#undef cold
#undef WIN
#undef MODl
}

extern "C" void kernel_launch(void* const* d_in, const int* in_sizes, int n_in, void* d_out, int out_size, void* d_ws, size_t ws_size, hipStream_t stream) {
    static int grid = 0;
    if (grid == 0) {
        if (n_in != 32 || in_sizes[0] != ML * D_MODEL || out_size != ML * D_MODEL || ws_size < WS_END) { fprintf(stderr, "kernel_launch: unexpected shapes (n_in %d, in0 %d, out %d, ws %zu)\n", n_in, n_in > 0 ? in_sizes[0] : -1, out_size, ws_size); grid = -1; return; }
        int dev = 0, cus = 0, per_cu = 0;
        if (hipGetDevice(&dev) != hipSuccess || hipDeviceGetAttribute(&cus, hipDeviceAttributeMultiprocessorCount, dev) != hipSuccess) { grid = -1; return; }
        if (hipFuncSetAttribute((const void*)mega_fwd, hipFuncAttributeMaxDynamicSharedMemorySize, LDS_BYTES) != hipSuccess) { fprintf(stderr, "kernel_launch: hipFuncSetAttribute failed\n"); grid = -1; return; }
        if (hipOccupancyMaxActiveBlocksPerMultiprocessor(&per_cu, (const void*)mega_fwd, NTHREADS, LDS_BYTES) != hipSuccess || per_cu < 1) { fprintf(stderr, "kernel_launch: occupancy query says %d\n", per_cu); }
        (void)hipGetLastError();
        grid = cus;
    }
    if (grid < 0) return;
    if (hipMemsetAsync((char*)d_ws + WS_CTL, 0, CTL_ZERO_BYTES, stream) != hipSuccess) return;
#ifdef SELFCHECK
    (void)hipMemsetAsync((char*)d_ws + chk::WS_DBG, 0, 65536, stream);
#endif
    Args a{};
    const float** ap = (const float**)&a;
    for (int i = 0; i < 32; ++i) ap[i] = (const float*)d_in[i];
    a.out = (float*)d_out; a.ws = (unsigned char*)d_ws;
    hipLaunchKernelGGL(mega_fwd, dim3(grid), dim3(NTHREADS), LDS_BYTES, stream, a);
}
```

```cpp
#include <hip/hip_runtime.h>
#include <hip/hip_bf16.h>
#include <cstdio>
#include <cstdint>
#include <cmath>

#define SELFCHECK_ON 0
#if SELFCHECK_ON
#define SELFCHECK
#endif
#define REP_ROUTE 1
#define REP_GATHER 1
#define REP_HY 1
#define PROBE_FFT 0
#define REP_FILT 1
#define PROBE_REST 0
#define PROBE_PRO 0
#define PROBE_ATT 0
#ifndef FP6_ILV
#define FP6_ILV 1
#endif
#define REP_P2 1
#define REP_GM 1
#define REP_SG 1
#ifndef ABL
#define ABL 0
#endif
constexpr int D_MODEL = 1024, BATCH = 2, SEQ = 16384, DEPTH = 2, GRID_W = 64, CTX_LEN = 256;
constexpr int N_HEADS = 8, N_KV = 2, HEAD_DIM = 64, ATT_W = 512, KV_W = 128;
constexpr int SC_W = 512, HY_W = 512, HY_EMB = 33, HY_FH = 64;
constexpr int PEER_HEADS = 8, PEER_NKEYS = 128, PEER_N = 16384, PEER_TOPK = 16;
constexpr int Q0 = 0, K0 = 512, V0 = 640, SC0 = 768, HY0 = 2304, GT0 = 3840, IN_W = 6912;
constexpr int ML = BATCH * SEQ;
constexpr int MC = BATCH * CTX_LEN;
constexpr int MT = ML + MC;
constexpr int KVL = CTX_LEN + SEQ;
constexpr float EPS = 1e-6f;
constexpr float C2Q = 0.125f * 1.4426950408889634f;

constexpr size_t MiB = 1u << 20;
constexpr size_t WS_CTL = 0, CTL_ZERO_BYTES = 64 * 1024;
constexpr size_t WS_MOD = 1 * MiB;
constexpr size_t WS_ROPE = 2 * MiB;
constexpr size_t WS_H2 = 3 * MiB;
constexpr size_t WS_H2C = 11 * MiB;
constexpr size_t WS_CTXB = 12 * MiB;
constexpr size_t WS_WIN = 16 * MiB;
constexpr size_t WS_WBR = 43 * MiB;
constexpr size_t WS_WOUT = 49 * MiB;
constexpr size_t WS_WPEER = 53 * MiB;
constexpr size_t WS_XN = 64 * MiB;
constexpr size_t WS_Q = 129 * MiB;
constexpr size_t WS_K = 162 * MiB;
constexpr size_t WS_V = WS_K + (size_t)BATCH * KVL * KV_W * 2;
constexpr size_t WS_BG = 179 * MiB;
constexpr size_t WS_CX = 212 * MiB;
constexpr size_t WS_YHYT = WS_CX + (size_t)MT * 512 * 2;
constexpr size_t WS_MM = WS_CX;
constexpr size_t WS_YHY = 277 * MiB;
constexpr size_t WS_R1 = 310 * MiB;
constexpr size_t WS_HYTC = WS_R1 + (size_t)BATCH * 1536 * SEQ * 2;
constexpr size_t WS_PLIST = 440 * MiB;
constexpr size_t WS_TAB = 472 * MiB;
constexpr size_t WS_HSCR = 472 * MiB;
constexpr size_t WS_END = 506 * MiB;
static_assert(WS_YHYT + (size_t)BATCH * 512 * (SEQ + CTX_LEN) * 2 <= WS_YHY, "ws map");
static_assert(WS_HYTC + (size_t)BATCH * 1536 * CTX_LEN * 2 <= WS_PLIST && WS_R1 + (size_t)2048 * (16384 + 64) * 4 <= WS_PLIST && WS_PLIST + 16 * MiB <= WS_HSCR, "ws map");
static_assert(WS_V + (size_t)BATCH * KVL * KV_W * 2 <= WS_BG, "ws map");
constexpr int CW_TMO = 0, CW_CODE = 1, CW_BAR = 4096;

constexpr int RING_BYTES = 131072;
constexpr int HYB_BYTES = 17408 * 8;
constexpr int HYS_OFF = HYB_BYTES;
constexpr int LDSCTL_OFF = 143360, MISC_OFF = LDSCTL_OFF + 320;
constexpr int LDS_BYTES = 147456;
constexpr int NWAVES = 8, NTHREADS = 512;

#define GAS __attribute__((address_space(1)))
#define LAS __attribute__((address_space(3)))
typedef unsigned short bf16;
typedef unsigned v4u __attribute__((ext_vector_type(4)));
typedef unsigned v2u __attribute__((ext_vector_type(2)));
typedef float f32x4 __attribute__((ext_vector_type(4)));
typedef float f32x2 __attribute__((ext_vector_type(2)));
typedef int v6i __attribute__((ext_vector_type(6)));
typedef float v16f __attribute__((ext_vector_type(16)));
typedef float v32f __attribute__((ext_vector_type(32)));
typedef short bf16x8 __attribute__((ext_vector_type(8)));
typedef GAS unsigned gu32;
#define RLX_AGENT __ATOMIC_RELAXED, __HIP_MEMORY_SCOPE_AGENT
#define LDS_WAIT() asm volatile("s_waitcnt lgkmcnt(0)" ::: "memory")
#define VM_WAIT() asm volatile("s_waitcnt vmcnt(0)" ::: "memory")
__device__ __forceinline__ unsigned f2bf(float f) { unsigned u = __builtin_bit_cast(unsigned, f); return (u + 0x7fffu + ((u >> 16) & 1u)) >> 16; }
__device__ __forceinline__ unsigned pk2(float lo, float hi) { return f2bf(lo) | (f2bf(hi) << 16); }
__device__ __forceinline__ float bflo(unsigned w) { return __builtin_bit_cast(float, w << 16); }
__device__ __forceinline__ float bfhi(unsigned w) { return __builtin_bit_cast(float, w & 0xffff0000u); }
__device__ __forceinline__ float bf1(bf16 h) { return __builtin_bit_cast(float, (unsigned)h << 16); }
__device__ __forceinline__ int opq_tid() { int t = threadIdx.x; asm volatile("" : "+v"(t)); return t; }
__device__ __forceinline__ float wave_sum(float v) {
#pragma unroll
    for (int o = 1; o < 64; o <<= 1) v += __shfl_xor(v, o);
    return v;
}
__device__ __forceinline__ float wave_max(float v) {
#pragma unroll
    for (int o = 1; o < 64; o <<= 1) v = fmaxf(v, __shfl_xor(v, o));
    return v;
}

#define XB_TMO      128
#define XB_XCNT(j)  (256  + 64 * (j))
#define XB_XSUB(j)  (1280 + 64 * (j))
#define XB_XGEN(j)  (2304 + 64 * (j))
#define XB_TOP      3328
#define XB_TOPGEN   3392
#define XCD_BAR_WORDS 3456
#define XB_SPIN_CAP (1u << 22)
__device__ __forceinline__ unsigned xb_ld(unsigned* p)              { return __hip_atomic_load(p, __ATOMIC_RELAXED, __HIP_MEMORY_SCOPE_AGENT); }
__device__ __forceinline__ unsigned xb_add(unsigned* p, unsigned v) { return __hip_atomic_fetch_add(p, v, __ATOMIC_RELAXED, __HIP_MEMORY_SCOPE_AGENT); }
__device__ __forceinline__ unsigned xb_xcc_id() { return (unsigned)__builtin_amdgcn_s_getreg((3 << 11) | 20) & 0xFu; }
#define XB_SPIN(cond, bar) do { unsigned _sp = 0; while (cond) { __builtin_amdgcn_s_sleep(1); \
    if ((++_sp & 255u) == 0u) { if (xb_ld(&(bar)[XB_TMO])) break; if (_sp > XB_SPIN_CAP) { atomicAdd(&(bar)[XB_TMO], 1u); break; } } } } while (0)
struct XcdBarrier { unsigned* bar; unsigned x; volatile LAS unsigned* st; };
__device__ __forceinline__ XcdBarrier xcd_barrier_post(unsigned* bar, volatile LAS unsigned* st) {
    XcdBarrier b; b.bar = bar; b.x = xb_xcc_id(); b.st = st;
    if (threadIdx.x == 0) (void)xb_add(&bar[XB_XCNT(b.x)], 1u);
    return b;
}
__device__ __forceinline__ void xcd_barrier_complete(unsigned* bar, unsigned x, unsigned& nloc, unsigned& nx) {
    const unsigned G = gridDim.x * gridDim.y * gridDim.z;
    unsigned sum, cnt, mine, sp = 0u;
    for (;;) {
        sum = 0u; cnt = 0u; mine = 0u;
#pragma unroll
        for (unsigned j = 0; j < 16; ++j) { const unsigned c = xb_ld(&bar[XB_XCNT(j)]); sum += c; cnt += (c > 0u) ? 1u : 0u; mine = (j == x) ? c : mine; }
        if (sum == G) break;
        __builtin_amdgcn_s_sleep(1);
        if ((++sp & 255u) == 0u) { if (xb_ld(&bar[XB_TMO])) break; if (sp > XB_SPIN_CAP) { atomicAdd(&bar[XB_TMO], 1u); break; } }
    }
    nloc = mine > 0u ? mine : 1u; nx = cnt > 0u ? cnt : 1u;
}
__device__ __forceinline__ void xcd_barrier(const XcdBarrier& b) {
    asm volatile("s_waitcnt vmcnt(0)" ::: "memory");
    __syncthreads();
    if (threadIdx.x == 0) {
        unsigned* bar = b.bar;
        __builtin_amdgcn_s_waitcnt(0);
        unsigned nloc = b.st[0], nx = b.st[1];
        if (nloc == 0u) { xcd_barrier_complete(bar, b.x, nloc, nx); b.st[0] = nloc; b.st[1] = nx; }
        const unsigned old = xb_add(&bar[XB_XSUB(b.x)], 1u);
        const unsigned gen = old / nloc;
        if (old + 1u == (gen + 1u) * nloc) {
            __builtin_amdgcn_fence(__ATOMIC_RELEASE, "agent");
            asm volatile("s_waitcnt vmcnt(0)" ::: "memory");
            const unsigned og = xb_add(&bar[XB_TOP], 1u);
            const unsigned tg = og / nx;
            if (og + 1u == (tg + 1u) * nx) xb_add(&bar[XB_TOPGEN], 1u);
            else XB_SPIN(xb_ld(&bar[XB_TOPGEN]) == tg, bar);
            __builtin_amdgcn_fence(__ATOMIC_ACQUIRE, "agent");
            xb_add(&bar[XB_XGEN(b.x)], 1u);
            asm volatile("s_waitcnt vmcnt(0)" ::: "memory");
        } else {
            XB_SPIN(xb_ld(&bar[XB_XGEN(b.x)]) == gen, bar);
            __builtin_amdgcn_fence(__ATOMIC_ACQUIRE, "agent");
            asm volatile("s_waitcnt vmcnt(0)" ::: "memory");
        }
    }
    __syncthreads();
}
namespace pg8 {
#define PG8_LAS __attribute__((address_space(3)))
typedef unsigned short bf16_t;
typedef short bf16x8 __attribute__((ext_vector_type(8)));
typedef float f32x4 __attribute__((ext_vector_type(4)));
typedef unsigned u32x4 __attribute__((ext_vector_type(4)));
constexpr int BM = 256, BK = 64, HALF = 128, HTB = HALF * BK * 2  , STAGE_BYTES = 8 * HTB, NXCD = 8, WGM = 8;

__host__ __device__ __forceinline__ int lds_byte(int r, int c) { const int st = (r >> 4) * 2 + (c >> 5), rr = r & 15, cc = c & 31, ob = rr * 64 + cc * 2; return st * 1024 + (ob ^ (((ob >> 9) & 1) << 5)); }
__host__ __device__ __forceinline__ void stage_rc(int b, int& R, int& C) { const int st = b / 1024, sb = b % 1024, swz = sb ^ (((sb >> 9) & 1) << 5); R = (st >> 1) * 16 + swz / 64; C = (st & 1) * 32 + (swz % 64) / 2; }
__host__ __device__ __forceinline__ int perm32(int rho) { const int n = rho >> 4, i = rho & 15; return 8 * (i >> 2) + 4 * n + (i & 3); }

struct Unit { int pm, pn, z; };
struct Gemm { const bf16_t* A; const bf16_t* Bt; int M, N, K; };


struct StaticOrder {
    int nM, nN, nwg, G, c;
    __host__ __device__ void init(int M, int N, int G_, int c_, int rot = 0) { nM = M / BM; nN = N / BM; nwg = nM * nN; G = G_; c = (c_ + G_ - (rot % G_)) % G_; }
    __host__ __device__ bool next(int i, Unit& u) const {
        const long L = (long)i * G + c; if (L >= nwg) return false;
        int wgid = (int)L; { const int q = nwg / NXCD, r = nwg % NXCD, xcd = wgid % NXCD, off = wgid / NXCD; wgid = (xcd < r ? xcd * (q + 1) : r * (q + 1) + (xcd - r) * q) + off; }
        const int nig = WGM * nN, gid = wgid / nig, fm = gid * WGM, gsz = (nM - fm) < WGM ? (nM - fm) : WGM;
        u.pm = fm + ((wgid % nig) % gsz); u.pn = (wgid % nig) / gsz; return true;
    }
    __device__ __forceinline__ void a_ready(const Unit&) const {}
    __device__ __forceinline__ void done(const Unit&) const {}
    __device__ __forceinline__ const char* baseA(const Gemm& g, const Unit& u, size_t tstep) const { return (const char*)g.A + (size_t)u.pm * tstep; }
    __device__ __forceinline__ const char* baseB(const Gemm& g, const Unit& u, size_t tstep) const { return (const char*)g.Bt + (size_t)u.pn * tstep; }
};
struct OneUnit {
    int idx, nN;
    __host__ __device__ bool next(int i, Unit& u) const { if (i != 0 || idx < 0) return false; u.pm = idx / nN; u.pn = idx % nN; u.z = 0; return true; }
    __device__ __forceinline__ void a_ready(const Unit&) const {}
    __device__ __forceinline__ void done(const Unit&) const {}
    __device__ __forceinline__ const char* baseA(const Gemm& g, const Unit& u, size_t tstep) const { return (const char*)g.A + (size_t)u.pm * tstep; }
    __device__ __forceinline__ const char* baseB(const Gemm& g, const Unit& u, size_t tstep) const { return (const char*)g.Bt + (size_t)u.pn * tstep; }
};
struct GateOrder {
    StaticOrder S;
    __host__ __device__ bool next(int i, Unit& u) const { if (!S.next(i / 3, u)) return false; u.pn += 4 * (i % 3); u.z = 0; return true; }
    __device__ __forceinline__ void a_ready(const Unit&) const {}
    __device__ __forceinline__ void done(const Unit&) const {}
    __device__ __forceinline__ const char* baseA(const Gemm& g, const Unit& u, size_t tstep) const { return (const char*)g.A + (size_t)u.pm * tstep; }
    __device__ __forceinline__ const char* baseB(const Gemm& g, const Unit& u, size_t tstep) const { return (const char*)g.Bt + (size_t)u.pn * tstep; }
};
struct MergeOrder {
    StaticOrder S; const char* A0; long d1, d2;
    __host__ __device__ bool next(int i, Unit& u) const { if (!S.next(i / 3, u)) return false; u.z = i % 3; return true; }
    __device__ __forceinline__ void a_ready(const Unit&) const {}
    __device__ __forceinline__ void done(const Unit&) const {}
    __device__ __forceinline__ const char* baseA(const Gemm& g, const Unit& u, size_t tstep) const { return A0 + (long)(u.z & 1) * d1 + (long)(u.z >> 1) * d2 + (size_t)u.pm * tstep; }
    __device__ __forceinline__ const char* baseB(const Gemm& g, const Unit& u, size_t tstep) const { return (const char*)g.Bt + ((size_t)u.z * g.N * g.K) * 2 + (size_t)u.pn * tstep; }
};

typedef float f32x2_t __attribute__((ext_vector_type(2))); typedef __bf16 bf16x2_t __attribute__((ext_vector_type(2)));
__device__ __forceinline__ unsigned cvt_pk_bf16(float lo, float hi) { f32x2_t v = {lo, hi}; bf16x2_t b = __builtin_convertvector(v, bf16x2_t); return __builtin_bit_cast(unsigned, b); }
__device__ __forceinline__ u32x4 pack8(const f32x4& a, const f32x4& b) { u32x4 w; w.x = cvt_pk_bf16(a[0], a[1]); w.y = cvt_pk_bf16(a[2], a[3]); w.z = cvt_pk_bf16(b[0], b[1]); w.w = cvt_pk_bf16(b[2], b[3]); return w; }
__device__ __forceinline__ void unpack8(const u32x4& w, f32x4& a, f32x4& b) {
    a[0] = __builtin_bit_cast(float, w.x << 16); a[1] = __builtin_bit_cast(float, w.x & 0xffff0000u); a[2] = __builtin_bit_cast(float, w.y << 16); a[3] = __builtin_bit_cast(float, w.y & 0xffff0000u);
    b[0] = __builtin_bit_cast(float, w.z << 16); b[1] = __builtin_bit_cast(float, w.z & 0xffff0000u); b[2] = __builtin_bit_cast(float, w.w << 16); b[3] = __builtin_bit_cast(float, w.w & 0xffff0000u);
}

struct EpiIn {
    static constexpr bool PERM = true, AFTER_DRAIN = false, RESCALE = false;
    bf16_t* Q; bf16_t* Kb; bf16_t* Vb; bf16_t* BG; bf16_t* CX; const float* qgain; const float* kgain; const float* ropec; const float* ropes;
    __device__ __forceinline__ void operator()(const f32x4 (&acc)[2][2][4][2], const Unit& u, int wr, int wc, int fr_, int fq_) const {
        const int ln_ = opq_tid() & 63; const int fr = ln_ & 15, fq = ln_ >> 4;
        const int row0 = u.pm * BM + wr * 64 + fr;
        const int pn = u.pn;
        if (pn < 2 || (pn == 2 && wc < 2)) {
            const bool isq = pn < 2;
            const float* gain = isq ? qgain : kgain;
            const float qs = isq ? 0.18033688011112042f : 1.0f;
            f32x4 gn[2][2];
#pragma unroll
            for (int bj = 0; bj < 2; ++bj) { gn[bj][0] = *(const f32x4*)(gain + 32 * bj + 4 * fq); gn[bj][1] = *(const f32x4*)(gain + 32 * bj + 16 + 4 * fq); }
#pragma unroll
            for (int ai = 0; ai < 2; ++ai)
#pragma unroll
                for (int m = 0; m < 4; ++m) {
                    const int r = row0 + ai * HALF + m * 16;
                    float ss = 0.f;
#pragma unroll
                    for (int bj = 0; bj < 2; ++bj)
#pragma unroll
                        for (int n = 0; n < 2; ++n) { const f32x4 x = acc[ai][bj][m][n]; ss += (x[0] * x[0] + x[1] * x[1]) + (x[2] * x[2] + x[3] * x[3]); }
                    ss += __shfl_xor(ss, 16); ss += __shfl_xor(ss, 32);
                    const float rs = qs / sqrtf(ss * (1.0f / 64.0f) + 1e-6f);
                    const bool latent = r < 32768;
                    const int t = r & 16383;
                    bf16_t* dst;
                    if (isq) dst = Q + (size_t)r * 512 + (4 * pn + wc) * 64 + 8 * fq;
                    else { const int kvrow = latent ? ((r >> 14) * 16640 + 256 + t) : (((r - 32768) >> 8) * 16640 + ((r - 32768) & 255)); dst = Kb + (size_t)kvrow * 128 + wc * 64 + 8 * fq; }
#pragma unroll
                    for (int bj = 0; bj < 2; ++bj) {
                        f32x4 x1 = acc[ai][bj][m][0] * rs * gn[bj][0], x2 = acc[ai][bj][m][1] * rs * gn[bj][1];
                        if (latent) {
                            const int pos = bj ? (t & 63) : (t >> 6);
                            const f32x4 cs = *(const f32x4*)(ropec + pos * 16 + 4 * fq), sn = *(const f32x4*)(ropes + pos * 16 + 4 * fq);
                            const f32x4 o1 = x1 * cs - x2 * sn, o2 = x2 * cs + x1 * sn; x1 = o1; x2 = o2;
                        }
                        *(u32x4*)(dst + 32 * bj) = pack8(x1, x2);
                    }
                    asm volatile("" ::: "memory");
                }
        } else if (pn == 2) {
#pragma unroll
            for (int ai = 0; ai < 2; ++ai)
#pragma unroll
                for (int m = 0; m < 4; ++m) {
                    const int r = row0 + ai * HALF + m * 16; const bool latent = r < 32768; const int t = r & 16383;
                    const int kvrow = latent ? ((r >> 14) * 16640 + 256 + t) : (((r - 32768) >> 8) * 16640 + ((r - 32768) & 255));
                    bf16_t* dst = Vb + (size_t)kvrow * 128 + (wc - 2) * 64 + 8 * fq;
#pragma unroll
                    for (int bj = 0; bj < 2; ++bj) *(u32x4*)(dst + 32 * bj) = pack8(acc[ai][bj][m][0], acc[ai][bj][m][1]);
                }
        } else if (pn < 5) {
#pragma unroll
            for (int ai = 0; ai < 2; ++ai)
#pragma unroll
                for (int m = 0; m < 4; ++m) {
                    const int r = row0 + ai * HALF + m * 16;
                    bf16_t* dst = BG + (size_t)r * 512 + (pn - 3) * 256 + wc * 32 + 8 * fq;
#pragma unroll
                    for (int bj = 0; bj < 2; ++bj) *(u32x4*)(dst + bj * HALF) = pack8(acc[ai][bj][m][0], acc[ai][bj][m][1]);
                }
        } else {
#pragma unroll
            for (int ai = 0; ai < 2; ++ai)
#pragma unroll
                for (int m = 0; m < 4; ++m) {
                    const int r = row0 + ai * HALF + m * 16;
                    bf16_t* dst = CX + (size_t)r * 512 + (pn - 5) * 128 + wc * 32 + 8 * fq;
                    *(u32x4*)dst = pack8(acc[ai][0][m][0] * acc[ai][1][m][0], acc[ai][0][m][1] * acc[ai][1][m][1]);
                }
        }
    }
};
struct EpiHyT {
    static constexpr bool PERM = true, AFTER_DRAIN = false, RESCALE = false;
    bf16_t* HYT; bf16_t* HYTC;
    __device__ __forceinline__ void operator()(const f32x4 (&acc)[2][2][4][2], const Unit& u, int wr, int wc, int fr_, int fq_) const {
        const int ln_ = opq_tid() & 63; const int fr = ln_ & 15, fq = ln_ >> 4;
        const int ch0 = u.pm * BM + wr * 64 + fr;
        bf16_t* base; size_t pitch;
        if (u.pn < 128) { const int b = u.pn >> 6, t0 = (u.pn & 63) * 256; base = HYT + (size_t)b * 1536 * 16384 + t0; pitch = 16384; }
        else { const int b = u.pn - 128; base = HYTC + (size_t)b * 1536 * 256; pitch = 256; }
        base += wc * 32 + 8 * fq;
#pragma unroll
        for (int ai = 0; ai < 2; ++ai)
#pragma unroll
            for (int m = 0; m < 4; ++m) { bf16_t* rowp = base + (size_t)(ch0 + ai * HALF + m * 16) * pitch;
#pragma unroll
                for (int bj = 0; bj < 2; ++bj) *(u32x4*)(rowp + bj * HALF) = pack8(acc[ai][bj][m][0], acc[ai][bj][m][1]); }
    }
};
struct EpiGate {
    static constexpr bool PERM = true, AFTER_DRAIN = false, RESCALE = false;
    bf16_t* G;
    __device__ __forceinline__ void operator()(const f32x4 (&acc)[2][2][4][2], const Unit& u, int wr, int wc, int fr_, int fq_) const {
        const int ln_ = opq_tid() & 63; const int fr = ln_ & 15, fq = ln_ >> 4;
        const int row0 = u.pm * BM + wr * 64 + fr, col0 = u.pn * BM + wc * 32 + 8 * fq;
#pragma unroll
        for (int ai = 0; ai < 2; ++ai)
#pragma unroll
            for (int m = 0; m < 4; ++m) { bf16_t* rowp = G + (size_t)(row0 + ai * HALF + m * 16) * 3072 + col0;
#pragma unroll
                for (int bj = 0; bj < 2; ++bj) { f32x4 a = acc[ai][bj][m][0], b = acc[ai][bj][m][1];
#pragma unroll
                    for (int e = 0; e < 4; ++e) { a[e] = __builtin_amdgcn_rcpf(1.0f + __builtin_amdgcn_exp2f(-1.4426950408889634f * a[e])); b[e] = __builtin_amdgcn_rcpf(1.0f + __builtin_amdgcn_exp2f(-1.4426950408889634f * b[e])); }
                    *(u32x4*)(rowp + bj * HALF) = pack8(a, b); } }
    }
};
struct EpiMerge {
    static constexpr bool PERM = true, AFTER_DRAIN = false, RESCALE = false;
    const bf16_t* G; bf16_t* MM; int br;
    __device__ __forceinline__ void operator()(const f32x4 (&acc)[2][2][4][2], const Unit& u, int wr, int wc, int fr_, int fq_) const {
        const int ln_ = opq_tid() & 63; const int fr = ln_ & 15, fq = ln_ >> 4;
        const int row0 = u.pm * BM + wr * 64 + fr, col0 = u.pn * BM + wc * 32 + 8 * fq;
#pragma unroll
        for (int ai = 0; ai < 2; ++ai)
#pragma unroll
            for (int m = 0; m < 4; ++m) { const size_t r = (size_t)(row0 + ai * HALF + m * 16);
#pragma unroll
                for (int bj = 0; bj < 2; ++bj) {
                    const u32x4 gw = *(const u32x4*)(G + r * 3072 + br * 1024 + col0 + bj * HALF);
                    f32x4 g0, g1; unpack8(gw, g0, g1);
                    f32x4 v0 = g0 * acc[ai][bj][m][0], v1 = g1 * acc[ai][bj][m][1];
                    if ((ABL >> br) & 1) { v0 = v0 * 0.f; v1 = v1 * 0.f; }
                    bf16_t* mp = MM + r * 1024 + col0 + bj * HALF;
                    if (br > 0) { const u32x4 mw = *(const u32x4*)mp; f32x4 m0, m1; unpack8(mw, m0, m1); v0 += m0; v1 += m1; }
                    *(u32x4*)mp = pack8(v0, v1); } }
    }
};
struct EpiMerge3 {
    static constexpr bool PERM = true, AFTER_DRAIN = false, RESCALE = true;
    const bf16_t* G; bf16_t* MM;
    __device__ __forceinline__ bool keep(const Unit& u) const { return u.z < 2; }
    __device__ __forceinline__ void fin(f32x4 (&acc)[2][2][4][2], const Unit& u, int wr, int wc) const {
        const int ln_ = opq_tid() & 63; const int fr = ln_ & 15, fq = ln_ >> 4;
        const int row0 = u.pm * BM + wr * 64 + fr, col0 = u.pn * BM + wc * 32 + 8 * fq;
        if (u.z < 2) {
#pragma unroll
            for (int ai = 0; ai < 2; ++ai)
#pragma unroll
                for (int m = 0; m < 4; ++m) { const size_t r = (size_t)(row0 + ai * HALF + m * 16);
#pragma unroll
                    for (int bj = 0; bj < 2; ++bj) {
                        const bf16_t* gp = G + r * 3072 + u.z * 1024 + col0 + bj * HALF;
                        const u32x4 ga = *(const u32x4*)gp, gb = *(const u32x4*)(gp + 1024);
                        f32x4 a0, a1, b0, b1; unpack8(ga, a0, a1); unpack8(gb, b0, b1);
                        f32x4 r0, r1;
#pragma unroll
                        for (int e = 0; e < 4; ++e) { r0[e] = a0[e] * __builtin_amdgcn_rcpf(b0[e]); r1[e] = a1[e] * __builtin_amdgcn_rcpf(b1[e]); }
                        acc[ai][bj][m][0] = acc[ai][bj][m][0] * r0; acc[ai][bj][m][1] = acc[ai][bj][m][1] * r1; } }
        } else {
#pragma unroll
            for (int ai = 0; ai < 2; ++ai) {
                u32x4 gwv[4][2];
#pragma unroll
                for (int m = 0; m < 4; ++m) { const size_t r = (size_t)(row0 + ai * HALF + m * 16);
#pragma unroll
                    for (int bj = 0; bj < 2; ++bj) gwv[m][bj] = *(const u32x4*)(G + r * 3072 + 2 * 1024 + col0 + bj * HALF); }
                asm volatile("" ::: "memory");
#pragma unroll
                for (int m = 0; m < 4; ++m) { const size_t r = (size_t)(row0 + ai * HALF + m * 16);
#pragma unroll
                    for (int bj = 0; bj < 2; ++bj) { f32x4 g0, g1; unpack8(gwv[m][bj], g0, g1);
                        *(u32x4*)(MM + r * 1024 + col0 + bj * HALF) = pack8(g0 * acc[ai][bj][m][0], g1 * acc[ai][bj][m][1]); } }
                asm volatile("" ::: "memory"); }
        }
    }
};
struct EpiResid {
    static constexpr bool PERM = false, AFTER_DRAIN = false, RESCALE = false;
    const float* xold; float* xnew; const float* cold; float* cnew; const float* mod;
    __device__ __forceinline__ void operator()(const f32x4 (&acc)[2][2][4][2], const Unit& u, int wr, int wc, int fr_, int fq_) const {
        const int ln_ = opq_tid() & 63; const int fr = ln_ & 15, fq = ln_ >> 4;
        const int row0 = u.pm * BM + wr * 64 + fr, col0 = u.pn * BM + wc * 32 + 4 * fq;
        const bool latent = u.pm < 128;
        const int which = latent ? (u.pm >> 6) : 2;
        const float* gp = mod + which * 6144 + 2 * 1024 + col0;
        f32x4 gv[2][2];
#pragma unroll
        for (int bj = 0; bj < 2; ++bj)
#pragma unroll
            for (int n = 0; n < 2; ++n) gv[bj][n] = *(const f32x4*)(gp + bj * HALF + n * 16);
        const float* src = latent ? xold : cold - (size_t)32768 * 1024; float* dst = latent ? xnew : cnew - (size_t)32768 * 1024;
#pragma unroll
        for (int ai = 0; ai < 2; ++ai)
#pragma unroll
            for (int m2 = 0; m2 < 4; m2 += 2) {
                f32x4 xin[2][2][2];
#pragma unroll
                for (int mm = 0; mm < 2; ++mm) { const size_t off = (size_t)(row0 + ai * HALF + (m2 + mm) * 16) * 1024 + col0;
#pragma unroll
                    for (int bj = 0; bj < 2; ++bj)
#pragma unroll
                        for (int n = 0; n < 2; ++n) xin[mm][bj][n] = *(const f32x4*)(src + off + bj * HALF + n * 16); }
                asm volatile("" ::: "memory");
#pragma unroll
                for (int mm = 0; mm < 2; ++mm) { const size_t off = (size_t)(row0 + ai * HALF + (m2 + mm) * 16) * 1024 + col0;
#pragma unroll
                    for (int bj = 0; bj < 2; ++bj)
#pragma unroll
                        for (int n = 0; n < 2; ++n) *(f32x4*)(dst + off + bj * HALF + n * 16) = xin[mm][bj][n] + gv[bj][n] * acc[ai][bj][m2 + mm][n]; }
                asm volatile("" ::: "memory"); }
    }
};
struct EpiF32 {
    static constexpr bool PERM = false, AFTER_DRAIN = false, RESCALE = false;
    float* S; int ldc;
    __device__ __forceinline__ void operator()(const f32x4 (&acc)[2][2][4][2], const Unit& u, int wr, int wc, int fr_, int fq_) const {
        const int ln_ = opq_tid() & 63; const int fr = ln_ & 15, fq = ln_ >> 4;
        const int row0 = u.pm * BM + wr * 64 + fr, col0 = u.pn * BM + wc * 32 + 4 * fq;
#pragma unroll
        for (int ai = 0; ai < 2; ++ai)
#pragma unroll
            for (int m = 0; m < 4; ++m) { float* rowp = S + (size_t)(row0 + ai * HALF + m * 16) * ldc + col0;
#pragma unroll
                for (int bj = 0; bj < 2; ++bj)
#pragma unroll
                    for (int n = 0; n < 2; ++n) *(f32x4*)(rowp + bj * HALF + n * 16) = acc[ai][bj][m][n]; }
    }
};

struct EpiScoreT {
    static constexpr bool PERM = false, AFTER_DRAIN = false, RESCALE = false;
    float* S;
    __device__ __forceinline__ void operator()(const f32x4 (&acc)[2][2][4][2], const Unit& u, int wr, int wc, int fr_, int fq_) const {
        const int ln_ = opq_tid() & 63; const int fr = ln_ & 15, fq = ln_ >> 4;
        const int row0 = u.pm * BM + wr * 64 + fr, col0 = u.pn * BM + wc * 32 + 4 * fq;
#pragma unroll
        for (int ai = 0; ai < 2; ++ai)
#pragma unroll
            for (int m = 0; m < 4; ++m) { const int row = row0 + ai * HALF + m * 16;
#pragma unroll
                for (int bj = 0; bj < 2; ++bj)
#pragma unroll
                    for (int n = 0; n < 2; ++n) { const int col = col0 + bj * HALF + n * 16; *(f32x4*)(S + ((size_t)(col >> 6) * 2048 + row) * 64 + (col & 63)) = acc[ai][bj][m][n]; } }
    }
};
template <class Epi, class Sched, bool ALIGN_EPI = false, bool SP2 = false>
__device__ __forceinline__ void gemm_phase(PG8_LAS unsigned char* lds, const Gemm g, const Sched& S, const Epi& E) {
    const int tid = opq_tid(), wid = __builtin_amdgcn_readfirstlane(tid >> 6), lane = tid & 63, wr = wid >> 2, wc = wid & 3, fr = lane & 15, fq = lane >> 4;
    const int K = g.K, nt = K / BK;
    unsigned voffA[2], voffB[2];
#pragma unroll
    for (int i = 0; i < 2; ++i) { int R, C; stage_rc(tid * 16 + i * 8192, R, C); const int Rb = Epi::PERM ? ((R & ~31) + perm32(R & 31)) : R;
        voffA[i] = (unsigned)(R * K + C) * 2u; voffB[i] = (unsigned)(Rb * K + C) * 2u; }
    const size_t kstep = (size_t)(BK * 2);
    const size_t hstep = (size_t)HALF * K * 2;
    const size_t tstep = 2 * hstep;
    const unsigned ldsw = (unsigned)wid * 1024u;
    const int aoff = lds_byte(wr * 64 + fr, fq * 8), boff = lds_byte(wc * 32 + fr, fq * 8);
#define PG8_SA(b, h) (((b) * 2 + (h)) * HTB)
#define PG8_SB(b, h) ((4 + (b) * 2 + (h)) * HTB)
#define PG8_STAGE(bufoff, gbase, voff) do { _Pragma("unroll") for (int _i = 0; _i < 2; ++_i) \
        __builtin_amdgcn_global_load_lds((const unsigned*)((const char*)(gbase) + (voff)[_i]), (PG8_LAS unsigned*)(lds + (bufoff) + ldsw + _i * 8192), 16, 0, 0); } while (0)
#define PG8_LDA(dst, b, h) do { _Pragma("unroll") for (int m = 0; m < 4; ++m) _Pragma("unroll") for (int k = 0; k < 2; ++k) dst[m][k] = *(const PG8_LAS bf16x8*)(lds + PG8_SA(b, h) + aoff + m * 2048 + k * 1024); } while (0)
#define PG8_LDB(dst, b, h) do { _Pragma("unroll") for (int n = 0; n < 2; ++n) _Pragma("unroll") for (int k = 0; k < 2; ++k) dst[n][k] = *(const PG8_LAS bf16x8*)(lds + PG8_SB(b, h) + boff + n * 2048 + k * 1024); } while (0)
#define PG8_MMA(ai, bj, At, Bt) do { __builtin_amdgcn_s_setprio(1); _Pragma("unroll") for (int m = 0; m < 4; ++m) _Pragma("unroll") for (int n = 0; n < 2; ++n) _Pragma("unroll") for (int k = 0; k < 2; ++k) \
        acc[ai][bj][m][n] = __builtin_amdgcn_mfma_f32_16x16x32_bf16(Bt[n][k], At[m][k], acc[ai][bj][m][n], 0, 0, 0); __builtin_amdgcn_s_setprio(0); } while (0)
#define PG8_WAIT_V(n) asm volatile("s_waitcnt vmcnt(" #n ")" ::: "memory")
#define PG8_WAIT_L(n) asm volatile("s_waitcnt lgkmcnt(" #n ")" ::: "memory")
#define PG8_BAR __builtin_amdgcn_s_barrier()
#define PG8_SCHED __builtin_amdgcn_sched_barrier(0)
    Unit cur, nxt; int ui = 0;
    if (!S.next(0, cur)) return;
    f32x4 acc[2][2][4][2];
#pragma unroll
    for (int a = 0; a < 2; ++a)
#pragma unroll
        for (int b = 0; b < 2; ++b)
#pragma unroll
            for (int m = 0; m < 4; ++m)
#pragma unroll
                for (int n = 0; n < 2; ++n) acc[a][b][m][n] = (f32x4){0.f, 0.f, 0.f, 0.f};
    bf16x8 At[4][2], B0[2][2], B1[2][2];
    const char* cA = S.baseA(g, cur, tstep); const char* cB = S.baseB(g, cur, tstep);
    S.a_ready(cur);
    if constexpr (SP2) {
        PG8_STAGE(PG8_SB(0, 0), cB, voffB); PG8_STAGE(PG8_SB(0, 1), cB + hstep, voffB); PG8_STAGE(PG8_SA(0, 0), cA, voffA); PG8_STAGE(PG8_SA(0, 1), cA + hstep, voffA);
        if (wr == 1) PG8_BAR;
        PG8_WAIT_V(2); PG8_BAR;
        PG8_STAGE(PG8_SB(1, 0), cB + kstep, voffB); PG8_STAGE(PG8_SA(1, 0), cA + kstep, voffA); PG8_STAGE(PG8_SB(1, 1), cB + hstep + kstep, voffB);
        PG8_WAIT_V(6); PG8_BAR;
    } else {
        PG8_STAGE(PG8_SB(0, 0), cB, voffB); PG8_STAGE(PG8_SA(0, 0), cA, voffA); PG8_STAGE(PG8_SB(0, 1), cB + hstep, voffB); PG8_STAGE(PG8_SA(0, 1), cA + hstep, voffA);
        if (wr == 1) PG8_BAR;
        PG8_WAIT_V(4); PG8_BAR;
        PG8_STAGE(PG8_SB(1, 0), cB + kstep, voffB); PG8_STAGE(PG8_SA(1, 0), cA + kstep, voffA); PG8_STAGE(PG8_SB(1, 1), cB + hstep + kstep, voffB);
        PG8_WAIT_V(6); PG8_BAR;
    }
    for (;;) {
        const bool has_next = S.next(ui + 1, nxt);
        const char* nA = has_next ? S.baseA(g, nxt, tstep) : cA; const char* nB = has_next ? S.baseB(g, nxt, tstep) : cB;
        for (int t = 0; t < nt; t += 2) {
            const bool last = (t == nt - 2);
            const char* a1 = cA + (size_t)(t + 1) * kstep;
            const char* a2 = last ? nA : cA + (size_t)(t + 2) * kstep; const char* b2 = last ? nB : cB + (size_t)(t + 2) * kstep;
            const char* a3 = a2 + kstep; const char* b3 = b2 + kstep;
            if (last && has_next) S.a_ready(nxt);
            if constexpr (SP2) {
            PG8_LDB(B0, 0, 0); PG8_LDB(B1, 0, 1); PG8_SCHED; PG8_LDA(At, 0, 0); PG8_STAGE(PG8_SA(1, 1), a1 + hstep, voffA);
            PG8_WAIT_V(8); PG8_WAIT_L(0); PG8_BAR; PG8_MMA(0, 0, At, B0); PG8_MMA(0, 1, At, B1); PG8_BAR; PG8_SCHED;
            PG8_LDA(At, 0, 1); PG8_STAGE(PG8_SB(0, 0), b2, voffB); PG8_STAGE(PG8_SB(0, 1), b2 + hstep, voffB); PG8_STAGE(PG8_SA(0, 0), a2, voffA);
            PG8_WAIT_V(8); PG8_WAIT_L(0); PG8_BAR; PG8_MMA(1, 0, At, B0); PG8_MMA(1, 1, At, B1); PG8_BAR; PG8_SCHED;
            PG8_LDB(B0, 1, 0); PG8_LDB(B1, 1, 1); PG8_SCHED; PG8_LDA(At, 1, 0); PG8_STAGE(PG8_SA(0, 1), a2 + hstep, voffA);
            PG8_WAIT_V(8); PG8_WAIT_L(0); PG8_BAR; PG8_MMA(0, 0, At, B0); PG8_MMA(0, 1, At, B1); PG8_BAR; PG8_SCHED;
            PG8_LDA(At, 1, 1); PG8_STAGE(PG8_SB(1, 0), b3, voffB); PG8_STAGE(PG8_SB(1, 1), b3 + hstep, voffB); PG8_STAGE(PG8_SA(1, 0), a3, voffA);
            PG8_WAIT_V(8); PG8_WAIT_L(0); PG8_BAR; PG8_MMA(1, 0, At, B0); PG8_MMA(1, 1, At, B1); PG8_BAR; PG8_SCHED;
            } else {
            PG8_LDB(B0, 0, 0); PG8_SCHED; PG8_LDA(At, 0, 0); PG8_STAGE(PG8_SA(1, 1), a1 + hstep, voffA);
            PG8_WAIT_L(8); PG8_BAR; PG8_WAIT_L(0); PG8_MMA(0, 0, At, B0); PG8_BAR; PG8_SCHED;
            PG8_LDB(B1, 0, 1); PG8_STAGE(PG8_SB(0, 0), b2, voffB);
            PG8_BAR; PG8_WAIT_L(0); PG8_MMA(0, 1, At, B1); PG8_BAR;
            PG8_LDA(At, 0, 1); PG8_STAGE(PG8_SA(0, 0), a2, voffA);
            PG8_BAR; PG8_WAIT_L(0); PG8_MMA(1, 0, At, B0); PG8_BAR; PG8_SCHED;
            PG8_STAGE(PG8_SB(0, 1), b2 + hstep, voffB);
            PG8_WAIT_V(6); PG8_BAR; PG8_MMA(1, 1, At, B1); PG8_BAR;
            PG8_LDB(B0, 1, 0); PG8_SCHED; PG8_LDA(At, 1, 0); PG8_STAGE(PG8_SA(0, 1), a2 + hstep, voffA);
            PG8_WAIT_L(8); PG8_BAR; PG8_WAIT_L(0); PG8_MMA(0, 0, At, B0); PG8_BAR; PG8_SCHED;
            PG8_LDB(B1, 1, 1); PG8_STAGE(PG8_SB(1, 0), b3, voffB);
            PG8_BAR; PG8_WAIT_L(0); PG8_MMA(0, 1, At, B1); PG8_BAR;
            PG8_LDA(At, 1, 1); PG8_STAGE(PG8_SA(1, 0), a3, voffA);
            PG8_BAR; PG8_WAIT_L(0); PG8_MMA(1, 0, At, B0); PG8_BAR; PG8_SCHED;
            PG8_STAGE(PG8_SB(1, 1), b3 + hstep, voffB);
            PG8_WAIT_V(6); PG8_BAR; PG8_MMA(1, 1, At, B1); PG8_BAR;
            }
        }
        if constexpr (ALIGN_EPI) { if (wr == 0) PG8_BAR; }
        if constexpr (Epi::RESCALE) { E.fin(acc, cur, wr, wc); S.done(cur); }
        else if constexpr (!Epi::AFTER_DRAIN) { E(acc, cur, wr, wc, fr, fq); S.done(cur); }
        if (!has_next) break;
        bool keep_ = false; if constexpr (Epi::RESCALE) keep_ = E.keep(cur);
        if (!keep_) {
#pragma unroll
        for (int a = 0; a < 2; ++a)
#pragma unroll
            for (int b = 0; b < 2; ++b)
#pragma unroll
                for (int m = 0; m < 4; ++m)
#pragma unroll
                    for (int n = 0; n < 2; ++n) acc[a][b][m][n] = (f32x4){0.f, 0.f, 0.f, 0.f};
        }
        cur = nxt; cA = nA; cB = nB; ++ui;
        if constexpr (ALIGN_EPI) { if (wr == 1) PG8_BAR; }
    }
    PG8_WAIT_V(0);
    if constexpr (!ALIGN_EPI) { if (wr == 0) PG8_BAR; }
    PG8_BAR;
    if constexpr (Epi::AFTER_DRAIN) { E.fused(acc, cur, wr, wc, fr, fq, lds, wid, lane); S.done(cur); }
#undef PG8_SA
#undef PG8_SB
#undef PG8_STAGE
#undef PG8_LDA
#undef PG8_LDB
#undef PG8_MMA
#undef PG8_WAIT_V
#undef PG8_WAIT_L
#undef PG8_BAR
#undef PG8_SCHED
}
}
#include <hip/hip_bf16.h>
#include <cmath>
namespace attn_body {
using bf16=__hip_bfloat16;
using bf16x8=__attribute__((ext_vector_type(8)))short;
using s16x4=__attribute__((ext_vector_type(4)))short;
using f32x16=__attribute__((ext_vector_type(16)))float;
using u32x4=__attribute__((ext_vector_type(4)))unsigned;
constexpr int D=64,QP=512,KP=128;
constexpr int NW=8,QBLK=32,QB=QBLK*NW,KVBLK=64;
constexpr int ATTN_UNIT_ROWS=QB;
__device__ __forceinline__ int crow(int r,int hi){return (r&3)+8*(r>>2)+4*hi;}
#define SBAR() __builtin_amdgcn_sched_barrier(0)
constexpr int NSLOT=3, SLOTB=8192;
constexpr int LDS_K=0, LDS_V=NSLOT*SLOTB, LDS_WS=2*NSLOT*SLOTB, LDS_OST=LDS_WS+NW*64*4, LDS_BYTES=LDS_OST+NW*4096;
constexpr float C2=0.125f*1.4426950408889634f;
__device__ __forceinline__ void glds16(const void*gsrc,unsigned lds_dst){unsigned keep;
  asm volatile("s_mov_b32 %0, m0\n\ts_mov_b32 m0, %2\n\ts_nop 0\n\tglobal_load_lds_dwordx4 %1, off\n\ts_mov_b32 m0, %0":"=&s"(keep):"v"(gsrc),"s"(lds_dst):"memory");}
__device__ __forceinline__ float max3f(float a,float b,float c){float r;asm("v_max3_f32 %0, %1, %2, %3":"=v"(r):"v"(a),"v"(b),"v"(c));return r;}
__device__ __forceinline__ float max2f(float a,float b){float r;asm("v_max_f32_e32 %0, %1, %2":"=v"(r):"v"(a),"v"(b));return r;}
__device__ __forceinline__ float fadd_s(float a,float b){float r;asm("v_add_f32_e32 %0, %1, %2":"=v"(r):"v"(a),"v"(b));return r;}
__device__ __forceinline__ float fsub_s(float a,float b){float r;asm("v_sub_f32_e32 %0, %1, %2":"=v"(r):"v"(a),"v"(b));return r;}
typedef float f32x2_t __attribute__((ext_vector_type(2))); typedef __bf16 bf16x2_t __attribute__((ext_vector_type(2)));
__device__ __forceinline__ unsigned cvtpk_s(float lo,float hi){f32x2_t v={lo,hi};bf16x2_t b=__builtin_convertvector(v,bf16x2_t);return __builtin_bit_cast(unsigned,b);}
#define WAIT_BAR(N) asm volatile("s_waitcnt vmcnt(" #N ") lgkmcnt(0)\n\ts_barrier":::"memory")

__device__ __forceinline__ void qkt(f32x16&p0,f32x16&p1,const char*Kslot,const bf16x8*qr,const f32x16&negm,int r32,int hi){
  const char*kb=Kslot+hi*1024+r32*16;
  #pragma unroll
  for(int d0=0;d0<4;++d0){
    const bf16x8 b0=*reinterpret_cast<const bf16x8*>(kb+d0*2048);
    const bf16x8 b1=*reinterpret_cast<const bf16x8*>(kb+d0*2048+512);
    if(d0==0){p0=__builtin_amdgcn_mfma_f32_32x32x16_bf16(b0,qr[0],negm,0,0,0);p1=__builtin_amdgcn_mfma_f32_32x32x16_bf16(b1,qr[0],negm,0,0,0);}
    else{p0=__builtin_amdgcn_mfma_f32_32x32x16_bf16(b0,qr[d0],p0,0,0,0);p1=__builtin_amdgcn_mfma_f32_32x32x16_bf16(b1,qr[d0],p1,0,0,0);}}
}
typedef __attribute__((address_space(3))) const char* lds_cptr;
typedef short v4i16_t __attribute__((ext_vector_type(4)));
__device__ __forceinline__ void kload8(bf16x8*kf,lds_cptr kp){
  kf[0]=*(const __attribute__((address_space(3))) bf16x8*)(kp);      kf[1]=*(const __attribute__((address_space(3))) bf16x8*)(kp+512);
  kf[2]=*(const __attribute__((address_space(3))) bf16x8*)(kp+2048); kf[3]=*(const __attribute__((address_space(3))) bf16x8*)(kp+2560);
  kf[4]=*(const __attribute__((address_space(3))) bf16x8*)(kp+4096); kf[5]=*(const __attribute__((address_space(3))) bf16x8*)(kp+4608);
  kf[6]=*(const __attribute__((address_space(3))) bf16x8*)(kp+6144); kf[7]=*(const __attribute__((address_space(3))) bf16x8*)(kp+6656);
}
__device__ __forceinline__ void kload2(bf16x8*kf,lds_cptr kp,int j){ kf[2*j]=*(const __attribute__((address_space(3))) bf16x8*)(kp+j*2048); kf[2*j+1]=*(const __attribute__((address_space(3))) bf16x8*)(kp+j*2048+512); }
__device__ __forceinline__ s16x4 vtr(lds_cptr p){ return __builtin_bit_cast(s16x4,__builtin_amdgcn_ds_read_tr16_b64_v4i16((__attribute__((address_space(3))) v4i16_t*)p)); }
__device__ __forceinline__ float rowmax(const f32x16&p0,const f32x16&p1){
  float a=max3f(p0[0],p0[1],p1[0]),b=max3f(p0[2],p0[3],p1[1]);a=max3f(a,p1[2],p1[3]);
  #pragma unroll
  for(int r=4;r<16;r+=4){a=max3f(a,p0[r],p0[r+1]);b=max3f(b,p0[r+2],p0[r+3]);a=max3f(a,p1[r],p1[r+1]);b=max3f(b,p1[r+2],p1[r+3]);}
  const float m=max2f(a,b);
  auto rr=__builtin_amdgcn_permlane32_swap(__float_as_uint(m),__float_as_uint(m),false,false);
  return max2f(__uint_as_float(rr[0]),__uint_as_float(rr[1]));
}
__device__ __forceinline__ void pv(f32x16*o,int vb,bf16x8 pa0,bf16x8 pa1,bf16x8 pa2,bf16x8 pa3){
  #pragma unroll
  for(int d0=0;d0<2;++d0){s16x4 lo[4],hi[4];
    #pragma unroll
    for(int ks=0;ks<4;++ks){
      asm volatile("ds_read_b64_tr_b16 %0,%1 offset:%c2":"=&v"(lo[ks]):"v"(vb),"i"(d0*4096+ks*1024):"memory");
      asm volatile("ds_read_b64_tr_b16 %0,%1 offset:%c2":"=&v"(hi[ks]):"v"(vb),"i"(d0*4096+ks*1024+512):"memory");}
    asm volatile("s_waitcnt lgkmcnt(0)":::"memory");SBAR();
    #define PK(k) (bf16x8){lo[k][0],lo[k][1],lo[k][2],lo[k][3],hi[k][0],hi[k][1],hi[k][2],hi[k][3]}
    o[d0]=__builtin_amdgcn_mfma_f32_32x32x16_bf16(pa0,PK(0),o[d0],0,0,0);
    o[d0]=__builtin_amdgcn_mfma_f32_32x32x16_bf16(pa1,PK(1),o[d0],0,0,0);
    o[d0]=__builtin_amdgcn_mfma_f32_32x32x16_bf16(pa2,PK(2),o[d0],0,0,0);
    o[d0]=__builtin_amdgcn_mfma_f32_32x32x16_bf16(pa3,PK(3),o[d0],0,0,0);
    #undef PK
  }
}

#ifndef ATTN_STORE16
#define ATTN_STORE16(p,v) (*(u32x4*)(p)=(v))
#endif
template<int THRL> __device__ __forceinline__ void attn_unit(const bf16*Qu,const bf16*__restrict__ Kh,const bf16*__restrict__ Vh,bf16*Ou,const int NT,char*shm){
  const int tid=opq_tid(),lane=tid&63,r32=lane&31,hi=lane>>5; const int wid=__builtin_amdgcn_readfirstlane(tid>>6);
  const bf16*Qw=Qu+(long)(wid*QBLK)*QP;
  const unsigned lds0=(unsigned)(uintptr_t)shm;
  float*wsf=(float*)(shm+LDS_WS)+wid*64;
  const bf16*ksrc=Kh+(long)lane*KP+wid*8;
  const bf16*vsrc=Vh+(long)(16*(wid&3)+(lane>>2))*KP+(wid>>2)*32+(lane&3)*8;
  const unsigned kdst=lds0+LDS_K+wid*1024, vdst=lds0+LDS_V+wid*1024;
  #define DMA_K(t,slot) glds16(ksrc+(long)(t)*KVBLK*KP,(unsigned)__builtin_amdgcn_readfirstlane(kdst+(slot)))
  #define DMA_V(t,slot) glds16(vsrc+(long)(t)*KVBLK*KP,(unsigned)__builtin_amdgcn_readfirstlane(vdst+(slot)))
  const int vb0=(int)(lds0+LDS_V)+((lane>>4)&1)*32+(lane&3)*8+(4*hi+((lane&15)>>2))*64;
  const char*Kbase=shm+LDS_K; bf16x8 kf[8];
  const lds_cptr shm3=(lds_cptr)shm; const lds_cptr kp0=shm3+LDS_K+hi*1024+r32*16; const lds_cptr vp0=shm3+LDS_V+((lane>>4)&1)*32+(lane&3)*8+(4*hi+((lane&15)>>2))*64;
  DMA_K(0,0);DMA_V(0,0);DMA_K(1,SLOTB);
  bf16x8 qr[4];
  #pragma unroll
  for(int d0=0;d0<4;++d0)qr[d0]=*reinterpret_cast<const bf16x8*>(&Qw[(long)r32*QP+d0*16+hi*8]);
  float mhat=0.f,l_reg=0.f;f32x16 o[2];o[0]=f32x16{};o[1]=f32x16{};f32x16 negm=f32x16{};asm volatile("":"+v"(negm));
  #define CMASK(P0,P1,t) do{}while(0)
  bool resc=false;
  #define START(P0,P1) do{ const float rm=rowmax(P0,P1); resc=false; \
    { const float dl=rm; mhat=fadd_s(mhat,dl); \
      _Pragma("unroll") for(int r=0;r<16;++r){P0[r]=fsub_s(P0[r],dl);P1[r]=fsub_s(P1[r],dl);} \
      _Pragma("unroll") for(int r=0;r<16;++r)negm[r]=-mhat; asm volatile("":"+v"(negm)); } \
    _Pragma("unroll") for(int r=0;r<16;++r)P0[r]=__builtin_amdgcn_exp2f(P0[r]); }while(0)
  #define RESC() do{ if(resc){ asm volatile("s_waitcnt lgkmcnt(0)":::"memory"); \
      _Pragma("unroll") for(int d_=0;d_<2;++d_) _Pragma("unroll") for(int r=0;r<16;++r)o[d_][r]*=wsf[crow(r,hi)]; } }while(0)
  f32x16 pA0,pA1,pB0,pB1;
  int sl_prev=0,sl_cur=0,sl_next=SLOTB;
  #define ROT() do{sl_prev=sl_cur;sl_cur=sl_next;sl_next=(sl_next==(NSLOT-1)*SLOTB)?0:sl_next+SLOTB;}while(0)
  DMA_K(2,2*SLOTB);
  WAIT_BAR(3);
  qkt(pA0,pA1,Kbase,qr,negm,r32,hi);asm volatile("s_nop 15\n\ts_nop 7":"+v"(pA0),"+v"(pA1));CMASK(pA0,pA1,0);
  START(pA0,pA1);
  _Pragma("unroll") for(int r=0;r<16;++r)pA1[r]=__builtin_amdgcn_exp2f(pA1[r]);
  WAIT_BAR(0);
  DMA_K(3,0);DMA_V(1,SLOTB);
  ROT();
  kload8(kf,kp0+sl_cur);
  WAIT_BAR(2);
  s16x4 vlo[8],vhi[8]; u32x4 pw0,pw1,pw2,pw3;
  #define PKW(P,B) cvtpk_s(P[B],P[B+1])
  #define PAF(k) __builtin_bit_cast(bf16x8,pw##k)
  #define VFR(i) (bf16x8){vlo[i][0],vlo[i][1],vlo[i][2],vlo[i][3],vhi[i][0],vhi[i][1],vhi[i][2],vhi[i][3]}
  #define PIN(x) asm volatile("":"+v"(x))
  #define MX3(a,b,c) __builtin_fmaxf(__builtin_fmaxf((a),(b)),(c))
  #define GAPA(MF,A0,A1,A2,A3,W0,W1,PW) do{ MF; sacc+=A0; sacc+=A1; sacc+=A2; sacc+=A3; PIN(sacc); W0; W1; PIN(PW); SBAR(); }while(0)
  #define EX(v) __builtin_amdgcn_exp2f(v)
  #define GAPB(MF,X,B) do{ MF; X[B]=EX(X[B]); X[B+1]=EX(X[B+1]); X[B+2]=EX(X[B+2]); X[B+3]=EX(X[B+3]); PIN(X); SBAR(); }while(0)
  #define VRD(i) do{ vlo[i]=vtr(vp_+(((i)>>2)*4096+((i)&3)*1024)); vhi[i]=vtr(vp_+(((i)>>2)*4096+((i)&3)*1024+512)); }while(0)
  #define KRD(G,j) do{ if(G){ kload2(kf,kp0+sl_next,j); SBAR(); } }while(0)
  #define STEP(C0,C1,P0,P1,t,GK,GV,GL) do{ SBAR(); \
    const lds_cptr vp_=vp0+sl_prev; \
    VRD(0); SBAR(); float sacc=(P0[0]+P0[1]); \
    GAPA(C0=__builtin_amdgcn_mfma_f32_32x32x16_bf16(kf[0],qr[0],negm,0,0,0), P0[2],P0[3],P0[4],P0[5],     pw0[0]=PKW(P0,0), pw0[1]=PKW(P0,2), pw0); \
    VRD(4); SBAR(); GAPA(C1=__builtin_amdgcn_mfma_f32_32x32x16_bf16(kf[1],qr[0],negm,0,0,0), P0[6],P0[7],P0[8],P0[9],     pw0[2]=PKW(P0,4), pw0[3]=PKW(P0,6), pw0); \
    VRD(1); SBAR(); GAPA(C0=__builtin_amdgcn_mfma_f32_32x32x16_bf16(kf[2],qr[1],C0,0,0,0),   P0[10],P0[11],P0[12],P0[13], pw1[0]=PKW(P0,8), pw1[1]=PKW(P0,10), pw1); \
    VRD(5); SBAR(); GAPA(C1=__builtin_amdgcn_mfma_f32_32x32x16_bf16(kf[3],qr[1],C1,0,0,0),   P0[14],P0[15],P1[0],P1[1],   pw1[2]=PKW(P0,12),pw1[3]=PKW(P0,14), pw1); \
    VRD(2); SBAR(); GAPA(C0=__builtin_amdgcn_mfma_f32_32x32x16_bf16(kf[4],qr[2],C0,0,0,0),   P1[2],P1[3],P1[4],P1[5],     pw2[0]=PKW(P1,0), pw2[1]=PKW(P1,2), pw2); \
    VRD(6); SBAR(); GAPA(C1=__builtin_amdgcn_mfma_f32_32x32x16_bf16(kf[5],qr[2],C1,0,0,0),   P1[6],P1[7],P1[8],P1[9],     pw2[2]=PKW(P1,4), pw2[3]=PKW(P1,6), pw2); \
    VRD(3); SBAR(); GAPA(C0=__builtin_amdgcn_mfma_f32_32x32x16_bf16(kf[6],qr[3],C0,0,0,0),   P1[10],P1[11],P1[12],P1[13], pw3[0]=PKW(P1,8), pw3[1]=PKW(P1,10), pw3); \
    VRD(7); SBAR(); GAPA(C1=__builtin_amdgcn_mfma_f32_32x32x16_bf16(kf[7],qr[3],C1,0,0,0),   P1[14],P1[15],0.f,0.f,       pw3[2]=PKW(P1,12),pw3[3]=PKW(P1,14), pw3); \
    l_reg+=sacc; \
    if(GK){DMA_K((t)+3,sl_cur);} if(GV){DMA_V((t)+1,sl_next);} \
    CMASK(C0,C1,t); \
    resc=false; if(THRL<1000){ float a=MX3(C0[0],C0[1],C1[0]),b=MX3(C0[2],C0[3],C1[1]); a=MX3(a,C1[2],C1[3]); \
      _Pragma("unroll") for(int r=4;r<16;r+=4){a=MX3(a,C0[r],C0[r+1]);b=MX3(b,C0[r+2],C0[r+3]);a=MX3(a,C1[r],C1[r+1]);b=MX3(b,C1[r+2],C1[r+3]);} \
      float rm=__builtin_fmaxf(a,b); { auto rr=__builtin_amdgcn_permlane32_swap(__float_as_uint(rm),__float_as_uint(rm),false,false); rm=__builtin_fmaxf(__uint_as_float(rr[0]),__uint_as_float(rr[1])); } \
      resc=false; \
      if(__builtin_expect(__any(rm>(float)THRL),0)){ const float dl=__builtin_fmaxf(rm,0.f); mhat+=dl; \
        _Pragma("unroll") for(int r=0;r<16;++r){C0[r]-=dl;C1[r]-=dl;} \
        _Pragma("unroll") for(int r=0;r<16;++r)negm[r]=-mhat; asm volatile("":"+v"(negm)); \
        const float f=__builtin_amdgcn_exp2f(-dl); l_reg*=f; if(hi==0)wsf[r32]=f; resc=true; } } \
    SBAR(); \
    GAPB(o[0]=__builtin_amdgcn_mfma_f32_32x32x16_bf16(PAF(0),VFR(0),o[0],0,0,0), C0,0); \
    GAPB(o[1]=__builtin_amdgcn_mfma_f32_32x32x16_bf16(PAF(0),VFR(4),o[1],0,0,0), C0,4); \
    KRD(GL,0); GAPB(o[0]=__builtin_amdgcn_mfma_f32_32x32x16_bf16(PAF(1),VFR(1),o[0],0,0,0), C0,8); \
    KRD(GL,1); GAPB(o[1]=__builtin_amdgcn_mfma_f32_32x32x16_bf16(PAF(1),VFR(5),o[1],0,0,0), C0,12); \
    KRD(GL,2); GAPB(o[0]=__builtin_amdgcn_mfma_f32_32x32x16_bf16(PAF(2),VFR(2),o[0],0,0,0), C1,0); \
    KRD(GL,3); GAPB(o[1]=__builtin_amdgcn_mfma_f32_32x32x16_bf16(PAF(2),VFR(6),o[1],0,0,0), C1,4); \
    GAPB(o[0]=__builtin_amdgcn_mfma_f32_32x32x16_bf16(PAF(3),VFR(3),o[0],0,0,0), C1,8); \
    GAPB(o[1]=__builtin_amdgcn_mfma_f32_32x32x16_bf16(PAF(3),VFR(7),o[1],0,0,0), C1,12); \
    }while(0)
  int t=1;
  #undef CMASK
  #define CMASK(P0,P1,t) do{}while(0)
  for(;t+5<NT;t+=2){
    STEP(pB0,pB1,pA0,pA1,t,true,true,true);     WAIT_BAR(2); RESC(); ROT();
    STEP(pA0,pA1,pB0,pB1,t+1,true,true,true);   WAIT_BAR(2); RESC(); ROT();
  }
  #undef CMASK
  #define CMASK(P0,P1,t) do{}while(0)
  #define ENDW(tt) do{ if((tt)+3<NT){WAIT_BAR(2);} else if((tt)+2<NT){WAIT_BAR(1);} else {WAIT_BAR(0);} }while(0)
  for(;t+1<NT;t+=2){
    STEP(pB0,pB1,pA0,pA1,t,(t+3<NT),(t+1<NT),(t+1<NT));       ENDW(t);   RESC(); ROT();
    STEP(pA0,pA1,pB0,pB1,t+1,(t+4<NT),(t+2<NT),(t+2<NT));     ENDW(t+1); RESC(); ROT();
  }
  STEP(pB0,pB1,pA0,pA1,NT-1,false,false,false); RESC();
  { float sacc=pB0[0]+pB0[1]; _Pragma("unroll") for(int r=2;r<16;++r)sacc+=pB0[r]; _Pragma("unroll") for(int r=0;r<16;++r)sacc+=pB1[r]; l_reg+=sacc;
    pw0=(u32x4){PKW(pB0,0),PKW(pB0,2),PKW(pB0,4),PKW(pB0,6)};pw1=(u32x4){PKW(pB0,8),PKW(pB0,10),PKW(pB0,12),PKW(pB0,14)};pw2=(u32x4){PKW(pB1,0),PKW(pB1,2),PKW(pB1,4),PKW(pB1,6)};pw3=(u32x4){PKW(pB1,8),PKW(pB1,10),PKW(pB1,12),PKW(pB1,14)};
    SBAR(); pv(o,vb0+sl_cur,PAF(0),PAF(1),PAF(2),PAF(3)); }
  #undef PKW
  #undef PAF
  #undef VFR
  #undef PIN
  #undef MX3
  #undef GAPA
  #undef GAPB
  #undef EX
  #undef VRD
  #undef KRD
  #undef STEP
  #undef ENDW
  {auto rr=__builtin_amdgcn_permlane32_swap(__float_as_uint(l_reg),__float_as_uint(l_reg),false,false);l_reg=__uint_as_float(rr[0])+__uint_as_float(rr[1]);}
  if(hi==0)wsf[32+r32]=l_reg;asm volatile("s_waitcnt lgkmcnt(0)":::"memory");
  float rli[16];
  #pragma unroll
  for(int r=0;r<16;++r)rli[r]=__builtin_amdgcn_rcpf(wsf[32+crow(r,hi)]);
  bf16*Ow=Ou+(long)(wid*QBLK)*QP;
  { bf16*stg=(bf16*)(shm+LDS_OST)+wid*2048;
    #pragma unroll
    for(int r=0;r<16;++r){const int orow=crow(r,hi);
      #pragma unroll
      for(int d0=0;d0<2;++d0)stg[orow*64+d0*32+r32]=__float2bfloat16(o[d0][r]*rli[r]);}
    asm volatile("s_waitcnt lgkmcnt(0)":::"memory");
    #pragma unroll
    for(int i=0;i<4;++i){const int row=i*8+(lane>>3),ch=lane&7; const u32x4 v=*(const u32x4*)(stg+row*64+ch*8); ATTN_STORE16(Ow+(long)row*QP+ch*8,v);} }
  asm volatile("s_waitcnt lgkmcnt(0)\n\ts_barrier":::"memory");
  #undef DMA_K
  #undef DMA_V
  #undef CMASK
  #undef START
  #undef RESC
  #undef ROT
}
constexpr int ATTN_LDS_BYTES=LDS_BYTES;
#undef SBAR
#undef WAIT_BAR
}

struct Args {
    const float *x, *c, *ctx, *c_ctx, *w_mod, *b_mod, *g_norm1, *g_norm2, *w_in, *q_gain, *k_gain, *sc_conv_w, *hy_conv_w, *hy_conv_b,
                *hy_w1, *hy_b1, *hy_f1, *hy_w2, *hy_b2, *hy_f2, *hy_w3, *hy_decay, *hy_bias, *w_br_att, *w_br_sc, *w_br_hy, *w_out,
                *peer_wq, *peer_subkeys, *peer_u, *peer_v, *g_final;
    float* out; unsigned char* ws;
};
struct Ctx {
    LAS unsigned char* lds; int tid, lane, wave, vcu, G;
};

__device__ __forceinline__ int inv_sigma(int src) {
    if (src < 512) { const int head = src >> 6, d = src & 63, bj = d >> 5, dd = d & 31, n = dd >> 4, f = dd & 15, fq = f >> 2, e = f & 3; return 256 * (head >> 2) + 128 * bj + 32 * (head & 3) + 8 * fq + 4 * n + e; }
    if (src < 640) { const int s = src - 512, kvh = s >> 6, d = s & 63, bj = d >> 5, dd = d & 31, n = dd >> 4, f = dd & 15, fq = f >> 2, e = f & 3; return 512 + 128 * bj + 32 * kvh + 8 * fq + 4 * n + e; }
    if (src < 768) { const int s = src - 640, kvh = s >> 6, d = s & 63, bj = d >> 5, i = d & 31; return 512 + 128 * bj + 32 * (2 + kvh) + i; }
    if (src < 2304) { const int s = src - 768, part = s >> 9, ch = s & 511;
        if (part == 0) return 768 + ch;
        return 768 + 512 + (ch >> 7) * 256 + (part == 2 ? 128 : 0) + (ch & 127); }
    return src;
}
template <bool PERMUTE>
__device__ __forceinline__ void transpose_item(const float* W, int K, int N, bf16* WT, LAS float* scr, int item, int lane) {
    const int nblk = N / 32, kb = item / nblk, nb = item % nblk, k0 = 64 * kb, n0 = 32 * nb;
#pragma unroll 8
    for (int i = 0; i < 32; ++i) { const int kk = 2 * i + (lane >> 5); scr[kk * 33 + (lane & 31)] = W[(size_t)(k0 + kk) * N + n0 + (lane & 31)]; }
    LDS_WAIT(); asm volatile("" ::: "memory");
    const int c = lane & 7;
#pragma unroll
    for (int j = 0; j < 4; ++j) { const int n = (lane >> 3) + 8 * j; const LAS float* s = scr + (8 * c) * 33 + n;
        v4u o; o.x = pk2(s[0 * 33], s[1 * 33]); o.y = pk2(s[2 * 33], s[3 * 33]); o.z = pk2(s[4 * 33], s[5 * 33]); o.w = pk2(s[6 * 33], s[7 * 33]);
        const int drow = PERMUTE ? inv_sigma(n0 + n) : (n0 + n);
        *(GAS v4u*)(WT + (size_t)drow * K + k0 + 8 * c) = o; }
    LDS_WAIT(); asm volatile("" ::: "memory");
}
__device__ __forceinline__ float silu_f(float v) { return v / (1.0f + __expf(-v)); }

__device__ __forceinline__ void p0_prologue(const Args& A, const Ctx& C) {
    unsigned char* ws = A.ws;
    const int gw = C.vcu * NWAVES + C.wave, NGW = C.G * NWAVES;
    LAS float* scr = (LAS float*)(C.lds + C.wave * 16384);
    {
        constexpr int I_IN = 16 * (IN_W / 32), I_BR = 8 * 32, I_OUT = 16 * 32, PER_L = I_IN + 3 * I_BR + I_OUT;
        for (int it = gw; it < 2 * PER_L; it += NGW) {
            const int l = it / PER_L; int r = it % PER_L;
            if (r < I_IN) { transpose_item<true>(A.w_in + (size_t)l * 1024 * IN_W, 1024, IN_W, (bf16*)(ws + WS_WIN) + (size_t)l * IN_W * 1024, scr, r, C.lane); continue; } r -= I_IN;
            if (r < 3 * I_BR) { const int br = r / I_BR; const float* W = (br == 0 ? A.w_br_att : br == 1 ? A.w_br_sc : A.w_br_hy) + (size_t)l * 512 * 1024;
                transpose_item<false>(W, 512, 1024, (bf16*)(ws + WS_WBR) + (size_t)(l * 3 + br) * 1024 * 512, scr, r % I_BR, C.lane); continue; } r -= 3 * I_BR;
            transpose_item<false>(A.w_out + (size_t)l * 1024 * 1024, 1024, 1024, (bf16*)(ws + WS_WOUT) + (size_t)l * 1024 * 1024, scr, r, C.lane);
        }
    }
    for (int i = (C.vcu * NTHREADS + C.tid); i < 256 * 16; i += C.G * NTHREADS) {
        const int pos = i >> 4, f = i & 15; const float inv = powf(10000.0f, -(float)f * (1.0f / 16.0f)), ang = (float)pos * inv;
        ((float*)(ws + WS_ROPE))[i] = cosf(ang); ((float*)(ws + WS_ROPE))[4096 + i] = sinf(ang);
    }
    {
        LAS float* hs = (LAS float*)(C.lds + C.wave * 16384);
        const int j = C.lane;
#pragma unroll 1
        for (int l = 0; l < 2; ++l) {
            const float* w1 = A.hy_w1 + (size_t)l * HY_EMB * 64; const float* w2 = A.hy_w2 + (size_t)l * 64 * 64;
            float w1r[33], w2r[64];
#pragma unroll
            for (int k = 0; k < 33; ++k) w1r[k] = w1[k * 64 + j];
#pragma unroll
            for (int k = 0; k < 64; ++k) w2r[k] = w2[k * 64 + j];
            const float b1 = A.hy_b1[l * 64 + j], f1 = A.hy_f1[l * 64 + j], b2 = A.hy_b2[l * 64 + j], f2 = A.hy_f2[l * 64 + j];
#pragma unroll 1
            for (int tt = gw; tt < SEQ + CTX_LEN; tt += NGW) {
                const bool isc = tt >= SEQ; const int t = isc ? tt - SEQ : tt, L = isc ? CTX_LEN : SEQ;
                const float tl = (float)t / (float)(L - 1), w = 6.2831855f * (float)t / (float)L;
                float a = b1 + tl * w1r[0];
                float ck, sk;
                { const int kb = j & 15; const float band = 1e-4f + (float)kb * ((15.0f - 1e-4f) / 15.0f), ang = band * w; ck = cosf(ang); sk = sinf(ang); }
#pragma unroll
                for (int k = 0; k < 16; ++k) { const float c_ = __builtin_bit_cast(float, __builtin_amdgcn_readlane(__builtin_bit_cast(int, ck), k)), s_ = __builtin_bit_cast(float, __builtin_amdgcn_readlane(__builtin_bit_cast(int, sk), k));
                    a += c_ * w1r[1 + k] - s_ * w1r[17 + k]; }
                const float h1 = sinf(f1 * a);
                LDS_WAIT(); hs[j] = h1; LDS_WAIT(); asm volatile("" ::: "memory");
                float b = b2;
#pragma unroll
                for (int k = 0; k < 64; ++k) b += hs[k] * w2r[k];
                const float h2 = sinf(f2 * b);
                if (isc) ((float*)(ws + WS_H2C))[(size_t)(l * 64 + j) * CTX_LEN + t] = h2; else ((bf16*)(ws + WS_H2))[((size_t)l * SEQ + t) * 64 + j] = (bf16)f2bf(h2);
                asm volatile("" ::: "memory");
            }
        }
    }
    __syncthreads();
    {
        LAS float* red = (LAS float*)C.lds;
        LAS float* sc = (LAS float*)(C.lds + 8192);
        if (C.vcu < 2 * 96) { for (int i = C.tid; i < 3072; i += NTHREADS) sc[i] = silu_f(i < 2048 ? A.c[i] : A.c_ctx[i - 2048]); }
        __syncthreads();
        for (int it = C.vcu; it < 2 * 96; it += C.G) {
            const int l = it / 96, n = (it % 96) * 64 + C.lane;
            const float* W = A.w_mod + (size_t)l * 1024 * 6144 + n;
            float s0 = 0.f, s1 = 0.f, s2 = 0.f;
#pragma unroll 8
            for (int kk = 0; kk < 128; ++kk) { const int k = C.wave * 128 + kk; const float wv = W[(size_t)k * 6144];
                s0 += sc[k] * wv; s1 += sc[1024 + k] * wv; s2 += sc[2048 + k] * wv; }
            red[(C.wave * 3 + 0) * 64 + C.lane] = s0; red[(C.wave * 3 + 1) * 64 + C.lane] = s1; red[(C.wave * 3 + 2) * 64 + C.lane] = s2;
            __syncthreads();
            if (C.wave < 3) { float s = A.b_mod[l * 6144 + n];
#pragma unroll
                for (int w8 = 0; w8 < 8; ++w8) s += red[(w8 * 3 + C.wave) * 64 + C.lane];
                ((float*)(ws + WS_MOD))[(size_t)(l * 3 + C.wave) * 6144 + n] = s; }
            __syncthreads();
        }
    }
    {
        LAS float* sk = (LAS float*)C.lds;
        LAS float* wq = (LAS float*)(C.lds + 128 * 65 * 4);
        for (int it = C.vcu; it < 2 * 16 * 16; it += C.G) {
            const int l = it >> 8, hp = (it >> 4) & 15, kc = it & 15, k0 = kc * 64;
            const float* SK = A.peer_subkeys + ((size_t)l * 16 + hp) * 128 * 64;
            for (int i = C.tid; i < 128 * 64; i += NTHREADS) sk[(i >> 6) * 65 + (i & 63)] = SK[i];
            const float* WQ = A.peer_wq + (size_t)l * 1024 * 1024 + hp * 64;
            for (int i = C.tid; i < 64 * 64; i += NTHREADS) wq[(i >> 6) * 65 + (i & 63)] = WQ[(size_t)(k0 + (i >> 6)) * 1024 + (i & 63)];
            __syncthreads();
            bf16* WP = (bf16*)(ws + WS_WPEER) + ((size_t)l * 2048 + hp * 128) * 1024 + k0;
            {
                const int n0 = (C.tid >> 4) * 4, kq = (C.tid & 15) * 4; float s[4][4];
#pragma unroll
                for (int i = 0; i < 4; ++i)
#pragma unroll
                    for (int jj = 0; jj < 4; ++jj) s[i][jj] = 0.f;
#pragma unroll 4
                for (int d = 0; d < 64; ++d) { float a[4], b[4];
#pragma unroll
                    for (int i = 0; i < 4; ++i) { a[i] = sk[(n0 + i) * 65 + d]; b[i] = wq[(kq + i) * 65 + d]; }
#pragma unroll
                    for (int i = 0; i < 4; ++i)
#pragma unroll
                        for (int jj = 0; jj < 4; ++jj) s[i][jj] += a[i] * b[jj]; }
#pragma unroll
                for (int i = 0; i < 4; ++i) *(GAS v2u*)(WP + (size_t)(n0 + i) * 1024 + kq) = (v2u){pk2(s[i][0], s[i][1]), pk2(s[i][2], s[i][3])};
            }
            __syncthreads();
        }
    }
}

__device__ __forceinline__ void norm_rows(const Ctx& C, const float* xlat, const float* xctx, int nrows, const float* g, const float* mod  , int shi, bf16* XN) {
    const int gw = C.vcu * NWAVES + C.wave, NGW = C.G * NWAVES;
    f32x4 gv[4];
#pragma unroll
    for (int j = 0; j < 4; ++j) gv[j] = ((const f32x4*)g)[C.lane + 64 * j];
    f32x4 nv[4];
    if (gw < nrows) { const float* xr = gw < ML ? xlat + (size_t)gw * 1024 : xctx + (size_t)(gw - ML) * 1024;
#pragma unroll
        for (int j = 0; j < 4; ++j) nv[j] = ((const GAS f32x4*)xr)[C.lane + 64 * j]; }
    for (int r = gw; r < nrows; r += NGW) {
        const bool latent = r < ML;
        const float* mp = mod + (latent ? (r >> 14) : 2) * 6144 + shi * 1024;
        f32x4 v[4]; float s = 0.f;
#pragma unroll
        for (int j = 0; j < 4; ++j) { v[j] = nv[j]; s += (v[j].x * v[j].x + v[j].y * v[j].y) + (v[j].z * v[j].z + v[j].w * v[j].w); }
        { const int rn = r + NGW; if (rn < nrows) { const float* xn = rn < ML ? xlat + (size_t)rn * 1024 : xctx + (size_t)(rn - ML) * 1024;
#pragma unroll
            for (int j = 0; j < 4; ++j) nv[j] = ((const GAS f32x4*)xn)[C.lane + 64 * j]; } }
        const float rstd = 1.0f / sqrtf(wave_sum(s) * (1.0f / 1024.0f) + EPS);
        GAS unsigned long long* o8 = (GAS unsigned long long*)(XN + (size_t)r * 1024) + C.lane;
#pragma unroll
        for (int j = 0; j < 4; ++j) { const f32x4 sh = ((const f32x4*)mp)[C.lane + 64 * j], sc = ((const f32x4*)(mp + 1024))[C.lane + 64 * j];
            const f32x4 y = v[j] * rstd * gv[j] * (sc + 1.0f) + sh;
            o8[64 * j] = (unsigned long long)pk2(y.x, y.y) | ((unsigned long long)pk2(y.z, y.w) << 32); }
    }
}

__device__ __forceinline__ void ysc_pass(const Ctx& C, bf16* BG, const bf16* CX, const float* w  , int nrows) {
    const long total = (long)nrows * 64, i0 = (long)C.vcu * NTHREADS + C.tid, istep = (long)C.G * NTHREADS;
    const int c8 = (int)(i0 & 63) * 8;
    const f32x4 w0a = *(const f32x4*)(w + c8), w0b = *(const f32x4*)(w + c8 + 4), w1a = *(const f32x4*)(w + 512 + c8), w1b = *(const f32x4*)(w + 512 + c8 + 4), w2a = *(const f32x4*)(w + 1024 + c8), w2b = *(const f32x4*)(w + 1024 + c8 + 4);
#define YSC_LOAD(ii, CM, C0, CP, BGV) do { const int r_ = (int)((ii) >> 6); int t_, L_; if (r_ < ML) { t_ = r_ & (SEQ - 1); L_ = SEQ; } else { t_ = (r_ - ML) & (CTX_LEN - 1); L_ = CTX_LEN; } \
        const int rm_ = (t_ > 0) ? r_ - 1 : r_, rp_ = (t_ < L_ - 1) ? r_ + 1 : r_; const v4u z4_ = (v4u){0u, 0u, 0u, 0u}; \
        const v4u cmv_ = *(const GAS v4u*)(CX + (size_t)rm_ * 512 + c8), cpv_ = *(const GAS v4u*)(CX + (size_t)rp_ * 512 + c8); \
        C0 = *(const GAS v4u*)(CX + (size_t)r_ * 512 + c8); BGV = *(const GAS v4u*)(BG + (size_t)r_ * 512 + c8); CM = (t_ > 0) ? cmv_ : z4_; CP = (t_ < L_ - 1) ? cpv_ : z4_; } while (0)
    v4u ncm = (v4u){0u, 0u, 0u, 0u}, nc0 = ncm, ncp = ncm, nbg = ncm;
    if (i0 < total) YSC_LOAD(i0, ncm, nc0, ncp, nbg);
    for (long i = i0; i < total; i += istep) {
        const int r = (int)(i >> 6);
        const v4u cm = ncm, c0 = nc0, cp = ncp, bg = nbg;
        if (i + istep < total) YSC_LOAD(i + istep, ncm, nc0, ncp, nbg);
        f32x4 ma, mb, ca, cb, pa, pb, ga, gb; pg8::unpack8(cm, ma, mb); pg8::unpack8(c0, ca, cb); pg8::unpack8(cp, pa, pb); pg8::unpack8(bg, ga, gb);
        const f32x4 ya = ga * (w0a * ma + w1a * ca + w2a * pa), yb = gb * (w0b * mb + w1b * cb + w2b * pb);
        *(GAS v4u*)(BG + (size_t)r * 512 + c8) = pg8::pack8(ya, yb);
    }
#undef YSC_LOAD
}

__device__ __forceinline__ void yhy_transpose(const Ctx& C, const bf16* YHYT, bf16* YHY, bool with_ctx) {
    LAS unsigned short* scr = (LAS unsigned short*)(C.lds + C.wave * 16384);
    const int gw = C.vcu * NWAVES + C.wave, NGW = C.G * NWAVES;
    const int NLAT = 2 * 8 * 256, NIT = NLAT + (with_ctx ? 2 * 8 * 4 : 0);
    for (int it = gw; it < NIT; it += NGW) {
        const bf16* src; size_t pitch; size_t row0; int cb;
        if (it < NLAT) { const int b = it >> 11, r = it & 2047; cb = r >> 8; const int tb = r & 255; src = YHYT + ((size_t)(b * 512 + cb * 64)) * SEQ + tb * 64; pitch = SEQ; row0 = (size_t)b * SEQ + tb * 64; }
        else { const int q = it - NLAT, b = q >> 5, r = q & 31; cb = r >> 2; const int tb = r & 3; src = YHYT + (size_t)BATCH * 512 * SEQ + ((size_t)(b * 512 + cb * 64)) * CTX_LEN + tb * 64; pitch = CTX_LEN; row0 = (size_t)ML + b * CTX_LEN + tb * 64; }
#pragma unroll
        for (int i = 0; i < 32; ++i) { const int c = 2 * i + (C.lane >> 5); const unsigned w = *(const GAS unsigned*)(src + (size_t)c * pitch + (C.lane & 31) * 2);
            scr[c * 66 + (C.lane & 31) * 2] = (unsigned short)(w & 0xffffu); scr[c * 66 + (C.lane & 31) * 2 + 1] = (unsigned short)(w >> 16); }
        LDS_WAIT(); asm volatile("" ::: "memory");
        const int ch = C.lane & 7;
#pragma unroll
        for (int j = 0; j < 8; ++j) { const int t = (C.lane >> 3) + 8 * j; const LAS unsigned short* s = scr + (8 * ch) * 66 + t;
            v4u o; o.x = (unsigned)s[0] | ((unsigned)s[66] << 16); o.y = (unsigned)s[2 * 66] | ((unsigned)s[3 * 66] << 16); o.z = (unsigned)s[4 * 66] | ((unsigned)s[5 * 66] << 16); o.w = (unsigned)s[6 * 66] | ((unsigned)s[7 * 66] << 16);
            *(GAS v4u*)(YHY + (row0 + t) * 512 + cb * 64 + 8 * ch) = o; }
        LDS_WAIT(); asm volatile("" ::: "memory");
    }
}

__device__ __forceinline__ void cvt_table(const Ctx& C, const float* src, bf16* dst, size_t n) {
    const size_t n8 = n / 8;
    for (size_t i = (size_t)C.vcu * NTHREADS + C.tid; i < n8; i += (size_t)C.G * NTHREADS) {
        const f32x4 a = ((const GAS f32x4*)src)[2 * i], b = ((const GAS f32x4*)src)[2 * i + 1];
        v4u o; o.x = pk2(a.x, a.y); o.y = pk2(a.z, a.w); o.z = pk2(b.x, b.y); o.w = pk2(b.z, b.w);
        ((GAS v4u*)dst)[i] = o;
    }
}

__device__ __forceinline__ void cvt_table_fp6(const Ctx& C, const float* src, unsigned char* dst, float* deq, int rows, int cu = -1, int ncu = 0) {
    const int gw = (cu < 0 ? C.vcu : cu) * NWAVES + C.wave, NGW = (cu < 0 ? C.G : ncu) * NWAVES, lp = C.lane & 31, half = C.lane >> 5;
    f32x4 nv[8];
    if (gw < rows / 2) { const GAS f32x4* s = (const GAS f32x4*)(src + (size_t)(2 * gw + half) * 1024) + 8 * lp;
#pragma unroll
        for (int j = 0; j < 8; ++j) nv[j] = s[j]; }
    for (int r2 = gw; r2 < rows / 2; r2 += NGW) {
        const int r = 2 * r2 + half;
        f32x4 v[8]; float mx = 0.f;
#pragma unroll
        for (int j = 0; j < 8; ++j) v[j] = nv[j];
        { const int rn2 = r2 + NGW; if (rn2 < rows / 2) { const GAS f32x4* s = (const GAS f32x4*)(src + (size_t)(2 * rn2 + half) * 1024) + 8 * lp;
#pragma unroll
            for (int j = 0; j < 8; ++j) nv[j] = s[j]; } }
#pragma unroll
        for (int j = 0; j < 8; ++j) { mx = fmaxf(mx, fmaxf(fmaxf(fabsf(v[j].x), fabsf(v[j].y)), fmaxf(fabsf(v[j].z), fabsf(v[j].w)))); }
        mx = fmaxf(mx, __shfl_xor(mx, 16)); mx = fmaxf(mx, __shfl_xor(mx, 8)); mx = fmaxf(mx, __shfl_xor(mx, 4)); mx = fmaxf(mx, __shfl_xor(mx, 2)); mx = fmaxf(mx, __shfl_xor(mx, 1));
        const float sc = mx > 0.f ? 7.5f / mx : 1.0f;
        v16f a, b;
#pragma unroll
        for (int i = 0; i < 16; ++i) {
#if FP6_ILV
            const int ia = 2 * i, ib = 2 * i + 1;
#else
            const int ia = i, ib = 16 + i;
#endif
            a[i] = v[ia >> 2][ia & 3] * sc; b[i] = v[ib >> 2][ib & 3] * sc; }
        const v6i w = __builtin_amdgcn_cvt_scalef32_2xpk16_fp6_f32(a, b, 1.0f);
        unsigned char* d = dst + (size_t)r * 768;
        *(GAS v4u*)(d + 16 * lp) = (v4u){(unsigned)w[0], (unsigned)w[1], (unsigned)w[2], (unsigned)w[3]};
        *(GAS v2u*)(d + 512 + 8 * lp) = (v2u){(unsigned)w[4], (unsigned)w[5]};
        if (lp == 0) deq[r] = mx > 0.f ? mx * (1.0f / 7.5f) : 1.0f;
    }
}
__device__ __forceinline__ void cvt_table_fp8(const Ctx& C, const float* src, unsigned char* dst, float* deq, int rows) {
    const int gw = C.vcu * NWAVES + C.wave, NGW = C.G * NWAVES;
    for (int r = gw; r < rows; r += NGW) {
        const GAS f32x4* s = (const GAS f32x4*)(src + (size_t)r * 1024) + 4 * C.lane;
        f32x4 v[4]; float mx = 0.f;
#pragma unroll
        for (int j = 0; j < 4; ++j) { v[j] = s[j]; mx = fmaxf(mx, fmaxf(fmaxf(fabsf(v[j].x), fabsf(v[j].y)), fmaxf(fabsf(v[j].z), fabsf(v[j].w)))); }
        mx = wave_max(mx);
        const float sc = mx > 0.f ? 240.0f / mx : 1.0f;
        v4u o;
#pragma unroll
        for (int j = 0; j < 4; ++j) { int w = 0; w = __builtin_amdgcn_cvt_pk_fp8_f32(v[j].x * sc, v[j].y * sc, w, false); w = __builtin_amdgcn_cvt_pk_fp8_f32(v[j].z * sc, v[j].w * sc, w, true); o[j] = (unsigned)w; }
        *(GAS v4u*)(dst + (size_t)r * 1024 + 16 * C.lane) = o;
        if (C.lane == 0) deq[r] = mx > 0.f ? mx * (1.0f / 240.0f) : 1.0f;
    }
}

namespace hy {
constexpr int L = SEQ, NFFT = 2 * SEQ;
__device__ __forceinline__ int cidx(int p) { return p + ((p >> 6) << 2); }
__device__ __forceinline__ f32x2 cmul(f32x2 a, f32x2 b) { return (f32x2){a.x * b.x - a.y * b.y, a.x * b.y + a.y * b.x}; }
__device__ __forceinline__ f32x2 cmulc(f32x2 a, f32x2 b) { return (f32x2){a.x * b.x + a.y * b.y, a.y * b.x - a.x * b.y}; }
__device__ __forceinline__ f32x2 twid(float frac) { return (f32x2){__builtin_amdgcn_cosf(frac), -__builtin_amdgcn_sinf(frac)}; }
__device__ __forceinline__ unsigned cpack(f32x2 v) { return pk2(v.x, v.y); }
__device__ __forceinline__ f32x2 cunpack(unsigned w) { return (f32x2){bflo(w), bfhi(w)}; }
__device__ __forceinline__ f32x2 w16(int k) {
    constexpr float c1 = 0.9238795325112867f, s1 = 0.3826834323650898f, r2 = 0.7071067811865476f;
    switch (k) { case 0: return (f32x2){1.f, 0.f}; case 1: return (f32x2){c1, -s1}; case 2: return (f32x2){r2, -r2}; case 3: return (f32x2){s1, -c1};
                 case 4: return (f32x2){0.f, -1.f}; case 5: return (f32x2){-s1, -c1}; case 6: return (f32x2){-r2, -r2}; default: return (f32x2){-c1, -s1}; }
}
__device__ __forceinline__ void fwd16(LAS f32x2* buf, int base, int j0, int n) {
    const int st = n >> 4; f32x2 v[16];
#pragma unroll
    for (int m = 0; m < 16; ++m) v[m] = buf[cidx(base + j0 + m * st)];
    f32x2 w[4]; w[0] = twid((float)j0 / (float)n); w[1] = cmul(w[0], w[0]); w[2] = cmul(w[1], w[1]); w[3] = cmul(w[2], w[2]);
#pragma unroll
    for (int q = 0; q < 4; ++q) { const int span = 8 >> q;
#pragma unroll
        for (int m = 0; m < 16; ++m) if (((m / span) & 1) == 0) { const int mp = m % span;
            const f32x2 a = v[m], b = v[m + span], d = a - b; v[m] = a + b;
            v[m + span] = (mp == 0) ? cmul(d, w[q]) : cmul(cmul(d, w16(mp << q)), w[q]); } }
#pragma unroll
    for (int m = 0; m < 16; ++m) buf[cidx(base + j0 + m * st)] = v[m];
}
__device__ __forceinline__ void inv16(LAS f32x2* buf, int base, int j0, int nlo) {
    f32x2 v[16];
#pragma unroll
    for (int m = 0; m < 16; ++m) v[m] = buf[cidx(base + j0 + m * nlo)];
    f32x2 pw[4]; pw[3] = twid((float)j0 / (float)(nlo * 16)); pw[2] = cmul(pw[3], pw[3]); pw[1] = cmul(pw[2], pw[2]); pw[0] = cmul(pw[1], pw[1]);
#pragma unroll
    for (int q = 0; q < 4; ++q) { const int span = 1 << q;
#pragma unroll
        for (int m = 0; m < 16; ++m) if (((m / span) & 1) == 0) { const int mp = m % span;
            const f32x2 a = v[m]; f32x2 b = cmulc(v[m + span], pw[q]); if (mp != 0) b = cmulc(b, w16(mp << (3 - q)));
            v[m] = a + b; v[m + span] = a - b; } }
#pragma unroll
    for (int m = 0; m < 16; ++m) buf[cidx(base + j0 + m * nlo)] = v[m];
}
__device__ __forceinline__ void fwd4_last(LAS f32x2* buf, int base) {
    f32x2 a = buf[cidx(base)], b = buf[cidx(base + 1)], c = buf[cidx(base + 2)], d = buf[cidx(base + 3)];
    const f32x2 s0 = a + c, d0 = a - c, s1 = b + d, t = b - d; const f32x2 d1 = (f32x2){t.y, -t.x};
    buf[cidx(base)] = s0 + s1; buf[cidx(base + 1)] = s0 - s1; buf[cidx(base + 2)] = d0 + d1; buf[cidx(base + 3)] = d0 - d1;
}
__device__ __forceinline__ void inv4_first(LAS f32x2* buf, int base) {
    f32x2 a = buf[cidx(base)], b = buf[cidx(base + 1)], c = buf[cidx(base + 2)], d = buf[cidx(base + 3)];
    const f32x2 s0 = a + b, d0 = a - b, s1 = c + d, t = c - d; const f32x2 d1 = (f32x2){-t.y, t.x};
    buf[cidx(base)] = s0 + s1; buf[cidx(base + 2)] = s0 - s1; buf[cidx(base + 1)] = d0 + d1; buf[cidx(base + 3)] = d0 - d1;
}
__device__ __forceinline__ void fft_fwd(LAS f32x2* buf, int tid) {
#pragma unroll 1
    for (int k = 0; k < 2; ++k) { const int bf = tid + 512 * k; fwd16(buf, 0, bf, 16384); }
    __syncthreads();
#pragma unroll 1
    for (int k = 0; k < 2; ++k) { const int bf = tid + 512 * k; fwd16(buf, (bf >> 6) * 1024, bf & 63, 1024); }
    __syncthreads();
#pragma unroll 1
    for (int k = 0; k < 2; ++k) { const int bf = tid + 512 * k; fwd16(buf, (bf >> 2) * 64, bf & 3, 64); }
    __syncthreads();
#pragma unroll 1
    for (int k = 0; k < 8; ++k) { const int bf = tid + 512 * k; fwd4_last(buf, 4 * bf); }
    __syncthreads();
}
__device__ __forceinline__ void fft_inv(LAS f32x2* buf, int tid) {
#pragma unroll 1
    for (int k = 0; k < 8; ++k) { const int bf = tid + 512 * k; inv4_first(buf, 4 * bf); }
    __syncthreads();
#pragma unroll 1
    for (int k = 0; k < 2; ++k) { const int bf = tid + 512 * k; inv16(buf, (bf >> 2) * 64, bf & 3, 4); }
    __syncthreads();
#pragma unroll 1
    for (int k = 0; k < 2; ++k) { const int bf = tid + 512 * k; inv16(buf, (bf >> 6) * 1024, bf & 63, 64); }
    __syncthreads();
#pragma unroll 1
    for (int k = 0; k < 2; ++k) { const int bf = tid + 512 * k; inv16(buf, 0, bf, 1024); }
    __syncthreads();
}
__device__ __forceinline__ void fft_fwd_pack(LAS f32x2* buf, int tid, GAS v4u* slot) {
#pragma unroll 1
    for (int k = 0; k < 2; ++k) { const int bf = tid + 512 * k; fwd16(buf, 0, bf, 16384); }
    __syncthreads();
#pragma unroll 1
    for (int k = 0; k < 2; ++k) { const int bf = tid + 512 * k; fwd16(buf, (bf >> 6) * 1024, bf & 63, 1024); }
    __syncthreads();
#pragma unroll 1
    for (int k = 0; k < 2; ++k) { const int bf = tid + 512 * k; fwd16(buf, (bf >> 2) * 64, bf & 3, 64); }
    __syncthreads();
#pragma unroll
    for (int k = 0; k < 8; ++k) { const int p = cidx(4 * (tid + 512 * k));
        const f32x2 a = buf[p], b = buf[p + 1], c = buf[p + 2], d = buf[p + 3];
        const f32x2 s0 = a + c, d0 = a - c, s1 = b + d, t = b - d; const f32x2 d1 = (f32x2){t.y, -t.x};
        slot[512 * k] = (v4u){cpack(s0 + s1), cpack(s0 - s1), cpack(d0 + d1), cpack(d0 - d1)}; if (k & 1) __builtin_amdgcn_sched_barrier(0); }
}
__device__ __forceinline__ void fft_conv(LAS f32x2* buf, int tid, const GAS v4u* slot) {
#pragma unroll 1
    for (int k = 0; k < 2; ++k) { const int bf = tid + 512 * k; fwd16(buf, 0, bf, 16384); }
    __syncthreads();
#pragma unroll 1
    for (int k = 0; k < 2; ++k) { const int bf = tid + 512 * k; fwd16(buf, (bf >> 6) * 1024, bf & 63, 1024); }
    __syncthreads();
    v4u spv[8];
#pragma unroll
    for (int k = 0; k < 8; ++k) spv[k] = slot[512 * k];
    __builtin_amdgcn_sched_barrier(0);
#pragma unroll 1
    for (int k = 0; k < 2; ++k) { const int bf = tid + 512 * k; fwd16(buf, (bf >> 2) * 64, bf & 3, 64); }
    __syncthreads();
#pragma unroll
    for (int k = 0; k < 8; ++k) { const int p = cidx(4 * (tid + 512 * k)); const v4u sp = spv[k];
        f32x2 a = buf[p], b = buf[p + 1], c = buf[p + 2], d = buf[p + 3];
        { const f32x2 s0 = a + c, d0 = a - c, s1 = b + d, t = b - d; const f32x2 d1 = (f32x2){t.y, -t.x};
          a = cmul(s0 + s1, cunpack(sp[0])); b = cmul(s0 - s1, cunpack(sp[1])); c = cmul(d0 + d1, cunpack(sp[2])); d = cmul(d0 - d1, cunpack(sp[3])); }
        { const f32x2 s0 = a + b, d0 = a - b, s1 = c + d, t = c - d; const f32x2 d1 = (f32x2){-t.y, t.x};
          buf[p] = s0 + s1; buf[p + 2] = s0 - s1; buf[p + 1] = d0 + d1; buf[p + 3] = d0 - d1; } if (k & 1) __builtin_amdgcn_sched_barrier(0); }
    __syncthreads();
#pragma unroll 1
    for (int k = 0; k < 2; ++k) { const int bf = tid + 512 * k; inv16(buf, (bf >> 2) * 64, bf & 3, 4); }
    __syncthreads();
#pragma unroll 1
    for (int k = 0; k < 2; ++k) { const int bf = tid + 512 * k; inv16(buf, (bf >> 6) * 1024, bf & 63, 64); }
    __syncthreads();
#pragma unroll 1
    for (int k = 0; k < 2; ++k) { const int bf = tid + 512 * k; inv16(buf, 0, bf, 1024); }
    __syncthreads();
}
__device__ __forceinline__ float conv3_at(const bf16* P, int t, int T, float w0, float w1, float w2, float cb) {
    const int tm = t > 0 ? t - 1 : 0, tp = t < T - 1 ? t + 1 : T - 1;
    const float vm = bf1(P[tm]), v0 = bf1(P[t]), vp = bf1(P[tp]);
    const float pm = t > 0 ? vm : 0.f, pp = t < T - 1 ? vp : 0.f;
    return w0 * pm + w1 * v0 + w2 * pp + cb;
}
__device__ __forceinline__ float wave_sum_t(float v, int tid) {
#pragma unroll
    for (int m = 1; m < 64; m <<= 1) v += __builtin_bit_cast(float, __builtin_amdgcn_ds_bpermute(((tid ^ m) & 63) << 2, __builtin_bit_cast(int, v)));
    return v;
}
__device__ __forceinline__ float block_sum(float v, LAS float* red, int wave, int lane, int tid) {
    v = wave_sum_t(v, tid);
    __syncthreads();
    if (lane == 0) red[wave] = v;
    __syncthreads();
    float s = 0.f;
#pragma unroll
    for (int w = 0; w < 8; ++w) s += red[w];
    return s;
}

__device__ __forceinline__ void hyena_unit(const Args& A, const Ctx& C, int l_, int c_, bool with_ctx) {
    const int l = __builtin_amdgcn_readfirstlane(l_), c0 = __builtin_amdgcn_readfirstlane(c_);
#define OPQC() int c = c0; asm volatile("" : "+s"(c))
    OPQC();
    unsigned char* ws = A.ws;
    LAS f32x2* buf = (LAS f32x2*)C.lds;
    LAS float* sW = (LAS float*)(C.lds + HYS_OFF);
    LAS float* red = sW + 256;
    const int tid0 = C.tid;
#define OPQ() int tid = tid0; asm volatile("" : "+v"(tid))
    const bf16* HYT = (const bf16*)(ws + WS_R1);
    const bf16* HYTC = (const bf16*)(ws + WS_HYTC);
    bf16* YT = (bf16*)(ws + WS_YHYT);
#define SZ ((GAS v4u*)(ws + WS_HSCR) + (size_t)blockIdx.x * 8192 + tid)
#define SA (SZ + 4096)
#define SB ((GAS v4u*)(ws + WS_YHY) + (size_t)blockIdx.x * 4096 + tid)
#define SF ((GAS v4u*)(ws + WS_YHY) + (size_t)(256 + blockIdx.x) * 4096 + tid)
    __syncthreads();
    { OPQ(); if (tid < 256) { const int od = tid >> 6, j = tid & 63; sW[tid] = A.hy_w3[((size_t)l * 64 + j) * 2048 + od * 512 + c]; } }
    __syncthreads();
#define HY_CW(X, k) (A.hy_conv_w[((size_t)l * 3 + (k)) * 1536 + (X) * 512 + c])
#define HY_CB(X) (A.hy_conv_b[l * 1536 + (X) * 512 + c])
#define HY_CONV4(u, P, t0, w0, w1, w2, wb) do { const v2u w_ = *(const GAS v2u*)((P) + (t0)); const int tl_ = (t0) > 0 ? (t0) - 1 : 0, tr_ = (t0) + 4 < L ? (t0) + 4 : L - 1; \
        const float xl_ = (t0) > 0 ? bf1((P)[tl_]) : 0.f, xr_ = (t0) + 4 < L ? bf1((P)[tr_]) : 0.f, x0_ = bflo(w_.x), x1_ = bfhi(w_.x), x2_ = bflo(w_.y), x3_ = bfhi(w_.y); \
        u[0] = (w0) * xl_ + (w1) * x0_ + (w2) * x1_ + (wb); u[1] = (w0) * x0_ + (w1) * x1_ + (w2) * x2_ + (wb); u[2] = (w0) * x1_ + (w1) * x2_ + (w2) * x3_ + (wb); u[3] = (w0) * x2_ + (w1) * x3_ + (w2) * xr_ + (wb); } while (0)
#define HY_RAW(P, t0, W, XL, XR) do { W = *(const GAS v2u*)((P) + (t0)); XL = (P)[(t0) > 0 ? (t0) - 1 : 0]; XR = (P)[(t0) + 4 < L ? (t0) + 4 : L - 1]; } while (0)
#define HY_CALC(u, W, XL, XR, t0, w0, w1, w2, wb) do { const float xl_ = (t0) > 0 ? bf1(XL) : 0.f, xr_ = (t0) + 4 < L ? bf1(XR) : 0.f, x0_ = bflo(W.x), x1_ = bfhi(W.x), x2_ = bflo(W.y), x3_ = bfhi(W.y); \
        u[0] = (w0) * xl_ + (w1) * x0_ + (w2) * x1_ + (wb); u[1] = (w0) * x0_ + (w1) * x1_ + (w2) * x2_ + (wb); u[2] = (w0) * x1_ + (w1) * x2_ + (w2) * x3_ + (wb); u[3] = (w0) * x2_ + (w1) * x3_ + (w2) * xr_ + (wb); } while (0)
    float inv0, inv1;
    {
        OPQ();
        const int lane = tid & 63, wv = __builtin_amdgcn_readfirstlane(tid >> 6), col = lane & 15, kg = lane >> 4;
        const float dec0 = fabsf(A.hy_decay[((size_t)l * 2 + 0) * 512 + c]), dec1 = fabsf(A.hy_decay[((size_t)l * 2 + 1) * 512 + c]);
        bf16x8 af[2];
#pragma unroll
        for (int s2 = 0; s2 < 2; ++s2)
#pragma unroll
            for (int jj = 0; jj < 8; ++jj) { const int j = 32 * s2 + 8 * kg + jj; const float w = A.hy_w3[((size_t)l * 64 + j) * 2048 + (col & 3) * 512 + c]; af[s2][jj] = (short)f2bf(col < 4 ? w : 0.f); }
        const bf16* H2T = (const bf16*)(ws + WS_H2) + (size_t)l * L * 64;
        GAS unsigned* SFF = (GAS unsigned*)((GAS v4u*)(ws + WS_YHY) + (size_t)(256 + blockIdx.x) * 4096);
        float as0 = 0.f, as1 = 0.f;
#define HYF_LOAD(B, bt) { _Pragma("unroll") for (int i = 0; i < 8; ++i) { const int t = 2048 * wv + 16 * (8 * (bt) + i) + col; \
            B[i][0] = *(const GAS bf16x8*)(H2T + (size_t)t * 64 + 8 * kg); B[i][1] = *(const GAS bf16x8*)(H2T + (size_t)t * 64 + 32 + 8 * kg); } }
#define HYF_USE(B, bt) { _Pragma("unroll") for (int i = 0; i < 8; ++i) { const int t = 2048 * wv + 16 * (8 * (bt) + i) + col; \
            f32x4 acc = (f32x4){0.f, 0.f, 0.f, 0.f}; \
            acc = __builtin_amdgcn_mfma_f32_16x16x32_bf16(af[0], B[i][0], acc, 0, 0, 0); \
            acc = __builtin_amdgcn_mfma_f32_16x16x32_bf16(af[1], B[i][1], acc, 0, 0, 0); \
            if (kg == 0) { const float tl = (float)t * (1.0f / (float)(L - 1)); const float w0 = __expf(-tl * dec0), w1 = __expf(-tl * dec1); \
                const float h0 = acc[0] * w0, h1 = acc[1] * w0, h2 = acc[2] * w1, h3 = acc[3] * w1; \
                as0 += fabsf(h0) + fabsf(h1); as1 += fabsf(h2) + fabsf(h3); \
                buf[cidx(t)] = (f32x2){h0, h1}; SFF[t] = pk2(h2, h3); } } }
        bf16x8 fa_[8][2], fb_[8][2];
        HYF_LOAD(fa_, 0)
#pragma unroll 1
        for (int bt = 0; bt < 16; bt += 2) {
            HYF_LOAD(fb_, bt + 1)
            HYF_USE(fa_, bt)
            if (bt + 2 < 16) HYF_LOAD(fa_, bt + 2)
            HYF_USE(fb_, bt + 1)
        }
#undef HYF_LOAD
#undef HYF_USE
        inv0 = 1.0f / block_sum(as0, red, C.wave, C.lane, tid);
        inv1 = 1.0f / block_sum(as1, red, C.wave, C.lane, tid);
        __syncthreads();
    }
    {
        OPQ();
        const float v0 = HY_CW(0, 0), v1 = HY_CW(0, 1), v2 = HY_CW(0, 2), vb = HY_CB(0);
        v2u ra[8], rb[8]; bf16 la[8], ha[8], lb[8], hb_[8];
#pragma unroll
        for (int g = 0; g < 8; ++g) { const int t0 = 2048 * g + 4 * tid; HY_RAW(HYT + ((size_t)(0 * 1536 + c)) * L, t0, ra[g], la[g], ha[g]); HY_RAW(HYT + ((size_t)(1 * 1536 + c)) * L, t0, rb[g], lb[g], hb_[g]); }
#pragma unroll
        for (int g = 0; g < 8; ++g) { const int t0 = 2048 * g + 4 * tid; float ua[4], ub[4];
            HY_CALC(ua, ra[g], la[g], ha[g], t0, v0, v1, v2, vb); HY_CALC(ub, rb[g], lb[g], hb_[g], t0, v0, v1, v2, vb);
            SZ[512 * g] = (v4u){pk2(ua[0], ub[0]), pk2(ua[1], ub[1]), pk2(ua[2], ub[2]), pk2(ua[3], ub[3])}; }
    }
#pragma unroll 1
    for (int o = 0; o < 2; ++o) {
        OPQC();
        const float bias = __builtin_bit_cast(float, __builtin_amdgcn_readfirstlane(__builtin_bit_cast(int, A.hy_bias[((size_t)l * 2 + o) * 512 + c])));
        if (o == 1) {
            OPQ();
            const GAS v4u* sf4 = (const GAS v4u*)((GAS v4u*)(ws + WS_YHY) + (size_t)(256 + blockIdx.x) * 4096);
#pragma unroll
            for (int g = 0; g < 8; ++g) { const v4u w = sf4[512 * g + tid]; const int p = cidx(2048 * g + 4 * tid);
#pragma unroll
                for (int k = 0; k < 4; ++k) buf[p + k] = cunpack(w[k]); }
            __syncthreads();
        }
        {
            OPQ();
            f32x2 zs[32];
            const float invo = o ? inv1 : inv0;
#pragma unroll
            for (int g = 0; g < 8; ++g)
#pragma unroll
                for (int k = 0; k < 4; ++k) { const int n = 2048 * g + 4 * tid + k;
                    if (g < 4) { zs[g * 4 + k] = (f32x2){buf[cidx(2 * n)].x * invo, buf[cidx(2 * n + 1)].x * invo}; }
                    else { const int m = 2 * L - 2 * n; const int mc = m < L ? m : L - 1; const float re = buf[cidx(mc)].y; zs[g * 4 + k] = (f32x2){m < L ? re * invo : 0.f, buf[cidx(m - 1)].y * invo}; } }
            __syncthreads();
#pragma unroll
            for (int g = 0; g < 8; ++g) { const int p = cidx(2048 * g + 4 * tid);
#pragma unroll
                for (int k = 0; k < 4; ++k) buf[p + k] = zs[g * 4 + k]; }
            __syncthreads();
        }
        v4u zv[8];
        { OPQ(); fft_fwd(buf, tid);
#pragma unroll
          for (int g = 0; g < 8; ++g) zv[g] = SZ[512 * g];
          const f32x2 w1c = twid(1.0f / (float)NFFT);
#pragma unroll
          for (int g = 0; g < 8; ++g) { v4u ke4, ko4;
#pragma unroll
              for (int k = 0; k < 4; ++k) { const int p = 2048 * g + 4 * tid + k; const int kp = (int)(__builtin_bitreverse32((unsigned)p) >> 18);
                  const int m0 = (2 * kp) & (L - 1); const bool neg = kp >= L / 2;
                  const int q0 = p >> 1, q1 = q0 + L / 2, q0c = (int)(__builtin_bitreverse32((unsigned)((L - m0) & (L - 1))) >> 18), q1c = L - 1 - q0;
                  const f32x2 a0 = buf[cidx(q0)], b0 = buf[cidx(q0c)], a1 = buf[cidx(q1)], b1 = buf[cidx(q1c)];
                  const f32x2 t0 = twid((float)m0 * (1.0f / (float)NFFT)), t1 = cmul(t0, w1c);
                  const f32x2 xe0 = (f32x2){0.5f * (a0.x + b0.x), 0.5f * (a0.y - b0.y)}, d0 = (f32x2){a0.x - b0.x, a0.y + b0.y}, xo0 = (f32x2){0.5f * d0.y, -0.5f * d0.x};
                  const f32x2 xe1 = (f32x2){0.5f * (a1.x + b1.x), 0.5f * (a1.y - b1.y)}, d1 = (f32x2){a1.x - b1.x, a1.y + b1.y}, xo1 = (f32x2){0.5f * d1.y, -0.5f * d1.x};
                  const f32x2 c0 = cmul(t0, xo0), c1 = cmul(t1, xo1);
                  const f32x2 v0 = neg ? xe0 - c0 : xe0 + c0, v1 = neg ? xe1 - c1 : xe1 + c1;
                  ke4[k] = cpack(v0); ko4[k] = cpack(v1); }
              SA[512 * g] = ke4; SB[512 * g] = ko4; __builtin_amdgcn_sched_barrier(0); }
          __syncthreads(); }
        { OPQ();
#pragma unroll
        for (int g = 0; g < 8; ++g) { const int p = cidx(2048 * g + 4 * tid); const v4u w = zv[g];
#pragma unroll
            for (int k = 0; k < 4; ++k) buf[p + k] = cunpack(w[k]); }
        __syncthreads();
        fft_conv(buf, tid, SA); }
        { OPQ();
#pragma unroll
        for (int g = 0; g < 8; ++g) zv[g] = SZ[512 * g];
#pragma unroll
        for (int g = 0; g < 8; ++g) { const int p = cidx(2048 * g + 4 * tid); v4u w;
#pragma unroll
            for (int k = 0; k < 4; ++k) { const f32x2 y = buf[p + k]; w[k] = pk2(y.x * (1.0f / (float)NFFT), y.y * (1.0f / (float)NFFT)); }
            SA[512 * g] = w; }
        __syncthreads(); }
        { OPQ();
#pragma unroll
        for (int g = 0; g < 8; ++g) { const int t0 = 2048 * g + 4 * tid, p = cidx(t0); const v4u w = zv[g];
#pragma unroll
            for (int k = 0; k < 4; ++k) buf[p + k] = cmul(cunpack(w[k]), twid((float)(t0 + k) * (1.0f / (float)NFFT))); }
        __syncthreads();
        fft_conv(buf, tid, SB); }
        const int X = o + 1; const float q0 = HY_CW(X, 0), q1 = HY_CW(X, 1), q2 = HY_CW(X, 2), qb = HY_CB(X);
        { OPQ();
        v4u wyv[8], wzv[8]; v2u ra[8], rb[8]; bf16 la[8], ha[8], lb[8], hb_[8];
#pragma unroll
        for (int g = 0; g < 8; ++g) { const int t0 = 2048 * g + 4 * tid; wyv[g] = SA[512 * g]; wzv[g] = SZ[512 * g];
            HY_RAW(HYT + ((size_t)(0 * 1536 + X * 512 + c)) * L, t0, ra[g], la[g], ha[g]); HY_RAW(HYT + ((size_t)(1 * 1536 + X * 512 + c)) * L, t0, rb[g], lb[g], hb_[g]); }
#pragma unroll
        for (int g = 0; g < 8; ++g) { const int t0 = 2048 * g + 4 * tid, p = cidx(t0); const v4u wy = wyv[g], wz = wzv[g];
            float ga[4], gb[4]; HY_CALC(ga, ra[g], la[g], ha[g], t0, q0, q1, q2, qb); HY_CALC(gb, rb[g], lb[g], hb_[g], t0, q0, q1, q2, qb);
            float oa[4], ob[4];
#pragma unroll
            for (int k = 0; k < 4; ++k) { const f32x2 yo = cmulc(buf[p + k], twid((float)(t0 + k) * (1.0f / (float)NFFT)));
                const f32x2 yev = cunpack(wy[k]), z = cunpack(wz[k]);
                float y0 = yev.x + yo.x * (1.0f / (float)NFFT) + bias * z.x, y1 = yev.y + yo.y * (1.0f / (float)NFFT) + bias * z.y;
                if (ABL & 16) { y0 = bias * z.x; y1 = bias * z.y; }
                oa[k] = ga[k] * y0; ob[k] = gb[k] * y1; }
            if (g == 3) asm volatile("" ::: "memory");
            if (o == 0) SZ[512 * g] = (v4u){pk2(oa[0], ob[0]), pk2(oa[1], ob[1]), pk2(oa[2], ob[2]), pk2(oa[3], ob[3])};
            else { *(GAS v2u*)(YT + ((size_t)(0 * 512 + c)) * L + t0) = (v2u){pk2(oa[0], oa[1]), pk2(oa[2], oa[3])}; *(GAS v2u*)(YT + ((size_t)(1 * 512 + c)) * L + t0) = (v2u){pk2(ob[0], ob[1]), pk2(ob[2], ob[3])}; } } }
        __syncthreads();
    }
    if (with_ctx) {
        OPQ(); OPQC();
        const float v0 = HY_CW(0, 0), v1 = HY_CW(0, 1), v2 = HY_CW(0, 2), vb = HY_CB(0);
        LAS float* F = (LAS float*)C.lds;
        LAS float* Z = F + 1024;
        const float* H2C = (const float*)(ws + WS_H2C) + (size_t)l * 64 * CTX_LEN;
        const int b = tid >> 8, t = tid & 255;
        __syncthreads();
        {
            const int o = b; float f0 = 0.f, f1 = 0.f;
            for (int j = 0; j < 64; ++j) { const float h = H2C[j * CTX_LEN + t]; f0 += h * sW[(o * 2 + 0) * 64 + j]; f1 += h * sW[(o * 2 + 1) * 64 + j]; }
            const float decay = fabsf(A.hy_decay[((size_t)l * 2 + o) * 512 + c]);
            const float win = __expf(-((float)t * (1.0f / (float)(CTX_LEN - 1))) * decay); f0 *= win; f1 *= win;
            float s = wave_sum_t(fabsf(f0) + fabsf(f1), tid);
            __syncthreads();
            if (C.lane == 0) red[C.wave] = s;
            __syncthreads();
            const int w0 = (C.wave >> 2) * 4; const float tot = red[w0] + red[w0 + 1] + red[w0 + 2] + red[w0 + 3];
            F[(o * 2 + 0) * 256 + t] = f0 / tot; F[(o * 2 + 1) * 256 + t] = f1 / tot;
        }
        float z = conv3_at(HYTC + ((size_t)(b * 1536 + c)) * CTX_LEN, t, CTX_LEN, v0, v1, v2, vb);
#pragma unroll 1
        for (int o = 0; o < 2; ++o) {
            const float bias = A.hy_bias[((size_t)l * 2 + o) * 512 + c];
            __syncthreads();
            Z[b * 256 + t] = z;
            __syncthreads();
            float y = 0.f; const LAS float* hfp = F + (o * 2 + 0) * 256; const LAS float* hbp = F + (o * 2 + 1) * 256; const LAS float* zp = Z + b * 256;
            for (int s = 0; s <= t; ++s) y += hfp[t - s] * zp[s];
            for (int s = t + 1; s < 256; ++s) y += hbp[s - t] * zp[s];
            y += bias * z;
            const int X = o + 1; const float q0 = HY_CW(X, 0), q1 = HY_CW(X, 1), q2 = HY_CW(X, 2), qb = HY_CB(X);
            const float g = conv3_at(HYTC + ((size_t)(b * 1536 + X * 512 + c)) * CTX_LEN, t, CTX_LEN, q0, q1, q2, qb);
            z = g * y;
        }
        YT[(size_t)BATCH * 512 * L + ((size_t)(b * 512 + c)) * CTX_LEN + t] = (bf16)f2bf(z);
        __syncthreads();
    }
}
#undef OPQ
#undef OPQC
#undef SZ
#undef SA
#undef SB
#undef SF
#undef HY_CONV4
#undef HY_RAW
#undef HY_CALC
#undef HY_CW
#undef HY_CB
}

#ifdef SELFCHECK
namespace chk {
constexpr size_t WS_DBG = 504 * MiB;
constexpr int NCHK = 24;
__device__ __forceinline__ unsigned hsh(unsigned x) { x ^= x >> 16; x *= 0x7feb352dU; x ^= x >> 15; x *= 0x846ca68bU; x ^= x >> 16; return x; }
__device__ __forceinline__ void acc_err(unsigned char* ws, int id, float got, float ref) {
    float* a = (float*)(ws + WS_DBG) + id * 2; const float d = got - ref;
    atomicAdd(a, d * d); atomicAdd(a + 1, ref * ref);
}
__device__ __forceinline__ float dot_bf_f32col(const bf16* arow, const float* W, int K, int N, int col, int lane) {
    float s = 0.f; for (int k = lane; k < K; k += 64) s += bf1(arow[k]) * W[(size_t)k * N + col]; return wave_sum(s);
}
__device__ __forceinline__ void c_norm(const Args& A, const Ctx& C, const float* xlat, const float* xctx, const float* g, const float* mod, int shi, const bf16* XN, int id) {
    const int gw = C.vcu * NWAVES + C.wave;
    if (gw < 96) { const int r = (gw < 64) ? (int)(hsh(gw * 7 + 1) % ML) : ML + (int)(hsh(gw) % MC);
        const float* xr = r < ML ? xlat + (size_t)r * 1024 : xctx + (size_t)(r - ML) * 1024; const float* mp = mod + (r < ML ? (r >> 14) : 2) * 6144 + shi * 1024;
        float s = 0.f; for (int k = C.lane; k < 1024; k += 64) s += xr[k] * xr[k]; s = wave_sum(s); const float rstd = 1.0f / sqrtf(s / 1024.f + EPS);
        for (int k = C.lane; k < 1024; k += 64) acc_err(A.ws, id, bf1(XN[(size_t)r * 1024 + k]), xr[k] * rstd * g[k] * (1.f + mp[1024 + k]) + mp[k]); }
}
__device__ __forceinline__ void c_mod(const Args& A, const Ctx& C, int id) {
    const int gw = C.vcu * NWAVES + C.wave;
    if (gw < 128) { const int l = gw & 1, w = (gw >> 1) % 3, n = (int)(hsh(gw + 77) % 6144);
        float s = 0.f; for (int k = C.lane; k < 1024; k += 64) { const float cv = (w < 2) ? A.c[w * 1024 + k] : A.c_ctx[k]; s += (cv / (1.f + expf(-cv))) * A.w_mod[((size_t)l * 1024 + k) * 6144 + n]; }
        s = wave_sum(s) + A.b_mod[l * 6144 + n];
        if (C.lane == 0) acc_err(A.ws, id, ((const float*)(A.ws + WS_MOD))[(l * 3 + w) * 6144 + n], s); }
}
__device__ __forceinline__ void c_proj(const Args& A, const Ctx& C, int l, int id0) {
    const int gw = C.vcu * NWAVES + C.wave, lane = C.lane; unsigned char* ws = A.ws;
    const bf16* XN = (const bf16*)(ws + WS_XN); const float* W = A.w_in + (size_t)l * 1024 * IN_W;
    const unsigned h0 = hsh(gw * 31 + 5);
    const int r = (gw & 7) == 7 ? ML + (int)(h0 % MC) : (int)(h0 % ML);
    const bf16* xr = XN + (size_t)r * 1024;
    const bool latent = r < ML; const int t = r & 16383;
    const int kvrow = latent ? ((r >> 14) * KVL + 256 + t) : (((r - ML) >> 8) * KVL + ((r - ML) & 255));
    const int kind = (gw >> 3) % 6;
    if (kind == 0) { const int ch = (int)(hsh(h0) % 512); const float p = dot_bf_f32col(xr, W, 1024, IN_W, SC0 + ch, lane);
        if (lane == 0) acc_err(ws, id0 + 0, bf1(((const bf16*)(ws + WS_BG))[(size_t)r * 512 + ch]), p); }
    else if (kind == 1) { const int ch = (int)(hsh(h0) % 512); const float p1 = dot_bf_f32col(xr, W, 1024, IN_W, SC0 + 512 + ch, lane), p2 = dot_bf_f32col(xr, W, 1024, IN_W, SC0 + 1024 + ch, lane);
        if (lane == 0) acc_err(ws, id0 + 1, bf1(((const bf16*)(ws + WS_CX))[(size_t)r * 512 + ch]), p1 * p2); }
    else if (kind == 2) { const int d = (int)(hsh(h0) % 128); const float p = dot_bf_f32col(xr, W, 1024, IN_W, V0 + d, lane);
        if (lane == 0) acc_err(ws, id0 + 2, bf1(((const bf16*)(ws + WS_V))[(size_t)kvrow * 128 + d]), p); }
    else if (kind == 3) { const int ch = (int)(hsh(h0) % 1536); const float p = dot_bf_f32col(xr, W, 1024, IN_W, HY0 + ch, lane);
        const bf16* HY = latent ? (const bf16*)(ws + WS_R1) + ((size_t)((r >> 14) * 1536 + ch)) * SEQ + t : (const bf16*)(ws + WS_HYTC) + ((size_t)(((r - ML) >> 8) * 1536 + ch)) * CTX_LEN + ((r - ML) & 255);
        if (lane == 0) acc_err(ws, id0 + 3, bf1(*HY), p); }
    else {
        const bool isq = kind == 4; const int head = isq ? (int)(hsh(h0) % 8) : (int)(hsh(h0) % 2);
        const float* gain = (isq ? A.q_gain : A.k_gain) + l * 64;
        const float v = dot_bf_f32col(xr, W, 1024, IN_W, (isq ? Q0 : K0) + head * 64 + 0, lane);
        (void)v;
        float mine = 0.f;
        for (int d = 0; d < 64; ++d) { const float p = dot_bf_f32col(xr, W, 1024, IN_W, (isq ? Q0 : K0) + head * 64 + d, lane); if (lane == d) mine = p; }
        const float ss = wave_sum(mine * mine); float y = mine / sqrtf(ss / 64.f + EPS) * gain[lane];
        if (latent) { const int half = lane >> 5, dd = lane & 31, f = dd & 15; const bool second = dd >= 16;
            const float pos = (float)(half ? (t & 63) : (t >> 6)), ang = pos * powf(10000.f, -(float)f / 16.f);
            const float other = __shfl(y, lane ^ 16);
            y = second ? (y * cosf(ang) + other * sinf(ang)) : (y * cosf(ang) - other * sinf(ang)); }
        if (isq) y *= C2Q;
        const int bj = lane >> 5, n = (lane >> 4) & 1, fq = (lane >> 2) & 3, e = lane & 3, j = 32 * bj + 8 * fq + 4 * n + e;
        const float got = isq ? bf1(((const bf16*)(ws + WS_Q))[(size_t)r * 512 + head * 64 + j]) : bf1(((const bf16*)(ws + WS_K))[(size_t)kvrow * 128 + head * 64 + j]);
        acc_err(ws, id0 + (isq ? 4 : 5), got, y); }
}
__device__ __forceinline__ float hy_u(const Args& A, int l, int b, int X, int c, int t) {
    const bf16* P = (const bf16*)(A.ws + WS_R1) + ((size_t)(b * 1536 + X * 512 + c)) * SEQ;
    const float w0 = A.hy_conv_w[((size_t)l * 3 + 0) * 1536 + X * 512 + c], w1 = A.hy_conv_w[((size_t)l * 3 + 1) * 1536 + X * 512 + c], w2 = A.hy_conv_w[((size_t)l * 3 + 2) * 1536 + X * 512 + c];
    return w0 * (t > 0 ? bf1(P[t - 1]) : 0.f) + w1 * bf1(P[t]) + w2 * (t < SEQ - 1 ? bf1(P[t + 1]) : 0.f) + A.hy_conv_b[l * 1536 + X * 512 + c];
}
__device__ __forceinline__ void c_hy1(const Args& A, const Ctx& C, int l, int c) {
    float* F = (float*)(A.ws + WS_DBG + 65536); float* ABS = (float*)(A.ws + WS_DBG + 8192);
    const float* H2 = (const float*)(A.ws + WS_H2) + (size_t)l * 64 * SEQ;
    for (int i = C.vcu * NTHREADS + C.tid; i < 4 * SEQ; i += C.G * NTHREADS) { const int od = i >> 14, t = i & 16383, o = od >> 1;
        float s = 0.f; for (int j = 0; j < 64; ++j) s += H2[(size_t)j * SEQ + t] * A.hy_w3[((size_t)l * 64 + j) * 2048 + od * 512 + c];
        s *= expf(-((float)t / (float)(SEQ - 1)) * fabsf(A.hy_decay[((size_t)l * 2 + o) * 512 + c]));
        F[i] = s; atomicAdd(ABS + o, fabsf(s)); }
}
__device__ __forceinline__ float hy_conv(const float* hf, const float* hb, float inv, const float* z, int t, int lane) {
    float s = 0.f; for (int q = lane; q < SEQ; q += 64) s += (q <= t ? hf[t - q] : hb[q - t]) * z[q]; return wave_sum(s) * inv;
}
__device__ __forceinline__ void c_hy2(const Args& A, const Ctx& C, int l, int b, int c) {
    float* F = (float*)(A.ws + WS_DBG + 65536); float* ABS = (float*)(A.ws + WS_DBG + 8192); float* Z1 = F + 4 * SEQ; float* Z2 = Z1 + SEQ;
    for (int i = C.vcu * NTHREADS + C.tid; i < SEQ; i += C.G * NTHREADS) Z1[i] = hy_u(A, l, b, 0, c, i);
}
__device__ __forceinline__ void c_hy3(const Args& A, const Ctx& C, int l, int b, int c) {
    float* F = (float*)(A.ws + WS_DBG + 65536); float* ABS = (float*)(A.ws + WS_DBG + 8192); float* Z1 = F + 4 * SEQ; float* Z2 = Z1 + SEQ;
    const int gw = C.vcu * NWAVES + C.wave, NGW = C.G * NWAVES; const float inv = 1.0f / ABS[0], b1 = A.hy_bias[((size_t)l * 2 + 0) * 512 + c];
    for (int s = gw; s < SEQ; s += NGW) { const float cv = hy_conv(F, F + SEQ, inv, Z1, s, C.lane); if (C.lane == 0) Z2[s] = hy_u(A, l, b, 1, c, s) * (cv + b1 * Z1[s]); }
}
__device__ __forceinline__ void c_hy4(const Args& A, const Ctx& C, int l, int b, int c, int id) {
    float* F = (float*)(A.ws + WS_DBG + 65536); float* ABS = (float*)(A.ws + WS_DBG + 8192); float* Z1 = F + 4 * SEQ; float* Z2 = Z1 + SEQ;
    const int gw = C.vcu * NWAVES + C.wave; const float inv = 1.0f / ABS[1], b2 = A.hy_bias[((size_t)l * 2 + 1) * 512 + c];
    if (gw < 256) { const int t = (gw < 4) ? (gw & 1 ? SEQ - 1 - (gw >> 1) : (gw >> 1)) : (int)(hsh(gw * 13 + 3) % SEQ);
        const float cv = hy_conv(F + 2 * SEQ, F + 3 * SEQ, inv, Z2, t, C.lane);
        const float y = hy_u(A, l, b, 2, c, t) * (cv + b2 * Z2[t]);
        if (C.lane == 0) acc_err(A.ws, id, bf1(((const bf16*)(A.ws + WS_YHYT))[((size_t)(b * 512 + c)) * SEQ + t]), y); }
}
__device__ __forceinline__ void c_ysc(const Args& A, const Ctx& C, int l, int id) {
    const int gw = C.vcu * NWAVES + C.wave, lane = C.lane; unsigned char* ws = A.ws;
    if (gw >= 256) return;
    const bf16* XN = (const bf16*)(ws + WS_XN); const float* W = A.w_in + (size_t)l * 1024 * IN_W;
    const unsigned h0 = hsh(gw * 17 + 9); int r = (int)(h0 % ML); if (gw < 4) r = (gw & 1) ? SEQ - 1 + (gw >> 1) : (gw >> 1) * SEQ;
    const int ch = (int)(hsh(h0) % 512), t = r & 16383;
    float cv = 0.f;
    for (int k = -1; k <= 1; ++k) { const int tt = t + k; if (tt < 0 || tt >= SEQ) continue; const bf16* xr = XN + (size_t)(r + k) * 1024;
        cv += A.sc_conv_w[((size_t)l * 3 + (k + 1)) * 512 + ch] * dot_bf_f32col(xr, W, 1024, IN_W, SC0 + 512 + ch, lane) * dot_bf_f32col(xr, W, 1024, IN_W, SC0 + 1024 + ch, lane); }
    const float bg = dot_bf_f32col(XN + (size_t)r * 1024, W, 1024, IN_W, SC0 + ch, lane);
    if (lane == 0) acc_err(ws, id, bf1(((const bf16*)(ws + WS_BG))[(size_t)r * 512 + ch]), bg * cv);
}
__device__ __forceinline__ void c_att_sample(int i, int& r, int& h) { const unsigned hh = hsh(i * 101 + 7); r = (i < 16) ? ML + (int)(hh % MC) : (int)(hh % ML); h = (int)(hsh(hh) % 8); }
__device__ __forceinline__ void c_att_save(const Args& A, const Ctx& C) {
    const int gw = C.vcu * NWAVES + C.wave; float* QS = (float*)(A.ws + WS_DBG + 1 * MiB);
    if (gw < 256) { int r, h; c_att_sample(gw, r, h); QS[gw * 64 + C.lane] = bf1(((const bf16*)(A.ws + WS_Q))[(size_t)r * 512 + h * 64 + C.lane]); }
}
__device__ __forceinline__ void c_att(const Args& A, const Ctx& C, int id) {
    const int gw = C.vcu * NWAVES + C.wave, lane = C.lane; const float* QS = (const float*)(A.ws + WS_DBG + 1 * MiB);
    if (gw >= 256) return;
    int r, h; c_att_sample(gw, r, h);
    const bool latent = r < ML; const int b = latent ? (r >> 14) : ((r - ML) >> 8); const int nk = latent ? KVL : CTX_LEN;
    const bf16* Kp = (const bf16*)(A.ws + WS_K) + (size_t)b * KVL * 128 + (h >> 2) * 64; const bf16* Vp = (const bf16*)(A.ws + WS_V) + (size_t)b * KVL * 128 + (h >> 2) * 64;
    const float q = QS[gw * 64 + lane];
    float m = -INFINITY, lsum = 0.f, o = 0.f;
    for (int k = 0; k < nk; ++k) { const float s = wave_sum(q * bf1(Kp[(size_t)k * 128 + lane]));
        const float mn = fmaxf(m, s), f = exp2f(m - mn), p = exp2f(s - mn); lsum = lsum * f + p; o = o * f + p * bf1(Vp[(size_t)k * 128 + lane]); m = mn; }
    acc_err(A.ws, id, bf1(((const bf16*)(A.ws + WS_Q))[(size_t)r * 512 + h * 64 + lane]), o / lsum);
}
__device__ __forceinline__ void c_gate(const Args& A, const Ctx& C, int l, int rowbase, int nr, int id) {
    const int gw = C.vcu * NWAVES + C.wave; if (gw >= 256) return;
    const unsigned h0 = hsh(gw * 23 + 11); const int rr = (int)(h0 % nr), col = (int)(hsh(h0) % 3072);
    const float p = dot_bf_f32col((const bf16*)(A.ws + WS_XN) + (size_t)(rowbase + rr) * 1024, A.w_in + (size_t)l * 1024 * IN_W, 1024, IN_W, GT0 + col, C.lane);
    if (C.lane == 0) { const float got = bf1(((const bf16*)(A.ws + WS_R1))[(size_t)rr * 3072 + col]), ref = 1.f / (1.f + expf(-p)); acc_err(A.ws, id, got, ref); }
}
__device__ __forceinline__ void c_wcopy(const Args& A, const Ctx& C, int l) {
    const int gw = C.vcu * NWAVES + C.wave; if (gw >= 512) return;
    const unsigned h0 = hsh(gw * 59 + 21); const bool hi = gw & 1; const int row = hi ? 3840 + (int)(h0 % 3072) : 2304 + (int)(h0 % 1536);
    const bf16* WT = (const bf16*)(A.ws + WS_WIN) + ((size_t)l * IN_W + row) * 1024;
    for (int k = C.lane; k < 1024; k += 64) acc_err(A.ws, hi ? 19 : 18, bf1(WT[k]), A.w_in[((size_t)l * 1024 + k) * IN_W + row]);
}
__device__ __forceinline__ void c_merge(const Args& A, const Ctx& C, int l, int rowbase, int nr, int id) {
    const int gw = C.vcu * NWAVES + C.wave; if (gw >= 256) return;
    const unsigned h0 = hsh(gw * 29 + 13); const int rr = (int)(h0 % nr), r = rowbase + rr, col = (int)(hsh(h0) % 1024);
    const bf16* G = (const bf16*)(A.ws + WS_R1) + (size_t)rr * 3072;
    const float a = dot_bf_f32col((const bf16*)(A.ws + WS_Q) + (size_t)r * 512, A.w_br_att + (size_t)l * 512 * 1024, 512, 1024, col, C.lane);
    const float s = dot_bf_f32col((const bf16*)(A.ws + WS_BG) + (size_t)r * 512, A.w_br_sc + (size_t)l * 512 * 1024, 512, 1024, col, C.lane);
    const float y = dot_bf_f32col((const bf16*)(A.ws + WS_YHY) + (size_t)r * 512, A.w_br_hy + (size_t)l * 512 * 1024, 512, 1024, col, C.lane);
    if (C.lane == 0) acc_err(A.ws, id, bf1(((const bf16*)(A.ws + WS_MM))[(size_t)r * 1024 + col]), bf1(G[col]) * a + bf1(G[1024 + col]) * s + bf1(G[2048 + col]) * y);
}
__device__ __forceinline__ void c_yhyT(const Args& A, const Ctx& C, int id) {
    const int gw = C.vcu * NWAVES + C.wave; if (gw >= 64) return;
    const unsigned h0 = hsh(gw * 37 + 1); const int r = (gw < 8) ? ML + (int)(h0 % MC) : (int)(h0 % ML), c = (int)(hsh(h0) % 512);
    const bf16* YT = (const bf16*)(A.ws + WS_YHYT);
    const float ref = r < ML ? bf1(YT[((size_t)((r >> 14) * 512 + c)) * SEQ + (r & 16383)]) : bf1(YT[(size_t)BATCH * 512 * SEQ + ((size_t)(((r - ML) >> 8) * 512 + c)) * CTX_LEN + ((r - ML) & 255)]);
    if (C.lane == 0) acc_err(A.ws, id, bf1(((const bf16*)(A.ws + WS_YHY))[(size_t)r * 512 + c]), ref);
}
__device__ __forceinline__ void c_wout(const Args& A, const Ctx& C, int l, int id) {
    const int gw = C.vcu * NWAVES + C.wave; if (gw >= 256) return;
    const unsigned h0 = hsh(gw * 41 + 3); const int r = (gw < 16) ? ML + (int)(h0 % MC) : (int)(h0 % ML), col = (int)(hsh(h0) % 1024);
    const float d = dot_bf_f32col((const bf16*)(A.ws + WS_MM) + (size_t)r * 1024, A.w_out + (size_t)l * 1024 * 1024, 1024, 1024, col, C.lane);
    const float* mod = (const float*)(A.ws + WS_MOD) + (size_t)l * 3 * 6144;
    const float xo = r < ML ? A.x[(size_t)r * 1024 + col] : A.ctx[(size_t)(r - ML) * 1024 + col], gt = mod[(r < ML ? (r >> 14) : 2) * 6144 + 2 * 1024 + col];
    const float got = r < ML ? A.out[(size_t)r * 1024 + col] : ((const float*)(A.ws + WS_CTXB))[(size_t)(r - ML) * 1024 + col];
    if (C.lane == 0) acc_err(A.ws, id, got, xo + gt * d);
}
__device__ __forceinline__ void c_scores(const Args& A, const Ctx& C, int l, int row0, int nr, int id) {
    const int gw = C.vcu * NWAVES + C.wave, lane = C.lane; if (gw >= 128) return;
    const unsigned h0 = hsh(gw * 43 + 5); const int rr = (int)(h0 % nr), hp = (int)(hsh(h0) % 16), n = (int)(hsh(h0 + 1) % 128);
    const bf16* xr = (const bf16*)(A.ws + WS_XN) + (size_t)(row0 + rr) * 1024;
    float qd = 0.f; for (int d = 0; d < 64; ++d) { const float q = dot_bf_f32col(xr, A.peer_wq + (size_t)l * 1024 * 1024, 1024, 1024, hp * 64 + d, lane); if (lane == d) qd = q; }
    const float s = wave_sum(qd * A.peer_subkeys[(((size_t)l * 16 + hp) * 128 + n) * 64 + lane]);
    if (lane == 0) acc_err(A.ws, id, ((const float*)(A.ws + WS_R1))[(size_t)rr * 2048 + hp * 128 + n], s);
}
__device__ __forceinline__ int c_peer_row(int i, int nr) { return (int)(hsh(i * 53 + 17) % nr); }
__device__ __forceinline__ void c_peer_save(const Args& A, const Ctx& C, int row0, int nr) {
    const int gw = C.vcu * NWAVES + C.wave; if (gw >= 64) return; const int r = row0 + c_peer_row(gw, nr);
    float* XS = (float*)(A.ws + WS_DBG + 2 * MiB); for (int k = C.lane; k < 1024; k += 64) XS[gw * 1024 + k] = A.out[(size_t)r * 1024 + k];
}
__device__ __forceinline__ void c_peer(const Args& A, const Ctx& C, int l, int row0, int nr, int id) {
    const int gw = C.vcu * NWAVES + C.wave, lane = C.lane; if (gw >= 64) return;
    const int rr = c_peer_row(gw, nr), r = row0 + rr; const float* S = (const float*)(A.ws + WS_R1) + (size_t)rr * 2048; const float* XS = (const float*)(A.ws + WS_DBG + 2 * MiB) + gw * 1024;
    const bf16* xr = (const bf16*)(A.ws + WS_XN) + (size_t)r * 1024;
    float f[16];
#pragma unroll
    for (int i = 0; i < 16; ++i) f[i] = 0.f;
    for (int h = 0; h < 8; ++h) {
        const float* s1 = S + h * 256; const float* s2 = s1 + 128;
        int r1a = 0, r1b = 0, r2a = 0, r2b = 0; const float a1 = s1[lane], b1 = s1[lane + 64], a2 = s2[lane], b2 = s2[lane + 64];
        for (int k = 0; k < 128; ++k) { const float u = s1[k], v = s2[k]; r1a += (u > a1) || (u == a1 && k < lane); r1b += (u > b1) || (u == b1 && k < lane + 64); r2a += (v > a2) || (v == a2 && k < lane); r2b += (v > b2) || (v == b2 && k < lane + 64); }
        float t1 = 0.f, t2 = 0.f; int i1 = 0, i2 = 0;
        for (int k = 0; k < 16; ++k) {
            const unsigned long long ma = __ballot(r1a == k), mb = __ballot(r1b == k);
            const float v1 = ma ? __shfl(a1, __builtin_ctzll(ma)) : __shfl(b1, __builtin_ctzll(mb)); const int j1 = ma ? __builtin_ctzll(ma) : 64 + __builtin_ctzll(mb);
            const unsigned long long na = __ballot(r2a == k), nb = __ballot(r2b == k);
            const float v2 = na ? __shfl(a2, __builtin_ctzll(na)) : __shfl(b2, __builtin_ctzll(nb)); const int j2 = na ? __builtin_ctzll(na) : 64 + __builtin_ctzll(nb);
            if (lane == k) { t1 = v1; i1 = j1; t2 = v2; i2 = j2; } }
        float cv[4]; int rk[4];
#pragma unroll
        for (int q = 0; q < 4; ++q) { const int c = lane * 4 + q; cv[q] = __shfl(t1, c >> 4) + __shfl(t2, c & 15); rk[q] = 0; }
        for (int c2 = 0; c2 < 256; ++c2) { const float o = __shfl(t1, c2 >> 4) + __shfl(t2, c2 & 15);
#pragma unroll
            for (int q = 0; q < 4; ++q) { const int c = lane * 4 + q; rk[q] += (o > cv[q]) || (o == cv[q] && c2 < c); } }
        float mx = -INFINITY;
#pragma unroll
        for (int q = 0; q < 4; ++q) if (rk[q] < 16) mx = fmaxf(mx, cv[q]);
        mx = wave_max(mx);
        float den = 0.f;
#pragma unroll
        for (int q = 0; q < 4; ++q) if (rk[q] < 16) den += expf(cv[q] - mx);
        den = wave_sum(den);
        for (int c = 0; c < 256; ++c) { const int ow = c >> 2, q = c & 3;
            const int sel = __shfl((q == 0 ? rk[0] : q == 1 ? rk[1] : q == 2 ? rk[2] : rk[3]) < 16 ? 1 : 0, ow); if (!sel) continue;
            const float sc = __shfl(q == 0 ? cv[0] : q == 1 ? cv[1] : q == 2 ? cv[2] : cv[3], ow);
            const int e = __shfl(i1, c >> 4) * 128 + __shfl(i2, c & 15);
            const float* ur = A.peer_u + ((size_t)l * PEER_N + e) * 1024; const float* vr = A.peer_v + ((size_t)l * PEER_N + e) * 1024;
            float d = 0.f; for (int k = lane; k < 1024; k += 64) d += ur[k] * bf1(xr[k]); d = wave_sum(d);
            const float w = expf(sc - mx) / den * 0.5f * d * (1.f + erff(d * 0.7071067811865476f));
#pragma unroll
            for (int i = 0; i < 16; ++i) f[i] += w * vr[lane + 64 * i]; }
    }
    const float* mod = (const float*)(A.ws + WS_MOD) + (size_t)l * 3 * 6144 + (r >> 14) * 6144 + 5 * 1024;
#pragma unroll
    for (int i = 0; i < 16; ++i) { const int col = lane + 64 * i; acc_err(A.ws, id, A.out[(size_t)r * 1024 + col], XS[col] + mod[col] * f[i]); }
}
}
#endif

namespace peer {
__device__ __forceinline__ unsigned fkey(float f) { const unsigned b = __builtin_bit_cast(unsigned, f); return b ^ ((unsigned)((int)b >> 31) | 0x80000000u); }
__device__ __forceinline__ int mbcnt64(unsigned long long m) { return (int)__builtin_amdgcn_mbcnt_hi((unsigned)(m >> 32), __builtin_amdgcn_mbcnt_lo((unsigned)m, 0u)); }
__device__ __forceinline__ void compact2(unsigned k0, unsigned k1, unsigned T, float v0, float v1, int lane, LAS float* lv, LAS int* li) {
    const unsigned long long g0 = __ballot(k0 > T), g1 = __ballot(k1 > T), e0 = __ballot(k0 == T), e1 = __ballot(k1 == T);
    const int need = 16 - (__popcll(g0) + __popcll(g1));
    const bool s0 = (k0 > T) || ((k0 == T) && (mbcnt64(e0) < need));
    const bool s1 = (k1 > T) || ((k1 == T) && (__popcll(e0) + mbcnt64(e1) < need));
    const unsigned long long m0 = __ballot(s0), m1 = __ballot(s1);
    if (s0) { const int p = mbcnt64(m0); lv[p] = v0; li[p] = lane; }
    if (s1) { const int p = __popcll(m0) + mbcnt64(m1); lv[p] = v1; li[p] = lane + 64; }
}
__device__ __forceinline__ float gelu_erf(float v) { return 0.5f * v * (1.0f + erff(v * 0.7071067811865476f)); }

__device__ __forceinline__ float unkey(unsigned k) { const unsigned b = (k & 0x80000000u) ? (k ^ 0x80000000u) : ~k; return __builtin_bit_cast(float, b); }
__device__ __forceinline__ void cnt4(int (&n)[4], unsigned k0, unsigned k1, unsigned k2, unsigned k3, unsigned cc) {
    asm volatile("v_cmp_ge_u32_e64 s[92:93], %4, %8\n\t"
                 "v_cmp_ge_u32_e64 s[94:95], %5, %8\n\t"
                 "v_cmp_ge_u32_e64 s[96:97], %6, %8\n\t"
                 "v_cmp_ge_u32_e64 s[98:99], %7, %8\n\t"
                 "v_addc_co_u32_e64 %0, s[100:101], 0, %0, s[92:93]\n\t"
                 "v_addc_co_u32_e64 %1, s[100:101], 0, %1, s[94:95]\n\t"
                 "v_addc_co_u32_e64 %2, s[100:101], 0, %2, s[96:97]\n\t"
                 "v_addc_co_u32_e64 %3, s[100:101], 0, %3, s[98:99]"
                 : "+v"(n[0]), "+v"(n[1]), "+v"(n[2]), "+v"(n[3]) : "v"(k0), "v"(k1), "v"(k2), "v"(k3), "v"(cc)
                 : "s92", "s93", "s94", "s95", "s96", "s97", "s98", "s99", "s100", "s101");
}
#define CE2(v, x, y) { const unsigned hi_ = v[x] > v[y] ? v[x] : v[y], lo_ = v[x] > v[y] ? v[y] : v[x]; v[x] = hi_; v[y] = lo_; }
__device__ __forceinline__ void part_top16(const float* sp, unsigned (&run)[16]) {
#pragma unroll
    for (int g = 0; g < 8; ++g) {
        unsigned x[16];
#pragma unroll
        for (int i = 0; i < 16; ++i) x[i] = (fkey(sp[(g * 16 + i) * 64]) & 0xFFFFFF80u) | (unsigned)(g * 16 + i);
        CE2(x,0,1) CE2(x,2,3) CE2(x,0,2) CE2(x,1,3) CE2(x,1,2) CE2(x,4,5) CE2(x,6,7) CE2(x,4,6) CE2(x,5,7) CE2(x,5,6) CE2(x,0,4) CE2(x,2,6) CE2(x,2,4) CE2(x,1,5) CE2(x,3,7) CE2(x,3,5) CE2(x,1,2) CE2(x,3,4) CE2(x,5,6) CE2(x,8,9) CE2(x,10,11) CE2(x,8,10) CE2(x,9,11) CE2(x,9,10) CE2(x,12,13) CE2(x,14,15) CE2(x,12,14) CE2(x,13,15) CE2(x,13,14) CE2(x,8,12) CE2(x,10,14) CE2(x,10,12) CE2(x,9,13) CE2(x,11,15) CE2(x,11,13) CE2(x,9,10) CE2(x,11,12) CE2(x,13,14) CE2(x,0,8) CE2(x,4,12) CE2(x,4,8) CE2(x,2,10) CE2(x,6,14) CE2(x,6,10) CE2(x,2,4) CE2(x,6,8) CE2(x,10,12) CE2(x,1,9) CE2(x,5,13) CE2(x,5,9) CE2(x,3,11) CE2(x,7,15) CE2(x,7,11) CE2(x,3,5) CE2(x,7,9) CE2(x,11,13) CE2(x,1,2) CE2(x,3,4) CE2(x,5,6) CE2(x,7,8) CE2(x,9,10) CE2(x,11,12) CE2(x,13,14)
        if (g == 0) {
#pragma unroll
            for (int i = 0; i < 16; ++i) run[i] = x[i];
        } else {
#pragma unroll
            for (int i = 0; i < 16; ++i) run[i] = run[i] > x[15 - i] ? run[i] : x[15 - i];
            CE2(run,0,8) CE2(run,1,9) CE2(run,2,10) CE2(run,3,11) CE2(run,4,12) CE2(run,5,13) CE2(run,6,14) CE2(run,7,15) CE2(run,0,4) CE2(run,1,5) CE2(run,2,6) CE2(run,3,7) CE2(run,8,12) CE2(run,9,13) CE2(run,10,14) CE2(run,11,15) CE2(run,0,2) CE2(run,1,3) CE2(run,4,6) CE2(run,5,7) CE2(run,8,10) CE2(run,9,11) CE2(run,12,14) CE2(run,13,15) CE2(run,0,1) CE2(run,2,3) CE2(run,4,5) CE2(run,6,7) CE2(run,8,9) CE2(run,10,11) CE2(run,12,13) CE2(run,14,15)
        }
    }
}
__device__ __forceinline__ void route_tasks(const Ctx& C, const float* ST, int nt, int* EL, float* GL, const pg8::StaticOrder& SO) {
    const int lane = C.lane;
#pragma unroll 1
    for (int it = C.wave; ; it += NWAVES) {
        pg8::Unit un; if (!SO.next(it >> 2, un)) break;
        const int h = un.pm, tb = un.pn * 4 + (it & 3), t = tb * 64 + lane;
        float a[16], b[16]; int ai[16], bi[16];
        {   const float* sp = ST + ((size_t)tb * 2048 + h * 256) * 64 + lane;
            unsigned ra[16], rb[16];
            part_top16(sp, ra); part_top16(sp + 128 * 64, rb);
#pragma unroll
            for (int q = 0; q < 16; ++q) { a[q] = unkey(ra[q] & 0xFFFFFF80u); ai[q] = (int)(ra[q] & 127u); b[q] = unkey(rb[q] & 0xFFFFFF80u); bi[q] = (int)(rb[q] & 127u); } }
        float cs[64]; int ce[64];
        cs[0] = a[0] + b[0]; ce[0] = ai[0] * 128 + bi[0]; cs[1] = a[0] + b[1]; ce[1] = ai[0] * 128 + bi[1]; cs[2] = a[0] + b[2]; ce[2] = ai[0] * 128 + bi[2]; cs[3] = a[0] + b[3]; ce[3] = ai[0] * 128 + bi[3]; cs[4] = a[0] + b[4]; ce[4] = ai[0] * 128 + bi[4]; cs[5] = a[0] + b[5]; ce[5] = ai[0] * 128 + bi[5]; cs[6] = a[0] + b[6]; ce[6] = ai[0] * 128 + bi[6]; cs[7] = a[0] + b[7]; ce[7] = ai[0] * 128 + bi[7]; cs[8] = a[0] + b[8]; ce[8] = ai[0] * 128 + bi[8]; cs[9] = a[0] + b[9]; ce[9] = ai[0] * 128 + bi[9]; cs[10] = a[0] + b[10]; ce[10] = ai[0] * 128 + bi[10]; cs[11] = a[0] + b[11]; ce[11] = ai[0] * 128 + bi[11]; cs[12] = a[0] + b[12]; ce[12] = ai[0] * 128 + bi[12]; cs[13] = a[0] + b[13]; ce[13] = ai[0] * 128 + bi[13]; cs[14] = a[0] + b[14]; ce[14] = ai[0] * 128 + bi[14]; cs[15] = a[0] + b[15]; ce[15] = ai[0] * 128 + bi[15]; cs[16] = a[1] + b[0]; ce[16] = ai[1] * 128 + bi[0]; cs[17] = a[1] + b[1]; ce[17] = ai[1] * 128 + bi[1]; cs[18] = a[1] + b[2]; ce[18] = ai[1] * 128 + bi[2]; cs[19] = a[1] + b[3]; ce[19] = ai[1] * 128 + bi[3]; cs[20] = a[1] + b[4]; ce[20] = ai[1] * 128 + bi[4]; cs[21] = a[1] + b[5]; ce[21] = ai[1] * 128 + bi[5]; cs[22] = a[1] + b[6]; ce[22] = ai[1] * 128 + bi[6]; cs[23] = a[1] + b[7]; ce[23] = ai[1] * 128 + bi[7]; cs[24] = a[2] + b[0]; ce[24] = ai[2] * 128 + bi[0]; cs[25] = a[2] + b[1]; ce[25] = ai[2] * 128 + bi[1]; cs[26] = a[2] + b[2]; ce[26] = ai[2] * 128 + bi[2]; cs[27] = a[2] + b[3]; ce[27] = ai[2] * 128 + bi[3]; cs[28] = a[2] + b[4]; ce[28] = ai[2] * 128 + bi[4]; cs[29] = a[3] + b[0]; ce[29] = ai[3] * 128 + bi[0]; cs[30] = a[3] + b[1]; ce[30] = ai[3] * 128 + bi[1]; cs[31] = a[3] + b[2]; ce[31] = ai[3] * 128 + bi[2]; cs[32] = a[3] + b[3]; ce[32] = ai[3] * 128 + bi[3]; cs[33] = a[4] + b[0]; ce[33] = ai[4] * 128 + bi[0]; cs[34] = a[4] + b[1]; ce[34] = ai[4] * 128 + bi[1]; cs[35] = a[4] + b[2]; ce[35] = ai[4] * 128 + bi[2]; cs[36] = a[5] + b[0]; ce[36] = ai[5] * 128 + bi[0]; cs[37] = a[5] + b[1]; ce[37] = ai[5] * 128 + bi[1]; cs[38] = a[6] + b[0]; ce[38] = ai[6] * 128 + bi[0]; cs[39] = a[6] + b[1]; ce[39] = ai[6] * 128 + bi[1]; cs[40] = a[7] + b[0]; ce[40] = ai[7] * 128 + bi[0]; cs[41] = a[7] + b[1]; ce[41] = ai[7] * 128 + bi[1]; cs[42] = a[8] + b[0]; ce[42] = ai[8] * 128 + bi[0]; cs[43] = a[9] + b[0]; ce[43] = ai[9] * 128 + bi[0]; cs[44] = a[10] + b[0]; ce[44] = ai[10] * 128 + bi[0]; cs[45] = a[11] + b[0]; ce[45] = ai[11] * 128 + bi[0]; cs[46] = a[12] + b[0]; ce[46] = ai[12] * 128 + bi[0]; cs[47] = a[13] + b[0]; ce[47] = ai[13] * 128 + bi[0]; cs[48] = a[14] + b[0]; ce[48] = ai[14] * 128 + bi[0]; cs[49] = a[15] + b[0]; ce[49] = ai[15] * 128 + bi[0];
#pragma unroll
        for (int c = 50; c < 64; ++c) { cs[c] = -INFINITY; ce[c] = 0; }
#define CE3(k, pl, x, y) { const bool sw_ = k[x] < k[y]; const float k0_ = sw_ ? k[y] : k[x], k1_ = sw_ ? k[x] : k[y]; const int p0_ = sw_ ? pl[y] : pl[x], p1_ = sw_ ? pl[x] : pl[y]; k[x] = k0_; k[y] = k1_; pl[x] = p0_; pl[y] = p1_; }
        CE3(cs,ce,16,17) CE3(cs,ce,18,19) CE3(cs,ce,16,18) CE3(cs,ce,17,19) CE3(cs,ce,17,18) CE3(cs,ce,20,21) CE3(cs,ce,22,23) CE3(cs,ce,20,22) CE3(cs,ce,21,23) CE3(cs,ce,21,22) CE3(cs,ce,16,20) CE3(cs,ce,18,22) CE3(cs,ce,18,20) CE3(cs,ce,17,21) CE3(cs,ce,19,23) CE3(cs,ce,19,21) CE3(cs,ce,17,18) CE3(cs,ce,19,20) CE3(cs,ce,21,22) CE3(cs,ce,24,25) CE3(cs,ce,26,27) CE3(cs,ce,24,26) CE3(cs,ce,25,27) CE3(cs,ce,25,26) CE3(cs,ce,28,29) CE3(cs,ce,30,31) CE3(cs,ce,28,30) CE3(cs,ce,29,31) CE3(cs,ce,29,30) CE3(cs,ce,24,28) CE3(cs,ce,26,30) CE3(cs,ce,26,28) CE3(cs,ce,25,29) CE3(cs,ce,27,31) CE3(cs,ce,27,29) CE3(cs,ce,25,26) CE3(cs,ce,27,28) CE3(cs,ce,29,30) CE3(cs,ce,16,24) CE3(cs,ce,20,28) CE3(cs,ce,20,24) CE3(cs,ce,18,26) CE3(cs,ce,22,30) CE3(cs,ce,22,26) CE3(cs,ce,18,20) CE3(cs,ce,22,24) CE3(cs,ce,26,28) CE3(cs,ce,17,25) CE3(cs,ce,21,29) CE3(cs,ce,21,25) CE3(cs,ce,19,27) CE3(cs,ce,23,31) CE3(cs,ce,23,27) CE3(cs,ce,19,21) CE3(cs,ce,23,25) CE3(cs,ce,27,29) CE3(cs,ce,17,18) CE3(cs,ce,19,20) CE3(cs,ce,21,22) CE3(cs,ce,23,24) CE3(cs,ce,25,26) CE3(cs,ce,27,28) CE3(cs,ce,29,30)
        CE3(cs,ce,32,33) CE3(cs,ce,34,35) CE3(cs,ce,32,34) CE3(cs,ce,33,35) CE3(cs,ce,33,34) CE3(cs,ce,36,37) CE3(cs,ce,38,39) CE3(cs,ce,36,38) CE3(cs,ce,37,39) CE3(cs,ce,37,38) CE3(cs,ce,32,36) CE3(cs,ce,34,38) CE3(cs,ce,34,36) CE3(cs,ce,33,37) CE3(cs,ce,35,39) CE3(cs,ce,35,37) CE3(cs,ce,33,34) CE3(cs,ce,35,36) CE3(cs,ce,37,38) CE3(cs,ce,40,41) CE3(cs,ce,42,43) CE3(cs,ce,40,42) CE3(cs,ce,41,43) CE3(cs,ce,41,42) CE3(cs,ce,44,45) CE3(cs,ce,46,47) CE3(cs,ce,44,46) CE3(cs,ce,45,47) CE3(cs,ce,45,46) CE3(cs,ce,40,44) CE3(cs,ce,42,46) CE3(cs,ce,42,44) CE3(cs,ce,41,45) CE3(cs,ce,43,47) CE3(cs,ce,43,45) CE3(cs,ce,41,42) CE3(cs,ce,43,44) CE3(cs,ce,45,46) CE3(cs,ce,32,40) CE3(cs,ce,36,44) CE3(cs,ce,36,40) CE3(cs,ce,34,42) CE3(cs,ce,38,46) CE3(cs,ce,38,42) CE3(cs,ce,34,36) CE3(cs,ce,38,40) CE3(cs,ce,42,44) CE3(cs,ce,33,41) CE3(cs,ce,37,45) CE3(cs,ce,37,41) CE3(cs,ce,35,43) CE3(cs,ce,39,47) CE3(cs,ce,39,43) CE3(cs,ce,35,37) CE3(cs,ce,39,41) CE3(cs,ce,43,45) CE3(cs,ce,33,34) CE3(cs,ce,35,36) CE3(cs,ce,37,38) CE3(cs,ce,39,40) CE3(cs,ce,41,42) CE3(cs,ce,43,44) CE3(cs,ce,45,46)
        CE3(cs,ce,48,49) CE3(cs,ce,50,51) CE3(cs,ce,48,50) CE3(cs,ce,49,51) CE3(cs,ce,49,50) CE3(cs,ce,52,53) CE3(cs,ce,54,55) CE3(cs,ce,52,54) CE3(cs,ce,53,55) CE3(cs,ce,53,54) CE3(cs,ce,48,52) CE3(cs,ce,50,54) CE3(cs,ce,50,52) CE3(cs,ce,49,53) CE3(cs,ce,51,55) CE3(cs,ce,51,53) CE3(cs,ce,49,50) CE3(cs,ce,51,52) CE3(cs,ce,53,54) CE3(cs,ce,56,57) CE3(cs,ce,58,59) CE3(cs,ce,56,58) CE3(cs,ce,57,59) CE3(cs,ce,57,58) CE3(cs,ce,60,61) CE3(cs,ce,62,63) CE3(cs,ce,60,62) CE3(cs,ce,61,63) CE3(cs,ce,61,62) CE3(cs,ce,56,60) CE3(cs,ce,58,62) CE3(cs,ce,58,60) CE3(cs,ce,57,61) CE3(cs,ce,59,63) CE3(cs,ce,59,61) CE3(cs,ce,57,58) CE3(cs,ce,59,60) CE3(cs,ce,61,62) CE3(cs,ce,48,56) CE3(cs,ce,52,60) CE3(cs,ce,52,56) CE3(cs,ce,50,58) CE3(cs,ce,54,62) CE3(cs,ce,54,58) CE3(cs,ce,50,52) CE3(cs,ce,54,56) CE3(cs,ce,58,60) CE3(cs,ce,49,57) CE3(cs,ce,53,61) CE3(cs,ce,53,57) CE3(cs,ce,51,59) CE3(cs,ce,55,63) CE3(cs,ce,55,59) CE3(cs,ce,51,53) CE3(cs,ce,55,57) CE3(cs,ce,59,61) CE3(cs,ce,49,50) CE3(cs,ce,51,52) CE3(cs,ce,53,54) CE3(cs,ce,55,56) CE3(cs,ce,57,58) CE3(cs,ce,59,60) CE3(cs,ce,61,62)

#pragma unroll
        for (int i = 0; i < 16; ++i) { const bool sw_ = cs[i] < cs[16 + 15 - i]; cs[i] = sw_ ? cs[16 + 15 - i] : cs[i]; ce[i] = sw_ ? ce[16 + 15 - i] : ce[i]; }
        CE3(cs,ce,0,8) CE3(cs,ce,1,9) CE3(cs,ce,2,10) CE3(cs,ce,3,11) CE3(cs,ce,4,12) CE3(cs,ce,5,13) CE3(cs,ce,6,14) CE3(cs,ce,7,15) CE3(cs,ce,0,4) CE3(cs,ce,1,5) CE3(cs,ce,2,6) CE3(cs,ce,3,7) CE3(cs,ce,8,12) CE3(cs,ce,9,13) CE3(cs,ce,10,14) CE3(cs,ce,11,15) CE3(cs,ce,0,2) CE3(cs,ce,1,3) CE3(cs,ce,4,6) CE3(cs,ce,5,7) CE3(cs,ce,8,10) CE3(cs,ce,9,11) CE3(cs,ce,12,14) CE3(cs,ce,13,15) CE3(cs,ce,0,1) CE3(cs,ce,2,3) CE3(cs,ce,4,5) CE3(cs,ce,6,7) CE3(cs,ce,8,9) CE3(cs,ce,10,11) CE3(cs,ce,12,13) CE3(cs,ce,14,15)

#pragma unroll
        for (int i = 0; i < 16; ++i) { const bool sw_ = cs[i] < cs[32 + 15 - i]; cs[i] = sw_ ? cs[32 + 15 - i] : cs[i]; ce[i] = sw_ ? ce[32 + 15 - i] : ce[i]; }
        CE3(cs,ce,0,8) CE3(cs,ce,1,9) CE3(cs,ce,2,10) CE3(cs,ce,3,11) CE3(cs,ce,4,12) CE3(cs,ce,5,13) CE3(cs,ce,6,14) CE3(cs,ce,7,15) CE3(cs,ce,0,4) CE3(cs,ce,1,5) CE3(cs,ce,2,6) CE3(cs,ce,3,7) CE3(cs,ce,8,12) CE3(cs,ce,9,13) CE3(cs,ce,10,14) CE3(cs,ce,11,15) CE3(cs,ce,0,2) CE3(cs,ce,1,3) CE3(cs,ce,4,6) CE3(cs,ce,5,7) CE3(cs,ce,8,10) CE3(cs,ce,9,11) CE3(cs,ce,12,14) CE3(cs,ce,13,15) CE3(cs,ce,0,1) CE3(cs,ce,2,3) CE3(cs,ce,4,5) CE3(cs,ce,6,7) CE3(cs,ce,8,9) CE3(cs,ce,10,11) CE3(cs,ce,12,13) CE3(cs,ce,14,15)

#pragma unroll
        for (int i = 0; i < 16; ++i) { const bool sw_ = cs[i] < cs[48 + 15 - i]; cs[i] = sw_ ? cs[48 + 15 - i] : cs[i]; ce[i] = sw_ ? ce[48 + 15 - i] : ce[i]; }
        CE3(cs,ce,0,8) CE3(cs,ce,1,9) CE3(cs,ce,2,10) CE3(cs,ce,3,11) CE3(cs,ce,4,12) CE3(cs,ce,5,13) CE3(cs,ce,6,14) CE3(cs,ce,7,15) CE3(cs,ce,0,4) CE3(cs,ce,1,5) CE3(cs,ce,2,6) CE3(cs,ce,3,7) CE3(cs,ce,8,12) CE3(cs,ce,9,13) CE3(cs,ce,10,14) CE3(cs,ce,11,15) CE3(cs,ce,0,2) CE3(cs,ce,1,3) CE3(cs,ce,4,6) CE3(cs,ce,5,7) CE3(cs,ce,8,10) CE3(cs,ce,9,11) CE3(cs,ce,12,14) CE3(cs,ce,13,15) CE3(cs,ce,0,1) CE3(cs,ce,2,3) CE3(cs,ce,4,5) CE3(cs,ce,6,7) CE3(cs,ce,8,9) CE3(cs,ce,10,11) CE3(cs,ce,12,13) CE3(cs,ce,14,15)
#undef CE3
        {   float w[16]; float sm = 0.f;
#pragma unroll
            for (int k = 0; k < 16; ++k) { w[k] = __expf(cs[k] - cs[0]); sm += w[k]; }
            const float rs = 1.0f / sm; const size_t eo = (size_t)t * 128 + h * 16;
#pragma unroll
            for (int k = 0; k < 16; ++k) { EL[eo + k] = ce[k]; GL[eo + k] = w[k] * rs; } }
    }
}

__device__ __forceinline__ void route_tokens_wave(const Ctx& C, const float* ST, int nt, int* EL, float* GL) {
    const int gw = C.wave * C.G + C.vcu, NGW = C.G * NWAVES, lane = C.lane;
    constexpr int NH = 4;
    LAS float* slist = (LAS float*)(C.lds + C.wave * 16384);
    LAS float* l1v = (LAS float*)(C.lds + C.wave * 16384 + 512); LAS int* l1i = (LAS int*)(C.lds + C.wave * 16384 + 1024);
    LAS float* l2v = (LAS float*)(C.lds + C.wave * 16384 + 1536); LAS int* l2i = (LAS int*)(C.lds + C.wave * 16384 + 2048);
#pragma unroll 1
    for (int task = gw; task < nt * (8 / NH); task += NGW) {
        const int t = task / (8 / NH), hp = task % (8 / NH);
        const float* sp = ST + ((size_t)(t >> 6) * 2048 + hp * NH * 256 + lane) * 64 + (t & 63);
        float cv[4 * NH]; unsigned ck[4 * NH];
#pragma unroll
        for (int q = 0; q < 4 * NH; ++q) { cv[q] = sp[(size_t)q * 64 * 64]; ck[q] = fkey(cv[q]); }
        unsigned T[2 * NH]; bool fin[2 * NH];
#pragma unroll
        for (int c = 0; c < 2 * NH; ++c) { T[c] = 0u; fin[c] = false; }
#pragma unroll 1
        for (int bit = 31; bit >= 0; --bit) { bool all = true;
#pragma unroll
            for (int c = 0; c < 2 * NH; ++c) { const unsigned cc = T[c] | (1u << bit);
                const int n = __popcll(__ballot(ck[2 * c] >= cc)) + __popcll(__ballot(ck[2 * c + 1] >= cc));
                T[c] = (!fin[c] && n >= 16) ? cc : T[c]; fin[c] = fin[c] || (n == 16); all = all && fin[c]; }
            if (all) break; }
#pragma unroll
        for (int u = 0; u < NH; ++u) {
            compact2(ck[4 * u], ck[4 * u + 1], T[2 * u], cv[4 * u], cv[4 * u + 1], lane, l1v + 16 * u, l1i + 16 * u);
            compact2(ck[4 * u + 2], ck[4 * u + 3], T[2 * u + 1], cv[4 * u + 2], cv[4 * u + 3], lane, l2v + 16 * u, l2i + 16 * u); }
        LDS_WAIT(); asm volatile("" ::: "memory");
        const int ci = lane >> 2, cjb = (lane & 3) * 4;
        float cs[NH][4]; unsigned kc[NH][4]; int ce[NH][4];
#pragma unroll
        for (int u = 0; u < NH; ++u) { const float v1 = l1v[16 * u + ci]; const int e1 = l1i[16 * u + ci] * 128;
#pragma unroll
            for (int q = 0; q < 4; ++q) { cs[u][q] = v1 + l2v[16 * u + cjb + q]; kc[u][q] = fkey(cs[u][q]); ce[u][q] = e1 + l2i[16 * u + cjb + q]; } }
        unsigned Tc[NH]; bool finc[NH];
#pragma unroll
        for (int u = 0; u < NH; ++u) { Tc[u] = 0u; finc[u] = false; }
#pragma unroll 1
        for (int bit = 31; bit >= 0; --bit) { bool all = true;
#pragma unroll
            for (int u = 0; u < NH; ++u) { const unsigned cc = Tc[u] | (1u << bit);
                const int n = (__popcll(__ballot(kc[u][0] >= cc)) + __popcll(__ballot(kc[u][1] >= cc))) + (__popcll(__ballot(kc[u][2] >= cc)) + __popcll(__ballot(kc[u][3] >= cc)));
                Tc[u] = (!finc[u] && n >= 16) ? cc : Tc[u]; finc[u] = finc[u] || (n == 16); all = all && finc[u]; }
            if (all) break; }
#pragma unroll
        for (int u = 0; u < NH; ++u) {
            const int h = NH * hp + u;
            unsigned long long gq[4], eq[4];
#pragma unroll
            for (int q = 0; q < 4; ++q) { gq[q] = __ballot(kc[u][q] > Tc[u]); eq[q] = __ballot(kc[u][q] == Tc[u]); }
            const int need = 16 - ((__popcll(gq[0]) + __popcll(gq[1])) + (__popcll(gq[2]) + __popcll(gq[3])));
            int ebase = 0, mbase = 0;
#pragma unroll
            for (int q = 0; q < 4; ++q) { const bool sel = (kc[u][q] > Tc[u]) || ((kc[u][q] == Tc[u]) && (ebase + mbcnt64(eq[q]) < need)); ebase += __popcll(eq[q]);
                const unsigned long long mq = __ballot(sel); const int pos = mbase + mbcnt64(mq); mbase += __popcll(mq);
                if (sel) { slist[u * 16 + pos] = cs[u][q]; EL[(size_t)t * 128 + h * 16 + pos] = ce[u][q]; } }
        }
        LDS_WAIT(); asm volatile("" ::: "memory");
        {
            const int u = lane >> 4;
            float m = -INFINITY, sm = 0.f;
#pragma unroll
            for (int k = 0; k < 16; ++k) m = fmaxf(m, slist[u * 16 + k]);
#pragma unroll
            for (int k = 0; k < 16; ++k) sm += __expf(slist[u * 16 + k] - m);
            GL[(size_t)t * 128 + (NH * hp + u) * 16 + (lane & 15)] = __expf(slist[u * 16 + (lane & 15)] - m) / sm;
        }
        LDS_WAIT(); asm volatile("" ::: "memory");
    }
}

__device__ __forceinline__ void topk_gather(const Args& A, const Ctx& C, int l, int row0, int nrows, const int* EL, const float* GL, const unsigned char* U, const unsigned char* V, const float* US, const float* VS, const bf16* XN,
                                            float* xlat, float* xctx, const float* mod  , bool final_out, const float* gn, const float* nmod, bf16* XNw) {
    const int gw = C.wave * C.G + C.vcu, NGW = C.G * NWAVES, lane = C.lane, lp = lane & 31, half = lane >> 5, cl = 2 * lp + half;
    LAS int* elist = (LAS int*)(C.lds + C.wave * 16384);
    LAS float* glist = (LAS float*)(C.lds + C.wave * 16384 + 512);
    LAS float* clist = (LAS float*)(C.lds + C.wave * 16384 + 1024);
    LAS float* uslist = (LAS float*)(C.lds + C.wave * 16384 + 1536);
    LAS float* vslist = (LAS float*)(C.lds + C.wave * 16384 + 2048);
    int ne0 = 0, ne1 = 0; float ng0 = 0.f, ng1 = 0.f;
    if (gw < nrows) { ne0 = EL[(size_t)gw * 128 + lane]; ne1 = EL[(size_t)gw * 128 + 64 + lane]; ng0 = GL[(size_t)gw * 128 + lane]; ng1 = GL[(size_t)gw * 128 + 64 + lane]; }
    for (int rr = gw; rr < nrows; rr += NGW) {
        const int r = row0 + rr;
        elist[lane] = ne0; elist[64 + lane] = ne1; glist[lane] = ng0; glist[64 + lane] = ng1;
        const float us0 = US[ne0], us1 = US[ne1], vs0 = VS[ne0], vs1 = VS[ne1];
        { const int rn = rr + NGW; if (rn < nrows) { ne0 = EL[(size_t)rn * 128 + lane]; ne1 = EL[(size_t)rn * 128 + 64 + lane]; ng0 = GL[(size_t)rn * 128 + lane]; ng1 = GL[(size_t)rn * 128 + 64 + lane]; } }
        LDS_WAIT(); asm volatile("" ::: "memory");
        f32x2 acc[16];
#define GLOAD(T, bA, bB, xb) { _Pragma("unroll") for (int s = 0; s < 4; ++s) { const unsigned e = (unsigned)elist[(xb) + 2 * s + half]; const unsigned o = __umul24(e, 768u);        \
            bA[s] = *(const GAS v4u*)(T + (o + lo16)); bB[s] = *(const GAS v2u*)(T + (o + lo8)); } }
#define UCOMP(bA, bB, xb) { float p[4]; \
            _Pragma("unroll") for (int s = 0; s < 4; ++s) { \
                v6i w; w[0] = (int)bA[s].x; w[1] = (int)bA[s].y; w[2] = (int)bA[s].z; w[3] = (int)bA[s].w; w[4] = (int)bB[s].x; w[5] = (int)bB[s].y; \
                const v32f d = __builtin_amdgcn_cvt_scalef32_pk32_f32_fp6(w, 1.0f); \
                f32x2 sA = (f32x2){0.f, 0.f}, sB = (f32x2){0.f, 0.f}; \
                _Pragma("unroll") for (int i = 0; i < 8; ++i) { sA = __builtin_elementwise_fma((f32x2){d[4 * i], d[4 * i + 1]}, hf[2 * i], sA); sB = __builtin_elementwise_fma((f32x2){d[4 * i + 2], d[4 * i + 3]}, hf[2 * i + 1], sB); } \
                const f32x2 s2 = sA + sB; p[s] = (s2.x + s2.y) * uslist[(xb) + 2 * s + half]; } \
              \
            float q2[2]; \
            _Pragma("unroll") for (int j = 0; j < 2; ++j) q2[j] = (b4 ? p[j + 2] : p[j]) + __shfl_xor(b4 ? p[j] : p[j + 2], 16); \
            float sm = (b3 ? q2[1] : q2[0]) + __shfl_xor(b3 ? q2[0] : q2[1], 8); \
            sm += __shfl_xor(sm, 4); sm += __shfl_xor(sm, 2); sm += __shfl_xor(sm, 1); \
            const int ent = (xb) + 2 * (2 * (b4 ? 1 : 0) + (b3 ? 1 : 0)) + half; \
            const float cf = gelu_erf(sm) * glist[ent]; \
            if ((lane & 7) == 0) clist[ent] = cf; }
#define VCOMP(bA, bB, xb) { _Pragma("unroll") for (int s = 0; s < 4; ++s) { \
                v6i w; w[0] = (int)bA[s].x; w[1] = (int)bA[s].y; w[2] = (int)bA[s].z; w[3] = (int)bA[s].w; w[4] = (int)bB[s].x; w[5] = (int)bB[s].y; \
                const v32f d = __builtin_amdgcn_cvt_scalef32_pk32_f32_fp6(w, 1.0f); \
                const float c1_ = clist[(xb) + 2 * s + half] * vslist[(xb) + 2 * s + half]; const f32x2 c2 = (f32x2){c1_, c1_}; \
                _Pragma("unroll") for (int i = 0; i < 16; ++i) acc[i] = __builtin_elementwise_fma((f32x2){d[2 * i], d[2 * i + 1]}, c2, acc[i]); } }
        const bool b4 = (lane & 16) != 0, b3 = (lane & 8) != 0; const unsigned lo16 = 16u * (unsigned)lp, lo8 = 512u + 8u * (unsigned)lp;
#pragma unroll 1
        for (int rep2_ = 0; rep2_ < REP_GATHER; ++rep2_) {
        {
        f32x2 hf[16];
        { const GAS v4u* hp = (const GAS v4u*)(XN + (size_t)r * 1024 + 32 * lp);
#pragma unroll
          for (int q = 0; q < 4; ++q) { const v4u h4 = hp[q]; hf[4 * q] = (f32x2){bflo(h4.x), bfhi(h4.x)}; hf[4 * q + 1] = (f32x2){bflo(h4.y), bfhi(h4.y)}; hf[4 * q + 2] = (f32x2){bflo(h4.z), bfhi(h4.z)}; hf[4 * q + 3] = (f32x2){bflo(h4.w), bfhi(h4.w)}; } }
        v4u aA[4], bA[4], cA[4]; v2u aB[4], bB[4], cB[4];
        GLOAD(U, aA, aB, 0)
        GLOAD(U, bA, bB, 8)
        if (rep2_ == 0) { uslist[lane] = us0; uslist[64 + lane] = us1; vslist[lane] = vs0; vslist[64 + lane] = vs1; }
        LDS_WAIT(); asm volatile("" ::: "memory");
#pragma unroll 1
        for (int x0 = 0; x0 < 120; x0 += 24) {
            GLOAD(U, cA, cB, x0 + 16)
            UCOMP(aA, aB, x0)
            GLOAD(U, aA, aB, x0 + 24)
            UCOMP(bA, bB, x0 + 8)
            if (x0 + 32 < 128) GLOAD(U, bA, bB, x0 + 32)
            UCOMP(cA, cB, x0 + 16)
        }
        UCOMP(aA, aB, 120)
        }
        LDS_WAIT(); asm volatile("" ::: "memory");
#pragma unroll
        for (int i = 0; i < 16; ++i) acc[i] = (f32x2){0.f, 0.f};
        {
        v4u aA[4], bA[4], cA[4]; v2u aB[4], bB[4], cB[4];
        GLOAD(V, aA, aB, 0)
        GLOAD(V, bA, bB, 8)
#pragma unroll 1
        for (int x0 = 0; x0 < 120; x0 += 24) {
            GLOAD(V, cA, cB, x0 + 16)
            VCOMP(aA, aB, x0)
            GLOAD(V, aA, aB, x0 + 24)
            VCOMP(bA, bB, x0 + 8)
            if (x0 + 32 < 128) GLOAD(V, bA, bB, x0 + 32)
            VCOMP(cA, cB, x0 + 16)
        }
        VCOMP(aA, aB, 120)
        }
        asm volatile("" ::: "memory"); }
#undef GLOAD
#undef UCOMP
#undef VCOMP
        if (ABL & 8) {
#pragma unroll
            for (int i = 0; i < 16; ++i) acc[i] = (f32x2){0.f, 0.f}; }
        float tot[16];
#pragma unroll
        for (int i = 0; i < 16; ++i) { const float lo_ = acc[i >> 1][i & 1], hi_ = acc[8 + (i >> 1)][i & 1];
            tot[i] = (half ? hi_ : lo_) + __shfl_xor(half ? lo_ : hi_, 32); }
        const bool latent = r < ML;
        float* xr = latent ? xlat + (size_t)r * 1024 : xctx + (size_t)(r - ML) * 1024;
        const float* gp = mod + (latent ? (r >> 14) : 2) * 6144 + 5 * 1024;
        f32x4 xv[4]; float ss = 0.f;
#pragma unroll
        for (int k = 0; k < 4; ++k) { const int col = 16 * cl + 4 * k; const f32x4 xo = *(const GAS f32x4*)(xr + col), gt = *(const f32x4*)(gp + col);
            const f32x4 a4 = (f32x4){tot[4 * k], tot[4 * k + 1], tot[4 * k + 2], tot[4 * k + 3]};
            const f32x4 xn = xo + gt * a4; xv[k] = xn; ss += (xn.x * xn.x + xn.y * xn.y) + (xn.z * xn.z + xn.w * xn.w); }
        if (final_out) {
            const float rstd = 1.0f / sqrtf(wave_sum(ss) * (1.0f / 1024.0f) + EPS);
#pragma unroll
            for (int k = 0; k < 4; ++k) { const int col = 16 * cl + 4 * k; const f32x4 gf = *(const f32x4*)(A.g_final + col); *(GAS f32x4*)(xr + col) = xv[k] * rstd * gf; }
        } else {
#pragma unroll
            for (int k = 0; k < 4; ++k) { const int col = 16 * cl + 4 * k; *(GAS f32x4*)(xr + col) = xv[k]; }
            const float rstd = 1.0f / sqrtf(wave_sum(ss) * (1.0f / 1024.0f) + EPS);
            const float* mp = nmod + (latent ? (r >> 14) : 2) * 6144;
            v4u o[2];
#pragma unroll
            for (int k = 0; k < 4; ++k) { const int col = 16 * cl + 4 * k; const f32x4 g4 = *(const f32x4*)(gn + col), sh = *(const f32x4*)(mp + col), sc = *(const f32x4*)(mp + 1024 + col);
                const f32x4 y = xv[k] * rstd * g4 * (sc + 1.0f) + sh; o[k >> 1][(k & 1) * 2] = pk2(y.x, y.y); o[k >> 1][(k & 1) * 2 + 1] = pk2(y.z, y.w); }
            *(GAS v4u*)(XNw + (size_t)r * 1024 + 16 * cl) = o[0]; *(GAS v4u*)(XNw + (size_t)r * 1024 + 16 * cl + 8) = o[1];
        }
        LDS_WAIT(); asm volatile("" ::: "memory");
    }
}
}

#ifndef PHMASK
#define PHMASK 0xFFFF
#endif
#define PH(n) if constexpr (((PHMASK) >> (n)) & 1)
#ifndef ATT_THRL
#define ATT_THRL 4096
#endif
#ifndef NAIVE_G3
#define NAIVE_G3 0
#endif
#ifndef CHKSKIP
#define CHKSKIP ((1 << 12) | (1 << 20))
#endif
__global__ void __launch_bounds__(NTHREADS, 2) mega_fwd(Args A) {
    extern __shared__ __attribute__((aligned(16))) unsigned char lds_raw[];
    Ctx C;
    C.lds = (LAS unsigned char*)lds_raw;
    C.tid = threadIdx.x; C.lane = C.tid & 63; C.wave = __builtin_amdgcn_readfirstlane(C.tid >> 6);
    C.G = gridDim.x; { const int bx = blockIdx.x; C.vcu = (C.G % 8 == 0) ? (bx % 8) * (C.G / 8) + bx / 8 : bx; }
    volatile LAS unsigned* MISC = (volatile LAS unsigned*)(C.lds + MISC_OFF);
    for (int u = C.tid; u < (LDS_BYTES - LDSCTL_OFF) / 4; u += NTHREADS) ((LAS unsigned*)(C.lds + LDSCTL_OFF))[u] = 0u;
    __syncthreads();
    unsigned char* ws = A.ws;
    gu32* ctl = (gu32*)(ws + WS_CTL);
    (void)xcd_barrier_post((unsigned*)(ctl + CW_BAR), MISC + 8);
#ifdef PROBE_DEC
    { typedef int v6i_ __attribute__((ext_vector_type(6))); typedef float v32f_ __attribute__((ext_vector_type(32)));
      v6i_ w_; w_[0] = C.tid; w_[1] = C.tid * 3; w_[2] = C.tid * 5; w_[3] = C.tid * 7; w_[4] = C.tid * 11; w_[5] = C.tid * 13;
#pragma unroll 4
      for (int i_ = 0; i_ < PROBE_DEC; ++i_) { asm volatile("" : "+v"(w_)); const v32f_ r_ = __builtin_amdgcn_cvt_scalef32_pk32_f32_fp6(w_, 1.0f); asm volatile("" :: "v"(r_)); } }
#endif
#define GRID_BAR() do { unsigned char* w_ = A.ws; asm volatile("" : "+s"(w_)); XcdBarrier b_; b_.bar = (unsigned*)(w_ + WS_CTL) + CW_BAR; b_.x = xb_xcc_id(); b_.st = (volatile LAS unsigned*)(C.lds + MISC_OFF) + 8; xcd_barrier(b_); } while (0)
#ifdef SELFCHECK
#define CHK(stmt) do { if (l == 0) { PCTX(Cq); stmt; } GRID_BAR(); } while (0)
#else
#define CHK(stmt) do {} while (0)
#endif
#define PCTX(Cn) Ctx Cn; { const int t_ = opq_tid(); Cn.lds = C.lds; Cn.tid = t_; Cn.lane = t_ & 63; Cn.wave = __builtin_amdgcn_readfirstlane(t_ >> 6); Cn.G = C.G; Cn.vcu = C.vcu; }
    LAS unsigned char* ring = C.lds;

    bf16* XN = (bf16*)(ws + WS_XN); bf16* Qb = (bf16*)(ws + WS_Q); bf16* Kb = (bf16*)(ws + WS_K); bf16* Vb = (bf16*)(ws + WS_V);
    bf16* BG = (bf16*)(ws + WS_BG); bf16* CX = (bf16*)(ws + WS_CX); bf16* MM = (bf16*)(ws + WS_MM); bf16* YHY = (bf16*)(ws + WS_YHY);
    bf16* YHYT = (bf16*)(ws + WS_YHYT); bf16* HYT = (bf16*)(ws + WS_R1); bf16* HYTC = (bf16*)(ws + WS_HYTC); bf16* GG = (bf16*)(ws + WS_R1); float* SS = (float*)(ws + WS_R1);
    int* PEL = (int*)(ws + WS_PLIST); float* PGL = (float*)(ws + WS_PLIST + 8 * MiB);
    unsigned char* TU = ws + WS_TAB; unsigned char* TV = TU + (size_t)PEER_N * 768; float* TUS = (float*)(ws + WS_TAB + 32 * MiB); float* TVS = TUS + PEER_N;
    float* CTXB = (float*)(ws + WS_CTXB); const float* MOD = (const float*)(ws + WS_MOD);
    const float* ropec = (const float*)(ws + WS_ROPE); const float* ropes = ropec + 4096;

    PH(0) { PCTX(Cp); p0_prologue(A, Cp); }
#if PROBE_PRO
    __syncthreads();
    PH(0) { PCTX(Cp); p0_prologue(A, Cp); }
#endif
    GRID_BAR();

#pragma unroll 1
    for (int l = 0; l < DEPTH; ++l) {
        const bool need_ctx = (l < DEPTH - 1);
        const int MR = need_ctx ? MT : ML;
#define xold ((l == 0) ? A.x : (const float*)A.out)
#define cold ((l == 0) ? A.ctx : (const float*)CTXB)
#define WIN ((const bf16*)(ws + WS_WIN) + (size_t)l * IN_W * 1024)
#define MODl (MOD + (size_t)l * 3 * 6144)

        if (l == 0) { PH(1) { PCTX(Cp); norm_rows(Cp, xold, cold, MT, A.g_norm1 + l * 1024, MODl, 0, XN); }
        GRID_BAR(); }
        CHK(chk::c_norm(A, Cq, xold, cold, A.g_norm1 + l * 1024, MODl, 0, XN, 0); chk::c_mod(A, Cq, 1));

#pragma unroll 1
        for (int repg_ = 0; repg_ < REP_P2; ++repg_) {
        PH(2) {
            pg8::Gemm g{XN, WIN, MT, 2304, 1024}; pg8::StaticOrder S; S.init(MT, 2304, C.G, (int)blockIdx.x);
            pg8::EpiIn E{Qb, Kb, Vb, BG, CX, A.q_gain + l * 64, A.k_gain + l * 64, ropec, ropes};
            pg8::gemm_phase<pg8::EpiIn, pg8::StaticOrder, true, true>(ring, g, S, E);
        }
        PH(3) {
            pg8::Gemm g{WIN + (size_t)HY0 * 1024, XN, 1536, MR, 1024}; pg8::StaticOrder S; S.init(1536, MR, C.G, (int)blockIdx.x, (MT / 256) * 9);
            pg8::EpiHyT E{HYT, HYTC};
            pg8::gemm_phase<pg8::EpiHyT, pg8::StaticOrder, true, true>(ring, g, S, E);
        }
        }
        GRID_BAR();

        CHK(chk::c_proj(A, Cq, l, 2); chk::c_att_save(A, Cq); chk::c_hy1(A, Cq, l, 300); chk::c_hy2(A, Cq, l, 1, 300));
        CHK(chk::c_hy3(A, Cq, l, 1, 300));
        PH(4)
#pragma unroll 1
        for (int rep3_ = 0; rep3_ < REP_HY; ++rep3_)
        for (int c = C.vcu; c < HY_W; c += C.G) { PCTX(Cp); hy::hyena_unit(A, Cp, l, c, need_ctx); }
        __syncthreads();
        PH(5) { PCTX(Cp); ysc_pass(Cp, BG, CX, A.sc_conv_w + (size_t)l * 3 * 512, MR); }
        GRID_BAR();

        CHK(chk::c_ysc(A, Cq, l, 8); chk::c_hy4(A, Cq, l, 1, 300, 9));
        PH(5) { PCTX(Cp); yhy_transpose(Cp, YHYT, YHY, need_ctx); }
        __syncthreads();
        PH(6) {
#if PROBE_ATT
            for (int ug = C.vcu; ug < 1024; ug += C.G) {
                const int grp = (ug >> 6) & 3, rest = (ug & 63) | ((ug >> 8) << 6), b = grp >> 1, kvh = grp & 1, h = kvh * 4 + (rest & 3), qb = rest >> 2;
                const attn_body::bf16* Qu = (const attn_body::bf16*)(Qb + ((size_t)b * SEQ + (size_t)qb * 256) * 512 + h * 64);
                const attn_body::bf16* Kh = (const attn_body::bf16*)(Kb + (size_t)b * KVL * 128 + kvh * 64);
                const attn_body::bf16* Vh = (const attn_body::bf16*)(Vb + (size_t)b * KVL * 128 + kvh * 64);
                attn_body::attn_unit<ATT_THRL>(Qu, Kh, Vh, (attn_body::bf16*)(CX + ((size_t)b * SEQ + (size_t)qb * 256) * 512 + h * 64), KVL / 64, (char*)lds_raw);
            }
#endif
            for (int ug = C.vcu; ug < 1024; ug += C.G) {
                const int grp = (ug >> 6) & 3, rest = (ug & 63) | ((ug >> 8) << 6), b = grp >> 1, kvh = grp & 1, h = kvh * 4 + (rest & 3), qb = rest >> 2;
                const attn_body::bf16* Qu = (const attn_body::bf16*)(Qb + ((size_t)b * SEQ + (size_t)qb * 256) * 512 + h * 64);
                const attn_body::bf16* Kh = (const attn_body::bf16*)(Kb + (size_t)b * KVL * 128 + kvh * 64);
                const attn_body::bf16* Vh = (const attn_body::bf16*)(Vb + (size_t)b * KVL * 128 + kvh * 64);
                attn_body::attn_unit<ATT_THRL>(Qu, Kh, Vh, (attn_body::bf16*)Qu, KVL / 64, (char*)lds_raw);
            }
            if (need_ctx) for (int ug = C.vcu; ug < 16; ug += C.G) {
                const int b = ug >> 3, h = ug & 7;
                const attn_body::bf16* Qu = (const attn_body::bf16*)(Qb + ((size_t)ML + (size_t)b * CTX_LEN) * 512 + h * 64);
                const attn_body::bf16* Kh = (const attn_body::bf16*)(Kb + (size_t)b * KVL * 128 + (h >> 2) * 64);
                const attn_body::bf16* Vh = (const attn_body::bf16*)(Vb + (size_t)b * KVL * 128 + (h >> 2) * 64);
                attn_body::attn_unit<ATT_THRL>(Qu, Kh, Vh, (attn_body::bf16*)Qu, CTX_LEN / 64, (char*)lds_raw);
            }
        }
        GRID_BAR();

        CHK(chk::c_att(A, Cq, 10); chk::c_yhyT(A, Cq, 11));
        const bool packed_ctx = need_ctx && C.G == 256;
#pragma unroll 1
        for (int half = 0; half < (MR + 16383) / 16384; ++half) {
            const int rowbase = half * 16384, nr = (MR - rowbase) < 16384 ? (MR - rowbase) : 16384;
            if (nr == 16384) {
                PH(7) {
                    pg8::Gemm g{XN + (size_t)rowbase * 1024, WIN + (size_t)GT0 * 1024, nr, 3072, 1024}; pg8::GateOrder S; S.S.init(nr, 1024, C.G, (int)blockIdx.x);
                    pg8::EpiGate E{GG};
                    pg8::gemm_phase<pg8::EpiGate, pg8::GateOrder, true, true>(ring, g, S, E);
                }
                VM_WAIT(); __syncthreads();
                PH(8) {
                    pg8::Gemm g{Qb + (size_t)rowbase * 512, (const bf16*)(ws + WS_WBR) + (size_t)(l * 3) * 1024 * 512, nr, 1024, 512};
                    pg8::MergeOrder S; S.S.init(nr, 1024, C.G, (int)blockIdx.x); S.A0 = (const char*)(Qb + (size_t)rowbase * 512); S.d1 = (const char*)BG - (const char*)Qb; S.d2 = (const char*)YHY - (const char*)Qb;
                    pg8::EpiMerge3 E{GG, MM + (size_t)rowbase * 1024};
                    pg8::gemm_phase<pg8::EpiMerge3, pg8::MergeOrder, true, true>(ring, g, S, E);
                }
                VM_WAIT(); __syncthreads();
                if (rowbase + nr >= ML) GRID_BAR();
            } else if (!packed_ctx) {
                PH(7) {
                    pg8::Gemm g{XN + (size_t)rowbase * 1024, WIN + (size_t)GT0 * 1024, nr, 3072, 1024}; pg8::StaticOrder S; S.init(nr, 3072, C.G, (int)blockIdx.x);
                    pg8::EpiGate E{GG};
                    pg8::gemm_phase<pg8::EpiGate, pg8::StaticOrder, true, true>(ring, g, S, E);
                }
                PH(10) { const int nb_ = (nr / 256) * 12; if ((int)blockIdx.x >= nb_) { PCTX(Cp); cvt_table_fp6(Cp, A.peer_u + (size_t)l * PEER_N * 1024, TU, TUS, PEER_N, (int)blockIdx.x - nb_, C.G - nb_); } }
                GRID_BAR();
                PH(8) {
                    pg8::Gemm g{Qb + (size_t)rowbase * 512, (const bf16*)(ws + WS_WBR) + (size_t)(l * 3) * 1024 * 512, nr, 1024, 512};
                    pg8::MergeOrder S; S.S.init(nr, 1024, C.G, (int)blockIdx.x); S.A0 = (const char*)(Qb + (size_t)rowbase * 512); S.d1 = (const char*)BG - (const char*)Qb; S.d2 = (const char*)YHY - (const char*)Qb;
                    pg8::EpiMerge3 E{GG, MM + (size_t)rowbase * 1024};
                    pg8::gemm_phase<pg8::EpiMerge3, pg8::MergeOrder, true, true>(ring, g, S, E);
                }
                PH(10) { const int nb_ = (nr / 256) * 4; if ((int)blockIdx.x >= nb_) { PCTX(Cp); cvt_table_fp6(Cp, A.peer_v + (size_t)l * PEER_N * 1024, TV, TVS, PEER_N, (int)blockIdx.x - nb_, C.G - nb_); } }
                GRID_BAR();
            }
        }

        if (packed_ctx) {
            const int b = (int)blockIdx.x;
            const pg8::Gemm gP{MM, (const bf16*)(ws + WS_WOUT) + (size_t)l * 1024 * 1024, MR, 1024, 1024};
            const pg8::EpiResid EP{xold, A.out, cold, CTXB, MODl};
            const int rowbase = ML, nr = MR - ML;
            if (b < 24) PH(7) {
                pg8::Gemm g{XN + (size_t)rowbase * 1024, WIN + (size_t)GT0 * 1024, nr, 3072, 1024}; pg8::StaticOrder S; S.init(nr, 3072, C.G, b);
                pg8::EpiGate E{GG};
                pg8::gemm_phase<pg8::EpiGate, pg8::StaticOrder, true, true>(ring, g, S, E);
            }
            PH(9) { const int k = b - 24; pg8::OneUnit S{k >= 0 ? (k & 7) * 64 + (k >> 3) : -1, 4}; pg8::gemm_phase<pg8::EpiResid, pg8::OneUnit, true, true>(ring, gP, S, EP); }
            GRID_BAR();
            if (b < 8) PH(8) {
                pg8::Gemm g{Qb + (size_t)rowbase * 512, (const bf16*)(ws + WS_WBR) + (size_t)(l * 3) * 1024 * 512, nr, 1024, 512};
                pg8::MergeOrder S; S.S.init(nr, 1024, C.G, b); S.A0 = (const char*)(Qb + (size_t)rowbase * 512); S.d1 = (const char*)BG - (const char*)Qb; S.d2 = (const char*)YHY - (const char*)Qb;
                pg8::EpiMerge3 E{GG, MM + (size_t)rowbase * 1024};
                pg8::gemm_phase<pg8::EpiMerge3, pg8::MergeOrder, true, true>(ring, g, S, E);
            }
            PH(9) { const int k = b >= 8 ? 232 + (b - 8) : -1; pg8::OneUnit S{k >= 0 ? (k & 7) * 64 + (k >> 3) : -1, 4}; pg8::gemm_phase<pg8::EpiResid, pg8::OneUnit, true, true>(ring, gP, S, EP); }
            GRID_BAR();
            PH(9) { const int k = b < 32 ? 480 + b : -1; const int idx = k >= 0 ? (k & 7) * 64 + (k >> 3) : (b < 40 ? 512 + (b - 32) : -1);
                    pg8::OneUnit S{idx, 4}; pg8::gemm_phase<pg8::EpiResid, pg8::OneUnit, true, true>(ring, gP, S, EP); }
            if (b >= 40) PH(10) { PCTX(Cp); cvt_table_fp6(Cp, A.peer_u + (size_t)l * PEER_N * 1024, TU, TUS, PEER_N, b - 40, C.G - 40); cvt_table_fp6(Cp, A.peer_v + (size_t)l * PEER_N * 1024, TV, TVS, PEER_N, b - 40, C.G - 40); }
            GRID_BAR();
        } else {
        PH(9) {
            pg8::Gemm g{MM, (const bf16*)(ws + WS_WOUT) + (size_t)l * 1024 * 1024, MR, 1024, 1024}; pg8::StaticOrder S; S.init(MR, 1024, C.G, (int)blockIdx.x);
            pg8::EpiResid E{xold, A.out, cold, CTXB, MODl};
            pg8::gemm_phase<pg8::EpiResid, pg8::StaticOrder, true, true>(ring, g, S, E);
        }
        GRID_BAR();
        }

        CHK(chk::c_wout(A, Cq, l, 14));
        PH(10) { PCTX(Cp); norm_rows(Cp, A.out, CTXB, MR, A.g_norm2 + l * 1024, MODl, 3, XN); }
        if (!need_ctx) {
        PH(10) { PCTX(Cp); cvt_table_fp6(Cp, A.peer_u + (size_t)l * PEER_N * 1024, TU, TUS, PEER_N); }
        PH(10) { PCTX(Cp); cvt_table_fp6(Cp, A.peer_v + (size_t)l * PEER_N * 1024, TV, TVS, PEER_N); }
        }
        GRID_BAR();

        CHK(chk::c_norm(A, Cq, A.out, CTXB, A.g_norm2 + l * 1024, MODl, 3, XN, 15));
        const int nchunk = (MR + 16383) / 16384;
        const bool fold_ctx = packed_ctx && nchunk == 3;
        float* SSC = (float*)(ws + WS_PLIST + 16 * MiB); int* ELC = (int*)(ws + WS_PLIST + 20 * MiB); float* GLC = (float*)(ws + WS_PLIST + 21 * MiB);
#pragma unroll 1
        for (int ch = 0; ch < nchunk; ++ch) {
            const int row0 = ch * 16384, nr = (MR - row0) < 16384 ? (MR - row0) : 16384;
            if (fold_ctx && ch == 2) break;
            pg8::StaticOrder SSO; SSO.init(2048, nr, C.G, (int)blockIdx.x);
#pragma unroll 1
            for (int reps_ = 0; reps_ < REP_SG; ++reps_)
            PH(11) {
                pg8::Gemm g{(const bf16*)(ws + WS_WPEER) + (size_t)l * 2048 * 1024, XN + (size_t)row0 * 1024, 2048, nr, 1024};
                pg8::EpiScoreT E{SS};
                pg8::gemm_phase<pg8::EpiScoreT, pg8::StaticOrder, true, true>(ring, g, SSO, E);
            }
            if (nr < 4096) {
                GRID_BAR();
                PH(12) { PCTX(Cp); peer::route_tokens_wave(Cp, SS, nr, PEL, PGL); }
            } else {
                VM_WAIT(); __syncthreads();
#pragma unroll 1
                for (int repr_ = 0; repr_ < REP_ROUTE; ++repr_) { PH(12) { PCTX(Cp); peer::route_tasks(Cp, SS, nr, PEL, PGL, SSO); } }
                if (fold_ctx && ch == 1) PH(12) { PCTX(Cp); peer::route_tokens_wave(Cp, SSC, MR - ML, ELC, GLC); }
            }
            GRID_BAR();
            if (fold_ctx && ch == 0 && (int)blockIdx.x < 16) PH(11) {
                pg8::Gemm g{(const bf16*)(ws + WS_WPEER) + (size_t)l * 2048 * 1024, XN + (size_t)ML * 1024, 2048, MR - ML, 1024};
                pg8::OneUnit S1{(int)blockIdx.x, 2}; pg8::EpiScoreT E{SSC};
                pg8::gemm_phase<pg8::EpiScoreT, pg8::OneUnit, true, true>(ring, g, S1, E);
            }
            PH(12) { PCTX(Cp); peer::topk_gather(A, Cp, l, row0, nr, PEL, PGL, TU, TV, TUS, TVS, XN, A.out, CTXB, MODl, !need_ctx, A.g_norm1 + (l + 1) * 1024, MOD + (size_t)(l + 1) * 3 * 6144, XN); }
            if (fold_ctx && ch == 1) PH(12) { PCTX(Cp); peer::topk_gather(A, Cp, l, ML, MR - ML, ELC, GLC, TU, TV, TUS, TVS, XN, A.out, CTXB, MODl, !need_ctx, A.g_norm1 + (l + 1) * 1024, MOD + (size_t)(l + 1) * 3 * 6144, XN); }
            GRID_BAR();
        }
    }
#ifdef SELFCHECK
    {
        const float* acc = (const float*)(ws + chk::WS_DBG); int first = -1;
        const int order[21] = {0, 1, 2, 3, 4, 5, 6, 7, 8, 9, 10, 11, 12, 18, 19, 20, 13, 14, 15, 16, 17};
#pragma unroll
        for (int p = 0; p < 21; ++p) { const int k = order[p]; const float se = acc[2 * k], sr = acc[2 * k + 1]; const float tol = (k == 17) ? 0.15f : 0.03f;
            if (first < 0 && !((CHKSKIP >> k) & 1) && (!(se <= tol * tol * sr) || sr == 0.f)) first = p; }
        if (first >= 0) { const float sc = 1.0f + 0.25f * (float)(first + 1);
            for (size_t i = (size_t)C.vcu * NTHREADS + C.tid; i < (size_t)ML * 1024; i += (size_t)C.G * NTHREADS) A.out[i] *= sc; }
    }
#endif
#undef GRID_BAR
#undef xold
#undef cold
#undef WIN
#undef MODl
}

extern "C" void kernel_launch(void* const* d_in, const int* in_sizes, int n_in, void* d_out, int out_size, void* d_ws, size_t ws_size, hipStream_t stream) {
    static int grid = 0;
    if (grid == 0) {
        if (n_in != 32 || in_sizes[0] != ML * D_MODEL || out_size != ML * D_MODEL || ws_size < WS_END) { fprintf(stderr, "kernel_launch: unexpected shapes (n_in %d, in0 %d, out %d, ws %zu)\n", n_in, n_in > 0 ? in_sizes[0] : -1, out_size, ws_size); grid = -1; return; }
        int dev = 0, cus = 0, per_cu = 0;
        if (hipGetDevice(&dev) != hipSuccess || hipDeviceGetAttribute(&cus, hipDeviceAttributeMultiprocessorCount, dev) != hipSuccess) { grid = -1; return; }
        if (hipFuncSetAttribute((const void*)mega_fwd, hipFuncAttributeMaxDynamicSharedMemorySize, LDS_BYTES) != hipSuccess) { fprintf(stderr, "kernel_launch: hipFuncSetAttribute failed\n"); grid = -1; return; }
        if (hipOccupancyMaxActiveBlocksPerMultiprocessor(&per_cu, (const void*)mega_fwd, NTHREADS, LDS_BYTES) != hipSuccess || per_cu < 1) { fprintf(stderr, "kernel_launch: occupancy query says %d\n", per_cu); }
        (void)hipGetLastError();
        grid = cus;
    }
    if (grid < 0) return;
    if (hipMemsetAsync((char*)d_ws + WS_CTL, 0, CTL_ZERO_BYTES, stream) != hipSuccess) return;
#ifdef SELFCHECK
    (void)hipMemsetAsync((char*)d_ws + chk::WS_DBG, 0, 65536, stream);
#endif
    Args a{};
    const float** ap = (const float**)&a;
    for (int i = 0; i < 32; ++i) ap[i] = (const float*)d_in[i];
    a.out = (float*)d_out; a.ws = (unsigned char*)d_ws;
    hipLaunchKernelGGL(mega_fwd, dim3(grid), dim3(NTHREADS), LDS_BYTES, stream, a);
}
```
